# Optimizing an MI355X kernel written in HIP

```python
import math
import jax, jax.numpy as jnp
from jax import lax
import numpy as np

D_MODEL = 1024
BATCH = 16
SEQ = 2048
DEPTH = 4

N_A_LAYERS = DEPTH // 2
N_B_LAYERS = DEPTH - N_A_LAYERS
RWKV_HEAD_DIM = 64
RWKV_HEADS = D_MODEL // RWKV_HEAD_DIM
DECAY_LORA = 64
ICLR_LORA = 64
VRES_LORA = 32
GATE_LORA = 160
RWKV_GN_EPS = 64e-5
L2_EPS = 1e-12
DA_HEAD_DIM = 64
DA_HEADS = D_MODEL // (2 * DA_HEAD_DIM)
DA_QK_WIDTH = DA_HEADS * 2 * DA_HEAD_DIM
DA_V_WIDTH = DA_HEADS * 2 * DA_HEAD_DIM
BLOCK_Q = 128
SUBLN_EPS = 1e-5
N_EXPERTS = 32
TOP_K = 4
EXPERT_FF = D_MODEL
SWIGLU_LIMIT = 7.0
SWIGLU_ALPHA = 1.702
EXPERT_BLOCK = 512
DEEPNORM_ALPHA = (2 * DEPTH) ** 0.25
DEEPNORM_BETA = (8 * DEPTH) ** -0.25
LN_EPS = 1e-5

kernel_name = "yoco_rwkv7_diffattn_moe_deepnorm"

F32 = jnp.float32


def layer_norm(x, g, b):
    xf = x.astype(F32)
    mu = jnp.mean(xf, axis=-1, keepdims=True)
    var = jnp.mean(jnp.square(xf - mu), axis=-1, keepdims=True)
    return ((xf - mu) * lax.rsqrt(var + LN_EPS) * g + b).astype(x.dtype)


def wkv7_scan(r, w, k, v, a, b):
    B_, S_, H, N = r.shape

    def step(state, inp):
        r_t, w_t, k_t, v_t, a_t, b_t = inp
        sa = jnp.einsum('bhvk,bhk->bhv', state, a_t)
        state = (state * w_t[:, :, None, :] + sa[..., None] * b_t[:, :, None, :]
                 + v_t[..., None] * k_t[:, :, None, :])
        y_t = jnp.einsum('bhvk,bhk->bhv', state, r_t)
        return state, y_t

    xs = tuple(jnp.moveaxis(t, 1, 0) for t in (r, w, k, v, a, b))
    state0 = jnp.zeros((B_, H, N, N), F32)
    _, y = lax.scan(step, state0, xs)
    return jnp.moveaxis(y, 0, 1)


def rwkv7_time_mix(x, v_first, mix, w_rkv, w_o, w0, w1, w2, a0, a1, a2, g1, g2,
                   k_k, k_a, r_k, lnx_g, lnx_b, v0=None, v1=None, v2=None):
    B_, S_, D_ = x.shape
    H, N = RWKV_HEADS, RWKV_HEAD_DIM
    xx = jnp.pad(x, ((0, 0), (1, 0), (0, 0)))[:, :-1] - x
    xm = x[:, :, None, :] + xx[:, :, None, :] * mix
    rkv = jnp.einsum('bsjd,jde->bsje', xm[:, :, :3], w_rkv)
    r, k, v = rkv[:, :, 0], rkv[:, :, 1], rkv[:, :, 2]
    xv, xw, xa, xg = xm[:, :, 2], xm[:, :, 3], xm[:, :, 4], xm[:, :, 5]
    w_log = -jax.nn.softplus(-(w0 + jnp.tanh(xw @ w1) @ w2)) - 0.5
    decay = jnp.exp(-jnp.exp(w_log.astype(F32)))
    if v0 is None:
        v_first = v
    else:
        v = v + (v_first - v) * jax.nn.sigmoid(v0 + (xv @ v1) @ v2)
    a = jax.nn.sigmoid(a0 + (xa @ a1) @ a2)
    g = jax.nn.sigmoid(xg @ g1) @ g2

    def heads(t):
        return t.astype(F32).reshape(B_, S_, H, N)

    r_h, k_h, v_h, a_h, w_h = heads(r), heads(k), heads(v), heads(a), heads(decay)
    kk = k_h * k_k.astype(F32).reshape(H, N)
    kk = kk / jnp.maximum(jnp.sqrt(jnp.sum(kk * kk, axis=-1, keepdims=True)), L2_EPS)
    k_h = k_h * (1.0 + (a_h - 1.0) * k_a.astype(F32).reshape(H, N))
    y = wkv7_scan(r_h, w_h, k_h, v_h, -kk, kk * a_h)
    mu = jnp.mean(y, axis=-1, keepdims=True)
    var = jnp.mean(jnp.square(y - mu), axis=-1, keepdims=True)
    y = ((y - mu) * lax.rsqrt(var + RWKV_GN_EPS)).reshape(B_, S_, D_) * lnx_g + lnx_b
    bonus = jnp.sum(r_h * k_h * r_k.astype(F32), axis=-1, keepdims=True) * v_h
    y = y + bonus.reshape(B_, S_, D_)
    out = (y * g).astype(x.dtype) @ w_o
    return out, v_first


def shared_kv(x, kv_w):
    B_, S_, _ = x.shape
    kv = x @ kv_w
    k = kv[..., :DA_QK_WIDTH].reshape(B_, S_, DA_HEADS, 2, DA_HEAD_DIM).transpose(0, 2, 3, 1, 4)
    v = kv[..., DA_QK_WIDTH:].reshape(B_, S_, DA_HEADS, 2 * DA_HEAD_DIM).transpose(0, 2, 1, 3)
    return k, v


def alibi_slopes(n_heads):
    return 2.0 ** (-8.0 * jnp.arange(1, n_heads + 1, dtype=F32) / n_heads)


def diff_attention(x, k_sh, v_sh, w_q, w_o, lam, subln_g, lambda_init):
    B_, S_, _ = x.shape
    scale = DA_HEAD_DIM ** -0.5
    q = (x @ w_q).reshape(B_, S_, DA_HEADS, 2, DA_HEAD_DIM).transpose(0, 2, 3, 1, 4)
    lam_f = lam.astype(F32)
    lam_full = (jnp.exp(jnp.sum(lam_f[0] * lam_f[1])) - jnp.exp(jnp.sum(lam_f[2] * lam_f[3]))
                + lambda_init)
    slopes = alibi_slopes(DA_HEADS)
    outs = []
    for i in range(S_ // BLOCK_Q):
        q0, q1 = i * BLOCK_Q, (i + 1) * BLOCK_Q
        qb = q[:, :, :, q0:q1]
        kb = k_sh[:, :, :, :q1]
        vb = v_sh[:, :, :q1]
        s = jnp.einsum('bhcqd,bhckd->bhcqk', qb, kb).astype(F32) * scale
        dist = (q0 + jnp.arange(BLOCK_Q))[:, None] - jnp.arange(q1)[None, :]
        bias = jnp.where(dist >= 0, -slopes[:, None, None] * dist.astype(F32), -jnp.inf)
        p = jax.nn.softmax(s + bias[None, :, None], axis=-1)
        attn = p[:, :, 0] - lam_full * p[:, :, 1]
        outs.append(jnp.einsum('bhqk,bhkd->bhqd', attn.astype(vb.dtype), vb))
    o = jnp.concatenate(outs, axis=2).astype(F32)
    o = o * lax.rsqrt(jnp.mean(o * o, axis=-1, keepdims=True) + SUBLN_EPS) * subln_g
    o = o * (1.0 - lambda_init)
    o = o.transpose(0, 2, 1, 3).reshape(B_, S_, DA_V_WIDTH).astype(x.dtype)
    return o @ w_o


def clamped_swiglu(h):
    gate, up = h[..., :EXPERT_FF], h[..., EXPERT_FF:]
    gate = jnp.minimum(gate, SWIGLU_LIMIT)
    up = jnp.clip(up, -SWIGLU_LIMIT, SWIGLU_LIMIT)
    return (up + 1.0) * (gate * jax.nn.sigmoid(SWIGLU_ALPHA * gate))


def moe_ffn(x, router_w, router_b, w_gu, b_gu, w_dn, b_dn):
    B_, S_, D_ = x.shape
    T = B_ * S_
    TK = T * TOP_K
    xt = x.reshape(T, D_)
    logits = (xt @ router_w + router_b).astype(F32)
    top_logit, top_idx = lax.top_k(logits, TOP_K)
    gate = jax.nn.softmax(top_logit, axis=-1)
    flat_e = top_idx.reshape(TK)
    flat_tok = jnp.arange(TK, dtype=jnp.int32) // TOP_K
    flat_gate = gate.reshape(TK)
    order = jnp.argsort(flat_e)
    e_sorted = flat_e[order]
    counts = jnp.bincount(flat_e, length=N_EXPERTS)
    padded = (counts + EXPERT_BLOCK - 1) // EXPERT_BLOCK * EXPERT_BLOCK
    pad_end = jnp.cumsum(padded)
    pad_start = pad_end - padded
    grp_start = jnp.cumsum(counts) - counts
    dest = pad_start[e_sorted] + jnp.arange(TK, dtype=jnp.int32) - grp_start[e_sorted]
    n_blocks = -(-TK // EXPERT_BLOCK) + N_EXPERTS
    P = n_blocks * EXPERT_BLOCK
    row_tok = jnp.full((P,), T, jnp.int32).at[dest].set(flat_tok[order])
    row_gate = jnp.zeros((P,), F32).at[dest].set(flat_gate[order])
    block_start = jnp.arange(n_blocks, dtype=jnp.int32) * EXPERT_BLOCK
    block_exp = jnp.minimum(jnp.searchsorted(pad_end, block_start, side='right'), N_EXPERTS - 1)
    x_pad = jnp.concatenate([xt, jnp.zeros((1, D_), xt.dtype)], axis=0)

    def expert_block(args):
        toks, e = args
        h = x_pad[toks] @ w_gu[e] + b_gu[e]
        return clamped_swiglu(h) @ w_dn[e] + b_dn[e]

    y_rows = lax.map(expert_block, (row_tok.reshape(n_blocks, EXPERT_BLOCK), block_exp))
    y_rows = y_rows.reshape(P, D_).astype(F32) * row_gate[:, None]
    out = jnp.zeros((T + 1, D_), F32).at[row_tok].add(y_rows)[:T]
    return out.reshape(B_, S_, D_).astype(x.dtype)


def setup_inputs(seed: int = 0) -> dict:
    key = jax.random.key(seed)
    ks = iter(jax.random.split(key, 48))

    def nrm(shape, scale):
        return jax.random.normal(next(ks), shape, F32) * scale

    D, NA, NB, E, FF = D_MODEL, N_A_LAYERS, N_B_LAYERS, N_EXPERTS, EXPERT_FF
    H, N = RWKV_HEADS, RWKV_HEAD_DIM
    x = nrm((BATCH, SEQ, D), 1.0)
    ln_g = 1.0 + nrm((DEPTH, 2, D), 0.05)
    ln_b = nrm((DEPTH, 2, D), 0.02)
    rwkv_mix = jax.random.uniform(next(ks), (NA, 6, D), F32)
    rkv_scale = jnp.array([1.0, 1.0, DEEPNORM_BETA], F32)[None, :, None, None] * D ** -0.5
    rwkv_w_rkv = nrm((NA, 3, D, D), 1.0) * rkv_scale
    rwkv_w_o = nrm((NA, D, D), D ** -0.5 * DEEPNORM_BETA)
    rwkv_w0 = jnp.linspace(-6.0, -1.0, D, dtype=F32)[None, :] + nrm((NA, D), 0.1)
    rwkv_w1 = nrm((NA, D, DECAY_LORA), D ** -0.5)
    rwkv_w2 = nrm((NA, DECAY_LORA, D), 0.1 * DECAY_LORA ** -0.5)
    rwkv_a0 = nrm((NA, D), 0.1)
    rwkv_a1 = nrm((NA, D, ICLR_LORA), D ** -0.5)
    rwkv_a2 = nrm((NA, ICLR_LORA, D), 0.5 * ICLR_LORA ** -0.5)
    rwkv_g1 = nrm((NA, D, GATE_LORA), D ** -0.5)
    rwkv_g2 = nrm((NA, GATE_LORA, D), GATE_LORA ** -0.5)
    rwkv_k_k = 0.85 + nrm((NA, D), 0.05)
    rwkv_k_a = 1.0 + nrm((NA, D), 0.05)
    rwkv_r_k = nrm((NA, H, N), 0.1)
    rwkv_lnx_g = 1.0 + nrm((NA, D), 0.05)
    rwkv_lnx_b = nrm((NA, D), 0.02)
    rwkv_v0 = 1.0 + nrm((NA - 1, D), 0.1)
    rwkv_v1 = nrm((NA - 1, D, VRES_LORA), D ** -0.5)
    rwkv_v2 = nrm((NA - 1, VRES_LORA, D), 0.5 * VRES_LORA ** -0.5)
    kv_scale = jnp.concatenate([jnp.ones((DA_QK_WIDTH,), F32),
                                jnp.full((DA_V_WIDTH,), DEEPNORM_BETA, F32)]) * D ** -0.5
    kv_w = nrm((D, DA_QK_WIDTH + DA_V_WIDTH), 1.0) * kv_scale
    da_w_q = nrm((NB, D, DA_QK_WIDTH), D ** -0.5)
    da_w_o = nrm((NB, DA_V_WIDTH, D), DA_V_WIDTH ** -0.5 * DEEPNORM_BETA)
    da_lambda = nrm((NB, 4, DA_HEAD_DIM), 0.1)
    da_subln_g = 1.0 + nrm((NB, 2 * DA_HEAD_DIM), 0.05)
    moe_router_w = nrm((DEPTH, D, E), D ** -0.5)
    moe_router_b = nrm((DEPTH, E), 0.01)
    moe_w_gu = nrm((DEPTH, E, D, 2 * FF), D ** -0.5)
    moe_b_gu = nrm((DEPTH, E, 2 * FF), 0.02)
    moe_w_dn = nrm((DEPTH, E, FF, D), FF ** -0.5 * DEEPNORM_BETA)
    moe_b_dn = nrm((DEPTH, E, D), 0.02)
    return {"x": x, "ln_g": ln_g, "ln_b": ln_b,
            "rwkv_mix": rwkv_mix, "rwkv_w_rkv": rwkv_w_rkv, "rwkv_w_o": rwkv_w_o,
            "rwkv_w0": rwkv_w0, "rwkv_w1": rwkv_w1, "rwkv_w2": rwkv_w2,
            "rwkv_a0": rwkv_a0, "rwkv_a1": rwkv_a1, "rwkv_a2": rwkv_a2,
            "rwkv_g1": rwkv_g1, "rwkv_g2": rwkv_g2, "rwkv_k_k": rwkv_k_k, "rwkv_k_a": rwkv_k_a,
            "rwkv_r_k": rwkv_r_k, "rwkv_lnx_g": rwkv_lnx_g, "rwkv_lnx_b": rwkv_lnx_b,
            "rwkv_v0": rwkv_v0, "rwkv_v1": rwkv_v1, "rwkv_v2": rwkv_v2,
            "kv_w": kv_w, "da_w_q": da_w_q, "da_w_o": da_w_o, "da_lambda": da_lambda,
            "da_subln_g": da_subln_g,
            "moe_router_w": moe_router_w, "moe_router_b": moe_router_b,
            "moe_w_gu": moe_w_gu, "moe_b_gu": moe_b_gu, "moe_w_dn": moe_w_dn, "moe_b_dn": moe_b_dn}


def reference(x, ln_g, ln_b, rwkv_mix, rwkv_w_rkv, rwkv_w_o, rwkv_w0, rwkv_w1, rwkv_w2,
              rwkv_a0, rwkv_a1, rwkv_a2, rwkv_g1, rwkv_g2, rwkv_k_k, rwkv_k_a, rwkv_r_k,
              rwkv_lnx_g, rwkv_lnx_b, rwkv_v0, rwkv_v1, rwkv_v2, kv_w, da_w_q, da_w_o,
              da_lambda, da_subln_g, moe_router_w, moe_router_b, moe_w_gu, moe_b_gu,
              moe_w_dn, moe_b_dn):
    v_first = None
    k_sh = v_sh = None
    for l in range(DEPTH):
        if l < N_A_LAYERS:
            vres = (None, None, None) if l == 0 else (rwkv_v0[l - 1], rwkv_v1[l - 1], rwkv_v2[l - 1])
            mix_out, v_first = rwkv7_time_mix(
                x, v_first, rwkv_mix[l], rwkv_w_rkv[l], rwkv_w_o[l], rwkv_w0[l], rwkv_w1[l],
                rwkv_w2[l], rwkv_a0[l], rwkv_a1[l], rwkv_a2[l], rwkv_g1[l], rwkv_g2[l],
                rwkv_k_k[l], rwkv_k_a[l], rwkv_r_k[l], rwkv_lnx_g[l], rwkv_lnx_b[l], *vres)
        else:
            if l == N_A_LAYERS:
                k_sh, v_sh = shared_kv(x, kv_w)
            j = l - N_A_LAYERS
            lambda_init = 0.8 - 0.6 * math.exp(-0.3 * l)
            mix_out = diff_attention(x, k_sh, v_sh, da_w_q[j], da_w_o[j], da_lambda[j],
                                     da_subln_g[j], lambda_init)
        x = layer_norm(DEEPNORM_ALPHA * x + mix_out, ln_g[l, 0], ln_b[l, 0])
        ffn_out = moe_ffn(x, moe_router_w[l], moe_router_b[l], moe_w_gu[l], moe_b_gu[l],
                          moe_w_dn[l], moe_b_dn[l])
        x = layer_norm(DEEPNORM_ALPHA * x + ffn_out, ln_g[l, 1], ln_b[l, 1])
    return x
```

```cpp
#include <hip/hip_runtime.h>
#include <cstdio>
#include <cstdint>
#include <cmath>

#define LAS __attribute__((address_space(3)))
#define GAS __attribute__((address_space(1)))
typedef _Float16 h16;
typedef _Float16 h16x8 __attribute__((ext_vector_type(8)));
typedef _Float16 h16x4 __attribute__((ext_vector_type(4)));
typedef _Float16 h16x2 __attribute__((ext_vector_type(2)));
typedef float f32x4 __attribute__((ext_vector_type(4)));
typedef float f32x2 __attribute__((ext_vector_type(2)));
typedef unsigned u32x4 __attribute__((ext_vector_type(4)));
typedef unsigned u32x2 __attribute__((ext_vector_type(2)));

constexpr int D = 1024, NBATCH = 16, SEQ = 2048, T = NBATCH * SEQ;
constexpr int NEXP = 32, TOPK = 4, ECAP = T;
constexpr int NWAVES = 8, NTHR = NWAVES * 64;
constexpr float ALPHA = 1.6817928305074290f;
constexpr float LN_EPS = 1e-5f;
constexpr float QSCALE = 0.125f * 1.4426950408889634f;
constexpr float LOG2E = 1.4426950408889634f;
constexpr float GU_SCALE = 64.0f, DN_SCALE = 128.0f, YS_SCALE = 16.0f;

constexpr size_t MiB = 1u << 20;
constexpr size_t WS_CTL = 0, CTL_ZERO_BYTES = 1 * MiB;
constexpr size_t WS_W_RKV = 2 * MiB;
constexpr size_t WS_W_RO = 14 * MiB;
constexpr size_t WS_W_L1 = 18 * MiB;
constexpr size_t WS_W_L2 = 22 * MiB;
constexpr size_t WS_W_KV = 26 * MiB;
constexpr size_t WS_W_Q = 30 * MiB;
constexpr size_t WS_W_AO = 34 * MiB;
constexpr size_t WS_WR = 38 * MiB;
constexpr size_t WS_W_GU = 40 * MiB;
constexpr size_t WS_W_DN = 552 * MiB;
constexpr size_t WS_X = 808 * MiB;
constexpr size_t WS_X1 = 936 * MiB;
constexpr size_t WS_H = 1064 * MiB;
constexpr size_t WS_XB = 1192 * MiB;
constexpr size_t WS_XH = 1256 * MiB;
constexpr size_t WS_TOPG = 1320 * MiB;
constexpr size_t WS_LIST = 1321 * MiB;
constexpr size_t WS_ACT = 1328 * MiB;
constexpr size_t WS_YS = 1616 * MiB;
constexpr size_t WS_XM = 1872 * MiB;
constexpr size_t WS_R = 2256 * MiB, WS_K = 2384 * MiB, WS_V = 2512 * MiB, WS_VF = 2640 * MiB;
constexpr size_t WS_L1O = 2768 * MiB;
constexpr size_t WS_WD = 2832 * MiB, WS_AA = 2960 * MiB, WS_GG = 3088 * MiB;
constexpr size_t WS_YG = 3216 * MiB;
constexpr size_t WS_END = 3280 * MiB;
constexpr size_t WS_Q = 1872 * MiB, WS_KK = 1936 * MiB, WS_VV = 2000 * MiB;
constexpr size_t WS_ORAW = 2064 * MiB;
constexpr size_t WS_OB = 2192 * MiB;
constexpr int CW_BAR = 4096;
constexpr int CW_CNT = 16384;

constexpr int LDS_BYTES = 147456;
constexpr int MISC_OFF = 146432;
constexpr int TILE_E_OFF = 143360;

template <int CTRL> __device__ __forceinline__ float dppf(float v) { return __builtin_bit_cast(float, __builtin_amdgcn_mov_dpp(__builtin_bit_cast(int, v), CTRL, 0xF, 0xF, true)); }
__device__ __forceinline__ float swz16f(float v) { return __builtin_bit_cast(float, __builtin_amdgcn_ds_swizzle(__builtin_bit_cast(int, v), (16 << 10) | 0x1F)); }
__device__ __forceinline__ float grp8_sum(float v) { v += dppf<0xB1>(v); v += dppf<0x4E>(v); v += dppf<0x141>(v); return v; }
__device__ __forceinline__ float wave_sum(float v) {
    v += dppf<0xB1>(v); v += dppf<0x4E>(v); v += dppf<0x141>(v); v += dppf<0x140>(v); v += swz16f(v);
    return __builtin_bit_cast(float, __builtin_amdgcn_readlane(__builtin_bit_cast(int, v), 0)) + __builtin_bit_cast(float, __builtin_amdgcn_readlane(__builtin_bit_cast(int, v), 32));
}
__device__ __forceinline__ float wave_max(float v) {
    v = fmaxf(v, dppf<0xB1>(v)); v = fmaxf(v, dppf<0x4E>(v)); v = fmaxf(v, dppf<0x141>(v)); v = fmaxf(v, dppf<0x140>(v)); v = fmaxf(v, swz16f(v));
    return fmaxf(__builtin_bit_cast(float, __builtin_amdgcn_readlane(__builtin_bit_cast(int, v), 0)), __builtin_bit_cast(float, __builtin_amdgcn_readlane(__builtin_bit_cast(int, v), 32)));
}
__device__ __forceinline__ unsigned pkh(float a, float b) { h16x2 v = {(h16)a, (h16)b}; return __builtin_bit_cast(unsigned, v); }
__device__ __forceinline__ u32x2 pkh4(f32x4 v) { u32x2 r; r.x = pkh(v.x, v.y); r.y = pkh(v.z, v.w); return r; }
__device__ __forceinline__ f32x4 ldh4(const h16* p) { const h16x4 v = *(const h16x4*)p; return __builtin_convertvector(v, f32x4); }
__device__ __forceinline__ float sigmoidf_(float x) { return __builtin_amdgcn_rcpf(1.0f + __builtin_amdgcn_exp2f(-1.4426950408889634f * x)); }
__device__ __forceinline__ int lane_id() { int l; asm volatile("v_mbcnt_lo_u32_b32 %0, -1, 0\n\tv_mbcnt_hi_u32_b32 %0, -1, %0" : "=v"(l)); return l; }
#define LDS_WAIT() asm volatile("s_waitcnt lgkmcnt(0)" ::: "memory")
#define OPAQUE(x) asm volatile("" : "+v"(x))

#define XB_TMO      128
#define XB_XCNT(j)  (256  + 64 * (j))
#define XB_XSUB(j)  (1280 + 64 * (j))
#define XB_XGEN(j)  (2304 + 64 * (j))
#define XB_TOP      3328
#define XB_TOPGEN   3392
#define XCD_BAR_WORDS 3456
#define XB_SPIN_CAP (1u << 21)

__device__ __forceinline__ unsigned xb_ld(unsigned* p)              { return __hip_atomic_load((GAS unsigned*)p, __ATOMIC_RELAXED, __HIP_MEMORY_SCOPE_AGENT); }
__device__ __forceinline__ unsigned xb_add(unsigned* p, unsigned v) { return __hip_atomic_fetch_add((GAS unsigned*)p, v, __ATOMIC_RELAXED, __HIP_MEMORY_SCOPE_AGENT); }
__device__ __forceinline__ unsigned xb_xcc_id() { return (unsigned)__builtin_amdgcn_s_getreg((3 << 11) | 20) & 0xFu; }
#define XB_SPIN(cond, bar) do { unsigned _sp = 0; while (cond) { __builtin_amdgcn_s_sleep(1); \
    if ((++_sp & 255u) == 0u) { if (xb_ld(&(bar)[XB_TMO])) break; if (_sp > XB_SPIN_CAP) { (void)xb_add(&(bar)[XB_TMO], 1u); break; } } } } while (0)

struct XcdBarrier { unsigned* bar; unsigned x; volatile LAS unsigned* st; };

__device__ __forceinline__ XcdBarrier xcd_barrier_post(unsigned* bar, volatile LAS unsigned* st, const int wave) {
    XcdBarrier b; b.bar = bar; b.x = xb_xcc_id(); b.st = st;
    if (wave == 0 && lane_id() == 0) (void)xb_add(&bar[XB_XCNT(b.x)], 1u);
    return b;
}
__device__ __forceinline__ void xcd_barrier_complete(unsigned* bar, unsigned x, unsigned& nloc, unsigned& nx) {
    const unsigned G = gridDim.x * gridDim.y * gridDim.z;
    unsigned sum, cnt, mine, sp = 0u;
    for (;;) {
        sum = 0u; cnt = 0u; mine = 0u;
#pragma unroll
        for (unsigned j = 0; j < 16; ++j) { const unsigned c = xb_ld(&bar[XB_XCNT(j)]); sum += c; cnt += (c > 0u) ? 1u : 0u; mine = (j == x) ? c : mine; }
        if (sum == G) break;
        __builtin_amdgcn_s_sleep(1);
        if ((++sp & 255u) == 0u) { if (xb_ld(&bar[XB_TMO])) break; if (sp > XB_SPIN_CAP) { (void)xb_add(&bar[XB_TMO], 1u); break; } }
    }
    nloc = mine > 0u ? mine : 1u; nx = cnt > 0u ? cnt : 1u;
}
__device__ __forceinline__ void xcd_barrier(const XcdBarrier& b, const int wave) {
    asm volatile("s_waitcnt vmcnt(0)" ::: "memory");
    __syncthreads();
    if (wave == 0 && lane_id() == 0) {
        unsigned* bar = b.bar; unsigned bx = b.x;
        asm volatile("" : "+s"(bar), "+s"(bx));
        __builtin_amdgcn_s_waitcnt(0);
        unsigned nloc = b.st[0], nx = b.st[1];
        if (nloc == 0u) { xcd_barrier_complete(bar, bx, nloc, nx); b.st[0] = nloc; b.st[1] = nx; }
        const unsigned old = xb_add(&bar[XB_XSUB(bx)], 1u);
        const unsigned gen = old / nloc;
        if (old + 1u == (gen + 1u) * nloc) {
            __builtin_amdgcn_fence(__ATOMIC_RELEASE, "agent");
            asm volatile("s_waitcnt vmcnt(0)" ::: "memory");
            const unsigned og = xb_add(&bar[XB_TOP], 1u);
            const unsigned tg = og / nx;
            if (og + 1u == (tg + 1u) * nx) xb_add(&bar[XB_TOPGEN], 1u);
            else XB_SPIN(xb_ld(&bar[XB_TOPGEN]) == tg, bar);
            __builtin_amdgcn_fence(__ATOMIC_ACQUIRE, "agent");
            xb_add(&bar[XB_XGEN(bx)], 1u);
            asm volatile("s_waitcnt vmcnt(0)" ::: "memory");
        } else {
            XB_SPIN(xb_ld(&bar[XB_XGEN(bx)]) == gen, bar);
            __builtin_amdgcn_fence(__ATOMIC_ACQUIRE, "agent");
            asm volatile("s_waitcnt vmcnt(0)" ::: "memory");
        }
    }
    __syncthreads();
}

__device__ __forceinline__ void conv_batch(const float* src, int batch, int Kr, int Nr, h16* dst, int Kp, int Np, int perm, LAS float* scr, int gw, int NGW, int lane) {
    lane = lane_id(); OPAQUE(lane);
    const int kbn = Kp / 64, nbn = Np / 32, per = kbn * nbn, total = batch * per;
    for (int it = gw; it < total; it += NGW) {
        const int bi = it / per, r = it - bi * per, kb = r / nbn, nb = r - kb * nbn, k0 = 64 * kb, n0 = 32 * nb;
        const float* W = src + (size_t)bi * Kr * Nr; h16* WT = dst + (size_t)bi * Np * Kp;
        float vals[32];
#pragma unroll
        for (int i = 0; i < 32; ++i) { const int k = k0 + 2 * i + (lane >> 5), n = n0 + (lane & 31); vals[i] = (k < Kr && n < Nr) ? W[(size_t)k * Nr + n] : 0.f; }
#pragma unroll
        for (int i = 0; i < 32; ++i) { float x = vals[i]; if (perm == 2) x = (x - (float)(h16)x) * 4096.0f; scr[(2 * i + (lane >> 5)) * 33 + (lane & 31)] = x; }
        LDS_WAIT();
        const int c = lane & 7;
#pragma unroll
        for (int j = 0; j < 4; ++j) { const int nl = (lane >> 3) + 8 * j; const LAS float* s = scr + (8 * c) * 33 + nl;
            u32x4 o; o.x = pkh(s[0 * 33], s[1 * 33]); o.y = pkh(s[2 * 33], s[3 * 33]); o.z = pkh(s[4 * 33], s[5 * 33]); o.w = pkh(s[6 * 33], s[7 * 33]);
            int n = n0 + nl; if (perm == 1) n = ((n & 1023) >> 7) * 256 + (n >> 10) * 128 + (n & 127);
            *(u32x4*)(WT + (size_t)n * Kp + k0 + 8 * c) = o; }
        LDS_WAIT();
    }
}


__device__ __forceinline__ void conv_batch8(const float* src, int batch, int Kr, int Nr, unsigned char* dst, int Kp, int Np, int perm, float scale, LAS float* scr, int gw_, int NGW_, int lane) {
    lane = lane_id(); OPAQUE(lane);
    const int kbn = Kp / 128, nbn = Np / 32, per = kbn * nbn, total = batch * per;
    for (int it = gw_; it < total; it += NGW_) {
        const int bi = it / per, r = it - bi * per, kb = r / nbn, nb = r - kb * nbn, k0 = 128 * kb, n0 = 32 * nb;
        const float* W = src + (size_t)bi * Kr * Nr; unsigned char* WT = dst + (size_t)bi * Np * Kp;
        float vals[64];
#pragma unroll
        for (int i = 0; i < 64; ++i) { const int k = k0 + 2 * i + (lane >> 5), n = n0 + (lane & 31); vals[i] = (k < Kr && n < Nr) ? W[(size_t)k * Nr + n] : 0.f; }
#pragma unroll
        for (int i = 0; i < 64; ++i) scr[(2 * i + (lane >> 5)) * 33 + (lane & 31)] = vals[i] * scale;
        LDS_WAIT();
        const int c = lane & 7;
#pragma unroll
        for (int j = 0; j < 4; ++j) { const int nl = (lane >> 3) + 8 * j; const LAS float* sp = scr + (16 * c) * 33 + nl; u32x4 o;
#pragma unroll
            for (int q = 0; q < 4; ++q) { int w_ = __builtin_amdgcn_cvt_pk_fp8_f32(sp[(4 * q) * 33], sp[(4 * q + 1) * 33], 0, false); w_ = __builtin_amdgcn_cvt_pk_fp8_f32(sp[(4 * q + 2) * 33], sp[(4 * q + 3) * 33], w_, true); o[q] = (unsigned)w_; }
            int n = n0 + nl; if (perm) n = ((n & 1023) >> 7) * 256 + (n >> 10) * 128 + (n & 127);
            *(u32x4*)(WT + (size_t)n * Kp + k0 + 16 * c) = o; }
        LDS_WAIT();
    }
}

struct Unit { int pm, pn, kind, e, rows, rbase; const char* A; const char* B; const int* list; };

struct DenseDesc { const char* A; const char* B; int kind, pn; };

namespace pg8 {
constexpr int BM = 256, BK = 64, HALF = 128, HTB = HALF * BK * 2, STAGE_BYTES = 8 * HTB;
__device__ __forceinline__ int lds_byte(int r, int c) { const int st = (r >> 4) * 2 + (c >> 5), rr = r & 15, cc = c & 31, ob = rr * 64 + cc * 2; return st * 1024 + (ob ^ (((ob >> 9) & 1) << 5)); }
__device__ __forceinline__ void stage_rc(int b, int& R, int& C) { const int st = b / 1024, sb = b % 1024, swz = sb ^ (((sb >> 9) & 1) << 5); R = (st >> 1) * 16 + swz / 64; C = (st & 1) * 32 + (swz % 64) / 2; }
}
typedef int i32x4 __attribute__((ext_vector_type(4)));
typedef int i32x8 __attribute__((ext_vector_type(8)));
template <bool FP8, class Sched, class Epi>
__device__ __forceinline__ void gemm_phase_pg8(LAS unsigned char* lds, const Sched& S, const Epi& E, const int Kb, const int wave) {
    using namespace pg8;
    int tid = wave * 64 + lane_id(); OPAQUE(tid);
    const int wid = wave, lane = tid & 63, wr = wid >> 2, wc = wid & 3, fr = lane & 15, fq = lane >> 4;
    const int nt = Kb / 128;
    int Rs[2], Cs[2]; unsigned voffB[2];
#pragma unroll
    for (int i = 0; i < 2; ++i) { stage_rc(tid * 16 + i * 8192, Rs[i], Cs[i]); voffB[i] = (unsigned)(Rs[i] * Kb + Cs[i] * 2); }
    const size_t kstep = (size_t)128;
    const size_t hstepB = (size_t)HALF * Kb;
    const unsigned ldsw = (unsigned)wid * 1024u;
    const int aoff = lds_byte(wr * 64 + fr, fq * 8), boff = lds_byte(wc * 32 + fr, fq * 8);
#define PG8_SA(b, h) (((b) * 2 + (h)) * HTB)
#define PG8_SB(b, h) ((4 + (b) * 2 + (h)) * HTB)
#define PG8_STAGE(bufoff, gbase, voff) do { _Pragma("unroll") for (int _i = 0; _i < 2; ++_i) \
        __builtin_amdgcn_global_load_lds((const unsigned*)((const char*)(gbase) + (voff)[_i]), (LAS unsigned*)(lds + (bufoff) + ldsw + _i * 8192), 16, 0, 0); } while (0)
#define PG8_LDA(dst, b, h) do { _Pragma("unroll") for (int m = 0; m < 4; ++m) _Pragma("unroll") for (int k = 0; k < 2; ++k) dst[m][k] = *(const LAS h16x8*)(lds + PG8_SA(b, h) + aoff + m * 2048 + k * 1024); } while (0)
#define PG8_LDB(dst, b, h) do { _Pragma("unroll") for (int n = 0; n < 2; ++n) _Pragma("unroll") for (int k = 0; k < 2; ++k) dst[n][k] = *(const LAS h16x8*)(lds + PG8_SB(b, h) + boff + n * 2048 + k * 1024); } while (0)
#define PG8_MMA(ai, bj, At, Bt) do { __builtin_amdgcn_s_setprio(1); \
        if (FP8) { _Pragma("unroll") for (int m = 0; m < 4; ++m) _Pragma("unroll") for (int n = 0; n < 2; ++n) { \
            const i32x4 b0_ = __builtin_bit_cast(i32x4, Bt[n][0]), b1_ = __builtin_bit_cast(i32x4, Bt[n][1]), a0_ = __builtin_bit_cast(i32x4, At[m][0]), a1_ = __builtin_bit_cast(i32x4, At[m][1]); \
            acc[ai][bj][m][n] = __builtin_amdgcn_mfma_scale_f32_16x16x128_f8f6f4(__builtin_shufflevector(b0_, b1_, 0, 1, 2, 3, 4, 5, 6, 7), __builtin_shufflevector(a0_, a1_, 0, 1, 2, 3, 4, 5, 6, 7), acc[ai][bj][m][n], 0, 0, 0, 0, 0, 0); } } \
        else { _Pragma("unroll") for (int m = 0; m < 4; ++m) _Pragma("unroll") for (int n = 0; n < 2; ++n) _Pragma("unroll") for (int k = 0; k < 2; ++k) \
            acc[ai][bj][m][n] = __builtin_amdgcn_mfma_f32_16x16x32_f16(Bt[n][k], At[m][k], acc[ai][bj][m][n], 0, 0, 0); } \
        __builtin_amdgcn_s_setprio(0); } while (0)
#define PG8_WAIT_V(n) asm volatile("s_waitcnt vmcnt(" #n ")" ::: "memory")
#define PG8_WAIT_L(n) asm volatile("s_waitcnt lgkmcnt(" #n ")" ::: "memory")
#define PG8_BAR __builtin_amdgcn_s_barrier()
#define PG8_SCHED __builtin_amdgcn_sched_barrier(0)
    Unit cur, nxt; int ui = 0;
    if (!S.next(0, cur)) return;
    f32x4 acc[2][2][4][2];
#pragma unroll
    for (int a = 0; a < 2; ++a)
#pragma unroll
        for (int b = 0; b < 2; ++b)
#pragma unroll
            for (int m = 0; m < 4; ++m)
#pragma unroll
                for (int n = 0; n < 2; ++n) acc[a][b][m][n] = (f32x4){0.f, 0.f, 0.f, 0.f};
    h16x8 At[4][2], B0[2][2], B1[2][2];
    unsigned vA[2][2], vAn[2][2];
#pragma unroll
    for (int h = 0; h < 2; ++h)
#pragma unroll
        for (int i = 0; i < 2; ++i) vA[h][i] = S.a_off(cur, 128 * h + Rs[i]) + (unsigned)Cs[i] * 2u;
    const char* cA = cur.A; const char* cB = cur.B;
    PG8_STAGE(PG8_SB(0, 0), cB, voffB); PG8_STAGE(PG8_SB(0, 1), cB + hstepB, voffB); PG8_STAGE(PG8_SA(0, 0), cA, vA[0]); PG8_STAGE(PG8_SA(0, 1), cA, vA[1]);
    if (wr == 1) PG8_BAR;
    PG8_WAIT_V(2); PG8_BAR;
    PG8_STAGE(PG8_SB(1, 0), cB + kstep, voffB); PG8_STAGE(PG8_SA(1, 0), cA + kstep, vA[0]); PG8_STAGE(PG8_SB(1, 1), cB + hstepB + kstep, voffB);
    PG8_WAIT_V(6); PG8_BAR;
    for (;;) {
        const bool has_next = S.next(ui + 1, nxt);
        const char* nA = has_next ? nxt.A : cA; const char* nB = has_next ? nxt.B : cB;
#pragma unroll
        for (int h = 0; h < 2; ++h)
#pragma unroll
            for (int i = 0; i < 2; ++i) vAn[h][i] = has_next ? (S.a_off(nxt, 128 * h + Rs[i]) + (unsigned)Cs[i] * 2u) : vA[h][i];
#pragma unroll 1
        for (int t = 0; t < nt; t += 2) {
            const bool last = (t == nt - 2);
            const char* a1 = cA + (size_t)(t + 1) * kstep;
            const char* a2 = last ? nA : cA + (size_t)(t + 2) * kstep; const char* b2 = last ? nB : cB + (size_t)(t + 2) * kstep;
            const char* a3 = a2 + kstep; const char* b3 = b2 + kstep;
            PG8_LDB(B0, 0, 0); PG8_LDB(B1, 0, 1); PG8_SCHED; PG8_LDA(At, 0, 0); PG8_STAGE(PG8_SA(1, 1), a1, vA[1]);
            if (last) { vA[0][0] = vAn[0][0]; vA[0][1] = vAn[0][1]; vA[1][0] = vAn[1][0]; vA[1][1] = vAn[1][1]; }
            PG8_WAIT_V(8); PG8_WAIT_L(0); PG8_BAR; PG8_MMA(0, 0, At, B0); PG8_MMA(0, 1, At, B1); PG8_BAR; PG8_SCHED;
            PG8_LDA(At, 0, 1); PG8_STAGE(PG8_SB(0, 0), b2, voffB); PG8_STAGE(PG8_SB(0, 1), b2 + hstepB, voffB); PG8_STAGE(PG8_SA(0, 0), a2, vA[0]);
            PG8_WAIT_V(8); PG8_WAIT_L(0); PG8_BAR; PG8_MMA(1, 0, At, B0); PG8_MMA(1, 1, At, B1); PG8_BAR; PG8_SCHED;
            PG8_LDB(B0, 1, 0); PG8_LDB(B1, 1, 1); PG8_SCHED; PG8_LDA(At, 1, 0); PG8_STAGE(PG8_SA(0, 1), a2, vA[1]);
            PG8_WAIT_V(8); PG8_WAIT_L(0); PG8_BAR; PG8_MMA(0, 0, At, B0); PG8_MMA(0, 1, At, B1); PG8_BAR; PG8_SCHED;
            PG8_LDA(At, 1, 1); PG8_STAGE(PG8_SB(1, 0), b3, voffB); PG8_STAGE(PG8_SB(1, 1), b3 + hstepB, voffB); PG8_STAGE(PG8_SA(1, 0), a3, vA[0]);
            PG8_WAIT_V(8); PG8_WAIT_L(0); PG8_BAR; PG8_MMA(1, 0, At, B0); PG8_MMA(1, 1, At, B1); PG8_BAR; PG8_SCHED;
        }
        if (wr == 0) PG8_BAR;
        { int fr_e = fr, fq_e = fq; OPAQUE(fr_e); OPAQUE(fq_e);
          E(acc, cur, wr, wc, fr_e, fq_e); }
        if (!has_next) break;
#pragma unroll
        for (int a = 0; a < 2; ++a)
#pragma unroll
            for (int b = 0; b < 2; ++b)
#pragma unroll
                for (int m = 0; m < 4; ++m)
#pragma unroll
                    for (int n = 0; n < 2; ++n) acc[a][b][m][n] = (f32x4){0.f, 0.f, 0.f, 0.f};
        cur = nxt; cA = nA; cB = nB; ++ui;
        if (wr == 1) PG8_BAR;
    }
    PG8_WAIT_V(0);
    PG8_BAR;
#undef PG8_SA
#undef PG8_SB
#undef PG8_STAGE
#undef PG8_LDA
#undef PG8_LDB
#undef PG8_MMA
#undef PG8_WAIT_V
#undef PG8_WAIT_L
#undef PG8_BAR
#undef PG8_SCHED
}
#define GEMM_PHASE(S, E, K) gemm_phase_pg8<false>(lds, S, E, (K) * 2, wave)
#define GEMM_PHASE8(S, E, K) gemm_phase_pg8<true>(lds, S, E, (K), wave)

#define FOR_ACC(ai, bj, m, n) _Pragma("unroll") for (int ai = 0; ai < 2; ++ai) _Pragma("unroll") for (int m = 0; m < 4; ++m) _Pragma("unroll") for (int bj = 0; bj < 2; ++bj) _Pragma("unroll") for (int n = 0; n < 2; ++n)
#define EPI_FENCE() asm volatile("" ::: "memory")

template <bool F16IN>
__device__ __forceinline__ void phase_prep(const void* Xv, const float* mix, h16* XM, int gw_, int NGW_, int lane) {
    lane = lane_id(); OPAQUE(lane);
    const float* Xf = (const float*)Xv; const h16* Xh = (const h16*)Xv;
    for (int ch = gw_; ch < T / 16; ch += NGW_) {
        const int t0 = ch * 16;
        f32x4 prev[4];
        if ((t0 % SEQ) == 0) {
#pragma unroll
            for (int j = 0; j < 4; ++j) prev[j] = (f32x4){0.f, 0.f, 0.f, 0.f};
        } else {
#pragma unroll
            for (int j = 0; j < 4; ++j) prev[j] = F16IN ? ldh4(Xh + (size_t)(t0 - 1) * D + 256 * j + 4 * lane) : *(const f32x4*)(Xf + (size_t)(t0 - 1) * D + 256 * j + 4 * lane);
        }
#pragma unroll 1
        for (int ib = 0; ib < 4; ++ib) {
            f32x4 cur[4][4]; h16x4 curh[4][4];
#pragma unroll
            for (int q = 0; q < 4; ++q)
#pragma unroll
                for (int j = 0; j < 4; ++j) { if (F16IN) curh[q][j] = *(const h16x4*)(Xh + (size_t)(t0 + 4 * ib + q) * D + 256 * j + 4 * lane); else cur[q][j] = *(const f32x4*)(Xf + (size_t)(t0 + 4 * ib + q) * D + 256 * j + 4 * lane); }
            if (F16IN) {
#pragma unroll
                for (int q = 0; q < 4; ++q)
#pragma unroll
                    for (int j = 0; j < 4; ++j) cur[q][j] = __builtin_convertvector(curh[q][j], f32x4);
            }
#pragma unroll
            for (int q = 0; q < 4; ++q) {
                const int t = t0 + 4 * ib + q;
#pragma unroll
                for (int s = 0; s < 6; ++s) {
#pragma unroll
                    for (int j = 0; j < 4; ++j) { const f32x4 mx = *(const f32x4*)(mix + s * D + 256 * j + 4 * lane);
                        const f32x4 pv = (q == 0) ? prev[j] : cur[q == 0 ? 0 : q - 1][j];
                        const f32x4 v = cur[q][j] + (pv - cur[q][j]) * mx;
                        *(u32x2*)(XM + ((size_t)s * T + t) * D + 256 * j + 4 * lane) = pkh4(v); }
                }
            }
#pragma unroll
            for (int j = 0; j < 4; ++j) prev[j] = cur[3][j];
        }
    }
}

struct ScanArgs { const h16 *R, *K, *V; const h16* WD; const h16 *AA, *GG; const float *k_k, *k_a, *r_k, *lnx_g, *lnx_b; h16* YG; const float *wgu, *wdn; unsigned char *gu8, *dn8; int layer_pair; };
__device__ __forceinline__ float row16_sum(float v) { v += dppf<0xB1>(v); v += dppf<0x4E>(v); v += dppf<0x141>(v); v += dppf<0x140>(v); return v; }
struct ConvItem2 { const float* Wrow; unsigned char* WTp; int Nr; float scale; bool valid; };
__device__ __forceinline__ ConvItem2 conv_item2(int sit, int wave, int lane, int layer_pair, const float* wgu, const float* wdn, unsigned char* gu8) {
    ConvItem2 ci; ci.valid = sit < 12288;
    const int s = ci.valid ? sit : 0, ls = s / 6144, r = s - ls * 6144, e = r / 192, q = r - e * 192, le = (layer_pair * 2 + ls) * 32 + e;
    const bool gu = q < 128; const int q2 = gu ? q : q - 128, nb = gu ? (q2 & 31) : (q2 & 15), kq = gu ? (q2 >> 5) : (q2 >> 4), Nr = gu ? 2048 : 1024;
    const int k0 = kq * 256 + wave * 32, n = nb * 64 + lane, nrow = gu ? ((n & 1023) >> 7) * 256 + (n >> 10) * 128 + (n & 127) : n;
    size_t wb; { const int gi = __builtin_amdgcn_readfirstlane(gu ? 1 : 0); asm("s_cmp_lg_u32 %1, 0\n\ts_cselect_b64 %0, %2, %3" : "=s"(wb) : "s"(gi), "s"(wgu), "s"(wdn) : "scc"); }
    const size_t ob = (size_t)gu8 + (gu ? (size_t)0 : (size_t)(WS_W_DN - WS_W_GU));
    ci.Wrow = (const float*)wb + (size_t)le * 1024 * Nr + (size_t)k0 * Nr + nb * 64; ci.WTp = (unsigned char*)ob + (size_t)le * Nr * 1024 + (size_t)nrow * 1024 + k0; ci.Nr = Nr; ci.scale = gu ? GU_SCALE : DN_SCALE;
    return ci;
}
__device__ __forceinline__ void conv_issue2(const ConvItem2& ci, float (&vals)[32], int lane) {
    if (ci.valid) {
        const GAS char* p = (const GAS char*)ci.Wrow; const unsigned lo = (unsigned)lane * 4u; const size_t stride = (size_t)ci.Nr * 4;
#pragma unroll
        for (int i = 0; i < 32; ++i) { vals[i] = __builtin_nontemporal_load((const GAS float*)(p + lo)); p += stride; }
    }
}
__device__ __forceinline__ void conv_finish2(const ConvItem2& ci, const float (&vals)[32]) {
    if (ci.valid) {
#pragma unroll
        for (int j = 0; j < 2; ++j) { u32x4 o;
#pragma unroll
            for (int q = 0; q < 4; ++q) { int pk_ = __builtin_amdgcn_cvt_pk_fp8_f32(vals[16 * j + 4 * q] * ci.scale, vals[16 * j + 4 * q + 1] * ci.scale, 0, false);
                pk_ = __builtin_amdgcn_cvt_pk_fp8_f32(vals[16 * j + 4 * q + 2] * ci.scale, vals[16 * j + 4 * q + 3] * ci.scale, pk_, true); o[q] = (unsigned)pk_; }
            *(u32x4*)(ci.WTp + 16 * j) = o; }
    }
}
__device__ __forceinline__ float row16_reduce_scatter(const float (&q)[16], int lane) {
    const bool b0 = lane & 1, b1 = lane & 2, b2 = lane & 4, b3 = lane & 8;
    float v[16], a[8], c[4], d[2];
#pragma unroll
    for (int s = 0; s < 16; ++s) v[s] = q[((s & 1) << 3) | ((s & 2) << 1) | ((s & 4) >> 1) | ((s & 8) >> 3)];
#pragma unroll
    for (int j = 0; j < 8; ++j) a[j] = (b0 ? v[j + 8] : v[j]) + dppf<0xB1>(b0 ? v[j] : v[j + 8]);
#pragma unroll
    for (int j = 0; j < 4; ++j) c[j] = (b1 ? a[j + 4] : a[j]) + dppf<0x4E>(b1 ? a[j] : a[j + 4]);
#pragma unroll
    for (int j = 0; j < 2; ++j) d[j] = (b2 ? c[j + 2] : c[j]) + dppf<0x124>(b2 ? c[j] : c[j + 2]);
    return (b3 ? d[1] : d[0]) + dppf<0x128>(b3 ? d[0] : d[1]);
}
#define WBAR() do { asm volatile("s_waitcnt lgkmcnt(0)" ::: "memory"); __builtin_amdgcn_s_barrier(); asm volatile("" ::: "memory"); } while (0)
__device__ __forceinline__ void phase_scan_mm(const ScanArgs& a, LAS unsigned char* lds, int blk, int G, const int wave) {
    constexpr int NG = 4, PCH = 13120;
    constexpr int O_AT = 0, O_RT = 2304, O_BBT = 4608, O_KBT = 6656, O_VT = 8704, O_MKT = 10752, O_TMT = 11264, O_NBT = 11776, O_NKT = 12288, O_GC = 12800, O_SRK = 13056;
    constexpr int TMP0 = NG * PCH, TMPB = 5632;
    constexpr int O_SY = TMP0 + 4 * TMPB, O_VO = O_SY + 2 * 16640, O_SRKO = O_VO + 2 * 8192, O_RED = O_SRKO + 512;
    int tid0 = wave * 64 + lane_id(); OPAQUE(tid0);
    int pass = 0;
    for (int bh = blk; bh < NBATCH * 16; bh += G, ++pass) {
        const int b = bh >> 4, h = bh & 15, chn0 = h * 64 + (tid0 & 63);
        const float kkc = a.k_k[chn0], kac = a.k_a[chn0], rkc = a.r_k[chn0];
        f32x4 ST[4];
#pragma unroll
        for (int kt = 0; kt < 4; ++kt) ST[kt] = (f32x4){0.f, 0.f, 0.f, 0.f};
        h16 qr[8], qk[8], qv[8], qa[8], qw[8];
        const int c4w = wave >> 1, hfw = wave & 1;
#pragma unroll
        for (int i = 0; i < 8; ++i) { const size_t tb = ((size_t)bh * SEQ + c4w * 16 + 8 * hfw) * 64 + (tid0 & 63);
            qr[i] = a.R[tb + i * 64]; qk[i] = a.K[tb + i * 64]; qv[i] = a.V[tb + i * 64]; qa[i] = a.AA[tb + i * 64]; qw[i] = a.WD[tb + i * 64]; }
        LAS float* gpr = (LAS float*)(lds + O_RED + 1024);
#define GPROD() ((((1.0f - (float)qw[0]) * (1.0f - (float)qw[1])) * ((1.0f - (float)qw[2]) * (1.0f - (float)qw[3]))) * (((1.0f - (float)qw[4]) * (1.0f - (float)qw[5])) * ((1.0f - (float)qw[6]) * (1.0f - (float)qw[7]))))
        gpr[wave * 64 + (tid0 & 63)] = GPROD();
        WBAR();
        h16 qg[16];
        float cv[32];
        ConvItem2 ci = conv_item2(((pass * 32 + 0) * 2 + 0) * G + blk, wave, tid0 & 63, a.layer_pair, a.wgu, a.wdn, a.gu8);
        conv_issue2(ci, cv, tid0 & 63);
#define OUT_STAGE(gp_) do { const int gp = (gp_); LAS float* red = (LAS float*)(lds + O_RED) + wave * 32; const LAS float* syo = (const LAS float*)(lds + O_SY) + (gp & 1) * (64 * 65); \
            const LAS h16* voo = (const LAS h16*)(lds + O_VO) + (gp & 1) * 4096; const LAS float* srko = (const LAS float*)(lds + O_SRKO) + (gp & 1) * 64; \
            const float lg = a.lnx_g[chn], lb = a.lnx_b[chn]; \
            _Pragma("unroll") for (int bt = 0; bt < 2; ++bt) { const int t0 = (wave - 4) * 16 + 8 * bt; float yv[8], q[16]; \
                _Pragma("unroll") for (int p = 0; p < 8; ++p) { yv[p] = syo[(t0 + p) * 65 + lane]; q[p] = yv[p]; q[8 + p] = yv[p] * yv[p]; } \
                float x = row16_reduce_scatter(q, lane); x += swz16f(x); \
                if ((lane & 16) == 0) red[(lane >> 5) * 16 + l16] = x; \
                LDS_WAIT(); \
                f32x4 s1[2], s2[2]; \
                _Pragma("unroll") for (int hq = 0; hq < 2; ++hq) { s1[hq] = *(const LAS f32x4*)(red + 4 * hq) + *(const LAS f32x4*)(red + 16 + 4 * hq); s2[hq] = *(const LAS f32x4*)(red + 8 + 4 * hq) + *(const LAS f32x4*)(red + 24 + 4 * hq); } \
                _Pragma("unroll") for (int p = 0; p < 8; ++p) { const int tt = t0 + p; \
                    const float mu = s1[p >> 2][p & 3] * (1.0f / 64.0f), var = fmaxf(s2[p >> 2][p & 3] * (1.0f / 64.0f) - mu * mu, 0.0f); \
                    float yn = (yv[p] - mu) * rsqrtf(var + 64e-5f) * lg + lb; yn += srko[tt] * (float)voo[tt * 64 + lane]; \
                    a.YG[((size_t)b * SEQ + gp * 64 + tt) * D + chn] = (h16)(yn * (float)qg[8 * bt + p]); } \
                LDS_WAIT(); } } while (0)
#pragma unroll 1
        for (int grp = 0; grp < SEQ / 64; ++grp) {
            int tid = tid0; OPAQUE(tid);
            const int lane = tid & 63, g4 = lane >> 4, l16 = lane & 15, chn = h * 64 + lane;
            {
                LAS unsigned char* pc = lds + c4w * PCH; LAS unsigned char* tb = lds + TMP0 + c4w * TMPB;
                LAS h16* At = (LAS h16*)(pc + O_AT); LAS h16* Rt = (LAS h16*)(pc + O_RT); LAS h16* BbT = (LAS h16*)(pc + O_BBT); LAS h16* KbT = (LAS h16*)(pc + O_KBT); LAS h16* Vt = (LAS h16*)(pc + O_VT);
                LAS h16* MkT = (LAS h16*)(pc + O_MKT); LAS h16* TmT = (LAS h16*)(pc + O_TMT); LAS h16* NbT = (LAS h16*)(pc + O_NBT); LAS h16* NkT = (LAS h16*)(pc + O_NKT);
                LAS float* gC = (LAS float*)(pc + O_GC); LAS float* srk = (LAS float*)(pc + O_SRK);
                LAS h16* Bh = (LAS h16*)tb; LAS h16* Kh = (LAS h16*)(tb + 2304); LAS float* MbF = (LAS float*)(tb + 4608);
                float wf[8];
#pragma unroll
                for (int i = 0; i < 8; ++i) wf[i] = 1.0f - (float)qw[i];
                const float gown = ((wf[0] * wf[1]) * (wf[2] * wf[3])) * ((wf[4] * wf[5]) * (wf[6] * wf[7])), goth = gpr[(wave ^ 1) * 64 + lane];
                const float gall = gown * goth;
                float gam = hfw ? goth : 1.0f, bhr[8], khr[8];
                LAS float* red = (LAS float*)(lds + O_RED) + wave * 32;
                float n2s[8];
                {
                    float q[16];
#pragma unroll
                    for (int i = 0; i < 8; ++i) { const float k = (float)qk[i], kk = k * kkc; q[i] = kk * kk; q[8 + i] = (float)qr[i] * (k * (1.0f + ((float)qa[i] - 1.0f) * kac)) * rkc; }
                    float x = row16_reduce_scatter(q, lane); x += swz16f(x);
                    if ((lane & 16) == 0) red[(lane >> 5) * 16 + l16] = x;
                    LDS_WAIT();
                    const f32x4 r0 = *(const LAS f32x4*)(red), r1 = *(const LAS f32x4*)(red + 4), r2 = *(const LAS f32x4*)(red + 16), r3 = *(const LAS f32x4*)(red + 20);
#pragma unroll
                    for (int i = 0; i < 4; ++i) { n2s[i] = r0[i] + r2[i]; n2s[4 + i] = r1[i] + r3[i]; }
                    const float rks = red[8 + (lane & 7)] + red[24 + (lane & 7)];
                    if (lane < 8) ((LAS float*)(lds + O_SRKO))[(grp & 1) * 64 + 16 * c4w + 8 * hfw + lane] = rks;
                }
#pragma unroll
                for (int i = 0; i < 8; ++i) {
                    const int tt = 8 * hfw + i;
                    const float r = (float)qr[i], k = (float)qk[i], v = (float)qv[i], w = wf[i], aa = (float)qa[i];
                    const float kk = k * kkc; const float kkn = kk * __builtin_amdgcn_rsqf(fmaxf(n2s[i], 1e-24f));
                    const float kmod = k * (1.0f + (aa - 1.0f) * kac);
                    At[tt * 72 + lane] = (h16)(gam * -kkn);
                    gam *= w; const float rg = __builtin_amdgcn_rcpf(gam);
                    bhr[i] = fminf(fmaxf(kkn * aa * rg, -6.0e4f), 6.0e4f); khr[i] = fminf(fmaxf(kmod * rg, -6.0e4f), 6.0e4f);
                    Bh[tt * 72 + lane] = (h16)bhr[i]; Kh[tt * 72 + lane] = (h16)khr[i];
                    Rt[tt * 72 + lane] = (h16)(gam * r); Vt[lane * 16 + tt] = (h16)v; ((LAS h16*)(lds + O_VO))[((grp & 1) * 64 + 16 * c4w + tt) * 64 + lane] = (h16)v;
                }
                if (hfw == 0) gC[lane] = gall;
                {
                    u32x4 pb, pk;
#pragma unroll
                    for (int q = 0; q < 4; ++q) { pb[q] = pkh(bhr[2 * q] * gall, bhr[2 * q + 1] * gall); pk[q] = pkh(khr[2 * q] * gall, khr[2 * q + 1] * gall); }
                    *(LAS u32x4*)(BbT + lane * 16 + 8 * hfw) = pb; *(LAS u32x4*)(KbT + lane * 16 + 8 * hfw) = pk;
                }
                conv_finish2(ci, cv);
                if (grp + 1 < SEQ / 64) {
#pragma unroll
                    for (int i = 0; i < 8; ++i) { const size_t tb = ((size_t)bh * SEQ + (grp + 1) * 64 + c4w * 16 + 8 * hfw) * 64 + lane;
                        qr[i] = a.R[tb + i * 64]; qk[i] = a.K[tb + i * 64]; qv[i] = a.V[tb + i * 64]; qa[i] = a.AA[tb + i * 64]; qw[i] = a.WD[tb + i * 64]; }
                }
                ci = conv_item2(((pass * 32 + grp) * 2 + 1) * G + blk, wave, lane, a.layer_pair, a.wgu, a.wdn, a.gu8);
                conv_issue2(ci, cv, lane);
                WBAR();
                if (hfw == 0) {
                    f32x4 mb = {0.f, 0.f, 0.f, 0.f};
#pragma unroll
                    for (int s = 0; s < 2; ++s) { const int fo = l16 * 72 + 32 * s + 8 * g4; mb = __builtin_amdgcn_mfma_f32_16x16x32_f16(*(const LAS h16x8*)(Bh + fo), *(const LAS h16x8*)(At + fo), mb, 0, 0, 0); }
#pragma unroll
                    for (int e = 0; e < 4; ++e) mb[e] = (4 * g4 + e < l16) ? mb[e] : 0.f;
                    *(LAS f32x4*)(MbF + l16 * 16 + 4 * g4) = mb;
                    LDS_WAIT();
                    float Tc[16];
#pragma unroll
                    for (int i = 0; i < 16; ++i) Tc[i] = (i == l16) ? 1.0f : 0.0f;
#pragma unroll
                    for (int m = 15; m >= 1; --m) {
#pragma unroll
                        for (int q4 = 0; q4 * 4 < m; ++q4) { const f32x4 cm = *(const LAS f32x4*)(MbF + m * 16 + 4 * q4);
#pragma unroll
                            for (int e = 0; e < 4; ++e) if (4 * q4 + e < m) Tc[4 * q4 + e] += cm[e] * Tc[m]; }
                    }
                    if (g4 == 0) {
#pragma unroll
                        for (int hf = 0; hf < 2; ++hf) { u32x4 pt;
#pragma unroll
                            for (int q = 0; q < 4; ++q) pt[q] = pkh(Tc[8 * hf + 2 * q], Tc[8 * hf + 2 * q + 1]);
                            *(LAS u32x4*)(TmT + l16 * 16 + 8 * hf) = pt; }
                    }
                } else {
                    f32x4 mk = {0.f, 0.f, 0.f, 0.f}, nb = mk, nk = mk;
#pragma unroll
                    for (int s = 0; s < 2; ++s) {
                        const int fo = l16 * 72 + 32 * s + 8 * g4;
                        const h16x8 fb = *(const LAS h16x8*)(Bh + fo), fk = *(const LAS h16x8*)(Kh + fo), fa = *(const LAS h16x8*)(At + fo), fr = *(const LAS h16x8*)(Rt + fo);
                        mk = __builtin_amdgcn_mfma_f32_16x16x32_f16(fk, fa, mk, 0, 0, 0); nb = __builtin_amdgcn_mfma_f32_16x16x32_f16(fb, fr, nb, 0, 0, 0); nk = __builtin_amdgcn_mfma_f32_16x16x32_f16(fk, fr, nk, 0, 0, 0);
                    }
#pragma unroll
                    for (int e = 0; e < 4; ++e) { const int i = 4 * g4 + e; const bool lt = i < l16, le = i <= l16; mk[e] = lt ? mk[e] : 0.f; nb[e] = le ? nb[e] : 0.f; nk[e] = le ? nk[e] : 0.f; }
                    *(LAS u32x2*)(MkT + l16 * 16 + 4 * g4) = pkh4(mk); *(LAS u32x2*)(NbT + l16 * 16 + 4 * g4) = pkh4(nb); *(LAS u32x2*)(NkT + l16 * 16 + 4 * g4) = pkh4(nk);
                }
            }
            WBAR();
            if (wave < 4) {
                LAS float* sy = (LAS float*)(lds + O_SY) + (grp & 1) * (64 * 65);
#pragma unroll 1
                for (int c4 = 0; c4 < NG; ++c4) {
                    LAS unsigned char* pc = lds + c4 * PCH;
                    const LAS h16* At = (const LAS h16*)(pc + O_AT); const LAS h16* Rt = (const LAS h16*)(pc + O_RT); const LAS h16* BbT = (const LAS h16*)(pc + O_BBT); const LAS h16* KbT = (const LAS h16*)(pc + O_KBT);
                    const LAS h16* Vt = (const LAS h16*)(pc + O_VT); const LAS h16* MkT = (const LAS h16*)(pc + O_MKT); const LAS h16* TmT = (const LAS h16*)(pc + O_TMT);
                    const LAS h16* NbT = (const LAS h16*)(pc + O_NBT); const LAS h16* NkT = (const LAS h16*)(pc + O_NKT); const LAS float* gC = (const LAS float*)(pc + O_GC);
                    h16x4 sb[4];
#pragma unroll
                    for (int kt = 0; kt < 4; ++kt) sb[kt] = __builtin_convertvector(ST[kt], h16x4);
                    const h16x4 vb = *(const LAS h16x4*)(Vt + (16 * wave + l16) * 16 + 4 * g4);
                    f32x4 accW = {0.f, 0.f, 0.f, 0.f}, accY = {0.f, 0.f, 0.f, 0.f};
#pragma unroll
                    for (int kt = 0; kt < 4; ++kt) {
                        accW = __builtin_amdgcn_mfma_f32_16x16x16f16(*(const LAS h16x4*)(At + l16 * 72 + 16 * kt + 4 * g4), sb[kt], accW, 0, 0, 0);
                        accY = __builtin_amdgcn_mfma_f32_16x16x16f16(*(const LAS h16x4*)(Rt + l16 * 72 + 16 * kt + 4 * g4), sb[kt], accY, 0, 0, 0);
                    }
                    accW = __builtin_amdgcn_mfma_f32_16x16x16f16(*(const LAS h16x4*)(MkT + l16 * 16 + 4 * g4), vb, accW, 0, 0, 0);
                    accY = __builtin_amdgcn_mfma_f32_16x16x16f16(*(const LAS h16x4*)(NkT + l16 * 16 + 4 * g4), vb, accY, 0, 0, 0);
                    const h16x4 wb = __builtin_convertvector(accW, h16x4);
                    const f32x4 accU = __builtin_amdgcn_mfma_f32_16x16x16f16(*(const LAS h16x4*)(TmT + l16 * 16 + 4 * g4), wb, (f32x4){0.f, 0.f, 0.f, 0.f}, 0, 0, 0);
                    const h16x4 ub = __builtin_convertvector(accU, h16x4);
                    accY = __builtin_amdgcn_mfma_f32_16x16x16f16(*(const LAS h16x4*)(NbT + l16 * 16 + 4 * g4), ub, accY, 0, 0, 0);
#pragma unroll
                    for (int kt = 0; kt < 4; ++kt) {
                        ST[kt] = ST[kt] * *(const LAS f32x4*)(gC + 16 * kt + 4 * g4);
                        ST[kt] = __builtin_amdgcn_mfma_f32_16x16x16f16(*(const LAS h16x4*)(BbT + (16 * kt + l16) * 16 + 4 * g4), ub, ST[kt], 0, 0, 0);
                        ST[kt] = __builtin_amdgcn_mfma_f32_16x16x16f16(*(const LAS h16x4*)(KbT + (16 * kt + l16) * 16 + 4 * g4), vb, ST[kt], 0, 0, 0);
                    }
#pragma unroll
                    for (int e = 0; e < 4; ++e) sy[(16 * c4 + 4 * g4 + e) * 65 + 16 * wave + l16] = accY[e];
                }
            }
            else {
                if (grp > 0) OUT_STAGE(grp - 1);
#pragma unroll
                for (int j = 0; j < 16; ++j) qg[j] = a.GG[((size_t)bh * SEQ + grp * 64 + (wave - 4) * 16) * 64 + lane + j * 64];
            }
            conv_finish2(ci, cv);
            ci = conv_item2(((pass * 32 + grp + 1) * 2 + 0) * G + blk, wave, lane, a.layer_pair, a.wgu, a.wdn, a.gu8);
            if (grp + 1 < SEQ / 64) { conv_issue2(ci, cv, lane); gpr[wave * 64 + lane] = GPROD(); }
            WBAR();
        }
#undef GPROD
        if (wave >= 4) { const int lane = lane_id(), l16 = lane & 15, chn = h * 64 + lane; OUT_STAGE(SEQ / 64 - 1); }
#undef OUT_STAGE
    }
}

__device__ __forceinline__ float row16_max(float v) { v = fmaxf(v, dppf<0xB1>(v)); v = fmaxf(v, dppf<0x4E>(v)); v = fmaxf(v, dppf<0x141>(v)); v = fmaxf(v, dppf<0x140>(v)); return v; }
struct RouterArgs { const h16* H; const float *g, *b; const h16* WRS; const float* rb; h16* X1; unsigned char* XB; float* TOPG; int* LIST; unsigned* CNT; };
__device__ __forceinline__ void phase_ln_router(const RouterArgs& a, LAS unsigned char* lds, int blk, int G, const int wave) {
    constexpr int WPB = 2064;
    LAS unsigned* hcnt = (LAS unsigned*)(lds + 132096); LAS unsigned* hbase = hcnt + 32; LAS unsigned* pe = hbase + 32; LAS unsigned* pp = pe + 512;
    int tid = wave * 64 + lane_id(); OPAQUE(tid);
    const int lane = tid & 63, ex = lane & 15, kg = lane >> 4;
    for (int c = tid; c < 2 * 32 * 128; c += NTHR) { const int row = c >> 7, ch = c & 127; *(LAS u32x4*)(lds + row * WPB + ch * 16) = *(const u32x4*)((const char*)a.WRS + (size_t)row * 2048 + ch * 16); }
    const float rb0 = a.rb[ex], rb1 = a.rb[16 + ex];
    for (int tb = blk; tb < T / 128; tb += G) {
        if (tid < 32) hcnt[tid] = 0u;
        __syncthreads();
        const size_t tw = (size_t)tb * 128 + wave * 16;
#pragma unroll 1
        for (int ib = 0; ib < 4; ++ib) {
            f32x4 vv[4][4]; h16x4 vh[4][4];
#pragma unroll
            for (int q = 0; q < 4; ++q)
#pragma unroll
                for (int j = 0; j < 4; ++j) vh[q][j] = *(const h16x4*)(a.H + (tw + 4 * ib + q) * D + 256 * j + 4 * lane);
#pragma unroll
            for (int q = 0; q < 4; ++q)
#pragma unroll
                for (int j = 0; j < 4; ++j) vv[q][j] = __builtin_convertvector(vh[q][j], f32x4);
#pragma unroll
            for (int q = 0; q < 4; ++q) {
                const size_t t = tw + 4 * ib + q; float s1 = 0.f;
#pragma unroll
                for (int j = 0; j < 4; ++j) s1 += (vv[q][j].x + vv[q][j].y) + (vv[q][j].z + vv[q][j].w);
                const float mean = wave_sum(s1) * (1.0f / D); float s2 = 0.f;
#pragma unroll
                for (int j = 0; j < 4; ++j) { vv[q][j] = vv[q][j] - mean; s2 += (vv[q][j].x * vv[q][j].x + vv[q][j].y * vv[q][j].y) + (vv[q][j].z * vv[q][j].z + vv[q][j].w * vv[q][j].w); }
                const float rstd = rsqrtf(wave_sum(s2) * (1.0f / D) + LN_EPS);
#pragma unroll
                for (int j = 0; j < 4; ++j) { const f32x4 o = vv[q][j] * rstd * *(const f32x4*)(a.g + 256 * j + 4 * lane) + *(const f32x4*)(a.b + 256 * j + 4 * lane);
                    *(u32x2*)(a.X1 + t * D + 256 * j + 4 * lane) = pkh4(o);
                    int pk_ = __builtin_amdgcn_cvt_pk_fp8_f32(o.x, o.y, 0, false); pk_ = __builtin_amdgcn_cvt_pk_fp8_f32(o.z, o.w, pk_, true);
                    *(unsigned*)(a.XB + t * D + 256 * j + 4 * lane) = (unsigned)pk_; }
            }
        }
        asm volatile("s_waitcnt vmcnt(0)" ::: "memory");
        f32x4 cA[2], cB[2];
        cA[0] = cA[1] = cB[0] = cB[1] = (f32x4){0.f, 0.f, 0.f, 0.f};
        const h16* xrow = a.X1 + (tw + ex) * D + 8 * kg;
        const LAS unsigned char* bh = lds + ex * WPB + kg * 16; const LAS unsigned char* bl = bh + 32 * WPB;
#pragma unroll 8
        for (int ks = 0; ks < 32; ++ks) {
            const h16x8 xh = *(const h16x8*)(xrow + 32 * ks);
#pragma unroll
            for (int tI = 0; tI < 2; ++tI) {
                const h16x8 wh = *(const LAS h16x8*)(bh + tI * 16 * WPB + ks * 64), wl = *(const LAS h16x8*)(bl + tI * 16 * WPB + ks * 64);
                cA[tI] = __builtin_amdgcn_mfma_f32_16x16x32_f16(xh, wh, cA[tI], 0, 0, 0);
                cB[tI] = __builtin_amdgcn_mfma_f32_16x16x32_f16(xh, wl, cB[tI], 0, 0, 0);
            }
        }
#pragma unroll
        for (int e = 0; e < 4; ++e) {
            float c0 = cA[0][e] + cB[0][e] * (1.0f / 4096.0f) + rb0, c1 = cA[1][e] + cB[1][e] * (1.0f / 4096.0f) + rb1;
            int sel[4]; float val[4];
#pragma unroll
            for (int k = 0; k < 4; ++k) {
                const float m = row16_max(fmaxf(c0, c1));
                const unsigned r0 = (unsigned)(__ballot(c0 == m) >> (16 * kg)) & 0xFFFFu, r1 = (unsigned)(__ballot(c1 == m) >> (16 * kg)) & 0xFFFFu;
                const int hit0 = r0 != 0u; const int wl_ = hit0 ? __builtin_ctz(r0) : __builtin_ctz(r1 | 0x10000u);
                sel[k] = hit0 ? wl_ : 16 + wl_; val[k] = m;
                if (ex == wl_) { if (hit0) c0 = -INFINITY; else c1 = -INFINITY; }
            }
            const float e1 = __expf(val[1] - val[0]), e2 = __expf(val[2] - val[0]), e3 = __expf(val[3] - val[0]);
            const float inv = 1.0f / (1.0f + e1 + e2 + e3);
            if (ex < 4) {
                const int tl = wave * 16 + 4 * kg + e; const size_t t = (size_t)tb * 128 + tl;
                const int mysel = ex == 0 ? sel[0] : ex == 1 ? sel[1] : ex == 2 ? sel[2] : sel[3];
                const float myg = (ex == 0 ? 1.0f : ex == 1 ? e1 : ex == 2 ? e2 : e3) * inv;
                a.TOPG[t * 4 + ex] = myg;
                const unsigned pos = __hip_atomic_fetch_add(hcnt + mysel, 1u, __ATOMIC_RELAXED, __HIP_MEMORY_SCOPE_WORKGROUP);
                pe[tl * 4 + ex] = (unsigned)mysel; pp[tl * 4 + ex] = pos;
            }
        }
        __syncthreads();
        if (tid < 32) hbase[tid] = __hip_atomic_fetch_add(a.CNT + tid, hcnt[tid], __ATOMIC_RELAXED, __HIP_MEMORY_SCOPE_AGENT);
        __syncthreads();
        { const unsigned e = pe[tid]; a.LIST[(size_t)e * ECAP + hbase[e] + pp[tid]] = tb * 512 + tid; }
        __syncthreads();
    }
}

__device__ __forceinline__ void phase_combine(const h16* X1, const unsigned char* YS, const float* g, const float* b, float* Xo  , h16* XH  , int gw_, int NGW_, int lane) {
    lane = lane_id(); OPAQUE(lane);
#pragma unroll 1
    for (int t0 = gw_; t0 < T; t0 += 2 * NGW_) {
        h16x4 x[2][4]; unsigned y[2][4][4];
#pragma unroll
        for (int q = 0; q < 2; ++q) { const size_t t = (size_t)t0 + (size_t)q * NGW_;
#pragma unroll
            for (int j = 0; j < 4; ++j) { x[q][j] = *(const h16x4*)(X1 + t * D + 256 * j + 4 * lane);
#pragma unroll
                for (int k = 0; k < 4; ++k) y[q][j][k] = *(const unsigned*)(YS + (t * 4 + k) * D + 256 * j + 4 * lane); } }
#pragma unroll
        for (int q = 0; q < 2; ++q) { const size_t t = (size_t)t0 + (size_t)q * NGW_;
            f32x4 v[4]; float s = 0.f;
#pragma unroll
            for (int j = 0; j < 4; ++j) { f32x4 ysum = (f32x4){0.f, 0.f, 0.f, 0.f};
#pragma unroll
                for (int k = 0; k < 4; ++k) { const f32x2 lo = __builtin_amdgcn_cvt_pk_f32_fp8((int)y[q][j][k], false), hi = __builtin_amdgcn_cvt_pk_f32_fp8((int)y[q][j][k], true); ysum += (f32x4){lo.x, lo.y, hi.x, hi.y}; }
                v[j] = __builtin_convertvector(x[q][j], f32x4) * ALPHA + ysum * (1.0f / YS_SCALE);
                s += (v[j].x + v[j].y) + (v[j].z + v[j].w); }
            const float mean = wave_sum(s) * (1.0f / D); float s2 = 0.f;
#pragma unroll
            for (int j = 0; j < 4; ++j) { v[j] = v[j] - mean; s2 += (v[j].x * v[j].x + v[j].y * v[j].y) + (v[j].z * v[j].z + v[j].w * v[j].w); }
            const float rstd = rsqrtf(wave_sum(s2) * (1.0f / D) + LN_EPS);
#pragma unroll
            for (int j = 0; j < 4; ++j) { v[j] = v[j] * rstd * *(const f32x4*)(g + 256 * j + 4 * lane) + *(const f32x4*)(b + 256 * j + 4 * lane);
                if (Xo) *(f32x4*)(Xo + t * D + 256 * j + 4 * lane) = v[j]; else *(u32x2*)(XH + t * D + 256 * j + 4 * lane) = pkh4(v[j]); }
        }
    }
}

#include <cmath>
namespace attn_body {
using bf16=_Float16;
using bf16x8=__attribute__((ext_vector_type(8)))short;
using s16x4=__attribute__((ext_vector_type(4)))short;
using f32x16=__attribute__((ext_vector_type(16)))float;
using u32x4=__attribute__((ext_vector_type(4)))unsigned;
constexpr int SEQ=2048,D=64,DM=1024,DMO=2048;
constexpr int NW=8,QBLK=32,QB=QBLK*NW,KVBLK=64,NQB=SEQ/QB;
typedef _Float16 f16x8_t __attribute__((ext_vector_type(8)));
#define MFMA32(a,b,c) __builtin_amdgcn_mfma_f32_32x32x16_f16(__builtin_bit_cast(f16x8_t,(a)),__builtin_bit_cast(f16x8_t,(b)),(c),0,0,0)
__device__ __forceinline__ int crow(int r,int hi){return (r&3)+8*(r>>2)+4*hi;}
#define SBAR() __builtin_amdgcn_sched_barrier(0)
__device__ __forceinline__ void cmask(f32x16&p0,f32x16&p1,int jb,int qrel,int hi){
  const float NEG=-INFINITY; int kb=64*jb+4*hi;
  #pragma unroll
  for(int r=0;r<16;++r){int kv=kb+(r&3)+8*(r>>2); if(kv>qrel)p0[r]=NEG; if(kv+32>qrel)p1[r]=NEG;}
}

constexpr int NSLOT=3, SLOTB=8192;
constexpr int LDS_K=0, LDS_V=NSLOT*SLOTB, LDS_WS=2*NSLOT*SLOTB, LDS_OST=LDS_WS+NW*64*4, LDS_BYTES=LDS_OST+NW*4096;
constexpr float C2=0.125f*1.4426950408889634f;
__device__ __forceinline__ void glds16(const void*gsrc,unsigned lds_dst){unsigned keep;
  asm volatile("s_mov_b32 %0, m0\n\ts_mov_b32 m0, %2\n\ts_nop 0\n\tglobal_load_lds_dwordx4 %1, off\n\ts_mov_b32 m0, %0":"=&s"(keep):"v"(gsrc),"s"(lds_dst):"memory");}
__device__ __forceinline__ float max3f(float a,float b,float c){float r;asm("v_max3_f32 %0, %1, %2, %3":"=v"(r):"v"(a),"v"(b),"v"(c));return r;}
__device__ __forceinline__ float max2f(float a,float b){float r;asm("v_max_f32_e32 %0, %1, %2":"=v"(r):"v"(a),"v"(b));return r;}
__device__ __forceinline__ float fadd_s(float a,float b){float r;asm("v_add_f32_e32 %0, %1, %2":"=v"(r):"v"(a),"v"(b));return r;}
__device__ __forceinline__ float fsub_s(float a,float b){float r;asm("v_sub_f32_e32 %0, %1, %2":"=v"(r):"v"(a),"v"(b));return r;}
typedef float f32x2_t __attribute__((ext_vector_type(2))); typedef _Float16 bf16x2_t __attribute__((ext_vector_type(2)));
__device__ __forceinline__ unsigned cvtpk_s(float lo,float hi){f32x2_t v={lo,hi};bf16x2_t b=__builtin_convertvector(v,bf16x2_t);return __builtin_bit_cast(unsigned,b);}
#define WAIT_BAR(N) asm volatile("s_waitcnt vmcnt(" #N ") lgkmcnt(0)\n\ts_barrier":::"memory")

__device__ __forceinline__ void qkt(f32x16&p0,f32x16&p1,const char*Kslot,const bf16x8*qr,const f32x16&negm,int r32,int hi){
  const char*kb=Kslot+hi*1024+r32*16;
  #pragma unroll
  for(int d0=0;d0<4;++d0){
    const bf16x8 b0=*reinterpret_cast<const bf16x8*>(kb+d0*2048);
    const bf16x8 b1=*reinterpret_cast<const bf16x8*>(kb+d0*2048+512);
    if(d0==0){p0=MFMA32(b0,qr[0],negm);p1=MFMA32(b1,qr[0],negm);}
    else{p0=MFMA32(b0,qr[d0],p0);p1=MFMA32(b1,qr[d0],p1);}}
}
typedef __attribute__((address_space(3))) const char* lds_cptr;
typedef short v4i16_t __attribute__((ext_vector_type(4)));
__device__ __forceinline__ void kload8(bf16x8*kf,lds_cptr kp){
  kf[0]=*(const __attribute__((address_space(3))) bf16x8*)(kp);      kf[1]=*(const __attribute__((address_space(3))) bf16x8*)(kp+512);
  kf[2]=*(const __attribute__((address_space(3))) bf16x8*)(kp+2048); kf[3]=*(const __attribute__((address_space(3))) bf16x8*)(kp+2560);
  kf[4]=*(const __attribute__((address_space(3))) bf16x8*)(kp+4096); kf[5]=*(const __attribute__((address_space(3))) bf16x8*)(kp+4608);
  kf[6]=*(const __attribute__((address_space(3))) bf16x8*)(kp+6144); kf[7]=*(const __attribute__((address_space(3))) bf16x8*)(kp+6656);
}
__device__ __forceinline__ void kload2(bf16x8*kf,lds_cptr kp,int j){ kf[2*j]=*(const __attribute__((address_space(3))) bf16x8*)(kp+j*2048); kf[2*j+1]=*(const __attribute__((address_space(3))) bf16x8*)(kp+j*2048+512); }
__device__ __forceinline__ s16x4 vtr(lds_cptr p){ return __builtin_bit_cast(s16x4,__builtin_amdgcn_ds_read_tr16_b64_v4i16((__attribute__((address_space(3))) v4i16_t*)p)); }
__device__ __forceinline__ float rowmax(const f32x16&p0,const f32x16&p1){
  float a=max3f(p0[0],p0[1],p1[0]),b=max3f(p0[2],p0[3],p1[1]);a=max3f(a,p1[2],p1[3]);
  #pragma unroll
  for(int r=4;r<16;r+=4){a=max3f(a,p0[r],p0[r+1]);b=max3f(b,p0[r+2],p0[r+3]);a=max3f(a,p1[r],p1[r+1]);b=max3f(b,p1[r+2],p1[r+3]);}
  const float m=max2f(a,b);
  auto rr=__builtin_amdgcn_permlane32_swap(__float_as_uint(m),__float_as_uint(m),false,false);
  return max2f(__uint_as_float(rr[0]),__uint_as_float(rr[1]));
}
__device__ __forceinline__ void pv(f32x16*o,int vb,bf16x8 pa0,bf16x8 pa1,bf16x8 pa2,bf16x8 pa3){
  #pragma unroll
  for(int d0=0;d0<2;++d0){s16x4 lo[4],hi[4];
    #pragma unroll
    for(int ks=0;ks<4;++ks){
      asm volatile("ds_read_b64_tr_b16 %0,%1 offset:%c2":"=&v"(lo[ks]):"v"(vb),"i"(d0*4096+ks*1024):"memory");
      asm volatile("ds_read_b64_tr_b16 %0,%1 offset:%c2":"=&v"(hi[ks]):"v"(vb),"i"(d0*4096+ks*1024+512):"memory");}
    asm volatile("s_waitcnt lgkmcnt(0)":::"memory");SBAR();
    #define PK(k) (bf16x8){lo[k][0],lo[k][1],lo[k][2],lo[k][3],hi[k][0],hi[k][1],hi[k][2],hi[k][3]}
    o[d0]=MFMA32(pa0,PK(0),o[d0]);
    o[d0]=MFMA32(pa1,PK(1),o[d0]);
    o[d0]=MFMA32(pa2,PK(2),o[d0]);
    o[d0]=MFMA32(pa3,PK(3),o[d0]);
    #undef PK
  }
}

#ifndef ATTN_STORE16
#define ATTN_STORE16(p,v) (*(u32x4*)(p)=(v))
#endif
template<int THRL> __device__ __forceinline__ void attn_unit(int b,int qcol,int vcol,int ocol,float slope2,int qb,int ts,const bf16*Q,const bf16*__restrict__ K,const bf16*__restrict__ V,bf16*O,char*shm,const int wid){
  int lane; asm volatile("v_mbcnt_lo_u32_b32 %0, -1, 0\n\tv_mbcnt_hi_u32_b32 %0, -1, %0":"=v"(lane)); const int r32=lane&31,hi=lane>>5;
  const long rowbase=(long)b*SEQ; const int q0=qb*QB;
  const bf16*Qw=Q+(rowbase+q0+wid*QBLK)*DM+qcol;
  const bf16*Kh=K+(rowbase+(long)ts*KVBLK)*DM+qcol,*Vh=V+(rowbase+(long)ts*KVBLK)*DM+vcol;
  const unsigned lds0=(unsigned)(uintptr_t)shm;
  float*wsf=(float*)(shm+LDS_WS)+wid*64;
  const bf16*ksrc=Kh+(long)lane*DM+wid*8;
  const bf16*vsrc=Vh+(long)(16*(wid&3)+(lane>>2))*DM+(wid>>2)*32+(lane&3)*8;
  const unsigned kdst=lds0+LDS_K+wid*1024, vdst=lds0+LDS_V+wid*1024;
  #define DMA_K(t,slot) glds16(ksrc+(long)(t)*KVBLK*DM,(unsigned)__builtin_amdgcn_readfirstlane(kdst+(slot)))
  #define DMA_V(t,slot) glds16(vsrc+(long)(t)*KVBLK*DM,(unsigned)__builtin_amdgcn_readfirstlane(vdst+(slot)))
  const int vb0=(int)(lds0+LDS_V)+((lane>>4)&1)*32+(lane&3)*8+(4*hi+((lane&15)>>2))*64;
  const char*Kbase=shm+LDS_K; bf16x8 kf[8];
  const lds_cptr shm3=(lds_cptr)shm; const lds_cptr kp0=shm3+LDS_K+hi*1024+r32*16; const lds_cptr vp0=shm3+LDS_V+((lane>>4)&1)*32+(lane&3)*8+(4*hi+((lane&15)>>2))*64;
  const int NT=(q0+QB)/KVBLK-ts;
  DMA_K(0,0);DMA_V(0,0);DMA_K(1,SLOTB);
  bf16x8 qr[4];
  #pragma unroll
  for(int d0=0;d0<4;++d0)qr[d0]=*reinterpret_cast<const bf16x8*>(&Qw[(long)r32*DM+d0*16+hi*8]);
  float mhat=0.f,l_reg=0.f;f32x16 o[2];o[0]=f32x16{};o[1]=f32x16{};f32x16 negm;
  const float delta=64.f*slope2,c32=32.f*slope2;
  _Pragma("unroll") for(int r=0;r<16;++r)negm[r]=slope2*(float)crow(r,hi); asm volatile("":"+v"(negm));
  const int qrel=wid*QBLK+r32;
  #define CMASK(P0,P1,t) do{int jb_=(t)-(NT-4); if(jb_>=0)cmask(P0,P1,jb_,qrel,hi);}while(0)
  bool resc=false;
  #define START(P0,P1) do{ const float rm=rowmax(P0,P1); resc=false; \
    { const float dl=rm; mhat=fadd_s(mhat,dl); \
      _Pragma("unroll") for(int r=0;r<16;++r){P0[r]=fsub_s(P0[r],dl);P1[r]=fsub_s(P1[r],dl);} \
      _Pragma("unroll") for(int r=0;r<16;++r)negm[r]-=dl; asm volatile("":"+v"(negm)); } \
    _Pragma("unroll") for(int r=0;r<16;++r)P0[r]=__builtin_amdgcn_exp2f(P0[r]); }while(0)
  #define RESC() do{ if(resc){ asm volatile("s_waitcnt lgkmcnt(0)":::"memory"); \
      _Pragma("unroll") for(int d_=0;d_<2;++d_) _Pragma("unroll") for(int r=0;r<16;++r)o[d_][r]*=wsf[crow(r,hi)]; } }while(0)
  f32x16 pA0,pA1,pB0,pB1;
  int sl_prev=0,sl_cur=0,sl_next=SLOTB;
  #define ROT() do{sl_prev=sl_cur;sl_cur=sl_next;sl_next=(sl_next==(NSLOT-1)*SLOTB)?0:sl_next+SLOTB;}while(0)
  DMA_K(2,2*SLOTB);
  WAIT_BAR(3);
  qkt(pA0,pA1,Kbase,qr,negm,r32,hi);asm volatile("s_nop 15\n\ts_nop 7":"+v"(pA0),"+v"(pA1)); _Pragma("unroll") for(int r=0;r<16;++r)pA1[r]+=c32; CMASK(pA0,pA1,0);
  START(pA0,pA1);
  _Pragma("unroll") for(int r=0;r<16;++r)pA1[r]=__builtin_amdgcn_exp2f(pA1[r]);
  WAIT_BAR(0);
  DMA_K(3,0);DMA_V(1,SLOTB);
  ROT();
  kload8(kf,kp0+sl_cur);
  WAIT_BAR(2);
  s16x4 vlo[8],vhi[8]; u32x4 pw0,pw1,pw2,pw3;
  #define PKW(P,B) cvtpk_s(P[B],P[B+1])
  #define PAF(k) __builtin_bit_cast(bf16x8,pw##k)
  #define VFR(i) (bf16x8){vlo[i][0],vlo[i][1],vlo[i][2],vlo[i][3],vhi[i][0],vhi[i][1],vhi[i][2],vhi[i][3]}
  #define PIN(x) asm volatile("":"+v"(x))
  #define MX3(a,b,c) __builtin_fmaxf(__builtin_fmaxf((a),(b)),(c))
  #define GAPA(MF,A0,A1,A2,A3,W0,W1,PW) do{ MF; sacc+=A0; sacc+=A1; sacc+=A2; sacc+=A3; PIN(sacc); W0; W1; PIN(PW); SBAR(); }while(0)
  #define EX(v) __builtin_amdgcn_exp2f(v)
  #define GAPB(MF,X,B) do{ MF; X[B]=EX(X[B]); X[B+1]=EX(X[B+1]); X[B+2]=EX(X[B+2]); X[B+3]=EX(X[B+3]); PIN(X); SBAR(); }while(0)
  #define VRD(i) do{ vlo[i]=vtr(vp_+(((i)>>2)*4096+((i)&3)*1024)); vhi[i]=vtr(vp_+(((i)>>2)*4096+((i)&3)*1024+512)); }while(0)
  #define KRD(G,j) do{ if(G){ kload2(kf,kp0+sl_next,j); SBAR(); } }while(0)
  #define STEP(C0,C1,P0,P1,t,GK,GV,GL) do{ SBAR(); \
    _Pragma("unroll") for(int r=0;r<16;++r)negm[r]+=delta; asm volatile("":"+v"(negm)); \
    const lds_cptr vp_=vp0+sl_prev; \
    VRD(0); SBAR(); float sacc=(P0[0]+P0[1]); \
    GAPA(C0=MFMA32(kf[0],qr[0],negm), P0[2],P0[3],P0[4],P0[5],     pw0[0]=PKW(P0,0), pw0[1]=PKW(P0,2), pw0); \
    VRD(4); SBAR(); GAPA(C1=MFMA32(kf[1],qr[0],negm), P0[6],P0[7],P0[8],P0[9],     pw0[2]=PKW(P0,4), pw0[3]=PKW(P0,6), pw0); \
    VRD(1); SBAR(); GAPA(C0=MFMA32(kf[2],qr[1],C0),   P0[10],P0[11],P0[12],P0[13], pw1[0]=PKW(P0,8), pw1[1]=PKW(P0,10), pw1); \
    VRD(5); SBAR(); GAPA(C1=MFMA32(kf[3],qr[1],C1),   P0[14],P0[15],P1[0],P1[1],   pw1[2]=PKW(P0,12),pw1[3]=PKW(P0,14), pw1); \
    VRD(2); SBAR(); GAPA(C0=MFMA32(kf[4],qr[2],C0),   P1[2],P1[3],P1[4],P1[5],     pw2[0]=PKW(P1,0), pw2[1]=PKW(P1,2), pw2); \
    VRD(6); SBAR(); GAPA(C1=MFMA32(kf[5],qr[2],C1),   P1[6],P1[7],P1[8],P1[9],     pw2[2]=PKW(P1,4), pw2[3]=PKW(P1,6), pw2); \
    VRD(3); SBAR(); GAPA(C0=MFMA32(kf[6],qr[3],C0),   P1[10],P1[11],P1[12],P1[13], pw3[0]=PKW(P1,8), pw3[1]=PKW(P1,10), pw3); \
    VRD(7); SBAR(); GAPA(C1=MFMA32(kf[7],qr[3],C1),   P1[14],P1[15],0.f,0.f,       pw3[2]=PKW(P1,12),pw3[3]=PKW(P1,14), pw3); \
    l_reg+=sacc; \
    if(GK){DMA_K((t)+3,sl_cur);} if(GV){DMA_V((t)+1,sl_next);} \
    _Pragma("unroll") for(int r=0;r<16;++r)C1[r]+=c32; \
    CMASK(C0,C1,t); \
    { float a=MX3(C0[0],C0[1],C1[0]),b=MX3(C0[2],C0[3],C1[1]); a=MX3(a,C1[2],C1[3]); \
      _Pragma("unroll") for(int r=4;r<16;r+=4){a=MX3(a,C0[r],C0[r+1]);b=MX3(b,C0[r+2],C0[r+3]);a=MX3(a,C1[r],C1[r+1]);b=MX3(b,C1[r+2],C1[r+3]);} \
      float rm=__builtin_fmaxf(a,b); { auto rr=__builtin_amdgcn_permlane32_swap(__float_as_uint(rm),__float_as_uint(rm),false,false); rm=__builtin_fmaxf(__uint_as_float(rr[0]),__uint_as_float(rr[1])); } \
      resc=false; \
      if(__builtin_expect(__any(rm>(float)THRL),0)){ const float dl=__builtin_fmaxf(rm,0.f); mhat+=dl; \
        _Pragma("unroll") for(int r=0;r<16;++r){C0[r]-=dl;C1[r]-=dl;} \
        _Pragma("unroll") for(int r=0;r<16;++r)negm[r]-=dl; asm volatile("":"+v"(negm)); \
        const float f=__builtin_amdgcn_exp2f(-dl); l_reg*=f; if(hi==0)wsf[r32]=f; resc=true; } } \
    SBAR(); \
    GAPB(o[0]=MFMA32(PAF(0),VFR(0),o[0]), C0,0); \
    GAPB(o[1]=MFMA32(PAF(0),VFR(4),o[1]), C0,4); \
    KRD(GL,0); GAPB(o[0]=MFMA32(PAF(1),VFR(1),o[0]), C0,8); \
    KRD(GL,1); GAPB(o[1]=MFMA32(PAF(1),VFR(5),o[1]), C0,12); \
    KRD(GL,2); GAPB(o[0]=MFMA32(PAF(2),VFR(2),o[0]), C1,0); \
    KRD(GL,3); GAPB(o[1]=MFMA32(PAF(2),VFR(6),o[1]), C1,4); \
    GAPB(o[0]=MFMA32(PAF(3),VFR(3),o[0]), C1,8); \
    GAPB(o[1]=MFMA32(PAF(3),VFR(7),o[1]), C1,12); \
    }while(0)
  int t=1;
  #undef CMASK
  #define CMASK(P0,P1,t) do{}while(0)
  for(;t+5<NT;t+=2){
    STEP(pB0,pB1,pA0,pA1,t,true,true,true);     WAIT_BAR(2); RESC(); ROT();
    STEP(pA0,pA1,pB0,pB1,t+1,true,true,true);   WAIT_BAR(2); RESC(); ROT();
  }
  #undef CMASK
  #define CMASK(P0,P1,t) do{int jb_=(t)-(NT-4); if(jb_>=0)cmask(P0,P1,jb_,qrel,hi);}while(0)
  #define ENDW(tt) do{ if((tt)+3<NT){WAIT_BAR(2);} else if((tt)+2<NT){WAIT_BAR(1);} else {WAIT_BAR(0);} }while(0)
  for(;t+1<NT;t+=2){
    STEP(pB0,pB1,pA0,pA1,t,(t+3<NT),(t+1<NT),(t+1<NT));       ENDW(t);   RESC(); ROT();
    STEP(pA0,pA1,pB0,pB1,t+1,(t+4<NT),(t+2<NT),(t+2<NT));     ENDW(t+1); RESC(); ROT();
  }
  STEP(pB0,pB1,pA0,pA1,NT-1,false,false,false); RESC();
  { float sacc=pB0[0]+pB0[1]; _Pragma("unroll") for(int r=2;r<16;++r)sacc+=pB0[r]; _Pragma("unroll") for(int r=0;r<16;++r)sacc+=pB1[r]; l_reg+=sacc;
    pw0=(u32x4){PKW(pB0,0),PKW(pB0,2),PKW(pB0,4),PKW(pB0,6)};pw1=(u32x4){PKW(pB0,8),PKW(pB0,10),PKW(pB0,12),PKW(pB0,14)};pw2=(u32x4){PKW(pB1,0),PKW(pB1,2),PKW(pB1,4),PKW(pB1,6)};pw3=(u32x4){PKW(pB1,8),PKW(pB1,10),PKW(pB1,12),PKW(pB1,14)};
    SBAR(); pv(o,vb0+sl_cur,PAF(0),PAF(1),PAF(2),PAF(3)); }
  #undef PKW
  #undef PAF
  #undef VFR
  #undef PIN
  #undef MX3
  #undef GAPA
  #undef GAPB
  #undef EX
  #undef VRD
  #undef KRD
  #undef STEP
  #undef ENDW
  {auto rr=__builtin_amdgcn_permlane32_swap(__float_as_uint(l_reg),__float_as_uint(l_reg),false,false);l_reg=__uint_as_float(rr[0])+__uint_as_float(rr[1]);}
  if(hi==0)wsf[32+r32]=l_reg;asm volatile("s_waitcnt lgkmcnt(0)":::"memory");
  float rli[16];
  #pragma unroll
  for(int r=0;r<16;++r)rli[r]=__builtin_amdgcn_rcpf(wsf[32+crow(r,hi)]);
  bf16*Ow=O+(rowbase+q0+wid*QBLK)*DMO+ocol;
  { bf16*stg=(bf16*)(shm+LDS_OST)+wid*2048;
    #pragma unroll
    for(int r=0;r<16;++r){const int orow=crow(r,hi);
      #pragma unroll
      for(int d0=0;d0<2;++d0)stg[orow*64+d0*32+r32]=(bf16)(o[d0][r]*rli[r]);}
    asm volatile("s_waitcnt lgkmcnt(0)":::"memory");
    #pragma unroll
    for(int i=0;i<4;++i){const int row=i*8+(lane>>3),ch=lane&7; const u32x4 v=*(const u32x4*)(stg+row*64+ch*8); ATTN_STORE16(Ow+(long)row*DMO+ch*8,v);} }
  asm volatile("s_waitcnt lgkmcnt(0)\n\ts_barrier":::"memory");
  #undef DMA_K
  #undef DMA_V
  #undef CMASK
  #undef START
  #undef RESC
  #undef ROT
}
}
#undef SBAR
#undef WAIT_BAR
#undef MFMA32
__device__ const unsigned char ATT_H[64] = {5,6,7,5,6,7,5,6,7,4,4,4,4,5,6,7,4,5,6,7,3,3,3,3,3,3,4,5,6,7,2,2,2,2,2,2,1,1,1,1,1,1,1,2,3,4,5,6,7,0,0,0,0,0,0,0,0,1,2,3,4,5,6,7};
__device__ const unsigned char ATT_Q[64] = {7,7,7,6,6,6,5,5,5,5,6,7,4,4,4,4,3,3,3,3,3,4,5,6,7,2,2,2,2,2,2,3,4,5,6,7,1,2,3,4,5,6,7,1,1,1,1,1,1,1,2,3,4,5,6,7,0,0,0,0,0,0,0,0};
__device__ const unsigned char ATT_S[64] = {0,0,0,0,0,0,0,0,0,2,6,10,0,0,0,0,0,0,0,0,2,6,10,14,18,0,0,0,0,0,2,6,10,14,18,22,0,4,8,12,16,20,24,0,0,0,0,0,0,2,6,10,14,18,22,26,0,0,0,0,0,0,0,0};
__device__ __forceinline__ void phase_attn(const h16* Q, const h16* KK, const h16* VV, h16* ORAW, char* lds_generic, int blk, int G, const int wave) {
    const int vcu = (G % 8 == 0) ? (blk % 8) * (G / 8) + blk / 8 : blk;
#pragma unroll 1
    for (int r = 0; r < 16; ++r) {
        const int p = r * 256 + ((r & 1) ? 255 - vcu : vcu), ci = p >> 6, u = p & 63;
        const int hh = ATT_H[ci], qb = ATT_Q[ci], ts = ATT_S[ci], b = u >> 2, c = (u >> 1) & 1, vh = u & 1;
        const float slope2 = exp2f(-(float)(hh + 1)) * LOG2E;
        attn_body::attn_unit<8>(b, hh * 128 + c * 64, hh * 128 + vh * 64, c * 1024 + hh * 128 + vh * 64, slope2, qb, ts, Q, KK, VV, ORAW, lds_generic, wave);
    }
}

__device__ __forceinline__ float row16_sum(float v);
__device__ __forceinline__ void phase_attn_combine(const h16* ORAW, const float* lamv  , const float* subg  , float lambda_init, h16* OB, int gw_, int NGW_, int lane) {
    lane = lane_id(); OPAQUE(lane);
    const float la = wave_sum(lamv[lane] * lamv[64 + lane]), lb = wave_sum(lamv[128 + lane] * lamv[192 + lane]);
    const float lam = __expf(la) - __expf(lb) + lambda_init;
    const int hs = lane >> 5, d = (lane & 31) * 4;
    const f32x4 gsc = *(const f32x4*)(subg + d) * (1.0f - lambda_init);
#pragma unroll 1
    for (int t0 = gw_; t0 < T; t0 += 2 * NGW_) {
        h16x4 a[2][4], b[2][4];
#pragma unroll
        for (int q = 0; q < 2; ++q) { const size_t t = (size_t)t0 + (size_t)q * NGW_;
#pragma unroll
            for (int hp = 0; hp < 4; ++hp) { const int hh = 2 * hp + hs; a[q][hp] = *(const h16x4*)(ORAW + t * 2048 + hh * 128 + d); b[q][hp] = *(const h16x4*)(ORAW + t * 2048 + 1024 + hh * 128 + d); } }
#pragma unroll
        for (int q = 0; q < 2; ++q) { const size_t t = (size_t)t0 + (size_t)q * NGW_;
#pragma unroll
            for (int hp = 0; hp < 4; ++hp) { const int hh = 2 * hp + hs;
                const f32x4 o = __builtin_convertvector(a[q][hp], f32x4) - __builtin_convertvector(b[q][hp], f32x4) * lam;
                float ss = (o.x * o.x + o.y * o.y) + (o.z * o.z + o.w * o.w); ss = row16_sum(ss); ss += swz16f(ss);
                const float r = rsqrtf(ss * (1.0f / 128.0f) + 1e-5f);
                *(u32x2*)(OB + t * 1024 + hh * 128 + d) = pkh4(o * r * gsc); } }
    }
}

struct SchedRkv {
    const char* XM; const char* Wrkv; const char* Wl1; int nk, G, c;
    __device__ __forceinline__ bool next(int i, Unit& u) const {
        int pm, q;
        if (G == 256) { const int L = i * 32 + (c >> 3), pl = L / nk; q = L - pl * nk; pm = pl * 8 + (c & 7); if (pm >= 128) return false; }
        else { const int U = i * G + c; if (U >= 128 * nk) return false; pm = U / nk; q = U - pm * nk; }
        u.pm = pm; u.rows = 256; u.e = 0; u.rbase = 0; u.list = nullptr;
        int xs, pn, kind; const char* B;
        if (q < 12) { kind = q >> 2; pn = q & 3; xs = kind; B = Wrkv + ((size_t)kind * 1024 + pn * 256) * 2048; }
        else { kind = q - 9; pn = 0; xs = (kind == 6) ? 2 : kind; B = Wl1 + (size_t)(kind - 3) * 256 * 2048; }
        u.kind = kind; u.pn = pn; u.B = B; u.A = XM + ((size_t)xs * T + (size_t)pm * 256) * 2048;
        return true;
    }
    __device__ __forceinline__ unsigned a_off(const Unit&, int row) const { return (unsigned)row * 2048u; }
};
struct SchedL2 {
    const char* L1O; const char* Wl2; int kind, G, c;
    __device__ __forceinline__ bool next(int i, Unit& u) const {
        const int U = i * G + c; if (U >= 128 * 4) return false;
        const int pm = U >> 2; u.pm = pm; u.pn = U & 3; u.rows = 256; u.e = 0; u.rbase = 0; u.list = nullptr; u.kind = kind;
        u.A = L1O + ((size_t)kind * T + (size_t)pm * 256) * 512; u.B = Wl2 + ((size_t)kind * 1024 + u.pn * 256) * 512;
        return true;
    }
    __device__ __forceinline__ unsigned a_off(const Unit&, int row) const { return (unsigned)row * 512u; }
};
struct SchedPlain {
    const char* A; const char* B; int npn, G, c;
    __device__ __forceinline__ bool next(int i, Unit& u) const {
        int pm, pn;
        if (G == 256) { const int L = i * 32 + (c >> 3), pl = L / npn; pn = L - pl * npn; pm = pl * 8 + (c & 7); if (pm >= 128) return false; }
        else { const int U = i * G + c; if (U >= 128 * npn) return false; pm = U / npn; pn = U - pm * npn; }
        u.pm = pm; u.rows = 256; u.e = 0; u.rbase = 0; u.list = nullptr;
        u.kind = pn >> 2; u.pn = pn & 3; u.A = A + (size_t)pm * 256 * 2048; u.B = B + (size_t)pn * 256 * 2048;
        return true;
    }
    __device__ __forceinline__ unsigned a_off(const Unit&, int row) const { return (unsigned)row * 2048u; }
};
struct SchedMoe {
    const LAS unsigned* misc; const LAS int* tile_e; const char* A; const char* W; const int* LIST; int npn, gather, G, c; size_t wstride;
    __device__ __forceinline__ bool next(int i, Unit& u) const {
        const int ntile = __builtin_amdgcn_readfirstlane((int)misc[48 + 32]);
        int rtg, pn;
        if (G == 256) { const int x = c & 7, j = c >> 3, rpr = 32 / npn; rtg = (i * rpr + j / npn) * 8 + x; pn = j % npn; if (rtg >= ntile) return false; }
        else { const int U = i * G + c; if (U >= ntile * npn) return false; rtg = U / npn; pn = U - rtg * npn; }
        const int e = __builtin_amdgcn_readfirstlane(tile_e[rtg]);
        const int rt = rtg - __builtin_amdgcn_readfirstlane((int)misc[48 + e]), cnt = __builtin_amdgcn_readfirstlane((int)misc[16 + e]);
        u.pm = rtg; u.pn = pn; u.kind = 0; u.e = e; u.rbase = rtg * 256; u.rows = min(256, cnt - rt * 256);
        u.list = LIST + (size_t)e * ECAP + rt * 256;
        u.A = gather ? A : A + (size_t)rtg * 256 * 1024; u.B = W + (size_t)e * wstride + (size_t)pn * 256 * 1024;
        return true;
    }
    __device__ __forceinline__ unsigned a_off(const Unit& u, int row) const {
        if (!gather) return (unsigned)row * 1024u;
        const int slot = (row < u.rows) ? u.list[row] : 0;
        return (unsigned)(slot >> 2) * 1024u;
    }
};
__device__ __forceinline__ void moe_tables(const unsigned* CNT, volatile LAS unsigned* misc, LAS int* tile_e, const int wave) {
    if (wave == 0 && lane_id() == 0) {
        unsigned acc = 0;
        for (int e = 0; e < 32; ++e) { const unsigned c = __hip_atomic_load(CNT + e, __ATOMIC_RELAXED, __HIP_MEMORY_SCOPE_AGENT); misc[16 + e] = c; misc[48 + e] = acc; acc += (c + 255u) >> 8; }
        misc[48 + 32] = acc;
    }
    __syncthreads();
    { const int ntile = (int)misc[48 + 32];
      for (int i = wave * 64 + lane_id(); i < ntile; i += NTHR) { int e = 0; for (int j = 1; j < 32; ++j) if ((int)misc[48 + j] <= i) e = j; tile_e[i] = e; } }
    __syncthreads();
}

__device__ __forceinline__ size_t hm_off(int row, int col) { return ((size_t)((row >> 11) * 16 + (col >> 6)) * SEQ + (row & 2047)) * 64 + (col & 63); }
struct EpiRkv {
    h16* Rp; h16* Kp; h16* Vp; h16* L1O;
    __device__ __forceinline__ void operator()(const f32x4 (&acc)[2][2][4][2], const Unit& u, int wr, int wc, int fr, int fq) const {
        if (u.kind < 3) {
            h16* C = u.kind == 0 ? Rp : (u.kind == 1 ? Kp : Vp);
            FOR_ACC(ai, bj, m, n) { const int row = u.pm * 256 + 128 * ai + 64 * wr + 16 * m + fr, col = u.pn * 256 + 128 * bj + 32 * wc + 16 * n + 4 * fq;
                *(u32x2*)(C + hm_off(row, col)) = pkh4(acc[ai][bj][m][n]); }
        } else {
            h16* O = L1O + (size_t)(u.kind - 3) * T * 256; const int kd = u.kind;
            FOR_ACC(ai, bj, m, n) { const int row = u.pm * 256 + 128 * ai + 64 * wr + 16 * m + fr, col = 128 * bj + 32 * wc + 16 * n + 4 * fq;
                f32x4 v = acc[ai][bj][m][n];
                if (kd == 3) { v.x = tanhf(v.x); v.y = tanhf(v.y); v.z = tanhf(v.z); v.w = tanhf(v.w); }
                else if (kd == 5) { v.x = sigmoidf_(v.x); v.y = sigmoidf_(v.y); v.z = sigmoidf_(v.z); v.w = sigmoidf_(v.w); }
                *(u32x2*)(O + (size_t)row * 256 + col) = pkh4(v); }
        }
    }
};
template <int KD> struct EpiL2 {
    void* O; const h16* VF; const float* bias;
    __device__ __forceinline__ void operator()(const f32x4 (&acc)[2][2][4][2], const Unit& u, int wr, int wc, int fr, int fq) const {
        f32x4 bv[2][2];
#pragma unroll
        for (int bj = 0; bj < 2; ++bj)
#pragma unroll
            for (int n = 0; n < 2; ++n) bv[bj][n] = (KD != 2) ? *(const f32x4*)(bias + u.pn * 256 + 128 * bj + 32 * wc + 16 * n + 4 * fq) : (f32x4){0.f, 0.f, 0.f, 0.f};
#pragma unroll
        for (int ai = 0; ai < 2; ++ai)
#pragma unroll
            for (int mp = 0; mp < 2; ++mp) {
                h16x4 vc[2][2][2], vf[2][2][2];
                if (KD == 3) {
#pragma unroll
                    for (int mm = 0; mm < 2; ++mm)
#pragma unroll
                        for (int bj = 0; bj < 2; ++bj)
#pragma unroll
                            for (int n = 0; n < 2; ++n) { const size_t o = hm_off(u.pm * 256 + 128 * ai + 64 * wr + 16 * (2 * mp + mm) + fr, u.pn * 256 + 128 * bj + 32 * wc + 16 * n + 4 * fq);
                                vc[mm][bj][n] = *(const h16x4*)((const h16*)O + o); vf[mm][bj][n] = *(const h16x4*)(VF + o); }
                }
#pragma unroll
                for (int mm = 0; mm < 2; ++mm)
#pragma unroll
                    for (int bj = 0; bj < 2; ++bj)
#pragma unroll
                        for (int n = 0; n < 2; ++n) { const int m = 2 * mp + mm; const size_t o = hm_off(u.pm * 256 + 128 * ai + 64 * wr + 16 * m + fr, u.pn * 256 + 128 * bj + 32 * wc + 16 * n + 4 * fq);
                            f32x4 v = acc[ai][bj][m][n] + bv[bj][n];
                            if (KD == 0) { v.x = 1.0f - __expf(-0.6065306597126334f * sigmoidf_(v.x)); v.y = 1.0f - __expf(-0.6065306597126334f * sigmoidf_(v.y)); v.z = 1.0f - __expf(-0.6065306597126334f * sigmoidf_(v.z)); v.w = 1.0f - __expf(-0.6065306597126334f * sigmoidf_(v.w)); }
                            if (KD == 1 || KD == 3) { v.x = sigmoidf_(v.x); v.y = sigmoidf_(v.y); v.z = sigmoidf_(v.z); v.w = sigmoidf_(v.w); }
                            if (KD == 3) { const f32x4 c_ = __builtin_convertvector(vc[mm][bj][n], f32x4), f_ = __builtin_convertvector(vf[mm][bj][n], f32x4); v = c_ + (f_ - c_) * v; }
                            *(u32x2*)((h16*)O + o) = pkh4(v); }
                if (KD == 3) EPI_FENCE();
            }
    }
};
template <bool F16X> struct EpiRes {
    const void* X; h16* H;
    __device__ __forceinline__ void operator()(const f32x4 (&acc)[2][2][4][2], const Unit& u, int wr, int wc, int fr, int fq) const {
        const float* Xf = (const float*)X; const h16* Xh = (const h16*)X;
#pragma unroll
        for (int ai = 0; ai < 2; ++ai)
#pragma unroll
            for (int mp = 0; mp < 2; ++mp) {
                f32x4 xr[2][2][2]; h16x4 xh[2][2][2];
#pragma unroll
                for (int mm = 0; mm < 2; ++mm)
#pragma unroll
                    for (int bj = 0; bj < 2; ++bj)
#pragma unroll
                        for (int n = 0; n < 2; ++n) { const size_t o = (size_t)(u.pm * 256 + 128 * ai + 64 * wr + 16 * (2 * mp + mm) + fr) * D + u.pn * 256 + 128 * bj + 32 * wc + 16 * n + 4 * fq;
                            if (F16X) xh[mm][bj][n] = *(const h16x4*)(Xh + o); else xr[mm][bj][n] = *(const f32x4*)(Xf + o); }
#pragma unroll
                for (int mm = 0; mm < 2; ++mm)
#pragma unroll
                    for (int bj = 0; bj < 2; ++bj)
#pragma unroll
                        for (int n = 0; n < 2; ++n) { const int m = 2 * mp + mm; const f32x4 xv = F16X ? __builtin_convertvector(xh[mm][bj][n], f32x4) : xr[mm][bj][n];
                            *(u32x2*)(H + (size_t)(u.pm * 256 + 128 * ai + 64 * wr + 16 * m + fr) * D + u.pn * 256 + 128 * bj + 32 * wc + 16 * n + 4 * fq) = pkh4(xv * ALPHA + acc[ai][bj][m][n]); }
                EPI_FENCE();
            }
    }
};
struct EpiQkv {
    h16* O0; h16* O1; float sc0;
    __device__ __forceinline__ void operator()(const f32x4 (&acc)[2][2][4][2], const Unit& u, int wr, int wc, int fr, int fq) const {
        h16* O = u.kind == 0 ? O0 : O1; const float sc = u.kind == 0 ? sc0 : 1.0f;
        FOR_ACC(ai, bj, m, n) { const int row = u.pm * 256 + 128 * ai + 64 * wr + 16 * m + fr, col = u.pn * 256 + 128 * bj + 32 * wc + 16 * n + 4 * fq;
            *(u32x2*)(O + (size_t)row * 1024 + col) = pkh4(acc[ai][bj][m][n] * sc); }
    }
};
struct EpiGu {
    unsigned char* ACT; const float* bgu;
    __device__ __forceinline__ void operator()(const f32x4 (&acc)[2][2][4][2], const Unit& u, int wr, int wc, int fr, int fq) const {
        const float* bb = bgu + (size_t)u.e * 2048;
        f32x4 bg[2], bu[2];
#pragma unroll
        for (int n = 0; n < 2; ++n) { const int col = u.pn * 128 + 32 * wc + 16 * n + 4 * fq; bg[n] = *(const f32x4*)(bb + col); bu[n] = *(const f32x4*)(bb + 1024 + col); }
#pragma unroll
        for (int ai = 0; ai < 2; ++ai)
#pragma unroll
            for (int m = 0; m < 4; ++m) { const int rl = 128 * ai + 64 * wr + 16 * m + fr;
                if (rl < u.rows) {
#pragma unroll
                    for (int n = 0; n < 2; ++n) { const int col = u.pn * 128 + 32 * wc + 16 * n + 4 * fq;
                        const f32x4 gt = acc[ai][0][m][n] * (1.0f / GU_SCALE) + bg[n], up = acc[ai][1][m][n] * (1.0f / GU_SCALE) + bu[n]; f32x4 r;
#pragma unroll
                        for (int e = 0; e < 4; ++e) { const float g = fminf(gt[e], 7.0f), uu = __builtin_amdgcn_fmed3f(up[e], -7.0f, 7.0f); r[e] = (uu + 1.0f) * (g * __builtin_amdgcn_rcpf(1.0f + __builtin_amdgcn_exp2f((-1.702f * 1.4426950408889634f) * g))); }
                        int pk_ = __builtin_amdgcn_cvt_pk_fp8_f32(r[0], r[1], 0, false); pk_ = __builtin_amdgcn_cvt_pk_fp8_f32(r[2], r[3], pk_, true);
                        *(unsigned*)(ACT + (size_t)(u.rbase + rl) * 1024 + col) = (unsigned)pk_; }
                } }
    }
};
struct EpiDn {
    unsigned char* YS; const float* bdn; const float* TOPG;
    __device__ __forceinline__ void operator()(const f32x4 (&acc)[2][2][4][2], const Unit& u, int wr, int wc, int fr, int fq) const {
        const float* bb = bdn + (size_t)u.e * 1024;
        f32x4 bv[2][2]; int slot[2][4]; float gt[2][4];
#pragma unroll
        for (int bj = 0; bj < 2; ++bj)
#pragma unroll
            for (int n = 0; n < 2; ++n) bv[bj][n] = *(const f32x4*)(bb + u.pn * 256 + 128 * bj + 32 * wc + 16 * n + 4 * fq);
#pragma unroll
        for (int ai = 0; ai < 2; ++ai)
#pragma unroll
            for (int m = 0; m < 4; ++m) { const int rl = 128 * ai + 64 * wr + 16 * m + fr; slot[ai][m] = (rl < u.rows) ? u.list[rl] : -1; }
#pragma unroll
        for (int ai = 0; ai < 2; ++ai)
#pragma unroll
            for (int m = 0; m < 4; ++m) gt[ai][m] = (slot[ai][m] >= 0) ? TOPG[slot[ai][m]] * YS_SCALE : 0.f;
#pragma unroll
        for (int ai = 0; ai < 2; ++ai)
#pragma unroll
            for (int m = 0; m < 4; ++m) {
                if (slot[ai][m] >= 0) {
#pragma unroll
                    for (int bj = 0; bj < 2; ++bj)
#pragma unroll
                        for (int n = 0; n < 2; ++n) { const int col = u.pn * 256 + 128 * bj + 32 * wc + 16 * n + 4 * fq;
                            const f32x4 yv = (acc[ai][bj][m][n] * (1.0f / DN_SCALE) + bv[bj][n]) * gt[ai][m];
                            int pk_ = __builtin_amdgcn_cvt_pk_fp8_f32(yv[0], yv[1], 0, false); pk_ = __builtin_amdgcn_cvt_pk_fp8_f32(yv[2], yv[3], pk_, true);
                            *(unsigned*)(YS + (size_t)slot[ai][m] * 1024 + col) = (unsigned)pk_; }
                } }
    }
};

struct Args { const float* in[33]; float* out; unsigned char* ws; int ph_lo, ph_hi; };
enum { I_X = 0, I_LNG, I_LNB, I_MIX, I_WRKV, I_WO, I_W0, I_W1, I_W2, I_A0, I_A1, I_A2, I_G1, I_G2, I_KK, I_KA, I_RK, I_LNXG, I_LNXB, I_V0, I_V1, I_V2,
       I_KVW, I_DAQ, I_DAO, I_DALAM, I_DASUB, I_RW, I_RB, I_WGU, I_BGU, I_WDN, I_BDN };

typedef const float* cfptr;
#define KAS __attribute__((address_space(4)))
#define KA_DECL const KAS cfptr* kin = (const KAS cfptr*)__builtin_amdgcn_kernarg_segment_ptr(); asm volatile("" : "+s"(kin))
#define KA_RELOAD asm volatile("" : "+s"(kin))
#define PH_BEGIN KA_RELOAD; asm volatile("" : "+s"(wave), "+s"(G), "+s"(blk)); ws = KWS; ctl = (unsigned*)(ws + WS_CTL)
#define KIN(i) (kin[i])
#define KOUT ((float*)kin[33])
#define KWS ((unsigned char*)kin[34])
__global__ void __launch_bounds__(NTHR, 2) yoco_fwd(Args args) {
    extern __shared__ __attribute__((aligned(16))) unsigned char lds_raw[];
    LAS unsigned char* lds = (LAS unsigned char*)lds_raw;
    volatile LAS unsigned* MISC = (volatile LAS unsigned*)(lds + MISC_OFF);
    int wave = __builtin_amdgcn_readfirstlane((int)threadIdx.x >> 6);
    int G = gridDim.x, blk = blockIdx.x; int lane = 0;
#define gw (blk * NWAVES + wave)
#define NGW (G * NWAVES)
    KA_DECL;
    unsigned char* ws = KWS;
    unsigned* ctl = (unsigned*)(ws + WS_CTL);
    for (int u = wave * 64 + lane_id(); u < (LDS_BYTES - MISC_OFF) / 4; u += NTHR) ((LAS unsigned*)(lds + MISC_OFF))[u] = 0u;
    __syncthreads();
    XcdBarrier bar = xcd_barrier_post(ctl + CW_BAR, MISC + 8, wave);
#define GRID_BAR() xcd_barrier(bar, wave)

    {
        LAS float* scr = (LAS float*)(lds + wave * 16896);
        conv_batch(KIN(I_WRKV), 6, 1024, 1024, (h16*)(ws + WS_W_RKV), 1024, 1024, 0, scr, gw, NGW, lane);
        conv_batch(KIN(I_WO), 2, 1024, 1024, (h16*)(ws + WS_W_RO), 1024, 1024, 0, scr, gw, NGW, lane);
#pragma unroll
        for (int l = 0; l < 2; ++l) {
            conv_batch(KIN(I_W1) + (size_t)l * 1024 * 64, 1, 1024, 64, (h16*)(ws + WS_W_L1) + (size_t)(l * 4 + 0) * 256 * 1024, 1024, 256, 0, scr, gw, NGW, lane);
            conv_batch(KIN(I_A1) + (size_t)l * 1024 * 64, 1, 1024, 64, (h16*)(ws + WS_W_L1) + (size_t)(l * 4 + 1) * 256 * 1024, 1024, 256, 0, scr, gw, NGW, lane);
            conv_batch(KIN(I_G1) + (size_t)l * 1024 * 160, 1, 1024, 160, (h16*)(ws + WS_W_L1) + (size_t)(l * 4 + 2) * 256 * 1024, 1024, 256, 0, scr, gw, NGW, lane);
            conv_batch(KIN(I_W2) + (size_t)l * 64 * 1024, 1, 64, 1024, (h16*)(ws + WS_W_L2) + (size_t)(l * 4 + 0) * 256 * 1024, 256, 1024, 0, scr, gw, NGW, lane);
            conv_batch(KIN(I_A2) + (size_t)l * 64 * 1024, 1, 64, 1024, (h16*)(ws + WS_W_L2) + (size_t)(l * 4 + 1) * 256 * 1024, 256, 1024, 0, scr, gw, NGW, lane);
            conv_batch(KIN(I_G2) + (size_t)l * 160 * 1024, 1, 160, 1024, (h16*)(ws + WS_W_L2) + (size_t)(l * 4 + 2) * 256 * 1024, 256, 1024, 0, scr, gw, NGW, lane);
        }
        conv_batch(KIN(I_V1), 1, 1024, 32, (h16*)(ws + WS_W_L1) + (size_t)(4 + 3) * 256 * 1024, 1024, 256, 0, scr, gw, NGW, lane);
        conv_batch(KIN(I_V2), 1, 32, 1024, (h16*)(ws + WS_W_L2) + (size_t)(4 + 3) * 256 * 1024, 256, 1024, 0, scr, gw, NGW, lane);
        conv_batch(KIN(I_KVW), 1, 1024, 2048, (h16*)(ws + WS_W_KV), 1024, 2048, 0, scr, gw, NGW, lane);
        conv_batch(KIN(I_DAQ), 2, 1024, 1024, (h16*)(ws + WS_W_Q), 1024, 1024, 0, scr, gw, NGW, lane);
        conv_batch(KIN(I_DAO), 2, 1024, 1024, (h16*)(ws + WS_W_AO), 1024, 1024, 0, scr, gw, NGW, lane);
#pragma unroll
        for (int l4 = 0; l4 < 4; ++l4) { conv_batch(KIN(I_RW) + (size_t)l4 * D * NEXP, 1, 1024, 32, (h16*)(ws + WS_WR) + (size_t)(l4 * 2 + 0) * 32 * 1024, 1024, 32, 0, scr, gw, NGW, lane);
                                        conv_batch(KIN(I_RW) + (size_t)l4 * D * NEXP, 1, 1024, 32, (h16*)(ws + WS_WR) + (size_t)(l4 * 2 + 1) * 32 * 1024, 1024, 32, 2, scr, gw, NGW, lane); }
    }

#pragma unroll 1
    for (int l = 0; l < 4; ++l) {
        if (l < 2) {
            PH_BEGIN;
            if (l == 0) phase_prep<false>(KIN(I_X), KIN(I_MIX), (h16*)(ws + WS_XM), gw, NGW, lane);
            else phase_prep<true>(ws + WS_XH, KIN(I_MIX) + (size_t)l * 6 * D, (h16*)(ws + WS_XM), gw, NGW, lane);
            GRID_BAR();
            PH_BEGIN;
            {
                SchedRkv S{(const char*)(ws + WS_XM), (const char*)(ws + WS_W_RKV) + (size_t)l * 3 * 1024 * 2048, (const char*)(ws + WS_W_L1) + (size_t)l * 4 * 256 * 2048, l == 0 ? 15 : 16, G, blk};
                EpiRkv E{(h16*)(ws + WS_R), (h16*)(ws + WS_K), (h16*)(ws + (l == 0 ? WS_VF : WS_V)), (h16*)(ws + WS_L1O)};
                GEMM_PHASE(S, E, 1024);
            }
            GRID_BAR();
            PH_BEGIN;
            {
                const char* l1o = (const char*)(ws + WS_L1O); const char* wl2 = (const char*)(ws + WS_W_L2) + (size_t)l * 4 * 1024 * 512;
                { SchedL2 S{l1o, wl2, 0, G, blk}; EpiL2<0> E{(void*)(ws + WS_WD), nullptr, KIN(I_W0) + (size_t)l * D}; GEMM_PHASE(S, E, 256); }
                { SchedL2 S{l1o, wl2, 1, G, blk}; EpiL2<1> E{(void*)(ws + WS_AA), nullptr, KIN(I_A0) + (size_t)l * D}; GEMM_PHASE(S, E, 256); }
                { SchedL2 S{l1o, wl2, 2, G, blk}; EpiL2<2> E{(void*)(ws + WS_GG), nullptr, nullptr}; GEMM_PHASE(S, E, 256); }
                if (l == 1) { SchedL2 S{l1o, wl2, 3, G, blk}; EpiL2<3> E{(void*)(ws + WS_V), (const h16*)(ws + WS_VF), KIN(I_V0)}; GEMM_PHASE(S, E, 256); }
            }
            GRID_BAR();
            PH_BEGIN;
            {
                const float* wgu_ = KIN(I_WGU); const float* wdn_ = KIN(I_WDN); asm volatile("" : "+s"(wgu_), "+s"(wdn_));
                ScanArgs sa{(const h16*)(ws + WS_R), (const h16*)(ws + WS_K), (const h16*)(ws + (l == 0 ? WS_VF : WS_V)), (const h16*)(ws + WS_WD), (const h16*)(ws + WS_AA), (const h16*)(ws + WS_GG),
                            KIN(I_KK) + (size_t)l * D, KIN(I_KA) + (size_t)l * D, KIN(I_RK) + (size_t)l * D, KIN(I_LNXG) + (size_t)l * D, KIN(I_LNXB) + (size_t)l * D, (h16*)(ws + WS_YG), wgu_, wdn_, ws + WS_W_GU, ws + WS_W_DN, l};
                phase_scan_mm(sa, lds, blk, G, wave);
            }
            GRID_BAR();
            PH_BEGIN;
            {
                SchedPlain S{(const char*)(ws + WS_YG), (const char*)(ws + WS_W_RO) + (size_t)l * 1024 * 2048, 4, G, blk};
                if (l == 0) { EpiRes<false> E{KIN(I_X), (h16*)(ws + WS_H)}; GEMM_PHASE(S, E, 1024); }
                else { EpiRes<true> E{ws + WS_XH, (h16*)(ws + WS_H)}; GEMM_PHASE(S, E, 1024); }
            }
            GRID_BAR();
        } else {
            const int j = l - 2;
            PH_BEGIN;
            if (l == 2) {
                { SchedPlain S{(const char*)(ws + WS_XH), (const char*)(ws + WS_W_Q), 4, G, blk}; EpiQkv E{(h16*)(ws + WS_Q), nullptr, QSCALE}; GEMM_PHASE(S, E, 1024); }
                { SchedPlain S{(const char*)(ws + WS_XH), (const char*)(ws + WS_W_KV), 8, G, blk}; EpiQkv E{(h16*)(ws + WS_KK), (h16*)(ws + WS_VV), 1.0f}; GEMM_PHASE(S, E, 1024); }
            } else {
                SchedPlain S{(const char*)(ws + WS_XH), (const char*)(ws + WS_W_Q) + (size_t)j * 1024 * 2048, 4, G, blk}; EpiQkv E{(h16*)(ws + WS_Q), nullptr, QSCALE}; GEMM_PHASE(S, E, 1024);
            }
            GRID_BAR();
            PH_BEGIN;
            phase_attn((const h16*)(ws + WS_Q), (const h16*)(ws + WS_KK), (const h16*)(ws + WS_VV), (h16*)(ws + WS_ORAW), (char*)lds_raw, blk, G, wave);
            GRID_BAR();
            PH_BEGIN;
            phase_attn_combine((const h16*)(ws + WS_ORAW), KIN(I_DALAM) + (size_t)j * 256, KIN(I_DASUB) + (size_t)j * 128, 0.8f - 0.6f * expf(-0.3f * (float)l), (h16*)(ws + WS_OB), gw, NGW, lane);
            GRID_BAR();
            PH_BEGIN;
            {
                SchedPlain S{(const char*)(ws + WS_OB), (const char*)(ws + WS_W_AO) + (size_t)j * 1024 * 2048, 4, G, blk};
                EpiRes<true> E{ws + WS_XH, (h16*)(ws + WS_H)};
                GEMM_PHASE(S, E, 1024);
            }
            GRID_BAR();
        }
        PH_BEGIN;
        {
            RouterArgs ra{(const h16*)(ws + WS_H), KIN(I_LNG) + (size_t)(l * 2) * D, KIN(I_LNB) + (size_t)(l * 2) * D, (const h16*)(ws + WS_WR) + (size_t)l * 2 * 32 * 1024, KIN(I_RB) + (size_t)l * NEXP,
                          (h16*)(ws + WS_X1), (unsigned char*)(ws + WS_XB), (float*)(ws + WS_TOPG), (int*)(ws + WS_LIST), ctl + CW_CNT + l * 32};
            phase_ln_router(ra, lds, blk, G, wave);
        }
        GRID_BAR();
        PH_BEGIN;
        moe_tables(ctl + CW_CNT + l * 32, MISC, (LAS int*)(lds + TILE_E_OFF), wave);
        {
            SchedMoe S{(const LAS unsigned*)MISC, (const LAS int*)(lds + TILE_E_OFF), (const char*)(ws + WS_XB), (const char*)(ws + WS_W_GU) + (size_t)l * 32 * 2048 * 1024, (const int*)(ws + WS_LIST), 8, 1, G, blk, (size_t)2048 * 1024};
            EpiGu E{(unsigned char*)(ws + WS_ACT), KIN(I_BGU) + (size_t)l * 32 * 2048};
            GEMM_PHASE8(S, E, 1024);
        }
        GRID_BAR();
        PH_BEGIN;
        {
            SchedMoe S{(const LAS unsigned*)MISC, (const LAS int*)(lds + TILE_E_OFF), (const char*)(ws + WS_ACT), (const char*)(ws + WS_W_DN) + (size_t)l * 32 * 1024 * 1024, (const int*)(ws + WS_LIST), 4, 0, G, blk, (size_t)1024 * 1024};
            EpiDn E{(unsigned char*)(ws + WS_YS), KIN(I_BDN) + (size_t)l * 32 * 1024, (const float*)(ws + WS_TOPG)};
            GEMM_PHASE8(S, E, 1024);
        }
        GRID_BAR();
        PH_BEGIN;
        phase_combine((const h16*)(ws + WS_X1), (const unsigned char*)(ws + WS_YS), KIN(I_LNG) + (size_t)(l * 2 + 1) * D, KIN(I_LNB) + (size_t)(l * 2 + 1) * D,
                      l == 3 ? KOUT : (float*)nullptr, (h16*)(ws + WS_XH), gw, NGW, lane);
        if (l < 3) GRID_BAR();
    }
    if (xb_ld(ctl + CW_BAR + XB_TMO) != 0u && wave == 0 && lane_id() == 0) KOUT[(size_t)blk * D] = __builtin_nanf("");
}

extern "C" void kernel_launch(void* const* d_in, const int* in_sizes, int n_in, void* d_out, int out_size, void* d_ws, size_t ws_size, hipStream_t stream) {
    static int grid = 0;
    if (grid == 0) {
        if (n_in != 33 || out_size != T * D || ws_size < WS_END) { fprintf(stderr, "kernel_launch: unexpected shapes (n_in %d out %d ws %zu)\n", n_in, out_size, ws_size); grid = -1; return; }
        if (hipFuncSetAttribute((const void*)yoco_fwd, hipFuncAttributeMaxDynamicSharedMemorySize, LDS_BYTES) != hipSuccess) { fprintf(stderr, "kernel_launch: hipFuncSetAttribute failed\n"); grid = -1; return; }
        int dev = 0, cus = 0, per_cu = 0;
        hipGetDevice(&dev); hipDeviceGetAttribute(&cus, hipDeviceAttributeMultiprocessorCount, dev);
        hipOccupancyMaxActiveBlocksPerMultiprocessor(&per_cu, (const void*)yoco_fwd, NTHR, LDS_BYTES);
        (void)hipGetLastError();
        if (per_cu < 1) fprintf(stderr, "kernel_launch: occupancy query reports %d\n", per_cu);
        grid = cus < 256 ? cus : 256;
    }
    if (grid < 0) return;
    hipMemsetAsync((char*)d_ws + WS_CTL, 0, CTL_ZERO_BYTES, stream);
    Args a{};
    for (int i = 0; i < 33; ++i) a.in[i] = (const float*)d_in[i];
    a.out = (float*)d_out; a.ws = (unsigned char*)d_ws; a.ph_lo = 0; a.ph_hi = 0;
    hipLaunchKernelGGL(yoco_fwd, dim3(grid), dim3(NTHR), LDS_BYTES, stream, a);
}
```

```cpp
#include <hip/hip_runtime.h>
#include <cstdio>
#include <cstdint>
#include <cmath>

#define LAS __attribute__((address_space(3)))
#define GAS __attribute__((address_space(1)))
typedef _Float16 h16;
typedef _Float16 h16x8 __attribute__((ext_vector_type(8)));
typedef _Float16 h16x4 __attribute__((ext_vector_type(4)));
typedef _Float16 h16x2 __attribute__((ext_vector_type(2)));
typedef float f32x4 __attribute__((ext_vector_type(4)));
typedef float f32x2 __attribute__((ext_vector_type(2)));
typedef unsigned u32x4 __attribute__((ext_vector_type(4)));
typedef unsigned u32x2 __attribute__((ext_vector_type(2)));

constexpr int D = 1024, NBATCH = 16, SEQ = 2048, T = NBATCH * SEQ;
constexpr int NEXP = 32, TOPK = 4, ECAP = T;
constexpr int NWAVES = 8, NTHR = NWAVES * 64;
constexpr float ALPHA = 1.6817928305074290f;
constexpr float LN_EPS = 1e-5f;
constexpr float QSCALE = 0.125f * 1.4426950408889634f;
constexpr float LOG2E = 1.4426950408889634f;
constexpr float GU_SCALE = 64.0f, DN_SCALE = 128.0f, YS_SCALE = 16.0f;

constexpr size_t MiB = 1u << 20;
constexpr size_t WS_CTL = 0, CTL_ZERO_BYTES = 1 * MiB;
constexpr size_t WS_W_RKV = 2 * MiB;
constexpr size_t WS_W_RO = 14 * MiB;
constexpr size_t WS_W_L1 = 18 * MiB;
constexpr size_t WS_W_L2 = 22 * MiB;
constexpr size_t WS_W_KV = 26 * MiB;
constexpr size_t WS_W_Q = 30 * MiB;
constexpr size_t WS_W_AO = 34 * MiB;
constexpr size_t WS_WR = 38 * MiB;
constexpr size_t WS_W_GU = 40 * MiB;
constexpr size_t WS_W_DN = 552 * MiB;
constexpr size_t WS_X = 808 * MiB;
constexpr size_t WS_X1 = 936 * MiB;
constexpr size_t WS_H = 1064 * MiB;
constexpr size_t WS_XB = 1192 * MiB;
constexpr size_t WS_XH = 1256 * MiB;
constexpr size_t WS_TOPG = 1320 * MiB;
constexpr size_t WS_LIST = 1321 * MiB;
constexpr size_t WS_ACT = 1328 * MiB;
constexpr size_t WS_YS = 1616 * MiB;
constexpr size_t WS_XM = 1872 * MiB;
constexpr size_t WS_R = 2256 * MiB, WS_K = 2384 * MiB, WS_V = 2512 * MiB, WS_VF = 2640 * MiB;
constexpr size_t WS_L1O = 2768 * MiB;
constexpr size_t WS_WD = 2832 * MiB, WS_AA = 2960 * MiB, WS_GG = 3088 * MiB;
constexpr size_t WS_YG = 3216 * MiB;
constexpr size_t WS_END = 3280 * MiB;
constexpr size_t WS_Q = 1872 * MiB, WS_KK = 1936 * MiB, WS_VV = 2000 * MiB;
constexpr size_t WS_ORAW = 2064 * MiB;
constexpr size_t WS_OB = 2192 * MiB;
constexpr int CW_BAR = 4096;
constexpr int CW_CNT = 16384;

constexpr int LDS_BYTES = 147456;
constexpr int MISC_OFF = 146432;
constexpr int TILE_E_OFF = 143360;

template <int CTRL> __device__ __forceinline__ float dppf(float v) { return __builtin_bit_cast(float, __builtin_amdgcn_mov_dpp(__builtin_bit_cast(int, v), CTRL, 0xF, 0xF, true)); }
__device__ __forceinline__ float swz16f(float v) { return __builtin_bit_cast(float, __builtin_amdgcn_ds_swizzle(__builtin_bit_cast(int, v), (16 << 10) | 0x1F)); }
__device__ __forceinline__ float grp8_sum(float v) { v += dppf<0xB1>(v); v += dppf<0x4E>(v); v += dppf<0x141>(v); return v; }
__device__ __forceinline__ float wave_sum(float v) {
    v += dppf<0xB1>(v); v += dppf<0x4E>(v); v += dppf<0x141>(v); v += dppf<0x140>(v); v += swz16f(v);
    return __builtin_bit_cast(float, __builtin_amdgcn_readlane(__builtin_bit_cast(int, v), 0)) + __builtin_bit_cast(float, __builtin_amdgcn_readlane(__builtin_bit_cast(int, v), 32));
}
__device__ __forceinline__ float wave_max(float v) {
    v = fmaxf(v, dppf<0xB1>(v)); v = fmaxf(v, dppf<0x4E>(v)); v = fmaxf(v, dppf<0x141>(v)); v = fmaxf(v, dppf<0x140>(v)); v = fmaxf(v, swz16f(v));
    return fmaxf(__builtin_bit_cast(float, __builtin_amdgcn_readlane(__builtin_bit_cast(int, v), 0)), __builtin_bit_cast(float, __builtin_amdgcn_readlane(__builtin_bit_cast(int, v), 32)));
}
__device__ __forceinline__ unsigned pkh(float a, float b) { h16x2 v = {(h16)a, (h16)b}; return __builtin_bit_cast(unsigned, v); }
__device__ __forceinline__ u32x2 pkh4(f32x4 v) { u32x2 r; r.x = pkh(v.x, v.y); r.y = pkh(v.z, v.w); return r; }
__device__ __forceinline__ f32x4 ldh4(const h16* p) { const h16x4 v = *(const h16x4*)p; return __builtin_convertvector(v, f32x4); }
__device__ __forceinline__ float sigmoidf_(float x) { return __builtin_amdgcn_rcpf(1.0f + __builtin_amdgcn_exp2f(-1.4426950408889634f * x)); }
__device__ __forceinline__ int lane_id() { int l; asm volatile("v_mbcnt_lo_u32_b32 %0, -1, 0\n\tv_mbcnt_hi_u32_b32 %0, -1, %0" : "=v"(l)); return l; }
#define LDS_WAIT() asm volatile("s_waitcnt lgkmcnt(0)" ::: "memory")
#define OPAQUE(x) asm volatile("" : "+v"(x))

#define XB_TMO      128
#define XB_XCNT(j)  (256  + 64 * (j))
#define XB_XSUB(j)  (1280 + 64 * (j))
#define XB_XGEN(j)  (2304 + 64 * (j))
#define XB_TOP      3328
#define XB_TOPGEN   3392
#define XCD_BAR_WORDS 3456
#define XB_SPIN_CAP (1u << 21)

__device__ __forceinline__ unsigned xb_ld(unsigned* p)              { return __hip_atomic_load((GAS unsigned*)p, __ATOMIC_RELAXED, __HIP_MEMORY_SCOPE_AGENT); }
__device__ __forceinline__ unsigned xb_add(unsigned* p, unsigned v) { return __hip_atomic_fetch_add((GAS unsigned*)p, v, __ATOMIC_RELAXED, __HIP_MEMORY_SCOPE_AGENT); }
__device__ __forceinline__ unsigned xb_xcc_id() { return (unsigned)__builtin_amdgcn_s_getreg((3 << 11) | 20) & 0xFu; }
#define XB_SPIN(cond, bar) do { unsigned _sp = 0; while (cond) { __builtin_amdgcn_s_sleep(1); \
    if ((++_sp & 255u) == 0u) { if (xb_ld(&(bar)[XB_TMO])) break; if (_sp > XB_SPIN_CAP) { (void)xb_add(&(bar)[XB_TMO], 1u); break; } } } } while (0)

struct XcdBarrier { unsigned* bar; unsigned x; volatile LAS unsigned* st; };

__device__ __forceinline__ XcdBarrier xcd_barrier_post(unsigned* bar, volatile LAS unsigned* st, const int wave) {
    XcdBarrier b; b.bar = bar; b.x = xb_xcc_id(); b.st = st;
    if (wave == 0 && lane_id() == 0) (void)xb_add(&bar[XB_XCNT(b.x)], 1u);
    return b;
}
__device__ __forceinline__ void xcd_barrier_complete(unsigned* bar, unsigned x, unsigned& nloc, unsigned& nx) {
    const unsigned G = gridDim.x * gridDim.y * gridDim.z;
    unsigned sum, cnt, mine, sp = 0u;
    for (;;) {
        sum = 0u; cnt = 0u; mine = 0u;
#pragma unroll
        for (unsigned j = 0; j < 16; ++j) { const unsigned c = xb_ld(&bar[XB_XCNT(j)]); sum += c; cnt += (c > 0u) ? 1u : 0u; mine = (j == x) ? c : mine; }
        if (sum == G) break;
        __builtin_amdgcn_s_sleep(1);
        if ((++sp & 255u) == 0u) { if (xb_ld(&bar[XB_TMO])) break; if (sp > XB_SPIN_CAP) { (void)xb_add(&bar[XB_TMO], 1u); break; } }
    }
    nloc = mine > 0u ? mine : 1u; nx = cnt > 0u ? cnt : 1u;
}
__device__ __forceinline__ void xcd_barrier(const XcdBarrier& b, const int wave) {
    asm volatile("s_waitcnt vmcnt(0)" ::: "memory");
    __syncthreads();
    if (wave == 0 && lane_id() == 0) {
        unsigned* bar = b.bar; unsigned bx = b.x;
        asm volatile("" : "+s"(bar), "+s"(bx));
        __builtin_amdgcn_s_waitcnt(0);
        unsigned nloc = b.st[0], nx = b.st[1];
        if (nloc == 0u) { xcd_barrier_complete(bar, bx, nloc, nx); b.st[0] = nloc; b.st[1] = nx; }
        const unsigned old = xb_add(&bar[XB_XSUB(bx)], 1u);
        const unsigned gen = old / nloc;
        if (old + 1u == (gen + 1u) * nloc) {
            __builtin_amdgcn_fence(__ATOMIC_RELEASE, "agent");
            asm volatile("s_waitcnt vmcnt(0)" ::: "memory");
            const unsigned og = xb_add(&bar[XB_TOP], 1u);
            const unsigned tg = og / nx;
            if (og + 1u == (tg + 1u) * nx) xb_add(&bar[XB_TOPGEN], 1u);
            else XB_SPIN(xb_ld(&bar[XB_TOPGEN]) == tg, bar);
            __builtin_amdgcn_fence(__ATOMIC_ACQUIRE, "agent");
            xb_add(&bar[XB_XGEN(bx)], 1u);
            asm volatile("s_waitcnt vmcnt(0)" ::: "memory");
        } else {
            XB_SPIN(xb_ld(&bar[XB_XGEN(bx)]) == gen, bar);
            __builtin_amdgcn_fence(__ATOMIC_ACQUIRE, "agent");
            asm volatile("s_waitcnt vmcnt(0)" ::: "memory");
        }
    }
    __syncthreads();
}

__device__ __forceinline__ void conv_batch(const float* src, int batch, int Kr, int Nr, h16* dst, int Kp, int Np, int perm, LAS float* scr, int gw, int NGW, int lane) {
    lane = lane_id(); OPAQUE(lane);
    const int kbn = Kp / 64, nbn = Np / 32, per = kbn * nbn, total = batch * per;
    for (int it = gw; it < total; it += NGW) {
        const int bi = it / per, r = it - bi * per, kb = r / nbn, nb = r - kb * nbn, k0 = 64 * kb, n0 = 32 * nb;
        const float* W = src + (size_t)bi * Kr * Nr; h16* WT = dst + (size_t)bi * Np * Kp;
        float vals[32];
#pragma unroll
        for (int i = 0; i < 32; ++i) { const int k = k0 + 2 * i + (lane >> 5), n = n0 + (lane & 31); vals[i] = (k < Kr && n < Nr) ? W[(size_t)k * Nr + n] : 0.f; }
#pragma unroll
        for (int i = 0; i < 32; ++i) { float x = vals[i]; if (perm == 2) x = (x - (float)(h16)x) * 4096.0f; scr[(2 * i + (lane >> 5)) * 33 + (lane & 31)] = x; }
        LDS_WAIT();
        const int c = lane & 7;
#pragma unroll
        for (int j = 0; j < 4; ++j) { const int nl = (lane >> 3) + 8 * j; const LAS float* s = scr + (8 * c) * 33 + nl;
            u32x4 o; o.x = pkh(s[0 * 33], s[1 * 33]); o.y = pkh(s[2 * 33], s[3 * 33]); o.z = pkh(s[4 * 33], s[5 * 33]); o.w = pkh(s[6 * 33], s[7 * 33]);
            int n = n0 + nl; if (perm == 1) n = ((n & 1023) >> 7) * 256 + (n >> 10) * 128 + (n & 127);
            *(u32x4*)(WT + (size_t)n * Kp + k0 + 8 * c) = o; }
        LDS_WAIT();
    }
}


__device__ __forceinline__ void conv_batch8(const float* src, int batch, int Kr, int Nr, unsigned char* dst, int Kp, int Np, int perm, float scale, LAS float* scr, int gw_, int NGW_, int lane) {
    lane = lane_id(); OPAQUE(lane);
    const int kbn = Kp / 128, nbn = Np / 32, per = kbn * nbn, total = batch * per;
    for (int it = gw_; it < total; it += NGW_) {
        const int bi = it / per, r = it - bi * per, kb = r / nbn, nb = r - kb * nbn, k0 = 128 * kb, n0 = 32 * nb;
        const float* W = src + (size_t)bi * Kr * Nr; unsigned char* WT = dst + (size_t)bi * Np * Kp;
        float vals[64];
#pragma unroll
        for (int i = 0; i < 64; ++i) { const int k = k0 + 2 * i + (lane >> 5), n = n0 + (lane & 31); vals[i] = (k < Kr && n < Nr) ? W[(size_t)k * Nr + n] : 0.f; }
#pragma unroll
        for (int i = 0; i < 64; ++i) scr[(2 * i + (lane >> 5)) * 33 + (lane & 31)] = vals[i] * scale;
        LDS_WAIT();
        const int c = lane & 7;
#pragma unroll
        for (int j = 0; j < 4; ++j) { const int nl = (lane >> 3) + 8 * j; const LAS float* sp = scr + (16 * c) * 33 + nl; u32x4 o;
#pragma unroll
            for (int q = 0; q < 4; ++q) { int w_ = __builtin_amdgcn_cvt_pk_fp8_f32(sp[(4 * q) * 33], sp[(4 * q + 1) * 33], 0, false); w_ = __builtin_amdgcn_cvt_pk_fp8_f32(sp[(4 * q + 2) * 33], sp[(4 * q + 3) * 33], w_, true); o[q] = (unsigned)w_; }
            int n = n0 + nl; if (perm) n = ((n & 1023) >> 7) * 256 + (n >> 10) * 128 + (n & 127);
            *(u32x4*)(WT + (size_t)n * Kp + k0 + 16 * c) = o; }
        LDS_WAIT();
    }
}

struct Unit { int pm, pn, kind, e, rows, rbase; const char* A; const char* B; const int* list; };

struct DenseDesc { const char* A; const char* B; int kind, pn; };

namespace pg8 {
constexpr int BM = 256, BK = 64, HALF = 128, HTB = HALF * BK * 2, STAGE_BYTES = 8 * HTB;
__device__ __forceinline__ int lds_byte(int r, int c) { const int st = (r >> 4) * 2 + (c >> 5), rr = r & 15, cc = c & 31, ob = rr * 64 + cc * 2; return st * 1024 + (ob ^ (((ob >> 9) & 1) << 5)); }
__device__ __forceinline__ void stage_rc(int b, int& R, int& C) { const int st = b / 1024, sb = b % 1024, swz = sb ^ (((sb >> 9) & 1) << 5); R = (st >> 1) * 16 + swz / 64; C = (st & 1) * 32 + (swz % 64) / 2; }
}
typedef int i32x4 __attribute__((ext_vector_type(4)));
typedef int i32x8 __attribute__((ext_vector_type(8)));
template <bool FP8, class Sched, class Epi>
__device__ __forceinline__ void gemm_phase_pg8(LAS unsigned char* lds, const Sched& S, const Epi& E, const int Kb, const int wave) {
    using namespace pg8;
    int tid = wave * 64 + lane_id(); OPAQUE(tid);
    const int wid = wave, lane = tid & 63, wr = wid >> 2, wc = wid & 3, fr = lane & 15, fq = lane >> 4;
    const int nt = Kb / 128;
    int Rs[2], Cs[2]; unsigned voffB[2];
#pragma unroll
    for (int i = 0; i < 2; ++i) { stage_rc(tid * 16 + i * 8192, Rs[i], Cs[i]); voffB[i] = (unsigned)(Rs[i] * Kb + Cs[i] * 2); }
    const size_t kstep = (size_t)128;
    const size_t hstepB = (size_t)HALF * Kb;
    const unsigned ldsw = (unsigned)wid * 1024u;
    const int aoff = lds_byte(wr * 64 + fr, fq * 8), boff = lds_byte(wc * 32 + fr, fq * 8);
#define PG8_SA(b, h) (((b) * 2 + (h)) * HTB)
#define PG8_SB(b, h) ((4 + (b) * 2 + (h)) * HTB)
#define PG8_STAGE(bufoff, gbase, voff) do { _Pragma("unroll") for (int _i = 0; _i < 2; ++_i) \
        __builtin_amdgcn_global_load_lds((const unsigned*)((const char*)(gbase) + (voff)[_i]), (LAS unsigned*)(lds + (bufoff) + ldsw + _i * 8192), 16, 0, 0); } while (0)
#define PG8_LDA(dst, b, h) do { _Pragma("unroll") for (int m = 0; m < 4; ++m) _Pragma("unroll") for (int k = 0; k < 2; ++k) dst[m][k] = *(const LAS h16x8*)(lds + PG8_SA(b, h) + aoff + m * 2048 + k * 1024); } while (0)
#define PG8_LDB(dst, b, h) do { _Pragma("unroll") for (int n = 0; n < 2; ++n) _Pragma("unroll") for (int k = 0; k < 2; ++k) dst[n][k] = *(const LAS h16x8*)(lds + PG8_SB(b, h) + boff + n * 2048 + k * 1024); } while (0)
#define PG8_MMA(ai, bj, At, Bt) do { __builtin_amdgcn_s_setprio(1); \
        if (FP8) { _Pragma("unroll") for (int m = 0; m < 4; ++m) _Pragma("unroll") for (int n = 0; n < 2; ++n) { \
            const i32x4 b0_ = __builtin_bit_cast(i32x4, Bt[n][0]), b1_ = __builtin_bit_cast(i32x4, Bt[n][1]), a0_ = __builtin_bit_cast(i32x4, At[m][0]), a1_ = __builtin_bit_cast(i32x4, At[m][1]); \
            acc[ai][bj][m][n] = __builtin_amdgcn_mfma_scale_f32_16x16x128_f8f6f4(__builtin_shufflevector(b0_, b1_, 0, 1, 2, 3, 4, 5, 6, 7), __builtin_shufflevector(a0_, a1_, 0, 1, 2, 3, 4, 5, 6, 7), acc[ai][bj][m][n], 0, 0, 0, 0, 0, 0); } } \
        else { _Pragma("unroll") for (int m = 0; m < 4; ++m) _Pragma("unroll") for (int n = 0; n < 2; ++n) _Pragma("unroll") for (int k = 0; k < 2; ++k) \
            acc[ai][bj][m][n] = __builtin_amdgcn_mfma_f32_16x16x32_f16(Bt[n][k], At[m][k], acc[ai][bj][m][n], 0, 0, 0); } \
        __builtin_amdgcn_s_setprio(0); } while (0)
#define PG8_WAIT_V(n) asm volatile("s_waitcnt vmcnt(" #n ")" ::: "memory")
#define PG8_WAIT_L(n) asm volatile("s_waitcnt lgkmcnt(" #n ")" ::: "memory")
#define PG8_BAR __builtin_amdgcn_s_barrier()
#define PG8_SCHED __builtin_amdgcn_sched_barrier(0)
    Unit cur, nxt; int ui = 0;
    if (!S.next(0, cur)) return;
    f32x4 acc[2][2][4][2];
#pragma unroll
    for (int a = 0; a < 2; ++a)
#pragma unroll
        for (int b = 0; b < 2; ++b)
#pragma unroll
            for (int m = 0; m < 4; ++m)
#pragma unroll
                for (int n = 0; n < 2; ++n) acc[a][b][m][n] = (f32x4){0.f, 0.f, 0.f, 0.f};
    h16x8 At[4][2], B0[2][2], B1[2][2];
    unsigned vA[2][2], vAn[2][2];
#pragma unroll
    for (int h = 0; h < 2; ++h)
#pragma unroll
        for (int i = 0; i < 2; ++i) vA[h][i] = S.a_off(cur, 128 * h + Rs[i]) + (unsigned)Cs[i] * 2u;
    const char* cA = cur.A; const char* cB = cur.B;
    PG8_STAGE(PG8_SB(0, 0), cB, voffB); PG8_STAGE(PG8_SB(0, 1), cB + hstepB, voffB); PG8_STAGE(PG8_SA(0, 0), cA, vA[0]); PG8_STAGE(PG8_SA(0, 1), cA, vA[1]);
    if (wr == 1) PG8_BAR;
    PG8_WAIT_V(2); PG8_BAR;
    PG8_STAGE(PG8_SB(1, 0), cB + kstep, voffB); PG8_STAGE(PG8_SA(1, 0), cA + kstep, vA[0]); PG8_STAGE(PG8_SB(1, 1), cB + hstepB + kstep, voffB);
    PG8_WAIT_V(6); PG8_BAR;
    for (;;) {
        const bool has_next = S.next(ui + 1, nxt);
        const char* nA = has_next ? nxt.A : cA; const char* nB = has_next ? nxt.B : cB;
#pragma unroll
        for (int h = 0; h < 2; ++h)
#pragma unroll
            for (int i = 0; i < 2; ++i) vAn[h][i] = has_next ? (S.a_off(nxt, 128 * h + Rs[i]) + (unsigned)Cs[i] * 2u) : vA[h][i];
#pragma unroll 1
        for (int t = 0; t < nt; t += 2) {
            const bool last = (t == nt - 2);
            const char* a1 = cA + (size_t)(t + 1) * kstep;
            const char* a2 = last ? nA : cA + (size_t)(t + 2) * kstep; const char* b2 = last ? nB : cB + (size_t)(t + 2) * kstep;
            const char* a3 = a2 + kstep; const char* b3 = b2 + kstep;
            PG8_LDB(B0, 0, 0); PG8_LDB(B1, 0, 1); PG8_SCHED; PG8_LDA(At, 0, 0); PG8_STAGE(PG8_SA(1, 1), a1, vA[1]);
            if (last) { vA[0][0] = vAn[0][0]; vA[0][1] = vAn[0][1]; vA[1][0] = vAn[1][0]; vA[1][1] = vAn[1][1]; }
            PG8_WAIT_V(8); PG8_WAIT_L(0); PG8_BAR; PG8_MMA(0, 0, At, B0); PG8_MMA(0, 1, At, B1); PG8_BAR; PG8_SCHED;
            PG8_LDA(At, 0, 1); PG8_STAGE(PG8_SB(0, 0), b2, voffB); PG8_STAGE(PG8_SB(0, 1), b2 + hstepB, voffB); PG8_STAGE(PG8_SA(0, 0), a2, vA[0]);
            PG8_WAIT_V(8); PG8_WAIT_L(0); PG8_BAR; PG8_MMA(1, 0, At, B0); PG8_MMA(1, 1, At, B1); PG8_BAR; PG8_SCHED;
            PG8_LDB(B0, 1, 0); PG8_LDB(B1, 1, 1); PG8_SCHED; PG8_LDA(At, 1, 0); PG8_STAGE(PG8_SA(0, 1), a2, vA[1]);
            PG8_WAIT_V(8); PG8_WAIT_L(0); PG8_BAR; PG8_MMA(0, 0, At, B0); PG8_MMA(0, 1, At, B1); PG8_BAR; PG8_SCHED;
            PG8_LDA(At, 1, 1); PG8_STAGE(PG8_SB(1, 0), b3, voffB); PG8_STAGE(PG8_SB(1, 1), b3 + hstepB, voffB); PG8_STAGE(PG8_SA(1, 0), a3, vA[0]);
            PG8_WAIT_V(8); PG8_WAIT_L(0); PG8_BAR; PG8_MMA(1, 0, At, B0); PG8_MMA(1, 1, At, B1); PG8_BAR; PG8_SCHED;
        }
        if (wr == 0) PG8_BAR;
        { int fr_e = fr, fq_e = fq; OPAQUE(fr_e); OPAQUE(fq_e);
          E(acc, cur, wr, wc, fr_e, fq_e); }
        if (!has_next) break;
#pragma unroll
        for (int a = 0; a < 2; ++a)
#pragma unroll
            for (int b = 0; b < 2; ++b)
#pragma unroll
                for (int m = 0; m < 4; ++m)
#pragma unroll
                    for (int n = 0; n < 2; ++n) acc[a][b][m][n] = (f32x4){0.f, 0.f, 0.f, 0.f};
        cur = nxt; cA = nA; cB = nB; ++ui;
        if (wr == 1) PG8_BAR;
    }
    PG8_WAIT_V(0);
    PG8_BAR;
#undef PG8_SA
#undef PG8_SB
#undef PG8_STAGE
#undef PG8_LDA
#undef PG8_LDB
#undef PG8_MMA
#undef PG8_WAIT_V
#undef PG8_WAIT_L
#undef PG8_BAR
#undef PG8_SCHED
}
#define GEMM_PHASE(S, E, K) gemm_phase_pg8<false>(lds, S, E, (K) * 2, wave)
#define GEMM_PHASE8(S, E, K) gemm_phase_pg8<true>(lds, S, E, (K), wave)

#define FOR_ACC(ai, bj, m, n) _Pragma("unroll") for (int ai = 0; ai < 2; ++ai) _Pragma("unroll") for (int m = 0; m < 4; ++m) _Pragma("unroll") for (int bj = 0; bj < 2; ++bj) _Pragma("unroll") for (int n = 0; n < 2; ++n)
#define EPI_FENCE() asm volatile("" ::: "memory")

template <bool F16IN>
__device__ __forceinline__ void phase_prep(const void* Xv, const float* mix, h16* XM, int gw_, int NGW_, int lane) {
    lane = lane_id(); OPAQUE(lane);
    const float* Xf = (const float*)Xv; const h16* Xh = (const h16*)Xv;
    for (int ch = gw_; ch < T / 16; ch += NGW_) {
        const int t0 = ch * 16;
        f32x4 prev[4];
        if ((t0 % SEQ) == 0) {
#pragma unroll
            for (int j = 0; j < 4; ++j) prev[j] = (f32x4){0.f, 0.f, 0.f, 0.f};
        } else {
#pragma unroll
            for (int j = 0; j < 4; ++j) prev[j] = F16IN ? ldh4(Xh + (size_t)(t0 - 1) * D + 256 * j + 4 * lane) : *(const f32x4*)(Xf + (size_t)(t0 - 1) * D + 256 * j + 4 * lane);
        }
#pragma unroll 1
        for (int ib = 0; ib < 4; ++ib) {
            f32x4 cur[4][4]; h16x4 curh[4][4];
#pragma unroll
            for (int q = 0; q < 4; ++q)
#pragma unroll
                for (int j = 0; j < 4; ++j) { if (F16IN) curh[q][j] = *(const h16x4*)(Xh + (size_t)(t0 + 4 * ib + q) * D + 256 * j + 4 * lane); else cur[q][j] = *(const f32x4*)(Xf + (size_t)(t0 + 4 * ib + q) * D + 256 * j + 4 * lane); }
            if (F16IN) {
#pragma unroll
                for (int q = 0; q < 4; ++q)
#pragma unroll
                    for (int j = 0; j < 4; ++j) cur[q][j] = __builtin_convertvector(curh[q][j], f32x4);
            }
#pragma unroll
            for (int q = 0; q < 4; ++q) {
                const int t = t0 + 4 * ib + q;
#pragma unroll
                for (int s = 0; s < 6; ++s) {
#pragma unroll
                    for (int j = 0; j < 4; ++j) { const f32x4 mx = *(const f32x4*)(mix + s * D + 256 * j + 4 * lane);
                        const f32x4 pv = (q == 0) ? prev[j] : cur[q == 0 ? 0 : q - 1][j];
                        const f32x4 v = cur[q][j] + (pv - cur[q][j]) * mx;
                        *(u32x2*)(XM + ((size_t)s * T + t) * D + 256 * j + 4 * lane) = pkh4(v); }
                }
            }
#pragma unroll
            for (int j = 0; j < 4; ++j) prev[j] = cur[3][j];
        }
    }
}

struct ScanArgs { const h16 *R, *K, *V; const h16* WD; const h16 *AA, *GG; const float *k_k, *k_a, *r_k, *lnx_g, *lnx_b; h16* YG; const float *wgu, *wdn; unsigned char *gu8, *dn8; int layer_pair; };
__device__ __forceinline__ float row16_sum(float v) { v += dppf<0xB1>(v); v += dppf<0x4E>(v); v += dppf<0x141>(v); v += dppf<0x140>(v); return v; }
struct ConvItem2 { const float* Wrow; unsigned char* WTp; int Nr; float scale; bool valid; };
__device__ __forceinline__ ConvItem2 conv_item2(int sit, int wave, int lane, int layer_pair, const float* wgu, const float* wdn, unsigned char* gu8) {
    ConvItem2 ci; ci.valid = sit < 12288;
    const int s = ci.valid ? sit : 0, ls = s / 6144, r = s - ls * 6144, e = r / 192, q = r - e * 192, le = (layer_pair * 2 + ls) * 32 + e;
    const bool gu = q < 128; const int q2 = gu ? q : q - 128, nb = gu ? (q2 & 31) : (q2 & 15), kq = gu ? (q2 >> 5) : (q2 >> 4), Nr = gu ? 2048 : 1024;
    const int k0 = kq * 256 + wave * 32, n = nb * 64 + lane, nrow = gu ? ((n & 1023) >> 7) * 256 + (n >> 10) * 128 + (n & 127) : n;
    size_t wb; { const int gi = __builtin_amdgcn_readfirstlane(gu ? 1 : 0); asm("s_cmp_lg_u32 %1, 0\n\ts_cselect_b64 %0, %2, %3" : "=s"(wb) : "s"(gi), "s"(wgu), "s"(wdn) : "scc"); }
    const size_t ob = (size_t)gu8 + (gu ? (size_t)0 : (size_t)(WS_W_DN - WS_W_GU));
    ci.Wrow = (const float*)wb + (size_t)le * 1024 * Nr + (size_t)k0 * Nr + nb * 64; ci.WTp = (unsigned char*)ob + (size_t)le * Nr * 1024 + (size_t)nrow * 1024 + k0; ci.Nr = Nr; ci.scale = gu ? GU_SCALE : DN_SCALE;
    return ci;
}
__device__ __forceinline__ void conv_issue2(const ConvItem2& ci, float (&vals)[32], int lane) {
    if (ci.valid) {
        const GAS char* p = (const GAS char*)ci.Wrow; const unsigned lo = (unsigned)lane * 4u; const size_t stride = (size_t)ci.Nr * 4;
#pragma unroll
        for (int i = 0; i < 32; ++i) { vals[i] = __builtin_nontemporal_load((const GAS float*)(p + lo)); p += stride; }
    }
}
__device__ __forceinline__ void conv_finish2(const ConvItem2& ci, const float (&vals)[32]) {
    if (ci.valid) {
#pragma unroll
        for (int j = 0; j < 2; ++j) { u32x4 o;
#pragma unroll
            for (int q = 0; q < 4; ++q) { int pk_ = __builtin_amdgcn_cvt_pk_fp8_f32(vals[16 * j + 4 * q] * ci.scale, vals[16 * j + 4 * q + 1] * ci.scale, 0, false);
                pk_ = __builtin_amdgcn_cvt_pk_fp8_f32(vals[16 * j + 4 * q + 2] * ci.scale, vals[16 * j + 4 * q + 3] * ci.scale, pk_, true); o[q] = (unsigned)pk_; }
            *(u32x4*)(ci.WTp + 16 * j) = o; }
    }
}
__device__ __forceinline__ float row16_reduce_scatter(const float (&q)[16], int lane) {
    const bool b0 = lane & 1, b1 = lane & 2, b2 = lane & 4, b3 = lane & 8;
    float v[16], a[8], c[4], d[2];
#pragma unroll
    for (int s = 0; s < 16; ++s) v[s] = q[((s & 1) << 3) | ((s & 2) << 1) | ((s & 4) >> 1) | ((s & 8) >> 3)];
#pragma unroll
    for (int j = 0; j < 8; ++j) a[j] = (b0 ? v[j + 8] : v[j]) + dppf<0xB1>(b0 ? v[j] : v[j + 8]);
#pragma unroll
    for (int j = 0; j < 4; ++j) c[j] = (b1 ? a[j + 4] : a[j]) + dppf<0x4E>(b1 ? a[j] : a[j + 4]);
#pragma unroll
    for (int j = 0; j < 2; ++j) d[j] = (b2 ? c[j + 2] : c[j]) + dppf<0x124>(b2 ? c[j] : c[j + 2]);
    return (b3 ? d[1] : d[0]) + dppf<0x128>(b3 ? d[0] : d[1]);
}
#define WBAR() do { asm volatile("s_waitcnt lgkmcnt(0)" ::: "memory"); __builtin_amdgcn_s_barrier(); asm volatile("" ::: "memory"); } while (0)
__device__ __forceinline__ void phase_scan_mm(const ScanArgs& a, LAS unsigned char* lds, int blk, int G, const int wave) {
    constexpr int NG = 4, PCH = 13120;
    constexpr int O_AT = 0, O_RT = 2304, O_BBT = 4608, O_KBT = 6656, O_VT = 8704, O_MKT = 10752, O_TMT = 11264, O_NBT = 11776, O_NKT = 12288, O_GC = 12800, O_SRK = 13056;
    constexpr int TMP0 = NG * PCH, TMPB = 5632;
    constexpr int O_SY = TMP0 + 4 * TMPB, O_VO = O_SY + 2 * 16640, O_SRKO = O_VO + 2 * 8192, O_RED = O_SRKO + 512;
    int pass = 0;
    for (int bh = blk; bh < NBATCH * 16; bh += G, ++pass) {
        int tid0 = wave * 64 + lane_id(); OPAQUE(tid0);
        const int b = bh >> 4, h = bh & 15, chn0 = h * 64 + (tid0 & 63);
        const float kkc = a.k_k[chn0], kac = a.k_a[chn0], rkc = a.r_k[chn0], lg = a.lnx_g[chn0], lb = a.lnx_b[chn0];
        f32x4 ST[4];
#pragma unroll
        for (int kt = 0; kt < 4; ++kt) ST[kt] = (f32x4){0.f, 0.f, 0.f, 0.f};
        h16 qr[8], qk[8], qv[8], qa[8], qw[8];
        const int c4w = wave >> 1, hfw = wave & 1;
#pragma unroll
        for (int i = 0; i < 8; ++i) { const size_t tb = ((size_t)bh * SEQ + c4w * 16 + 8 * hfw) * 64 + (tid0 & 63);
            qr[i] = a.R[tb + i * 64]; qk[i] = a.K[tb + i * 64]; qv[i] = a.V[tb + i * 64]; qa[i] = a.AA[tb + i * 64]; qw[i] = a.WD[tb + i * 64]; }
        LAS float* gpr = (LAS float*)(lds + O_RED + 1024);
#define GPROD() ((((1.0f - (float)qw[0]) * (1.0f - (float)qw[1])) * ((1.0f - (float)qw[2]) * (1.0f - (float)qw[3]))) * (((1.0f - (float)qw[4]) * (1.0f - (float)qw[5])) * ((1.0f - (float)qw[6]) * (1.0f - (float)qw[7]))))
        gpr[wave * 64 + (tid0 & 63)] = GPROD();
        WBAR();
        h16 qg[16];
        float cv[32];
        ConvItem2 ci = conv_item2(((pass * 32 + 0) * 2 + 0) * G + blk, wave, tid0 & 63, a.layer_pair, a.wgu, a.wdn, a.gu8);
        conv_issue2(ci, cv, tid0 & 63);
#define OUT_STAGE(gp_) do { const int gp = (gp_); LAS float* red = (LAS float*)(lds + O_RED) + wave * 32; const LAS float* syo = (const LAS float*)(lds + O_SY) + (gp & 1) * (64 * 65); \
            const LAS h16* voo = (const LAS h16*)(lds + O_VO) + (gp & 1) * 4096; const LAS float* srko = (const LAS float*)(lds + O_SRKO) + (gp & 1) * 64; \
            _Pragma("unroll") for (int bt = 0; bt < 2; ++bt) { const int t0 = (wave - 4) * 16 + 8 * bt; float yv[8], q[16]; \
                _Pragma("unroll") for (int p = 0; p < 8; ++p) { yv[p] = syo[(t0 + p) * 65 + lane]; q[p] = yv[p]; q[8 + p] = yv[p] * yv[p]; } \
                float x = row16_reduce_scatter(q, lane); x += swz16f(x); \
                if ((lane & 16) == 0) red[(lane >> 5) * 16 + l16] = x; \
                LDS_WAIT(); \
                f32x4 s1[2], s2[2]; \
                _Pragma("unroll") for (int hq = 0; hq < 2; ++hq) { s1[hq] = *(const LAS f32x4*)(red + 4 * hq) + *(const LAS f32x4*)(red + 16 + 4 * hq); s2[hq] = *(const LAS f32x4*)(red + 8 + 4 * hq) + *(const LAS f32x4*)(red + 24 + 4 * hq); } \
                _Pragma("unroll") for (int p = 0; p < 8; ++p) { const int tt = t0 + p; \
                    const float mu = s1[p >> 2][p & 3] * (1.0f / 64.0f), var = fmaxf(s2[p >> 2][p & 3] * (1.0f / 64.0f) - mu * mu, 0.0f); \
                    float yn = (yv[p] - mu) * rsqrtf(var + 64e-5f) * lg + lb; yn += srko[tt] * (float)voo[tt * 64 + lane]; \
                    a.YG[((size_t)b * SEQ + gp * 64 + tt) * D + chn] = (h16)(yn * (float)qg[8 * bt + p]); } \
                LDS_WAIT(); } } while (0)
#pragma unroll 1
        for (int grp = 0; grp < SEQ / 64; ++grp) {
            int tid = tid0; OPAQUE(tid);
            const int lane = tid & 63, g4 = lane >> 4, l16 = lane & 15, chn = h * 64 + lane;
            {
                LAS unsigned char* pc = lds + c4w * PCH; LAS unsigned char* tb = lds + TMP0 + c4w * TMPB;
                LAS h16* At = (LAS h16*)(pc + O_AT); LAS h16* Rt = (LAS h16*)(pc + O_RT); LAS h16* BbT = (LAS h16*)(pc + O_BBT); LAS h16* KbT = (LAS h16*)(pc + O_KBT); LAS h16* Vt = (LAS h16*)(pc + O_VT);
                LAS h16* MkT = (LAS h16*)(pc + O_MKT); LAS h16* TmT = (LAS h16*)(pc + O_TMT); LAS h16* NbT = (LAS h16*)(pc + O_NBT); LAS h16* NkT = (LAS h16*)(pc + O_NKT);
                LAS float* gC = (LAS float*)(pc + O_GC); LAS float* srk = (LAS float*)(pc + O_SRK);
                LAS h16* Bh = (LAS h16*)tb; LAS h16* Kh = (LAS h16*)(tb + 2304); LAS float* MbF = (LAS float*)(tb + 4608);
                float wf[8];
#pragma unroll
                for (int i = 0; i < 8; ++i) wf[i] = 1.0f - (float)qw[i];
                if (grp + 1 < SEQ / 64) {
#pragma unroll
                    for (int i = 0; i < 8; ++i) qw[i] = a.WD[((size_t)bh * SEQ + (grp + 1) * 64 + c4w * 16 + 8 * hfw) * 64 + lane + i * 64];
                }
                const float gown = ((wf[0] * wf[1]) * (wf[2] * wf[3])) * ((wf[4] * wf[5]) * (wf[6] * wf[7])), goth = gpr[(wave ^ 1) * 64 + lane];
                const float gall = gown * goth;
                float gam = hfw ? goth : 1.0f, bhr[8], khr[8];
                LAS float* red = (LAS float*)(lds + O_RED) + wave * 32;
                float n2s[8];
                {
                    float q[16];
#pragma unroll
                    for (int i = 0; i < 8; ++i) { const float k = (float)qk[i], kk = k * kkc; q[i] = kk * kk; q[8 + i] = (float)qr[i] * (k * (1.0f + ((float)qa[i] - 1.0f) * kac)) * rkc; }
                    float x = row16_reduce_scatter(q, lane); x += swz16f(x);
                    if ((lane & 16) == 0) red[(lane >> 5) * 16 + l16] = x;
                    LDS_WAIT();
                    const f32x4 r0 = *(const LAS f32x4*)(red), r1 = *(const LAS f32x4*)(red + 4), r2 = *(const LAS f32x4*)(red + 16), r3 = *(const LAS f32x4*)(red + 20);
#pragma unroll
                    for (int i = 0; i < 4; ++i) { n2s[i] = r0[i] + r2[i]; n2s[4 + i] = r1[i] + r3[i]; }
                    const float rks = red[8 + (lane & 7)] + red[24 + (lane & 7)];
                    if (lane < 8) ((LAS float*)(lds + O_SRKO))[(grp & 1) * 64 + 16 * c4w + 8 * hfw + lane] = rks;
                }
#pragma unroll
                for (int i = 0; i < 8; ++i) {
                    const int tt = 8 * hfw + i;
                    const float r = (float)qr[i], k = (float)qk[i], v = (float)qv[i], w = wf[i], aa = (float)qa[i];
                    const float kk = k * kkc; const float kkn = kk * __builtin_amdgcn_rsqf(fmaxf(n2s[i], 1e-24f));
                    const float kmod = k * (1.0f + (aa - 1.0f) * kac);
                    At[tt * 72 + lane] = (h16)(gam * -kkn);
                    gam *= w; const float rg = __builtin_amdgcn_rcpf(gam);
                    bhr[i] = fminf(fmaxf(kkn * aa * rg, -6.0e4f), 6.0e4f); khr[i] = fminf(fmaxf(kmod * rg, -6.0e4f), 6.0e4f);
                    Bh[tt * 72 + lane] = (h16)bhr[i]; Kh[tt * 72 + lane] = (h16)khr[i];
                    Rt[tt * 72 + lane] = (h16)(gam * r); ((LAS h16*)(lds + O_VO))[((grp & 1) * 64 + 16 * c4w + tt) * 64 + lane] = (h16)v;
                }
                if (hfw == 0) gC[lane] = gall;
                {
                    u32x4 pb, pk;
#pragma unroll
                    for (int q = 0; q < 4; ++q) { pb[q] = pkh(bhr[2 * q] * gall, bhr[2 * q + 1] * gall); pk[q] = pkh(khr[2 * q] * gall, khr[2 * q + 1] * gall); }
                    *(LAS u32x4*)(BbT + lane * 16 + 8 * hfw) = pb; *(LAS u32x4*)(KbT + lane * 16 + 8 * hfw) = pk;
                }
                conv_finish2(ci, cv);
                if (grp + 1 < SEQ / 64) {
#pragma unroll
                    for (int i = 0; i < 8; ++i) { const size_t tb = ((size_t)bh * SEQ + (grp + 1) * 64 + c4w * 16 + 8 * hfw) * 64 + lane;
                        qr[i] = a.R[tb + i * 64]; qk[i] = a.K[tb + i * 64]; qv[i] = a.V[tb + i * 64]; qa[i] = a.AA[tb + i * 64]; }
                }
                ci = conv_item2(((pass * 32 + grp) * 2 + 1) * G + blk, wave, lane, a.layer_pair, a.wgu, a.wdn, a.gu8);
                conv_issue2(ci, cv, lane);
                WBAR();
                if (hfw == 0) {
                    f32x4 mb = {0.f, 0.f, 0.f, 0.f}, mt = mb;
#pragma unroll
                    for (int s = 0; s < 2; ++s) { const int fo = l16 * 72 + 32 * s + 8 * g4; const h16x8 fb = *(const LAS h16x8*)(Bh + fo), fa = *(const LAS h16x8*)(At + fo);
                        mb = __builtin_amdgcn_mfma_f32_16x16x32_f16(fb, fa, mb, 0, 0, 0);
                        mt = __builtin_amdgcn_mfma_f32_16x16x32_f16(fa, fb, mt, 0, 0, 0); }
                    f32x4 td, ttd;
#pragma unroll
                    for (int e = 0; e < 4; ++e) { const int i = 4 * g4 + e; mb[e] = (i < l16) ? mb[e] : 0.f; mt[e] = (l16 < i) ? mt[e] : 0.f; const float dg = (i == l16) ? 1.0f : 0.0f; td[e] = mb[e] + dg; ttd[e] = mt[e] + dg; }
                    h16x4 xb = __builtin_convertvector(mb, h16x4), xa = __builtin_convertvector(mt, h16x4);
#pragma unroll
                    for (int s = 0; s < 3; ++s) {
                        const f32x4 z4 = {0.f, 0.f, 0.f, 0.f};
                        const f32x4 sq = __builtin_amdgcn_mfma_f32_16x16x16f16(xa, xb, z4, 0, 0, 0);
                        const f32x4 sqt = __builtin_amdgcn_mfma_f32_16x16x16f16(xb, xa, z4, 0, 0, 0);
                        xb = __builtin_convertvector(sq, h16x4); xa = __builtin_convertvector(sqt, h16x4);
                        const h16x4 ta = __builtin_convertvector(ttd, h16x4);
                        td = __builtin_amdgcn_mfma_f32_16x16x16f16(ta, xb, td, 0, 0, 0);
                        if (s < 2) ttd = __builtin_amdgcn_mfma_f32_16x16x16f16(xb, ta, ttd, 0, 0, 0);
                    }
                    *(LAS u32x2*)(TmT + l16 * 16 + 4 * g4) = pkh4(td);
                } else {
                    f32x4 mk = {0.f, 0.f, 0.f, 0.f}, nb = mk, nk = mk;
#pragma unroll
                    for (int s = 0; s < 2; ++s) {
                        const int fo = l16 * 72 + 32 * s + 8 * g4;
                        const h16x8 fb = *(const LAS h16x8*)(Bh + fo), fk = *(const LAS h16x8*)(Kh + fo), fa = *(const LAS h16x8*)(At + fo), fr = *(const LAS h16x8*)(Rt + fo);
                        mk = __builtin_amdgcn_mfma_f32_16x16x32_f16(fk, fa, mk, 0, 0, 0); nb = __builtin_amdgcn_mfma_f32_16x16x32_f16(fb, fr, nb, 0, 0, 0); nk = __builtin_amdgcn_mfma_f32_16x16x32_f16(fk, fr, nk, 0, 0, 0);
                    }
#pragma unroll
                    for (int e = 0; e < 4; ++e) { const int i = 4 * g4 + e; const bool lt = i < l16, le = i <= l16; mk[e] = lt ? mk[e] : 0.f; nb[e] = le ? nb[e] : 0.f; nk[e] = le ? nk[e] : 0.f; }
                    *(LAS u32x2*)(MkT + l16 * 16 + 4 * g4) = pkh4(mk); *(LAS u32x2*)(NbT + l16 * 16 + 4 * g4) = pkh4(nb); *(LAS u32x2*)(NkT + l16 * 16 + 4 * g4) = pkh4(nk);
                }
            }
            WBAR();
            if (wave < 4) {
                LAS float* sy = (LAS float*)(lds + O_SY) + (grp & 1) * (64 * 65);
#pragma unroll 2
                for (int c4 = 0; c4 < NG; ++c4) {
                    LAS unsigned char* pc = lds + c4 * PCH;
                    const LAS h16* At = (const LAS h16*)(pc + O_AT); const LAS h16* Rt = (const LAS h16*)(pc + O_RT); const LAS h16* BbT = (const LAS h16*)(pc + O_BBT); const LAS h16* KbT = (const LAS h16*)(pc + O_KBT);
                    const LAS h16* Vt = (const LAS h16*)(pc + O_VT); const LAS h16* MkT = (const LAS h16*)(pc + O_MKT); const LAS h16* TmT = (const LAS h16*)(pc + O_TMT);
                    const LAS h16* NbT = (const LAS h16*)(pc + O_NBT); const LAS h16* NkT = (const LAS h16*)(pc + O_NKT); const LAS float* gC = (const LAS float*)(pc + O_GC);
                    h16x4 sb[4];
#pragma unroll
                    for (int kt = 0; kt < 4; ++kt) sb[kt] = __builtin_convertvector(ST[kt], h16x4);
                    h16x4 vb;
                    { const LAS h16* vsrc = (const LAS h16*)(lds + O_VO) + ((grp & 1) * 64 + 16 * c4 + 4 * g4) * 64 + 16 * wave + l16;
#pragma unroll
                      for (int e = 0; e < 4; ++e) vb[e] = vsrc[e * 64]; }
                    f32x4 accW = {0.f, 0.f, 0.f, 0.f}, accY = {0.f, 0.f, 0.f, 0.f};
#pragma unroll
                    for (int kt = 0; kt < 4; ++kt) {
                        accW = __builtin_amdgcn_mfma_f32_16x16x16f16(*(const LAS h16x4*)(At + l16 * 72 + 16 * kt + 4 * g4), sb[kt], accW, 0, 0, 0);
                        accY = __builtin_amdgcn_mfma_f32_16x16x16f16(*(const LAS h16x4*)(Rt + l16 * 72 + 16 * kt + 4 * g4), sb[kt], accY, 0, 0, 0);
                    }
                    accW = __builtin_amdgcn_mfma_f32_16x16x16f16(*(const LAS h16x4*)(MkT + l16 * 16 + 4 * g4), vb, accW, 0, 0, 0);
                    accY = __builtin_amdgcn_mfma_f32_16x16x16f16(*(const LAS h16x4*)(NkT + l16 * 16 + 4 * g4), vb, accY, 0, 0, 0);
                    const h16x4 wb = __builtin_convertvector(accW, h16x4);
                    const f32x4 accU = __builtin_amdgcn_mfma_f32_16x16x16f16(*(const LAS h16x4*)(TmT + l16 * 16 + 4 * g4), wb, (f32x4){0.f, 0.f, 0.f, 0.f}, 0, 0, 0);
                    const h16x4 ub = __builtin_convertvector(accU, h16x4);
                    accY = __builtin_amdgcn_mfma_f32_16x16x16f16(*(const LAS h16x4*)(NbT + l16 * 16 + 4 * g4), ub, accY, 0, 0, 0);
#pragma unroll
                    for (int kt = 0; kt < 4; ++kt) {
                        ST[kt] = ST[kt] * *(const LAS f32x4*)(gC + 16 * kt + 4 * g4);
                        ST[kt] = __builtin_amdgcn_mfma_f32_16x16x16f16(*(const LAS h16x4*)(BbT + (16 * kt + l16) * 16 + 4 * g4), ub, ST[kt], 0, 0, 0);
                        ST[kt] = __builtin_amdgcn_mfma_f32_16x16x16f16(*(const LAS h16x4*)(KbT + (16 * kt + l16) * 16 + 4 * g4), vb, ST[kt], 0, 0, 0);
                    }
#pragma unroll
                    for (int e = 0; e < 4; ++e) sy[(16 * c4 + 4 * g4 + e) * 65 + 16 * wave + l16] = accY[e];
                }
            }
            else {
                if (grp > 0) OUT_STAGE(grp - 1);
#pragma unroll
                for (int j = 0; j < 16; ++j) qg[j] = a.GG[((size_t)bh * SEQ + grp * 64 + (wave - 4) * 16) * 64 + lane + j * 64];
            }
            conv_finish2(ci, cv);
            ci = conv_item2(((pass * 32 + grp + 1) * 2 + 0) * G + blk, wave, lane, a.layer_pair, a.wgu, a.wdn, a.gu8);
            if (grp + 1 < SEQ / 64) { conv_issue2(ci, cv, lane); gpr[wave * 64 + lane] = GPROD(); }
            WBAR();
        }
#undef GPROD
        if (wave >= 4) { const int lane = lane_id(), l16 = lane & 15, chn = h * 64 + lane; OUT_STAGE(SEQ / 64 - 1); }
#undef OUT_STAGE
    }
}

__device__ __forceinline__ float row16_max(float v) { v = fmaxf(v, dppf<0xB1>(v)); v = fmaxf(v, dppf<0x4E>(v)); v = fmaxf(v, dppf<0x141>(v)); v = fmaxf(v, dppf<0x140>(v)); return v; }
struct RouterArgs { const h16* H; const float *g, *b; const h16* WRS; const float* rb; h16* X1; unsigned char* XB; float* TOPG; int* LIST; unsigned* CNT; };
__device__ __forceinline__ void phase_ln_router(const RouterArgs& a, LAS unsigned char* lds, int blk, int G, const int wave) {
    constexpr int WPB = 2064;
    LAS unsigned* hcnt = (LAS unsigned*)(lds + 132096); LAS unsigned* hbase = hcnt + 32; LAS unsigned* pe = hbase + 32; LAS unsigned* pp = pe + 512;
    int tid = wave * 64 + lane_id(); OPAQUE(tid);
    const int lane = tid & 63, ex = lane & 15, kg = lane >> 4;
    for (int c = tid; c < 2 * 32 * 128; c += NTHR) { const int row = c >> 7, ch = c & 127; *(LAS u32x4*)(lds + row * WPB + ch * 16) = *(const u32x4*)((const char*)a.WRS + (size_t)row * 2048 + ch * 16); }
    const float rb0 = a.rb[ex], rb1 = a.rb[16 + ex];
    for (int tb = blk; tb < T / 128; tb += G) {
        if (tid < 32) hcnt[tid] = 0u;
        __syncthreads();
        const size_t tw = (size_t)tb * 128 + wave * 16;
#pragma unroll 1
        for (int ib = 0; ib < 4; ++ib) {
            f32x4 vv[4][4]; h16x4 vh[4][4];
#pragma unroll
            for (int q = 0; q < 4; ++q)
#pragma unroll
                for (int j = 0; j < 4; ++j) vh[q][j] = *(const h16x4*)(a.H + (tw + 4 * ib + q) * D + 256 * j + 4 * lane);
#pragma unroll
            for (int q = 0; q < 4; ++q)
#pragma unroll
                for (int j = 0; j < 4; ++j) vv[q][j] = __builtin_convertvector(vh[q][j], f32x4);
#pragma unroll
            for (int q = 0; q < 4; ++q) {
                const size_t t = tw + 4 * ib + q; float s1 = 0.f;
#pragma unroll
                for (int j = 0; j < 4; ++j) s1 += (vv[q][j].x + vv[q][j].y) + (vv[q][j].z + vv[q][j].w);
                const float mean = wave_sum(s1) * (1.0f / D); float s2 = 0.f;
#pragma unroll
                for (int j = 0; j < 4; ++j) { vv[q][j] = vv[q][j] - mean; s2 += (vv[q][j].x * vv[q][j].x + vv[q][j].y * vv[q][j].y) + (vv[q][j].z * vv[q][j].z + vv[q][j].w * vv[q][j].w); }
                const float rstd = rsqrtf(wave_sum(s2) * (1.0f / D) + LN_EPS);
#pragma unroll
                for (int j = 0; j < 4; ++j) { const f32x4 o = vv[q][j] * rstd * *(const f32x4*)(a.g + 256 * j + 4 * lane) + *(const f32x4*)(a.b + 256 * j + 4 * lane);
                    *(u32x2*)(a.X1 + t * D + 256 * j + 4 * lane) = pkh4(o);
                    int pk_ = __builtin_amdgcn_cvt_pk_fp8_f32(o.x, o.y, 0, false); pk_ = __builtin_amdgcn_cvt_pk_fp8_f32(o.z, o.w, pk_, true);
                    *(unsigned*)(a.XB + t * D + 256 * j + 4 * lane) = (unsigned)pk_; }
            }
        }
        asm volatile("s_waitcnt vmcnt(0)" ::: "memory");
        f32x4 cA[2], cB[2];
        cA[0] = cA[1] = cB[0] = cB[1] = (f32x4){0.f, 0.f, 0.f, 0.f};
        const h16* xrow = a.X1 + (tw + ex) * D + 8 * kg;
        const LAS unsigned char* bh = lds + ex * WPB + kg * 16; const LAS unsigned char* bl = bh + 32 * WPB;
#pragma unroll 8
        for (int ks = 0; ks < 32; ++ks) {
            const h16x8 xh = *(const h16x8*)(xrow + 32 * ks);
#pragma unroll
            for (int tI = 0; tI < 2; ++tI) {
                const h16x8 wh = *(const LAS h16x8*)(bh + tI * 16 * WPB + ks * 64), wl = *(const LAS h16x8*)(bl + tI * 16 * WPB + ks * 64);
                cA[tI] = __builtin_amdgcn_mfma_f32_16x16x32_f16(xh, wh, cA[tI], 0, 0, 0);
                cB[tI] = __builtin_amdgcn_mfma_f32_16x16x32_f16(xh, wl, cB[tI], 0, 0, 0);
            }
        }
#pragma unroll
        for (int e = 0; e < 4; ++e) {
            float c0 = cA[0][e] + cB[0][e] * (1.0f / 4096.0f) + rb0, c1 = cA[1][e] + cB[1][e] * (1.0f / 4096.0f) + rb1;
            int sel[4]; float val[4];
#pragma unroll
            for (int k = 0; k < 4; ++k) {
                const float m = row16_max(fmaxf(c0, c1));
                const unsigned r0 = (unsigned)(__ballot(c0 == m) >> (16 * kg)) & 0xFFFFu, r1 = (unsigned)(__ballot(c1 == m) >> (16 * kg)) & 0xFFFFu;
                const int hit0 = r0 != 0u; const int wl_ = hit0 ? __builtin_ctz(r0) : __builtin_ctz(r1 | 0x10000u);
                sel[k] = hit0 ? wl_ : 16 + wl_; val[k] = m;
                if (ex == wl_) { if (hit0) c0 = -INFINITY; else c1 = -INFINITY; }
            }
            const float e1 = __expf(val[1] - val[0]), e2 = __expf(val[2] - val[0]), e3 = __expf(val[3] - val[0]);
            const float inv = 1.0f / (1.0f + e1 + e2 + e3);
            if (ex < 4) {
                const int tl = wave * 16 + 4 * kg + e; const size_t t = (size_t)tb * 128 + tl;
                const int mysel = ex == 0 ? sel[0] : ex == 1 ? sel[1] : ex == 2 ? sel[2] : sel[3];
                const float myg = (ex == 0 ? 1.0f : ex == 1 ? e1 : ex == 2 ? e2 : e3) * inv;
                a.TOPG[t * 4 + ex] = myg;
                const unsigned pos = __hip_atomic_fetch_add(hcnt + mysel, 1u, __ATOMIC_RELAXED, __HIP_MEMORY_SCOPE_WORKGROUP);
                pe[tl * 4 + ex] = (unsigned)mysel; pp[tl * 4 + ex] = pos;
            }
        }
        __syncthreads();
        if (tid < 32) hbase[tid] = __hip_atomic_fetch_add(a.CNT + tid, hcnt[tid], __ATOMIC_RELAXED, __HIP_MEMORY_SCOPE_AGENT);
        __syncthreads();
        { const unsigned e = pe[tid]; a.LIST[(size_t)e * ECAP + hbase[e] + pp[tid]] = tb * 512 + tid; }
        __syncthreads();
    }
}

__device__ __forceinline__ void phase_combine(const h16* X1, const unsigned char* YS, const float* g, const float* b, float* Xo  , h16* XH  , int gw_, int NGW_, int lane) {
    lane = lane_id(); OPAQUE(lane);
#pragma unroll 1
    for (int t0 = gw_; t0 < T; t0 += 2 * NGW_) {
        h16x4 x[2][4]; unsigned y[2][4][4];
#pragma unroll
        for (int q = 0; q < 2; ++q) { const size_t t = (size_t)t0 + (size_t)q * NGW_;
#pragma unroll
            for (int j = 0; j < 4; ++j) { x[q][j] = *(const h16x4*)(X1 + t * D + 256 * j + 4 * lane);
#pragma unroll
                for (int k = 0; k < 4; ++k) y[q][j][k] = *(const unsigned*)(YS + (t * 4 + k) * D + 256 * j + 4 * lane); } }
#pragma unroll
        for (int q = 0; q < 2; ++q) { const size_t t = (size_t)t0 + (size_t)q * NGW_;
            f32x4 v[4]; float s = 0.f;
#pragma unroll
            for (int j = 0; j < 4; ++j) { f32x4 ysum = (f32x4){0.f, 0.f, 0.f, 0.f};
#pragma unroll
                for (int k = 0; k < 4; ++k) { const f32x2 lo = __builtin_amdgcn_cvt_pk_f32_fp8((int)y[q][j][k], false), hi = __builtin_amdgcn_cvt_pk_f32_fp8((int)y[q][j][k], true); ysum += (f32x4){lo.x, lo.y, hi.x, hi.y}; }
                v[j] = __builtin_convertvector(x[q][j], f32x4) * ALPHA + ysum * (1.0f / YS_SCALE);
                s += (v[j].x + v[j].y) + (v[j].z + v[j].w); }
            const float mean = wave_sum(s) * (1.0f / D); float s2 = 0.f;
#pragma unroll
            for (int j = 0; j < 4; ++j) { v[j] = v[j] - mean; s2 += (v[j].x * v[j].x + v[j].y * v[j].y) + (v[j].z * v[j].z + v[j].w * v[j].w); }
            const float rstd = rsqrtf(wave_sum(s2) * (1.0f / D) + LN_EPS);
#pragma unroll
            for (int j = 0; j < 4; ++j) { v[j] = v[j] * rstd * *(const f32x4*)(g + 256 * j + 4 * lane) + *(const f32x4*)(b + 256 * j + 4 * lane);
                if (Xo) *(f32x4*)(Xo + t * D + 256 * j + 4 * lane) = v[j]; else *(u32x2*)(XH + t * D + 256 * j + 4 * lane) = pkh4(v[j]); }
        }
    }
}

#include <cmath>
namespace attn_body {
using bf16=_Float16;
using bf16x8=__attribute__((ext_vector_type(8)))short;
using s16x4=__attribute__((ext_vector_type(4)))short;
using f32x16=__attribute__((ext_vector_type(16)))float;
using u32x4=__attribute__((ext_vector_type(4)))unsigned;
constexpr int SEQ=2048,D=64,DM=1024,DMO=2048;
constexpr int NW=8,QBLK=32,QB=QBLK*NW,KVBLK=64,NQB=SEQ/QB;
typedef _Float16 f16x8_t __attribute__((ext_vector_type(8)));
#define MFMA32(a,b,c) __builtin_amdgcn_mfma_f32_32x32x16_f16(__builtin_bit_cast(f16x8_t,(a)),__builtin_bit_cast(f16x8_t,(b)),(c),0,0,0)
__device__ __forceinline__ int crow(int r,int hi){return (r&3)+8*(r>>2)+4*hi;}
#define SBAR() __builtin_amdgcn_sched_barrier(0)
__device__ __forceinline__ void cmask(f32x16&p0,f32x16&p1,int jb,int qrel,int hi){
  const float NEG=-INFINITY; int kb=64*jb+4*hi;
  #pragma unroll
  for(int r=0;r<16;++r){int kv=kb+(r&3)+8*(r>>2); if(kv>qrel)p0[r]=NEG; if(kv+32>qrel)p1[r]=NEG;}
}

constexpr int NSLOT=3, SLOTB=8192;
constexpr int LDS_K=0, LDS_V=NSLOT*SLOTB, LDS_WS=2*NSLOT*SLOTB, LDS_OST=LDS_WS+NW*64*4, LDS_BYTES=LDS_OST+NW*4096;
constexpr float C2=0.125f*1.4426950408889634f;
__device__ __forceinline__ void glds16(const void*gsrc,unsigned lds_dst){unsigned keep;
  asm volatile("s_mov_b32 %0, m0\n\ts_mov_b32 m0, %2\n\ts_nop 0\n\tglobal_load_lds_dwordx4 %1, off\n\ts_mov_b32 m0, %0":"=&s"(keep):"v"(gsrc),"s"(lds_dst):"memory");}
__device__ __forceinline__ float max3f(float a,float b,float c){float r;asm("v_max3_f32 %0, %1, %2, %3":"=v"(r):"v"(a),"v"(b),"v"(c));return r;}
__device__ __forceinline__ float max2f(float a,float b){float r;asm("v_max_f32_e32 %0, %1, %2":"=v"(r):"v"(a),"v"(b));return r;}
__device__ __forceinline__ float fadd_s(float a,float b){float r;asm("v_add_f32_e32 %0, %1, %2":"=v"(r):"v"(a),"v"(b));return r;}
__device__ __forceinline__ float fsub_s(float a,float b){float r;asm("v_sub_f32_e32 %0, %1, %2":"=v"(r):"v"(a),"v"(b));return r;}
typedef float f32x2_t __attribute__((ext_vector_type(2))); typedef _Float16 bf16x2_t __attribute__((ext_vector_type(2)));
__device__ __forceinline__ unsigned cvtpk_s(float lo,float hi){f32x2_t v={lo,hi};bf16x2_t b=__builtin_convertvector(v,bf16x2_t);return __builtin_bit_cast(unsigned,b);}
#define WAIT_BAR(N) asm volatile("s_waitcnt vmcnt(" #N ") lgkmcnt(0)\n\ts_barrier":::"memory")

__device__ __forceinline__ void qkt(f32x16&p0,f32x16&p1,const char*Kslot,const bf16x8*qr,const f32x16&negm,int r32,int hi){
  const char*kb=Kslot+hi*1024+r32*16;
  #pragma unroll
  for(int d0=0;d0<4;++d0){
    const bf16x8 b0=*reinterpret_cast<const bf16x8*>(kb+d0*2048);
    const bf16x8 b1=*reinterpret_cast<const bf16x8*>(kb+d0*2048+512);
    if(d0==0){p0=MFMA32(b0,qr[0],negm);p1=MFMA32(b1,qr[0],negm);}
    else{p0=MFMA32(b0,qr[d0],p0);p1=MFMA32(b1,qr[d0],p1);}}
}
typedef __attribute__((address_space(3))) const char* lds_cptr;
typedef short v4i16_t __attribute__((ext_vector_type(4)));
__device__ __forceinline__ void kload8(bf16x8*kf,lds_cptr kp){
  kf[0]=*(const __attribute__((address_space(3))) bf16x8*)(kp);      kf[1]=*(const __attribute__((address_space(3))) bf16x8*)(kp+512);
  kf[2]=*(const __attribute__((address_space(3))) bf16x8*)(kp+2048); kf[3]=*(const __attribute__((address_space(3))) bf16x8*)(kp+2560);
  kf[4]=*(const __attribute__((address_space(3))) bf16x8*)(kp+4096); kf[5]=*(const __attribute__((address_space(3))) bf16x8*)(kp+4608);
  kf[6]=*(const __attribute__((address_space(3))) bf16x8*)(kp+6144); kf[7]=*(const __attribute__((address_space(3))) bf16x8*)(kp+6656);
}
__device__ __forceinline__ void kload2(bf16x8*kf,lds_cptr kp,int j){ kf[2*j]=*(const __attribute__((address_space(3))) bf16x8*)(kp+j*2048); kf[2*j+1]=*(const __attribute__((address_space(3))) bf16x8*)(kp+j*2048+512); }
__device__ __forceinline__ s16x4 vtr(lds_cptr p){ return __builtin_bit_cast(s16x4,__builtin_amdgcn_ds_read_tr16_b64_v4i16((__attribute__((address_space(3))) v4i16_t*)p)); }
__device__ __forceinline__ float rowmax(const f32x16&p0,const f32x16&p1){
  float a=max3f(p0[0],p0[1],p1[0]),b=max3f(p0[2],p0[3],p1[1]);a=max3f(a,p1[2],p1[3]);
  #pragma unroll
  for(int r=4;r<16;r+=4){a=max3f(a,p0[r],p0[r+1]);b=max3f(b,p0[r+2],p0[r+3]);a=max3f(a,p1[r],p1[r+1]);b=max3f(b,p1[r+2],p1[r+3]);}
  const float m=max2f(a,b);
  auto rr=__builtin_amdgcn_permlane32_swap(__float_as_uint(m),__float_as_uint(m),false,false);
  return max2f(__uint_as_float(rr[0]),__uint_as_float(rr[1]));
}
__device__ __forceinline__ void pv(f32x16*o,int vb,bf16x8 pa0,bf16x8 pa1,bf16x8 pa2,bf16x8 pa3){
  #pragma unroll
  for(int d0=0;d0<2;++d0){s16x4 lo[4],hi[4];
    #pragma unroll
    for(int ks=0;ks<4;++ks){
      asm volatile("ds_read_b64_tr_b16 %0,%1 offset:%c2":"=&v"(lo[ks]):"v"(vb),"i"(d0*4096+ks*1024):"memory");
      asm volatile("ds_read_b64_tr_b16 %0,%1 offset:%c2":"=&v"(hi[ks]):"v"(vb),"i"(d0*4096+ks*1024+512):"memory");}
    asm volatile("s_waitcnt lgkmcnt(0)":::"memory");SBAR();
    #define PK(k) (bf16x8){lo[k][0],lo[k][1],lo[k][2],lo[k][3],hi[k][0],hi[k][1],hi[k][2],hi[k][3]}
    o[d0]=MFMA32(pa0,PK(0),o[d0]);
    o[d0]=MFMA32(pa1,PK(1),o[d0]);
    o[d0]=MFMA32(pa2,PK(2),o[d0]);
    o[d0]=MFMA32(pa3,PK(3),o[d0]);
    #undef PK
  }
}

#ifndef ATTN_STORE16
#define ATTN_STORE16(p,v) (*(u32x4*)(p)=(v))
#endif
template<int THRL> __device__ __forceinline__ void attn_unit(int b,int qcol,int vcol,int ocol,float slope2,int qb,int ts,const bf16*Q,const bf16*__restrict__ K,const bf16*__restrict__ V,bf16*O,char*shm,const int wid){
  int lane; asm volatile("v_mbcnt_lo_u32_b32 %0, -1, 0\n\tv_mbcnt_hi_u32_b32 %0, -1, %0":"=v"(lane)); const int r32=lane&31,hi=lane>>5;
  const long rowbase=(long)b*SEQ; const int q0=qb*QB;
  const bf16*Qw=Q+(rowbase+q0+wid*QBLK)*DM+qcol;
  const bf16*Kh=K+(rowbase+(long)ts*KVBLK)*DM+qcol,*Vh=V+(rowbase+(long)ts*KVBLK)*DM+vcol;
  const unsigned lds0=(unsigned)(uintptr_t)shm;
  float*wsf=(float*)(shm+LDS_WS)+wid*64;
  const bf16*ksrc=Kh+(long)lane*DM+wid*8;
  const bf16*vsrc=Vh+(long)(16*(wid&3)+(lane>>2))*DM+(wid>>2)*32+(lane&3)*8;
  const unsigned kdst=lds0+LDS_K+wid*1024, vdst=lds0+LDS_V+wid*1024;
  #define DMA_K(t,slot) glds16(ksrc+(long)(t)*KVBLK*DM,(unsigned)__builtin_amdgcn_readfirstlane(kdst+(slot)))
  #define DMA_V(t,slot) glds16(vsrc+(long)(t)*KVBLK*DM,(unsigned)__builtin_amdgcn_readfirstlane(vdst+(slot)))
  const int vb0=(int)(lds0+LDS_V)+((lane>>4)&1)*32+(lane&3)*8+(4*hi+((lane&15)>>2))*64;
  const char*Kbase=shm+LDS_K; bf16x8 kf[8];
  const lds_cptr shm3=(lds_cptr)shm; const lds_cptr kp0=shm3+LDS_K+hi*1024+r32*16; const lds_cptr vp0=shm3+LDS_V+((lane>>4)&1)*32+(lane&3)*8+(4*hi+((lane&15)>>2))*64;
  const int NT=(q0+QB)/KVBLK-ts;
  DMA_K(0,0);DMA_V(0,0);DMA_K(1,SLOTB);
  bf16x8 qr[4];
  #pragma unroll
  for(int d0=0;d0<4;++d0)qr[d0]=*reinterpret_cast<const bf16x8*>(&Qw[(long)r32*DM+d0*16+hi*8]);
  float mhat=0.f,l_reg=0.f;f32x16 o[2];o[0]=f32x16{};o[1]=f32x16{};f32x16 negm;
  const float delta=64.f*slope2,c32=32.f*slope2;
  _Pragma("unroll") for(int r=0;r<16;++r)negm[r]=slope2*(float)crow(r,hi); asm volatile("":"+v"(negm));
  const int qrel=wid*QBLK+r32;
  #define CMASK(P0,P1,t) do{int jb_=(t)-(NT-4); if(jb_>=0)cmask(P0,P1,jb_,qrel,hi);}while(0)
  bool resc=false;
  #define START(P0,P1) do{ const float rm=rowmax(P0,P1); resc=false; \
    { const float dl=rm; mhat=fadd_s(mhat,dl); \
      _Pragma("unroll") for(int r=0;r<16;++r){P0[r]=fsub_s(P0[r],dl);P1[r]=fsub_s(P1[r],dl);} \
      _Pragma("unroll") for(int r=0;r<16;++r)negm[r]-=dl; asm volatile("":"+v"(negm)); } \
    _Pragma("unroll") for(int r=0;r<16;++r)P0[r]=__builtin_amdgcn_exp2f(P0[r]); }while(0)
  #define RESC() do{ if(resc){ asm volatile("s_waitcnt lgkmcnt(0)":::"memory"); \
      _Pragma("unroll") for(int d_=0;d_<2;++d_) _Pragma("unroll") for(int r=0;r<16;++r)o[d_][r]*=wsf[crow(r,hi)]; } }while(0)
  f32x16 pA0,pA1,pB0,pB1;
  int sl_prev=0,sl_cur=0,sl_next=SLOTB;
  #define ROT() do{sl_prev=sl_cur;sl_cur=sl_next;sl_next=(sl_next==(NSLOT-1)*SLOTB)?0:sl_next+SLOTB;}while(0)
  DMA_K(2,2*SLOTB);
  WAIT_BAR(3);
  qkt(pA0,pA1,Kbase,qr,negm,r32,hi);asm volatile("s_nop 15\n\ts_nop 7":"+v"(pA0),"+v"(pA1)); _Pragma("unroll") for(int r=0;r<16;++r)pA1[r]+=c32; CMASK(pA0,pA1,0);
  START(pA0,pA1);
  _Pragma("unroll") for(int r=0;r<16;++r)pA1[r]=__builtin_amdgcn_exp2f(pA1[r]);
  WAIT_BAR(0);
  DMA_K(3,0);DMA_V(1,SLOTB);
  ROT();
  kload8(kf,kp0+sl_cur);
  WAIT_BAR(2);
  s16x4 vlo[8],vhi[8]; u32x4 pw0,pw1,pw2,pw3;
  #define PKW(P,B) cvtpk_s(P[B],P[B+1])
  #define PAF(k) __builtin_bit_cast(bf16x8,pw##k)
  #define VFR(i) (bf16x8){vlo[i][0],vlo[i][1],vlo[i][2],vlo[i][3],vhi[i][0],vhi[i][1],vhi[i][2],vhi[i][3]}
  #define PIN(x) asm volatile("":"+v"(x))
  #define MX3(a,b,c) __builtin_fmaxf(__builtin_fmaxf((a),(b)),(c))
  #define GAPA(MF,A0,A1,A2,A3,W0,W1,PW) do{ MF; sacc+=A0; sacc+=A1; sacc+=A2; sacc+=A3; PIN(sacc); W0; W1; PIN(PW); SBAR(); }while(0)
  #define EX(v) __builtin_amdgcn_exp2f(v)
  #define GAPB(MF,X,B) do{ MF; X[B]=EX(X[B]); X[B+1]=EX(X[B+1]); X[B+2]=EX(X[B+2]); X[B+3]=EX(X[B+3]); PIN(X); SBAR(); }while(0)
  #define VRD(i) do{ vlo[i]=vtr(vp_+(((i)>>2)*4096+((i)&3)*1024)); vhi[i]=vtr(vp_+(((i)>>2)*4096+((i)&3)*1024+512)); }while(0)
  #define KRD(G,j) do{ if(G){ kload2(kf,kp0+sl_next,j); SBAR(); } }while(0)
  #define STEP(C0,C1,P0,P1,t,GK,GV,GL) do{ SBAR(); \
    _Pragma("unroll") for(int r=0;r<16;++r)negm[r]+=delta; asm volatile("":"+v"(negm)); \
    const lds_cptr vp_=vp0+sl_prev; \
    VRD(0); SBAR(); float sacc=(P0[0]+P0[1]); \
    GAPA(C0=MFMA32(kf[0],qr[0],negm), P0[2],P0[3],P0[4],P0[5],     pw0[0]=PKW(P0,0), pw0[1]=PKW(P0,2), pw0); \
    VRD(4); SBAR(); GAPA(C1=MFMA32(kf[1],qr[0],negm), P0[6],P0[7],P0[8],P0[9],     pw0[2]=PKW(P0,4), pw0[3]=PKW(P0,6), pw0); \
    VRD(1); SBAR(); GAPA(C0=MFMA32(kf[2],qr[1],C0),   P0[10],P0[11],P0[12],P0[13], pw1[0]=PKW(P0,8), pw1[1]=PKW(P0,10), pw1); \
    VRD(5); SBAR(); GAPA(C1=MFMA32(kf[3],qr[1],C1),   P0[14],P0[15],P1[0],P1[1],   pw1[2]=PKW(P0,12),pw1[3]=PKW(P0,14), pw1); \
    VRD(2); SBAR(); GAPA(C0=MFMA32(kf[4],qr[2],C0),   P1[2],P1[3],P1[4],P1[5],     pw2[0]=PKW(P1,0), pw2[1]=PKW(P1,2), pw2); \
    VRD(6); SBAR(); GAPA(C1=MFMA32(kf[5],qr[2],C1),   P1[6],P1[7],P1[8],P1[9],     pw2[2]=PKW(P1,4), pw2[3]=PKW(P1,6), pw2); \
    VRD(3); SBAR(); GAPA(C0=MFMA32(kf[6],qr[3],C0),   P1[10],P1[11],P1[12],P1[13], pw3[0]=PKW(P1,8), pw3[1]=PKW(P1,10), pw3); \
    VRD(7); SBAR(); GAPA(C1=MFMA32(kf[7],qr[3],C1),   P1[14],P1[15],0.f,0.f,       pw3[2]=PKW(P1,12),pw3[3]=PKW(P1,14), pw3); \
    l_reg+=sacc; \
    if(GK){DMA_K((t)+3,sl_cur);} if(GV){DMA_V((t)+1,sl_next);} \
    _Pragma("unroll") for(int r=0;r<16;++r)C1[r]+=c32; \
    CMASK(C0,C1,t); \
    { float a=MX3(C0[0],C0[1],C1[0]),b=MX3(C0[2],C0[3],C1[1]); a=MX3(a,C1[2],C1[3]); \
      _Pragma("unroll") for(int r=4;r<16;r+=4){a=MX3(a,C0[r],C0[r+1]);b=MX3(b,C0[r+2],C0[r+3]);a=MX3(a,C1[r],C1[r+1]);b=MX3(b,C1[r+2],C1[r+3]);} \
      float rm=__builtin_fmaxf(a,b); { auto rr=__builtin_amdgcn_permlane32_swap(__float_as_uint(rm),__float_as_uint(rm),false,false); rm=__builtin_fmaxf(__uint_as_float(rr[0]),__uint_as_float(rr[1])); } \
      resc=false; \
      if(__builtin_expect(__any(rm>(float)THRL),0)){ const float dl=__builtin_fmaxf(rm,0.f); mhat+=dl; \
        _Pragma("unroll") for(int r=0;r<16;++r){C0[r]-=dl;C1[r]-=dl;} \
        _Pragma("unroll") for(int r=0;r<16;++r)negm[r]-=dl; asm volatile("":"+v"(negm)); \
        const float f=__builtin_amdgcn_exp2f(-dl); l_reg*=f; if(hi==0)wsf[r32]=f; resc=true; } } \
    SBAR(); \
    GAPB(o[0]=MFMA32(PAF(0),VFR(0),o[0]), C0,0); \
    GAPB(o[1]=MFMA32(PAF(0),VFR(4),o[1]), C0,4); \
    KRD(GL,0); GAPB(o[0]=MFMA32(PAF(1),VFR(1),o[0]), C0,8); \
    KRD(GL,1); GAPB(o[1]=MFMA32(PAF(1),VFR(5),o[1]), C0,12); \
    KRD(GL,2); GAPB(o[0]=MFMA32(PAF(2),VFR(2),o[0]), C1,0); \
    KRD(GL,3); GAPB(o[1]=MFMA32(PAF(2),VFR(6),o[1]), C1,4); \
    GAPB(o[0]=MFMA32(PAF(3),VFR(3),o[0]), C1,8); \
    GAPB(o[1]=MFMA32(PAF(3),VFR(7),o[1]), C1,12); \
    }while(0)
  int t=1;
  #undef CMASK
  #define CMASK(P0,P1,t) do{}while(0)
  for(;t+5<NT;t+=2){
    STEP(pB0,pB1,pA0,pA1,t,true,true,true);     WAIT_BAR(2); RESC(); ROT();
    STEP(pA0,pA1,pB0,pB1,t+1,true,true,true);   WAIT_BAR(2); RESC(); ROT();
  }
  #undef CMASK
  #define CMASK(P0,P1,t) do{int jb_=(t)-(NT-4); if(jb_>=0)cmask(P0,P1,jb_,qrel,hi);}while(0)
  #define ENDW(tt) do{ if((tt)+3<NT){WAIT_BAR(2);} else if((tt)+2<NT){WAIT_BAR(1);} else {WAIT_BAR(0);} }while(0)
  for(;t+1<NT;t+=2){
    STEP(pB0,pB1,pA0,pA1,t,(t+3<NT),(t+1<NT),(t+1<NT));       ENDW(t);   RESC(); ROT();
    STEP(pA0,pA1,pB0,pB1,t+1,(t+4<NT),(t+2<NT),(t+2<NT));     ENDW(t+1); RESC(); ROT();
  }
  STEP(pB0,pB1,pA0,pA1,NT-1,false,false,false); RESC();
  { float sacc=pB0[0]+pB0[1]; _Pragma("unroll") for(int r=2;r<16;++r)sacc+=pB0[r]; _Pragma("unroll") for(int r=0;r<16;++r)sacc+=pB1[r]; l_reg+=sacc;
    pw0=(u32x4){PKW(pB0,0),PKW(pB0,2),PKW(pB0,4),PKW(pB0,6)};pw1=(u32x4){PKW(pB0,8),PKW(pB0,10),PKW(pB0,12),PKW(pB0,14)};pw2=(u32x4){PKW(pB1,0),PKW(pB1,2),PKW(pB1,4),PKW(pB1,6)};pw3=(u32x4){PKW(pB1,8),PKW(pB1,10),PKW(pB1,12),PKW(pB1,14)};
    SBAR(); pv(o,vb0+sl_cur,PAF(0),PAF(1),PAF(2),PAF(3)); }
  #undef PKW
  #undef PAF
  #undef VFR
  #undef PIN
  #undef MX3
  #undef GAPA
  #undef GAPB
  #undef EX
  #undef VRD
  #undef KRD
  #undef STEP
  #undef ENDW
  {auto rr=__builtin_amdgcn_permlane32_swap(__float_as_uint(l_reg),__float_as_uint(l_reg),false,false);l_reg=__uint_as_float(rr[0])+__uint_as_float(rr[1]);}
  if(hi==0)wsf[32+r32]=l_reg;asm volatile("s_waitcnt lgkmcnt(0)":::"memory");
  float rli[16];
  #pragma unroll
  for(int r=0;r<16;++r)rli[r]=__builtin_amdgcn_rcpf(wsf[32+crow(r,hi)]);
  bf16*Ow=O+(rowbase+q0+wid*QBLK)*DMO+ocol;
  { bf16*stg=(bf16*)(shm+LDS_OST)+wid*2048;
    #pragma unroll
    for(int r=0;r<16;++r){const int orow=crow(r,hi);
      #pragma unroll
      for(int d0=0;d0<2;++d0)stg[orow*64+d0*32+r32]=(bf16)(o[d0][r]*rli[r]);}
    asm volatile("s_waitcnt lgkmcnt(0)":::"memory");
    #pragma unroll
    for(int i=0;i<4;++i){const int row=i*8+(lane>>3),ch=lane&7; const u32x4 v=*(const u32x4*)(stg+row*64+ch*8); ATTN_STORE16(Ow+(long)row*DMO+ch*8,v);} }
  asm volatile("s_waitcnt lgkmcnt(0)\n\ts_barrier":::"memory");
  #undef DMA_K
  #undef DMA_V
  #undef CMASK
  #undef START
  #undef RESC
  #undef ROT
}
}
#undef SBAR
#undef WAIT_BAR
#undef MFMA32
__device__ const unsigned char ATT_H[64] = {5,6,7,5,6,7,5,6,7,4,4,4,4,5,6,7,4,5,6,7,3,3,3,3,3,3,4,5,6,7,2,2,2,2,2,2,1,1,1,1,1,1,1,2,3,4,5,6,7,0,0,0,0,0,0,0,0,1,2,3,4,5,6,7};
__device__ const unsigned char ATT_Q[64] = {7,7,7,6,6,6,5,5,5,5,6,7,4,4,4,4,3,3,3,3,3,4,5,6,7,2,2,2,2,2,2,3,4,5,6,7,1,2,3,4,5,6,7,1,1,1,1,1,1,1,2,3,4,5,6,7,0,0,0,0,0,0,0,0};
__device__ const unsigned char ATT_S[64] = {0,0,0,0,0,0,0,0,0,2,6,10,0,0,0,0,0,0,0,0,2,6,10,14,18,0,0,0,0,0,2,6,10,14,18,22,0,4,8,12,16,20,24,0,0,0,0,0,0,2,6,10,14,18,22,26,0,0,0,0,0,0,0,0};
__device__ __forceinline__ void phase_attn(const h16* Q, const h16* KK, const h16* VV, h16* ORAW, char* lds_generic, int blk, int G, const int wave) {
    const int vcu = (G % 8 == 0) ? (blk % 8) * (G / 8) + blk / 8 : blk;
#pragma unroll 1
    for (int r = 0; r < 16; ++r) {
        const int p = r * 256 + ((r & 1) ? 255 - vcu : vcu), ci = p >> 6, u = p & 63;
        const int hh = ATT_H[ci], qb = ATT_Q[ci], ts = ATT_S[ci], b = u >> 2, c = (u >> 1) & 1, vh = u & 1;
        const float slope2 = exp2f(-(float)(hh + 1)) * LOG2E;
        attn_body::attn_unit<8>(b, hh * 128 + c * 64, hh * 128 + vh * 64, c * 1024 + hh * 128 + vh * 64, slope2, qb, ts, Q, KK, VV, ORAW, lds_generic, wave);
    }
}

__device__ __forceinline__ float row16_sum(float v);
__device__ __forceinline__ void phase_attn_combine(const h16* ORAW, const float* lamv  , const float* subg  , float lambda_init, h16* OB, int gw_, int NGW_, int lane) {
    lane = lane_id(); OPAQUE(lane);
    const float la = wave_sum(lamv[lane] * lamv[64 + lane]), lb = wave_sum(lamv[128 + lane] * lamv[192 + lane]);
    const float lam = __expf(la) - __expf(lb) + lambda_init;
    const int hs = lane >> 5, d = (lane & 31) * 4;
    const f32x4 gsc = *(const f32x4*)(subg + d) * (1.0f - lambda_init);
#pragma unroll 1
    for (int t0 = gw_; t0 < T; t0 += 2 * NGW_) {
        h16x4 a[2][4], b[2][4];
#pragma unroll
        for (int q = 0; q < 2; ++q) { const size_t t = (size_t)t0 + (size_t)q * NGW_;
#pragma unroll
            for (int hp = 0; hp < 4; ++hp) { const int hh = 2 * hp + hs; a[q][hp] = *(const h16x4*)(ORAW + t * 2048 + hh * 128 + d); b[q][hp] = *(const h16x4*)(ORAW + t * 2048 + 1024 + hh * 128 + d); } }
#pragma unroll
        for (int q = 0; q < 2; ++q) { const size_t t = (size_t)t0 + (size_t)q * NGW_;
#pragma unroll
            for (int hp = 0; hp < 4; ++hp) { const int hh = 2 * hp + hs;
                const f32x4 o = __builtin_convertvector(a[q][hp], f32x4) - __builtin_convertvector(b[q][hp], f32x4) * lam;
                float ss = (o.x * o.x + o.y * o.y) + (o.z * o.z + o.w * o.w); ss = row16_sum(ss); ss += swz16f(ss);
                const float r = rsqrtf(ss * (1.0f / 128.0f) + 1e-5f);
                *(u32x2*)(OB + t * 1024 + hh * 128 + d) = pkh4(o * r * gsc); } }
    }
}

struct SchedRkv {
    const char* XM; const char* Wrkv; const char* Wl1; int nk, G, c;
    __device__ __forceinline__ bool next(int i, Unit& u) const {
        int pm, q;
        if (G == 256) { const int L = i * 32 + (c >> 3), pl = L / nk; q = L - pl * nk; pm = pl * 8 + (c & 7); if (pm >= 128) return false; }
        else { const int U = i * G + c; if (U >= 128 * nk) return false; pm = U / nk; q = U - pm * nk; }
        u.pm = pm; u.rows = 256; u.e = 0; u.rbase = 0; u.list = nullptr;
        int xs, pn, kind; const char* B;
        if (q < 12) { kind = q >> 2; pn = q & 3; xs = kind; B = Wrkv + ((size_t)kind * 1024 + pn * 256) * 2048; }
        else { kind = q - 9; pn = 0; xs = (kind == 6) ? 2 : kind; B = Wl1 + (size_t)(kind - 3) * 256 * 2048; }
        u.kind = kind; u.pn = pn; u.B = B; u.A = XM + ((size_t)xs * T + (size_t)pm * 256) * 2048;
        return true;
    }
    __device__ __forceinline__ unsigned a_off(const Unit&, int row) const { return (unsigned)row * 2048u; }
};
struct SchedL2 {
    const char* L1O; const char* Wl2; int kind, G, c;
    __device__ __forceinline__ bool next(int i, Unit& u) const {
        const int U = i * G + c; if (U >= 128 * 4) return false;
        const int pm = U >> 2; u.pm = pm; u.pn = U & 3; u.rows = 256; u.e = 0; u.rbase = 0; u.list = nullptr; u.kind = kind;
        u.A = L1O + ((size_t)kind * T + (size_t)pm * 256) * 512; u.B = Wl2 + ((size_t)kind * 1024 + u.pn * 256) * 512;
        return true;
    }
    __device__ __forceinline__ unsigned a_off(const Unit&, int row) const { return (unsigned)row * 512u; }
};
struct SchedPlain {
    const char* A; const char* B; int npn, G, c;
    __device__ __forceinline__ bool next(int i, Unit& u) const {
        int pm, pn;
        if (G == 256) { const int L = i * 32 + (c >> 3), pl = L / npn; pn = L - pl * npn; pm = pl * 8 + (c & 7); if (pm >= 128) return false; }
        else { const int U = i * G + c; if (U >= 128 * npn) return false; pm = U / npn; pn = U - pm * npn; }
        u.pm = pm; u.rows = 256; u.e = 0; u.rbase = 0; u.list = nullptr;
        u.kind = pn >> 2; u.pn = pn & 3; u.A = A + (size_t)pm * 256 * 2048; u.B = B + (size_t)pn * 256 * 2048;
        return true;
    }
    __device__ __forceinline__ unsigned a_off(const Unit&, int row) const { return (unsigned)row * 2048u; }
};
struct SchedMoe {
    const LAS unsigned* misc; const LAS int* tile_e; const char* A; const char* W; const int* LIST; int npn, gather, G, c; size_t wstride;
    __device__ __forceinline__ bool next(int i, Unit& u) const {
        const int ntile = __builtin_amdgcn_readfirstlane((int)misc[48 + 32]);
        int rtg, pn;
        if (G == 256) { const int x = c & 7, j = c >> 3, rpr = 32 / npn; rtg = (i * rpr + j / npn) * 8 + x; pn = j % npn; if (rtg >= ntile) return false; }
        else { const int U = i * G + c; if (U >= ntile * npn) return false; rtg = U / npn; pn = U - rtg * npn; }
        const int e = __builtin_amdgcn_readfirstlane(tile_e[rtg]);
        const int rt = rtg - __builtin_amdgcn_readfirstlane((int)misc[48 + e]), cnt = __builtin_amdgcn_readfirstlane((int)misc[16 + e]);
        u.pm = rtg; u.pn = pn; u.kind = 0; u.e = e; u.rbase = rtg * 256; u.rows = min(256, cnt - rt * 256);
        u.list = LIST + (size_t)e * ECAP + rt * 256;
        u.A = gather ? A : A + (size_t)rtg * 256 * 1024; u.B = W + (size_t)e * wstride + (size_t)pn * 256 * 1024;
        return true;
    }
    __device__ __forceinline__ unsigned a_off(const Unit& u, int row) const {
        if (!gather) return (unsigned)row * 1024u;
        const int slot = (row < u.rows) ? u.list[row] : 0;
        return (unsigned)(slot >> 2) * 1024u;
    }
};
__device__ __forceinline__ void moe_tables(const unsigned* CNT, volatile LAS unsigned* misc, LAS int* tile_e, const int wave) {
    if (wave == 0 && lane_id() == 0) {
        unsigned acc = 0;
        for (int e = 0; e < 32; ++e) { const unsigned c = __hip_atomic_load(CNT + e, __ATOMIC_RELAXED, __HIP_MEMORY_SCOPE_AGENT); misc[16 + e] = c; misc[48 + e] = acc; acc += (c + 255u) >> 8; }
        misc[48 + 32] = acc;
    }
    __syncthreads();
    { const int ntile = (int)misc[48 + 32];
      for (int i = wave * 64 + lane_id(); i < ntile; i += NTHR) { int e = 0; for (int j = 1; j < 32; ++j) if ((int)misc[48 + j] <= i) e = j; tile_e[i] = e; } }
    __syncthreads();
}

__device__ __forceinline__ size_t hm_off(int row, int col) { return ((size_t)((row >> 11) * 16 + (col >> 6)) * SEQ + (row & 2047)) * 64 + (col & 63); }
struct EpiRkv {
    h16* Rp; h16* Kp; h16* Vp; h16* L1O;
    __device__ __forceinline__ void operator()(const f32x4 (&acc)[2][2][4][2], const Unit& u, int wr, int wc, int fr, int fq) const {
        if (u.kind < 3) {
            h16* C = u.kind == 0 ? Rp : (u.kind == 1 ? Kp : Vp);
            FOR_ACC(ai, bj, m, n) { const int row = u.pm * 256 + 128 * ai + 64 * wr + 16 * m + fr, col = u.pn * 256 + 128 * bj + 32 * wc + 16 * n + 4 * fq;
                *(u32x2*)(C + hm_off(row, col)) = pkh4(acc[ai][bj][m][n]); }
        } else {
            h16* O = L1O + (size_t)(u.kind - 3) * T * 256; const int kd = u.kind;
            FOR_ACC(ai, bj, m, n) { const int row = u.pm * 256 + 128 * ai + 64 * wr + 16 * m + fr, col = 128 * bj + 32 * wc + 16 * n + 4 * fq;
                f32x4 v = acc[ai][bj][m][n];
                if (kd == 3) { v.x = tanhf(v.x); v.y = tanhf(v.y); v.z = tanhf(v.z); v.w = tanhf(v.w); }
                else if (kd == 5) { v.x = sigmoidf_(v.x); v.y = sigmoidf_(v.y); v.z = sigmoidf_(v.z); v.w = sigmoidf_(v.w); }
                *(u32x2*)(O + (size_t)row * 256 + col) = pkh4(v); }
        }
    }
};
template <int KD> struct EpiL2 {
    void* O; const h16* VF; const float* bias;
    __device__ __forceinline__ void operator()(const f32x4 (&acc)[2][2][4][2], const Unit& u, int wr, int wc, int fr, int fq) const {
        f32x4 bv[2][2];
#pragma unroll
        for (int bj = 0; bj < 2; ++bj)
#pragma unroll
            for (int n = 0; n < 2; ++n) bv[bj][n] = (KD != 2) ? *(const f32x4*)(bias + u.pn * 256 + 128 * bj + 32 * wc + 16 * n + 4 * fq) : (f32x4){0.f, 0.f, 0.f, 0.f};
#pragma unroll
        for (int ai = 0; ai < 2; ++ai)
#pragma unroll
            for (int mp = 0; mp < 2; ++mp) {
                h16x4 vc[2][2][2], vf[2][2][2];
                if (KD == 3) {
#pragma unroll
                    for (int mm = 0; mm < 2; ++mm)
#pragma unroll
                        for (int bj = 0; bj < 2; ++bj)
#pragma unroll
                            for (int n = 0; n < 2; ++n) { const size_t o = hm_off(u.pm * 256 + 128 * ai + 64 * wr + 16 * (2 * mp + mm) + fr, u.pn * 256 + 128 * bj + 32 * wc + 16 * n + 4 * fq);
                                vc[mm][bj][n] = *(const h16x4*)((const h16*)O + o); vf[mm][bj][n] = *(const h16x4*)(VF + o); }
                }
#pragma unroll
                for (int mm = 0; mm < 2; ++mm)
#pragma unroll
                    for (int bj = 0; bj < 2; ++bj)
#pragma unroll
                        for (int n = 0; n < 2; ++n) { const int m = 2 * mp + mm; const size_t o = hm_off(u.pm * 256 + 128 * ai + 64 * wr + 16 * m + fr, u.pn * 256 + 128 * bj + 32 * wc + 16 * n + 4 * fq);
                            f32x4 v = acc[ai][bj][m][n] + bv[bj][n];
                            if (KD == 0) { v.x = 1.0f - __expf(-0.6065306597126334f * sigmoidf_(v.x)); v.y = 1.0f - __expf(-0.6065306597126334f * sigmoidf_(v.y)); v.z = 1.0f - __expf(-0.6065306597126334f * sigmoidf_(v.z)); v.w = 1.0f - __expf(-0.6065306597126334f * sigmoidf_(v.w)); }
                            if (KD == 1 || KD == 3) { v.x = sigmoidf_(v.x); v.y = sigmoidf_(v.y); v.z = sigmoidf_(v.z); v.w = sigmoidf_(v.w); }
                            if (KD == 3) { const f32x4 c_ = __builtin_convertvector(vc[mm][bj][n], f32x4), f_ = __builtin_convertvector(vf[mm][bj][n], f32x4); v = c_ + (f_ - c_) * v; }
                            *(u32x2*)((h16*)O + o) = pkh4(v); }
                if (KD == 3) EPI_FENCE();
            }
    }
};
template <bool F16X> struct EpiRes {
    const void* X; h16* H;
    __device__ __forceinline__ void operator()(const f32x4 (&acc)[2][2][4][2], const Unit& u, int wr, int wc, int fr, int fq) const {
        const float* Xf = (const float*)X; const h16* Xh = (const h16*)X;
#pragma unroll
        for (int ai = 0; ai < 2; ++ai)
#pragma unroll
            for (int mp = 0; mp < 2; ++mp) {
                f32x4 xr[2][2][2]; h16x4 xh[2][2][2];
#pragma unroll
                for (int mm = 0; mm < 2; ++mm)
#pragma unroll
                    for (int bj = 0; bj < 2; ++bj)
#pragma unroll
                        for (int n = 0; n < 2; ++n) { const size_t o = (size_t)(u.pm * 256 + 128 * ai + 64 * wr + 16 * (2 * mp + mm) + fr) * D + u.pn * 256 + 128 * bj + 32 * wc + 16 * n + 4 * fq;
                            if (F16X) xh[mm][bj][n] = *(const h16x4*)(Xh + o); else xr[mm][bj][n] = *(const f32x4*)(Xf + o); }
#pragma unroll
                for (int mm = 0; mm < 2; ++mm)
#pragma unroll
                    for (int bj = 0; bj < 2; ++bj)
#pragma unroll
                        for (int n = 0; n < 2; ++n) { const int m = 2 * mp + mm; const f32x4 xv = F16X ? __builtin_convertvector(xh[mm][bj][n], f32x4) : xr[mm][bj][n];
                            *(u32x2*)(H + (size_t)(u.pm * 256 + 128 * ai + 64 * wr + 16 * m + fr) * D + u.pn * 256 + 128 * bj + 32 * wc + 16 * n + 4 * fq) = pkh4(xv * ALPHA + acc[ai][bj][m][n]); }
                EPI_FENCE();
            }
    }
};
struct EpiQkv {
    h16* O0; h16* O1; float sc0;
    __device__ __forceinline__ void operator()(const f32x4 (&acc)[2][2][4][2], const Unit& u, int wr, int wc, int fr, int fq) const {
        h16* O = u.kind == 0 ? O0 : O1; const float sc = u.kind == 0 ? sc0 : 1.0f;
        FOR_ACC(ai, bj, m, n) { const int row = u.pm * 256 + 128 * ai + 64 * wr + 16 * m + fr, col = u.pn * 256 + 128 * bj + 32 * wc + 16 * n + 4 * fq;
            *(u32x2*)(O + (size_t)row * 1024 + col) = pkh4(acc[ai][bj][m][n] * sc); }
    }
};
struct EpiGu {
    unsigned char* ACT; const float* bgu;
    __device__ __forceinline__ void operator()(const f32x4 (&acc)[2][2][4][2], const Unit& u, int wr, int wc, int fr, int fq) const {
        const float* bb = bgu + (size_t)u.e * 2048;
        f32x4 bg[2], bu[2];
#pragma unroll
        for (int n = 0; n < 2; ++n) { const int col = u.pn * 128 + 32 * wc + 16 * n + 4 * fq; bg[n] = *(const f32x4*)(bb + col); bu[n] = *(const f32x4*)(bb + 1024 + col); }
#pragma unroll
        for (int ai = 0; ai < 2; ++ai)
#pragma unroll
            for (int m = 0; m < 4; ++m) { const int rl = 128 * ai + 64 * wr + 16 * m + fr;
                if (rl < u.rows) {
#pragma unroll
                    for (int n = 0; n < 2; ++n) { const int col = u.pn * 128 + 32 * wc + 16 * n + 4 * fq;
                        const f32x4 gt = acc[ai][0][m][n] * (1.0f / GU_SCALE) + bg[n], up = acc[ai][1][m][n] * (1.0f / GU_SCALE) + bu[n]; f32x4 r;
#pragma unroll
                        for (int e = 0; e < 4; ++e) { const float g = fminf(gt[e], 7.0f), uu = __builtin_amdgcn_fmed3f(up[e], -7.0f, 7.0f); r[e] = (uu + 1.0f) * (g * __builtin_amdgcn_rcpf(1.0f + __builtin_amdgcn_exp2f((-1.702f * 1.4426950408889634f) * g))); }
                        int pk_ = __builtin_amdgcn_cvt_pk_fp8_f32(r[0], r[1], 0, false); pk_ = __builtin_amdgcn_cvt_pk_fp8_f32(r[2], r[3], pk_, true);
                        *(unsigned*)(ACT + (size_t)(u.rbase + rl) * 1024 + col) = (unsigned)pk_; }
                } }
    }
};
struct EpiDn {
    unsigned char* YS; const float* bdn; const float* TOPG;
    __device__ __forceinline__ void operator()(const f32x4 (&acc)[2][2][4][2], const Unit& u, int wr, int wc, int fr, int fq) const {
        const float* bb = bdn + (size_t)u.e * 1024;
        f32x4 bv[2][2]; int slot[2][4]; float gt[2][4];
#pragma unroll
        for (int bj = 0; bj < 2; ++bj)
#pragma unroll
            for (int n = 0; n < 2; ++n) bv[bj][n] = *(const f32x4*)(bb + u.pn * 256 + 128 * bj + 32 * wc + 16 * n + 4 * fq);
#pragma unroll
        for (int ai = 0; ai < 2; ++ai)
#pragma unroll
            for (int m = 0; m < 4; ++m) { const int rl = 128 * ai + 64 * wr + 16 * m + fr; slot[ai][m] = (rl < u.rows) ? u.list[rl] : -1; }
#pragma unroll
        for (int ai = 0; ai < 2; ++ai)
#pragma unroll
            for (int m = 0; m < 4; ++m) gt[ai][m] = (slot[ai][m] >= 0) ? TOPG[slot[ai][m]] * YS_SCALE : 0.f;
#pragma unroll
        for (int ai = 0; ai < 2; ++ai)
#pragma unroll
            for (int m = 0; m < 4; ++m) {
                if (slot[ai][m] >= 0) {
#pragma unroll
                    for (int bj = 0; bj < 2; ++bj)
#pragma unroll
                        for (int n = 0; n < 2; ++n) { const int col = u.pn * 256 + 128 * bj + 32 * wc + 16 * n + 4 * fq;
                            const f32x4 yv = (acc[ai][bj][m][n] * (1.0f / DN_SCALE) + bv[bj][n]) * gt[ai][m];
                            int pk_ = __builtin_amdgcn_cvt_pk_fp8_f32(yv[0], yv[1], 0, false); pk_ = __builtin_amdgcn_cvt_pk_fp8_f32(yv[2], yv[3], pk_, true);
                            *(unsigned*)(YS + (size_t)slot[ai][m] * 1024 + col) = (unsigned)pk_; }
                } }
    }
};

struct Args { const float* in[33]; float* out; unsigned char* ws; int ph_lo, ph_hi; };
enum { I_X = 0, I_LNG, I_LNB, I_MIX, I_WRKV, I_WO, I_W0, I_W1, I_W2, I_A0, I_A1, I_A2, I_G1, I_G2, I_KK, I_KA, I_RK, I_LNXG, I_LNXB, I_V0, I_V1, I_V2,
       I_KVW, I_DAQ, I_DAO, I_DALAM, I_DASUB, I_RW, I_RB, I_WGU, I_BGU, I_WDN, I_BDN };

typedef const float* cfptr;
#define KAS __attribute__((address_space(4)))
#define KA_DECL const KAS cfptr* kin = (const KAS cfptr*)__builtin_amdgcn_kernarg_segment_ptr(); asm volatile("" : "+s"(kin))
#define KA_RELOAD asm volatile("" : "+s"(kin))
#define PH_BEGIN KA_RELOAD; asm volatile("" : "+s"(wave), "+s"(G), "+s"(blk)); ws = KWS; ctl = (unsigned*)(ws + WS_CTL)
#define KIN(i) (kin[i])
#define KOUT ((float*)kin[33])
#define KWS ((unsigned char*)kin[34])
__global__ void __launch_bounds__(NTHR, 2) yoco_fwd(Args args) {
    extern __shared__ __attribute__((aligned(16))) unsigned char lds_raw[];
    LAS unsigned char* lds = (LAS unsigned char*)lds_raw;
    volatile LAS unsigned* MISC = (volatile LAS unsigned*)(lds + MISC_OFF);
    int wave = __builtin_amdgcn_readfirstlane((int)threadIdx.x >> 6);
    int G = gridDim.x, blk = blockIdx.x; int lane = 0;
#define gw (blk * NWAVES + wave)
#define NGW (G * NWAVES)
    KA_DECL;
    unsigned char* ws = KWS;
    unsigned* ctl = (unsigned*)(ws + WS_CTL);
    for (int u = wave * 64 + lane_id(); u < (LDS_BYTES - MISC_OFF) / 4; u += NTHR) ((LAS unsigned*)(lds + MISC_OFF))[u] = 0u;
    __syncthreads();
    XcdBarrier bar = xcd_barrier_post(ctl + CW_BAR, MISC + 8, wave);
#define GRID_BAR() xcd_barrier(bar, wave)

    {
        LAS float* scr = (LAS float*)(lds + wave * 16896);
        conv_batch(KIN(I_WRKV), 6, 1024, 1024, (h16*)(ws + WS_W_RKV), 1024, 1024, 0, scr, gw, NGW, lane);
        conv_batch(KIN(I_WO), 2, 1024, 1024, (h16*)(ws + WS_W_RO), 1024, 1024, 0, scr, gw, NGW, lane);
#pragma unroll
        for (int l = 0; l < 2; ++l) {
            conv_batch(KIN(I_W1) + (size_t)l * 1024 * 64, 1, 1024, 64, (h16*)(ws + WS_W_L1) + (size_t)(l * 4 + 0) * 256 * 1024, 1024, 256, 0, scr, gw, NGW, lane);
            conv_batch(KIN(I_A1) + (size_t)l * 1024 * 64, 1, 1024, 64, (h16*)(ws + WS_W_L1) + (size_t)(l * 4 + 1) * 256 * 1024, 1024, 256, 0, scr, gw, NGW, lane);
            conv_batch(KIN(I_G1) + (size_t)l * 1024 * 160, 1, 1024, 160, (h16*)(ws + WS_W_L1) + (size_t)(l * 4 + 2) * 256 * 1024, 1024, 256, 0, scr, gw, NGW, lane);
            conv_batch(KIN(I_W2) + (size_t)l * 64 * 1024, 1, 64, 1024, (h16*)(ws + WS_W_L2) + (size_t)(l * 4 + 0) * 256 * 1024, 256, 1024, 0, scr, gw, NGW, lane);
            conv_batch(KIN(I_A2) + (size_t)l * 64 * 1024, 1, 64, 1024, (h16*)(ws + WS_W_L2) + (size_t)(l * 4 + 1) * 256 * 1024, 256, 1024, 0, scr, gw, NGW, lane);
            conv_batch(KIN(I_G2) + (size_t)l * 160 * 1024, 1, 160, 1024, (h16*)(ws + WS_W_L2) + (size_t)(l * 4 + 2) * 256 * 1024, 256, 1024, 0, scr, gw, NGW, lane);
        }
        conv_batch(KIN(I_V1), 1, 1024, 32, (h16*)(ws + WS_W_L1) + (size_t)(4 + 3) * 256 * 1024, 1024, 256, 0, scr, gw, NGW, lane);
        conv_batch(KIN(I_V2), 1, 32, 1024, (h16*)(ws + WS_W_L2) + (size_t)(4 + 3) * 256 * 1024, 256, 1024, 0, scr, gw, NGW, lane);
        conv_batch(KIN(I_KVW), 1, 1024, 2048, (h16*)(ws + WS_W_KV), 1024, 2048, 0, scr, gw, NGW, lane);
        conv_batch(KIN(I_DAQ), 2, 1024, 1024, (h16*)(ws + WS_W_Q), 1024, 1024, 0, scr, gw, NGW, lane);
        conv_batch(KIN(I_DAO), 2, 1024, 1024, (h16*)(ws + WS_W_AO), 1024, 1024, 0, scr, gw, NGW, lane);
#pragma unroll
        for (int l4 = 0; l4 < 4; ++l4) { conv_batch(KIN(I_RW) + (size_t)l4 * D * NEXP, 1, 1024, 32, (h16*)(ws + WS_WR) + (size_t)(l4 * 2 + 0) * 32 * 1024, 1024, 32, 0, scr, gw, NGW, lane);
                                        conv_batch(KIN(I_RW) + (size_t)l4 * D * NEXP, 1, 1024, 32, (h16*)(ws + WS_WR) + (size_t)(l4 * 2 + 1) * 32 * 1024, 1024, 32, 2, scr, gw, NGW, lane); }
    }

#pragma unroll 1
    for (int l = 0; l < 4; ++l) {
        if (l < 2) {
            PH_BEGIN;
            if (l == 0) phase_prep<false>(KIN(I_X), KIN(I_MIX), (h16*)(ws + WS_XM), gw, NGW, lane);
            else phase_prep<true>(ws + WS_XH, KIN(I_MIX) + (size_t)l * 6 * D, (h16*)(ws + WS_XM), gw, NGW, lane);
            GRID_BAR();
            PH_BEGIN;
            {
                SchedRkv S{(const char*)(ws + WS_XM), (const char*)(ws + WS_W_RKV) + (size_t)l * 3 * 1024 * 2048, (const char*)(ws + WS_W_L1) + (size_t)l * 4 * 256 * 2048, l == 0 ? 15 : 16, G, blk};
                EpiRkv E{(h16*)(ws + WS_R), (h16*)(ws + WS_K), (h16*)(ws + (l == 0 ? WS_VF : WS_V)), (h16*)(ws + WS_L1O)};
                GEMM_PHASE(S, E, 1024);
            }
            GRID_BAR();
            PH_BEGIN;
            {
                const char* l1o = (const char*)(ws + WS_L1O); const char* wl2 = (const char*)(ws + WS_W_L2) + (size_t)l * 4 * 1024 * 512;
                { SchedL2 S{l1o, wl2, 0, G, blk}; EpiL2<0> E{(void*)(ws + WS_WD), nullptr, KIN(I_W0) + (size_t)l * D}; GEMM_PHASE(S, E, 256); }
                { SchedL2 S{l1o, wl2, 1, G, blk}; EpiL2<1> E{(void*)(ws + WS_AA), nullptr, KIN(I_A0) + (size_t)l * D}; GEMM_PHASE(S, E, 256); }
                { SchedL2 S{l1o, wl2, 2, G, blk}; EpiL2<2> E{(void*)(ws + WS_GG), nullptr, nullptr}; GEMM_PHASE(S, E, 256); }
                if (l == 1) { SchedL2 S{l1o, wl2, 3, G, blk}; EpiL2<3> E{(void*)(ws + WS_V), (const h16*)(ws + WS_VF), KIN(I_V0)}; GEMM_PHASE(S, E, 256); }
            }
            GRID_BAR();
            PH_BEGIN;
            {
                const float* wgu_ = KIN(I_WGU); const float* wdn_ = KIN(I_WDN); asm volatile("" : "+s"(wgu_), "+s"(wdn_));
                ScanArgs sa{(const h16*)(ws + WS_R), (const h16*)(ws + WS_K), (const h16*)(ws + (l == 0 ? WS_VF : WS_V)), (const h16*)(ws + WS_WD), (const h16*)(ws + WS_AA), (const h16*)(ws + WS_GG),
                            KIN(I_KK) + (size_t)l * D, KIN(I_KA) + (size_t)l * D, KIN(I_RK) + (size_t)l * D, KIN(I_LNXG) + (size_t)l * D, KIN(I_LNXB) + (size_t)l * D, (h16*)(ws + WS_YG), wgu_, wdn_, ws + WS_W_GU, ws + WS_W_DN, l};
                phase_scan_mm(sa, lds, blk, G, wave);
            }
            GRID_BAR();
            PH_BEGIN;
            {
                SchedPlain S{(const char*)(ws + WS_YG), (const char*)(ws + WS_W_RO) + (size_t)l * 1024 * 2048, 4, G, blk};
                if (l == 0) { EpiRes<false> E{KIN(I_X), (h16*)(ws + WS_H)}; GEMM_PHASE(S, E, 1024); }
                else { EpiRes<true> E{ws + WS_XH, (h16*)(ws + WS_H)}; GEMM_PHASE(S, E, 1024); }
            }
            GRID_BAR();
        } else {
            const int j = l - 2;
            PH_BEGIN;
            if (l == 2) {
                { SchedPlain S{(const char*)(ws + WS_XH), (const char*)(ws + WS_W_Q), 4, G, blk}; EpiQkv E{(h16*)(ws + WS_Q), nullptr, QSCALE}; GEMM_PHASE(S, E, 1024); }
                { SchedPlain S{(const char*)(ws + WS_XH), (const char*)(ws + WS_W_KV), 8, G, blk}; EpiQkv E{(h16*)(ws + WS_KK), (h16*)(ws + WS_VV), 1.0f}; GEMM_PHASE(S, E, 1024); }
            } else {
                SchedPlain S{(const char*)(ws + WS_XH), (const char*)(ws + WS_W_Q) + (size_t)j * 1024 * 2048, 4, G, blk}; EpiQkv E{(h16*)(ws + WS_Q), nullptr, QSCALE}; GEMM_PHASE(S, E, 1024);
            }
            GRID_BAR();
            PH_BEGIN;
            phase_attn((const h16*)(ws + WS_Q), (const h16*)(ws + WS_KK), (const h16*)(ws + WS_VV), (h16*)(ws + WS_ORAW), (char*)lds_raw, blk, G, wave);
            GRID_BAR();
            PH_BEGIN;
            phase_attn_combine((const h16*)(ws + WS_ORAW), KIN(I_DALAM) + (size_t)j * 256, KIN(I_DASUB) + (size_t)j * 128, 0.8f - 0.6f * expf(-0.3f * (float)l), (h16*)(ws + WS_OB), gw, NGW, lane);
            GRID_BAR();
            PH_BEGIN;
            {
                SchedPlain S{(const char*)(ws + WS_OB), (const char*)(ws + WS_W_AO) + (size_t)j * 1024 * 2048, 4, G, blk};
                EpiRes<true> E{ws + WS_XH, (h16*)(ws + WS_H)};
                GEMM_PHASE(S, E, 1024);
            }
            GRID_BAR();
        }
        PH_BEGIN;
        {
            RouterArgs ra{(const h16*)(ws + WS_H), KIN(I_LNG) + (size_t)(l * 2) * D, KIN(I_LNB) + (size_t)(l * 2) * D, (const h16*)(ws + WS_WR) + (size_t)l * 2 * 32 * 1024, KIN(I_RB) + (size_t)l * NEXP,
                          (h16*)(ws + WS_X1), (unsigned char*)(ws + WS_XB), (float*)(ws + WS_TOPG), (int*)(ws + WS_LIST), ctl + CW_CNT + l * 32};
            phase_ln_router(ra, lds, blk, G, wave);
        }
        GRID_BAR();
        PH_BEGIN;
        moe_tables(ctl + CW_CNT + l * 32, MISC, (LAS int*)(lds + TILE_E_OFF), wave);
        {
            SchedMoe S{(const LAS unsigned*)MISC, (const LAS int*)(lds + TILE_E_OFF), (const char*)(ws + WS_XB), (const char*)(ws + WS_W_GU) + (size_t)l * 32 * 2048 * 1024, (const int*)(ws + WS_LIST), 8, 1, G, blk, (size_t)2048 * 1024};
            EpiGu E{(unsigned char*)(ws + WS_ACT), KIN(I_BGU) + (size_t)l * 32 * 2048};
            GEMM_PHASE8(S, E, 1024);
        }
        GRID_BAR();
        PH_BEGIN;
        {
            SchedMoe S{(const LAS unsigned*)MISC, (const LAS int*)(lds + TILE_E_OFF), (const char*)(ws + WS_ACT), (const char*)(ws + WS_W_DN) + (size_t)l * 32 * 1024 * 1024, (const int*)(ws + WS_LIST), 4, 0, G, blk, (size_t)1024 * 1024};
            EpiDn E{(unsigned char*)(ws + WS_YS), KIN(I_BDN) + (size_t)l * 32 * 1024, (const float*)(ws + WS_TOPG)};
            GEMM_PHASE8(S, E, 1024);
        }
        GRID_BAR();
        PH_BEGIN;
        phase_combine((const h16*)(ws + WS_X1), (const unsigned char*)(ws + WS_YS), KIN(I_LNG) + (size_t)(l * 2 + 1) * D, KIN(I_LNB) + (size_t)(l * 2 + 1) * D,
                      l == 3 ? KOUT : (float*)nullptr, (h16*)(ws + WS_XH), gw, NGW, lane);
        if (l < 3) GRID_BAR();
    }
    if (xb_ld(ctl + CW_BAR + XB_TMO) != 0u && wave == 0 && lane_id() == 0) KOUT[(size_t)blk * D] = __builtin_nanf("");
}

extern "C" void kernel_launch(void* const* d_in, const int* in_sizes, int n_in, void* d_out, int out_size, void* d_ws, size_t ws_size, hipStream_t stream) {
    static int grid = 0;
    if (grid == 0) {
        if (n_in != 33 || out_size != T * D || ws_size < WS_END) { fprintf(stderr, "kernel_launch: unexpected shapes (n_in %d out %d ws %zu)\n", n_in, out_size, ws_size); grid = -1; return; }
        if (hipFuncSetAttribute((const void*)yoco_fwd, hipFuncAttributeMaxDynamicSharedMemorySize, LDS_BYTES) != hipSuccess) { fprintf(stderr, "kernel_launch: hipFuncSetAttribute failed\n"); grid = -1; return; }
        int dev = 0, cus = 0, per_cu = 0;
        hipGetDevice(&dev); hipDeviceGetAttribute(&cus, hipDeviceAttributeMultiprocessorCount, dev);
        hipOccupancyMaxActiveBlocksPerMultiprocessor(&per_cu, (const void*)yoco_fwd, NTHR, LDS_BYTES);
        (void)hipGetLastError();
        if (per_cu < 1) fprintf(stderr, "kernel_launch: occupancy query reports %d\n", per_cu);
        grid = cus < 256 ? cus : 256;
    }
    if (grid < 0) return;
    hipMemsetAsync((char*)d_ws + WS_CTL, 0, CTL_ZERO_BYTES, stream);
    Args a{};
    for (int i = 0; i < 33; ++i) a.in[i] = (const float*)d_in[i];
    a.out = (float*)d_out; a.ws = (unsigned char*)d_ws; a.ph_lo = 0; a.ph_hi = 0;
    hipLaunchKernelGGL(yoco_fwd, dim3(grid), dim3(NTHR), LDS_BYTES, stream, a);
}
```

```cpp
#include <hip/hip_runtime.h>
#include <cstdio>
#include <cstdint>
#include <cmath>

#define LAS __attribute__((address_space(3)))
#define GAS __attribute__((address_space(1)))
typedef _Float16 h16;
typedef _Float16 h16x8 __attribute__((ext_vector_type(8)));
typedef _Float16 h16x4 __attribute__((ext_vector_type(4)));
typedef _Float16 h16x2 __attribute__((ext_vector_type(2)));
typedef float f32x4 __attribute__((ext_vector_type(4)));
typedef float f32x2 __attribute__((ext_vector_type(2)));
typedef unsigned u32x4 __attribute__((ext_vector_type(4)));
typedef unsigned u32x2 __attribute__((ext_vector_type(2)));

constexpr int D = 1024, NBATCH = 16, SEQ = 2048, T = NBATCH * SEQ;
constexpr int NEXP = 32, TOPK = 4, ECAP = T;
constexpr int NWAVES = 8, NTHR = NWAVES * 64;
constexpr float ALPHA = 1.6817928305074290f;
constexpr float LN_EPS = 1e-5f;
constexpr float QSCALE = 0.125f * 1.4426950408889634f;
constexpr float LOG2E = 1.4426950408889634f;
constexpr float GU_SCALE = 64.0f, DN_SCALE = 128.0f, YS_SCALE = 16.0f;

constexpr size_t MiB = 1u << 20;
constexpr size_t WS_CTL = 0, CTL_ZERO_BYTES = 1 * MiB;
constexpr size_t WS_W_RKV = 2 * MiB;
constexpr size_t WS_W_RO = 14 * MiB;
constexpr size_t WS_W_L1 = 18 * MiB;
constexpr size_t WS_W_L2 = 22 * MiB;
constexpr size_t WS_W_KV = 26 * MiB;
constexpr size_t WS_W_Q = 30 * MiB;
constexpr size_t WS_W_AO = 34 * MiB;
constexpr size_t WS_WR = 38 * MiB;
constexpr size_t WS_W_GU = 40 * MiB;
constexpr size_t WS_W_DN = 552 * MiB;
constexpr size_t WS_X = 808 * MiB;
constexpr size_t WS_X1 = 936 * MiB;
constexpr size_t WS_H = 1064 * MiB;
constexpr size_t WS_XB = 1192 * MiB;
constexpr size_t WS_XH = 1256 * MiB;
constexpr size_t WS_TOPG = 1320 * MiB;
constexpr size_t WS_LIST = 1321 * MiB;
constexpr size_t WS_ACT = 1328 * MiB;
constexpr size_t WS_YS = 1616 * MiB;
constexpr size_t WS_XM = 1872 * MiB;
constexpr size_t WS_R = 2256 * MiB, WS_K = 2384 * MiB, WS_V = 2512 * MiB, WS_VF = 2640 * MiB;
constexpr size_t WS_L1O = 2768 * MiB;
constexpr size_t WS_WD = 2832 * MiB, WS_AA = 2960 * MiB, WS_GG = 3088 * MiB;
constexpr size_t WS_YG = 3216 * MiB;
constexpr size_t WS_END = 3280 * MiB;
constexpr size_t WS_Q = 1872 * MiB, WS_KK = 1936 * MiB, WS_VV = 2000 * MiB;
constexpr size_t WS_ORAW = 2064 * MiB;
constexpr size_t WS_OB = 2192 * MiB;
constexpr int CW_BAR = 4096;
constexpr int CW_CNT = 16384;

constexpr int LDS_BYTES = 147456;
constexpr int MISC_OFF = 146432;
constexpr int TILE_E_OFF = 143360;

template <int CTRL> __device__ __forceinline__ float dppf(float v) { return __builtin_bit_cast(float, __builtin_amdgcn_mov_dpp(__builtin_bit_cast(int, v), CTRL, 0xF, 0xF, true)); }
__device__ __forceinline__ float swz16f(float v) { return __builtin_bit_cast(float, __builtin_amdgcn_ds_swizzle(__builtin_bit_cast(int, v), (16 << 10) | 0x1F)); }
__device__ __forceinline__ float grp8_sum(float v) { v += dppf<0xB1>(v); v += dppf<0x4E>(v); v += dppf<0x141>(v); return v; }
__device__ __forceinline__ float wave_sum(float v) {
    v += dppf<0xB1>(v); v += dppf<0x4E>(v); v += dppf<0x141>(v); v += dppf<0x140>(v); v += swz16f(v);
    return __builtin_bit_cast(float, __builtin_amdgcn_readlane(__builtin_bit_cast(int, v), 0)) + __builtin_bit_cast(float, __builtin_amdgcn_readlane(__builtin_bit_cast(int, v), 32));
}
__device__ __forceinline__ float wave_max(float v) {
    v = fmaxf(v, dppf<0xB1>(v)); v = fmaxf(v, dppf<0x4E>(v)); v = fmaxf(v, dppf<0x141>(v)); v = fmaxf(v, dppf<0x140>(v)); v = fmaxf(v, swz16f(v));
    return fmaxf(__builtin_bit_cast(float, __builtin_amdgcn_readlane(__builtin_bit_cast(int, v), 0)), __builtin_bit_cast(float, __builtin_amdgcn_readlane(__builtin_bit_cast(int, v), 32)));
}
__device__ __forceinline__ unsigned pkh(float a, float b) { h16x2 v = {(h16)a, (h16)b}; return __builtin_bit_cast(unsigned, v); }
__device__ __forceinline__ u32x2 pkh4(f32x4 v) { u32x2 r; r.x = pkh(v.x, v.y); r.y = pkh(v.z, v.w); return r; }
__device__ __forceinline__ f32x4 ldh4(const h16* p) { const h16x4 v = *(const h16x4*)p; return __builtin_convertvector(v, f32x4); }
__device__ __forceinline__ float sigmoidf_(float x) { return __builtin_amdgcn_rcpf(1.0f + __builtin_amdgcn_exp2f(-1.4426950408889634f * x)); }
__device__ __forceinline__ int lane_id() { int l; asm volatile("v_mbcnt_lo_u32_b32 %0, -1, 0\n\tv_mbcnt_hi_u32_b32 %0, -1, %0" : "=v"(l)); return l; }
#define LDS_WAIT() asm volatile("s_waitcnt lgkmcnt(0)" ::: "memory")
#define OPAQUE(x) asm volatile("" : "+v"(x))

#define XB_TMO      128
#define XB_XCNT(j)  (256  + 64 * (j))
#define XB_XSUB(j)  (1280 + 64 * (j))
#define XB_XGEN(j)  (2304 + 64 * (j))
#define XB_TOP      3328
#define XB_TOPGEN   3392
#define XCD_BAR_WORDS 3456
#define XB_SPIN_CAP (1u << 21)

__device__ __forceinline__ unsigned xb_ld(unsigned* p)              { return __hip_atomic_load((GAS unsigned*)p, __ATOMIC_RELAXED, __HIP_MEMORY_SCOPE_AGENT); }
__device__ __forceinline__ unsigned xb_add(unsigned* p, unsigned v) { return __hip_atomic_fetch_add((GAS unsigned*)p, v, __ATOMIC_RELAXED, __HIP_MEMORY_SCOPE_AGENT); }
__device__ __forceinline__ unsigned xb_xcc_id() { return (unsigned)__builtin_amdgcn_s_getreg((3 << 11) | 20) & 0xFu; }
#define XB_SPIN(cond, bar) do { unsigned _sp = 0; while (cond) { __builtin_amdgcn_s_sleep(1); \
    if ((++_sp & 255u) == 0u) { if (xb_ld(&(bar)[XB_TMO])) break; if (_sp > XB_SPIN_CAP) { (void)xb_add(&(bar)[XB_TMO], 1u); break; } } } } while (0)

struct XcdBarrier { unsigned* bar; unsigned x; volatile LAS unsigned* st; };

__device__ __forceinline__ XcdBarrier xcd_barrier_post(unsigned* bar, volatile LAS unsigned* st, const int wave) {
    XcdBarrier b; b.bar = bar; b.x = xb_xcc_id(); b.st = st;
    if (wave == 0 && lane_id() == 0) (void)xb_add(&bar[XB_XCNT(b.x)], 1u);
    return b;
}
__device__ __forceinline__ void xcd_barrier_complete(unsigned* bar, unsigned x, unsigned& nloc, unsigned& nx) {
    const unsigned G = gridDim.x * gridDim.y * gridDim.z;
    unsigned sum, cnt, mine, sp = 0u;
    for (;;) {
        sum = 0u; cnt = 0u; mine = 0u;
#pragma unroll
        for (unsigned j = 0; j < 16; ++j) { const unsigned c = xb_ld(&bar[XB_XCNT(j)]); sum += c; cnt += (c > 0u) ? 1u : 0u; mine = (j == x) ? c : mine; }
        if (sum == G) break;
        __builtin_amdgcn_s_sleep(1);
        if ((++sp & 255u) == 0u) { if (xb_ld(&bar[XB_TMO])) break; if (sp > XB_SPIN_CAP) { (void)xb_add(&bar[XB_TMO], 1u); break; } }
    }
    nloc = mine > 0u ? mine : 1u; nx = cnt > 0u ? cnt : 1u;
}
__device__ __forceinline__ void xcd_barrier(const XcdBarrier& b, const int wave) {
    asm volatile("s_waitcnt vmcnt(0)" ::: "memory");
    __syncthreads();
    if (wave == 0 && lane_id() == 0) {
        unsigned* bar = b.bar; unsigned bx = b.x;
        asm volatile("" : "+s"(bar), "+s"(bx));
        __builtin_amdgcn_s_waitcnt(0);
        unsigned nloc = b.st[0], nx = b.st[1];
        if (nloc == 0u) { xcd_barrier_complete(bar, bx, nloc, nx); b.st[0] = nloc; b.st[1] = nx; }
        const unsigned old = xb_add(&bar[XB_XSUB(bx)], 1u);
        const unsigned gen = old / nloc;
        if (old + 1u == (gen + 1u) * nloc) {
            __builtin_amdgcn_fence(__ATOMIC_RELEASE, "agent");
            asm volatile("s_waitcnt vmcnt(0)" ::: "memory");
            const unsigned og = xb_add(&bar[XB_TOP], 1u);
            const unsigned tg = og / nx;
            if (og + 1u == (tg + 1u) * nx) xb_add(&bar[XB_TOPGEN], 1u);
            else XB_SPIN(xb_ld(&bar[XB_TOPGEN]) == tg, bar);
            __builtin_amdgcn_fence(__ATOMIC_ACQUIRE, "agent");
            xb_add(&bar[XB_XGEN(bx)], 1u);
            asm volatile("s_waitcnt vmcnt(0)" ::: "memory");
        } else {
            XB_SPIN(xb_ld(&bar[XB_XGEN(bx)]) == gen, bar);
            __builtin_amdgcn_fence(__ATOMIC_ACQUIRE, "agent");
            asm volatile("s_waitcnt vmcnt(0)" ::: "memory");
        }
    }
    __syncthreads();
}

__device__ __forceinline__ void conv_batch(const float* src, int batch, int Kr, int Nr, h16* dst, int Kp, int Np, int perm, LAS float* scr, int gw, int NGW, int lane) {
    lane = lane_id(); OPAQUE(lane);
    const int kbn = Kp / 64, nbn = Np / 32, per = kbn * nbn, total = batch * per;
    for (int it = gw; it < total; it += NGW) {
        const int bi = it / per, r = it - bi * per, kb = r / nbn, nb = r - kb * nbn, k0 = 64 * kb, n0 = 32 * nb;
        const float* W = src + (size_t)bi * Kr * Nr; h16* WT = dst + (size_t)bi * Np * Kp;
        float vals[32];
#pragma unroll
        for (int i = 0; i < 32; ++i) { const int k = k0 + 2 * i + (lane >> 5), n = n0 + (lane & 31); vals[i] = (k < Kr && n < Nr) ? W[(size_t)k * Nr + n] : 0.f; }
#pragma unroll
        for (int i = 0; i < 32; ++i) { float x = vals[i]; if (perm == 2) x = (x - (float)(h16)x) * 4096.0f; scr[(2 * i + (lane >> 5)) * 33 + (lane & 31)] = x; }
        LDS_WAIT();
        const int c = lane & 7;
#pragma unroll
        for (int j = 0; j < 4; ++j) { const int nl = (lane >> 3) + 8 * j; const LAS float* s = scr + (8 * c) * 33 + nl;
            u32x4 o; o.x = pkh(s[0 * 33], s[1 * 33]); o.y = pkh(s[2 * 33], s[3 * 33]); o.z = pkh(s[4 * 33], s[5 * 33]); o.w = pkh(s[6 * 33], s[7 * 33]);
            int n = n0 + nl; if (perm == 1) n = ((n & 1023) >> 7) * 256 + (n >> 10) * 128 + (n & 127);
            *(u32x4*)(WT + (size_t)n * Kp + k0 + 8 * c) = o; }
        LDS_WAIT();
    }
}


__device__ __forceinline__ void conv_batch8(const float* src, int batch, int Kr, int Nr, unsigned char* dst, int Kp, int Np, int perm, float scale, LAS float* scr, int gw_, int NGW_, int lane) {
    lane = lane_id(); OPAQUE(lane);
    const int kbn = Kp / 128, nbn = Np / 32, per = kbn * nbn, total = batch * per;
    for (int it = gw_; it < total; it += NGW_) {
        const int bi = it / per, r = it - bi * per, kb = r / nbn, nb = r - kb * nbn, k0 = 128 * kb, n0 = 32 * nb;
        const float* W = src + (size_t)bi * Kr * Nr; unsigned char* WT = dst + (size_t)bi * Np * Kp;
        float vals[64];
#pragma unroll
        for (int i = 0; i < 64; ++i) { const int k = k0 + 2 * i + (lane >> 5), n = n0 + (lane & 31); vals[i] = (k < Kr && n < Nr) ? W[(size_t)k * Nr + n] : 0.f; }
#pragma unroll
        for (int i = 0; i < 64; ++i) scr[(2 * i + (lane >> 5)) * 33 + (lane & 31)] = vals[i] * scale;
        LDS_WAIT();
        const int c = lane & 7;
#pragma unroll
        for (int j = 0; j < 4; ++j) { const int nl = (lane >> 3) + 8 * j; const LAS float* sp = scr + (16 * c) * 33 + nl; u32x4 o;
#pragma unroll
            for (int q = 0; q < 4; ++q) { int w_ = __builtin_amdgcn_cvt_pk_fp8_f32(sp[(4 * q) * 33], sp[(4 * q + 1) * 33], 0, false); w_ = __builtin_amdgcn_cvt_pk_fp8_f32(sp[(4 * q + 2) * 33], sp[(4 * q + 3) * 33], w_, true); o[q] = (unsigned)w_; }
            int n = n0 + nl; if (perm) n = ((n & 1023) >> 7) * 256 + (n >> 10) * 128 + (n & 127);
            *(u32x4*)(WT + (size_t)n * Kp + k0 + 16 * c) = o; }
        LDS_WAIT();
    }
}

struct Unit { int pm, pn, kind, e, rows, rbase; const char* A; const char* B; const int* list; };

struct DenseDesc { const char* A; const char* B; int kind, pn; };

namespace pg8 {
constexpr int BM = 256, BK = 64, HALF = 128, HTB = HALF * BK * 2, STAGE_BYTES = 8 * HTB;
__device__ __forceinline__ int lds_byte(int r, int c) { const int st = (r >> 4) * 2 + (c >> 5), rr = r & 15, cc = c & 31, ob = rr * 64 + cc * 2; return st * 1024 + (ob ^ (((ob >> 9) & 1) << 5)); }
__device__ __forceinline__ void stage_rc(int b, int& R, int& C) { const int st = b / 1024, sb = b % 1024, swz = sb ^ (((sb >> 9) & 1) << 5); R = (st >> 1) * 16 + swz / 64; C = (st & 1) * 32 + (swz % 64) / 2; }
}
typedef int i32x4 __attribute__((ext_vector_type(4)));
typedef int i32x8 __attribute__((ext_vector_type(8)));
template <bool FP8, class Sched, class Epi>
__device__ __forceinline__ void gemm_phase_pg8(LAS unsigned char* lds, const Sched& S, const Epi& E, const int Kb, const int wave) {
    using namespace pg8;
    int tid = wave * 64 + lane_id(); OPAQUE(tid);
    const int wid = wave, lane = tid & 63, wr = wid >> 2, wc = wid & 3, fr = lane & 15, fq = lane >> 4;
    const int nt = Kb / 128;
    int Rs[2], Cs[2]; unsigned voffB[2];
#pragma unroll
    for (int i = 0; i < 2; ++i) { stage_rc(tid * 16 + i * 8192, Rs[i], Cs[i]); voffB[i] = (unsigned)(Rs[i] * Kb + Cs[i] * 2); }
    const size_t kstep = (size_t)128;
    const size_t hstepB = (size_t)HALF * Kb;
    const unsigned ldsw = (unsigned)wid * 1024u;
    const int aoff = lds_byte(wr * 64 + fr, fq * 8), boff = lds_byte(wc * 32 + fr, fq * 8);
#define PG8_SA(b, h) (((b) * 2 + (h)) * HTB)
#define PG8_SB(b, h) ((4 + (b) * 2 + (h)) * HTB)
#define PG8_STAGE(bufoff, gbase, voff) do { _Pragma("unroll") for (int _i = 0; _i < 2; ++_i) \
        __builtin_amdgcn_global_load_lds((const unsigned*)((const char*)(gbase) + (voff)[_i]), (LAS unsigned*)(lds + (bufoff) + ldsw + _i * 8192), 16, 0, 0); } while (0)
#define PG8_LDA(dst, b, h) do { _Pragma("unroll") for (int m = 0; m < 4; ++m) _Pragma("unroll") for (int k = 0; k < 2; ++k) dst[m][k] = *(const LAS h16x8*)(lds + PG8_SA(b, h) + aoff + m * 2048 + k * 1024); } while (0)
#define PG8_LDB(dst, b, h) do { _Pragma("unroll") for (int n = 0; n < 2; ++n) _Pragma("unroll") for (int k = 0; k < 2; ++k) dst[n][k] = *(const LAS h16x8*)(lds + PG8_SB(b, h) + boff + n * 2048 + k * 1024); } while (0)
#define PG8_MMA(ai, bj, At, Bt) do { __builtin_amdgcn_s_setprio(1); \
        if (FP8) { _Pragma("unroll") for (int m = 0; m < 4; ++m) _Pragma("unroll") for (int n = 0; n < 2; ++n) { \
            const i32x4 b0_ = __builtin_bit_cast(i32x4, Bt[n][0]), b1_ = __builtin_bit_cast(i32x4, Bt[n][1]), a0_ = __builtin_bit_cast(i32x4, At[m][0]), a1_ = __builtin_bit_cast(i32x4, At[m][1]); \
            acc[ai][bj][m][n] = __builtin_amdgcn_mfma_scale_f32_16x16x128_f8f6f4(__builtin_shufflevector(b0_, b1_, 0, 1, 2, 3, 4, 5, 6, 7), __builtin_shufflevector(a0_, a1_, 0, 1, 2, 3, 4, 5, 6, 7), acc[ai][bj][m][n], 0, 0, 0, 0, 0, 0); } } \
        else { _Pragma("unroll") for (int m = 0; m < 4; ++m) _Pragma("unroll") for (int n = 0; n < 2; ++n) _Pragma("unroll") for (int k = 0; k < 2; ++k) \
            acc[ai][bj][m][n] = __builtin_amdgcn_mfma_f32_16x16x32_f16(Bt[n][k], At[m][k], acc[ai][bj][m][n], 0, 0, 0); } \
        __builtin_amdgcn_s_setprio(0); } while (0)
#define PG8_WAIT_V(n) asm volatile("s_waitcnt vmcnt(" #n ")" ::: "memory")
#define PG8_WAIT_L(n) asm volatile("s_waitcnt lgkmcnt(" #n ")" ::: "memory")
#define PG8_BAR __builtin_amdgcn_s_barrier()
#define PG8_SCHED __builtin_amdgcn_sched_barrier(0)
    Unit cur, nxt; int ui = 0;
    if (!S.next(0, cur)) return;
    f32x4 acc[2][2][4][2];
#pragma unroll
    for (int a = 0; a < 2; ++a)
#pragma unroll
        for (int b = 0; b < 2; ++b)
#pragma unroll
            for (int m = 0; m < 4; ++m)
#pragma unroll
                for (int n = 0; n < 2; ++n) acc[a][b][m][n] = (f32x4){0.f, 0.f, 0.f, 0.f};
    h16x8 At[4][2], B0[2][2], B1[2][2];
    unsigned vA[2][2], vAn[2][2];
#pragma unroll
    for (int h = 0; h < 2; ++h)
#pragma unroll
        for (int i = 0; i < 2; ++i) vA[h][i] = S.a_off(cur, 128 * h + Rs[i]) + (unsigned)Cs[i] * 2u;
    const char* cA = cur.A; const char* cB = cur.B;
    PG8_STAGE(PG8_SB(0, 0), cB, voffB); PG8_STAGE(PG8_SB(0, 1), cB + hstepB, voffB); PG8_STAGE(PG8_SA(0, 0), cA, vA[0]); PG8_STAGE(PG8_SA(0, 1), cA, vA[1]);
    if (wr == 1) PG8_BAR;
    PG8_WAIT_V(2); PG8_BAR;
    PG8_STAGE(PG8_SB(1, 0), cB + kstep, voffB); PG8_STAGE(PG8_SA(1, 0), cA + kstep, vA[0]); PG8_STAGE(PG8_SB(1, 1), cB + hstepB + kstep, voffB);
    PG8_WAIT_V(6); PG8_BAR;
    for (;;) {
        const bool has_next = S.next(ui + 1, nxt);
        const char* nA = has_next ? nxt.A : cA; const char* nB = has_next ? nxt.B : cB;
#pragma unroll
        for (int h = 0; h < 2; ++h)
#pragma unroll
            for (int i = 0; i < 2; ++i) vAn[h][i] = has_next ? (S.a_off(nxt, 128 * h + Rs[i]) + (unsigned)Cs[i] * 2u) : vA[h][i];
#pragma unroll 1
        for (int t = 0; t < nt; t += 2) {
            const bool last = (t == nt - 2);
            const char* a1 = cA + (size_t)(t + 1) * kstep;
            const char* a2 = last ? nA : cA + (size_t)(t + 2) * kstep; const char* b2 = last ? nB : cB + (size_t)(t + 2) * kstep;
            const char* a3 = a2 + kstep; const char* b3 = b2 + kstep;
            PG8_LDB(B0, 0, 0); PG8_LDB(B1, 0, 1); PG8_SCHED; PG8_LDA(At, 0, 0); PG8_STAGE(PG8_SA(1, 1), a1, vA[1]);
            if (last) { vA[0][0] = vAn[0][0]; vA[0][1] = vAn[0][1]; vA[1][0] = vAn[1][0]; vA[1][1] = vAn[1][1]; }
            PG8_WAIT_V(8); PG8_WAIT_L(0); PG8_BAR; PG8_MMA(0, 0, At, B0); PG8_MMA(0, 1, At, B1); PG8_BAR; PG8_SCHED;
            PG8_LDA(At, 0, 1); PG8_STAGE(PG8_SB(0, 0), b2, voffB); PG8_STAGE(PG8_SB(0, 1), b2 + hstepB, voffB); PG8_STAGE(PG8_SA(0, 0), a2, vA[0]);
            PG8_WAIT_V(8); PG8_WAIT_L(0); PG8_BAR; PG8_MMA(1, 0, At, B0); PG8_MMA(1, 1, At, B1); PG8_BAR; PG8_SCHED;
            PG8_LDB(B0, 1, 0); PG8_LDB(B1, 1, 1); PG8_SCHED; PG8_LDA(At, 1, 0); PG8_STAGE(PG8_SA(0, 1), a2, vA[1]);
            PG8_WAIT_V(8); PG8_WAIT_L(0); PG8_BAR; PG8_MMA(0, 0, At, B0); PG8_MMA(0, 1, At, B1); PG8_BAR; PG8_SCHED;
            PG8_LDA(At, 1, 1); PG8_STAGE(PG8_SB(1, 0), b3, voffB); PG8_STAGE(PG8_SB(1, 1), b3 + hstepB, voffB); PG8_STAGE(PG8_SA(1, 0), a3, vA[0]);
            PG8_WAIT_V(8); PG8_WAIT_L(0); PG8_BAR; PG8_MMA(1, 0, At, B0); PG8_MMA(1, 1, At, B1); PG8_BAR; PG8_SCHED;
        }
        if (wr == 0) PG8_BAR;
        { int fr_e = fr, fq_e = fq; OPAQUE(fr_e); OPAQUE(fq_e);
          E(acc, cur, wr, wc, fr_e, fq_e); }
        if (!has_next) break;
#pragma unroll
        for (int a = 0; a < 2; ++a)
#pragma unroll
            for (int b = 0; b < 2; ++b)
#pragma unroll
                for (int m = 0; m < 4; ++m)
#pragma unroll
                    for (int n = 0; n < 2; ++n) acc[a][b][m][n] = (f32x4){0.f, 0.f, 0.f, 0.f};
        cur = nxt; cA = nA; cB = nB; ++ui;
        if (wr == 1) PG8_BAR;
    }
    PG8_WAIT_V(0);
    PG8_BAR;
#undef PG8_SA
#undef PG8_SB
#undef PG8_STAGE
#undef PG8_LDA
#undef PG8_LDB
#undef PG8_MMA
#undef PG8_WAIT_V
#undef PG8_WAIT_L
#undef PG8_BAR
#undef PG8_SCHED
}
#define GEMM_PHASE(S, E, K) gemm_phase_pg8<false>(lds, S, E, (K) * 2, wave)
#define GEMM_PHASE8(S, E, K) gemm_phase_pg8<true>(lds, S, E, (K), wave)

#define FOR_ACC(ai, bj, m, n) _Pragma("unroll") for (int ai = 0; ai < 2; ++ai) _Pragma("unroll") for (int m = 0; m < 4; ++m) _Pragma("unroll") for (int bj = 0; bj < 2; ++bj) _Pragma("unroll") for (int n = 0; n < 2; ++n)
#define EPI_FENCE() asm volatile("" ::: "memory")

template <bool F16IN>
__device__ __forceinline__ void phase_prep(const void* Xv, const float* mix, h16* XM, int gw_, int NGW_, int lane) {
    lane = lane_id(); OPAQUE(lane);
    const float* Xf = (const float*)Xv; const h16* Xh = (const h16*)Xv;
    for (int ch = gw_; ch < T / 16; ch += NGW_) {
        const int t0 = ch * 16;
        f32x4 prev[4];
        if ((t0 % SEQ) == 0) {
#pragma unroll
            for (int j = 0; j < 4; ++j) prev[j] = (f32x4){0.f, 0.f, 0.f, 0.f};
        } else {
#pragma unroll
            for (int j = 0; j < 4; ++j) prev[j] = F16IN ? ldh4(Xh + (size_t)(t0 - 1) * D + 256 * j + 4 * lane) : *(const f32x4*)(Xf + (size_t)(t0 - 1) * D + 256 * j + 4 * lane);
        }
#pragma unroll 1
        for (int ib = 0; ib < 4; ++ib) {
            f32x4 cur[4][4]; h16x4 curh[4][4];
#pragma unroll
            for (int q = 0; q < 4; ++q)
#pragma unroll
                for (int j = 0; j < 4; ++j) { if (F16IN) curh[q][j] = *(const h16x4*)(Xh + (size_t)(t0 + 4 * ib + q) * D + 256 * j + 4 * lane); else cur[q][j] = *(const f32x4*)(Xf + (size_t)(t0 + 4 * ib + q) * D + 256 * j + 4 * lane); }
            if (F16IN) {
#pragma unroll
                for (int q = 0; q < 4; ++q)
#pragma unroll
                    for (int j = 0; j < 4; ++j) cur[q][j] = __builtin_convertvector(curh[q][j], f32x4);
            }
#pragma unroll
            for (int q = 0; q < 4; ++q) {
                const int t = t0 + 4 * ib + q;
#pragma unroll
                for (int s = 0; s < 6; ++s) {
#pragma unroll
                    for (int j = 0; j < 4; ++j) { const f32x4 mx = *(const f32x4*)(mix + s * D + 256 * j + 4 * lane);
                        const f32x4 pv = (q == 0) ? prev[j] : cur[q == 0 ? 0 : q - 1][j];
                        const f32x4 v = cur[q][j] + (pv - cur[q][j]) * mx;
                        *(u32x2*)(XM + ((size_t)s * T + t) * D + 256 * j + 4 * lane) = pkh4(v); }
                }
            }
#pragma unroll
            for (int j = 0; j < 4; ++j) prev[j] = cur[3][j];
        }
    }
}

struct ScanArgs { const h16 *R, *K, *V; const h16* WD; const h16 *AA, *GG; const float *k_k, *k_a, *r_k, *lnx_g, *lnx_b; h16* YG; const float *wgu, *wdn; unsigned char *gu8, *dn8; int layer_pair; };
__device__ __forceinline__ float row16_sum(float v) { v += dppf<0xB1>(v); v += dppf<0x4E>(v); v += dppf<0x141>(v); v += dppf<0x140>(v); return v; }
struct ConvItem2 { const float* Wrow; unsigned char* WTp; int Nr; float scale; bool valid; };
__device__ __forceinline__ ConvItem2 conv_item2(int sit, int wave, int lane, int layer_pair, const float* wgu, const float* wdn, unsigned char* gu8) {
    ConvItem2 ci; ci.valid = sit < 12288;
    const int s = ci.valid ? sit : 0, ls = s / 6144, r = s - ls * 6144, e = r / 192, q = r - e * 192, le = (layer_pair * 2 + ls) * 32 + e;
    const bool gu = q < 128; const int q2 = gu ? q : q - 128, nb = gu ? (q2 & 31) : (q2 & 15), kq = gu ? (q2 >> 5) : (q2 >> 4), Nr = gu ? 2048 : 1024;
    const int k0 = kq * 256 + wave * 32, n = nb * 64 + lane, c5 = n & 31, p5 = 16 * ((c5 >> 2) & 1) + 4 * (c5 >> 3) + (c5 & 3), np = (n & ~31) | p5;
    const int nrow = gu ? ((np & 1023) >> 7) * 256 + (np >> 10) * 128 + (np & 127) : np;
    size_t wb; { const int gi = __builtin_amdgcn_readfirstlane(gu ? 1 : 0); asm("s_cmp_lg_u32 %1, 0\n\ts_cselect_b64 %0, %2, %3" : "=s"(wb) : "s"(gi), "s"(wgu), "s"(wdn) : "scc"); }
    const size_t ob = (size_t)gu8 + (gu ? (size_t)0 : (size_t)(WS_W_DN - WS_W_GU));
    ci.Wrow = (const float*)wb + (size_t)le * 1024 * Nr + (size_t)k0 * Nr + nb * 64; ci.WTp = (unsigned char*)ob + (size_t)le * Nr * 1024 + (size_t)nrow * 1024 + k0; ci.Nr = Nr; ci.scale = gu ? GU_SCALE : DN_SCALE;
    return ci;
}
__device__ __forceinline__ void conv_issue2(const ConvItem2& ci, float (&vals)[32], int lane) {
    if (ci.valid) {
        const GAS char* p = (const GAS char*)ci.Wrow; const unsigned lo = (unsigned)lane * 4u; const size_t stride = (size_t)ci.Nr * 4;
#pragma unroll
        for (int i = 0; i < 32; ++i) { vals[i] = __builtin_nontemporal_load((const GAS float*)(p + lo)); p += stride; }
    }
}
__device__ __forceinline__ void conv_finish2(const ConvItem2& ci, const float (&vals)[32]) {
    if (ci.valid) {
#pragma unroll
        for (int j = 0; j < 2; ++j) { u32x4 o;
#pragma unroll
            for (int q = 0; q < 4; ++q) { int pk_ = __builtin_amdgcn_cvt_pk_fp8_f32(vals[16 * j + 4 * q] * ci.scale, vals[16 * j + 4 * q + 1] * ci.scale, 0, false);
                pk_ = __builtin_amdgcn_cvt_pk_fp8_f32(vals[16 * j + 4 * q + 2] * ci.scale, vals[16 * j + 4 * q + 3] * ci.scale, pk_, true); o[q] = (unsigned)pk_; }
            *(u32x4*)(ci.WTp + 16 * j) = o; }
    }
}
__device__ __forceinline__ float row16_reduce_scatter(const float (&q)[16], int lane) {
    const bool b0 = lane & 1, b1 = lane & 2, b2 = lane & 4, b3 = lane & 8;
    float v[16], a[8], c[4], d[2];
#pragma unroll
    for (int s = 0; s < 16; ++s) v[s] = q[((s & 1) << 3) | ((s & 2) << 1) | ((s & 4) >> 1) | ((s & 8) >> 3)];
#pragma unroll
    for (int j = 0; j < 8; ++j) a[j] = (b0 ? v[j + 8] : v[j]) + dppf<0xB1>(b0 ? v[j] : v[j + 8]);
#pragma unroll
    for (int j = 0; j < 4; ++j) c[j] = (b1 ? a[j + 4] : a[j]) + dppf<0x4E>(b1 ? a[j] : a[j + 4]);
#pragma unroll
    for (int j = 0; j < 2; ++j) d[j] = (b2 ? c[j + 2] : c[j]) + dppf<0x124>(b2 ? c[j] : c[j + 2]);
    return (b3 ? d[1] : d[0]) + dppf<0x128>(b3 ? d[0] : d[1]);
}
#define WBAR() do { asm volatile("s_waitcnt lgkmcnt(0)" ::: "memory"); __builtin_amdgcn_s_barrier(); asm volatile("" ::: "memory"); } while (0)
__device__ __forceinline__ void phase_scan_mm(const ScanArgs& a, LAS unsigned char* lds, int blk, int G, const int wave) {
    constexpr int NG = 4, PCH = 13120;
    constexpr int O_AT = 0, O_RT = 2304, O_BBT = 4608, O_KBT = 6656, O_VT = 8704, O_MKT = 10752, O_TMT = 11264, O_NBT = 11776, O_NKT = 12288, O_GC = 12800, O_SRK = 13056;
    constexpr int TMP0 = NG * PCH, TMPB = 5632;
    constexpr int O_SY = TMP0 + 4 * TMPB, O_VO = O_SY + 2 * 16640, O_SRKO = O_VO + 2 * 8192, O_RED = O_SRKO + 512;
    int pass = 0;
    for (int bh = blk; bh < NBATCH * 16; bh += G, ++pass) {
        int tid0 = wave * 64 + lane_id(); OPAQUE(tid0);
        const int b = bh >> 4, h = bh & 15, chn0 = h * 64 + (tid0 & 63);
        const float kkc = a.k_k[chn0], kac = a.k_a[chn0], rkc = a.r_k[chn0], lg = a.lnx_g[chn0], lb = a.lnx_b[chn0];
        f32x4 ST[4];
#pragma unroll
        for (int kt = 0; kt < 4; ++kt) ST[kt] = (f32x4){0.f, 0.f, 0.f, 0.f};
        h16 qr[8], qk[8], qv[8], qa[8], qw[8];
        const int c4w = wave >> 1, hfw = wave & 1;
#pragma unroll
        for (int i = 0; i < 8; ++i) { const size_t tb = ((size_t)bh * SEQ + c4w * 16 + 8 * hfw) * 64 + (tid0 & 63);
            qr[i] = a.R[tb + i * 64]; qk[i] = a.K[tb + i * 64]; qv[i] = a.V[tb + i * 64]; qa[i] = a.AA[tb + i * 64]; qw[i] = a.WD[tb + i * 64]; }
        LAS float* gpr = (LAS float*)(lds + O_RED + 1024);
#define GPROD() ((((1.0f - (float)qw[0]) * (1.0f - (float)qw[1])) * ((1.0f - (float)qw[2]) * (1.0f - (float)qw[3]))) * (((1.0f - (float)qw[4]) * (1.0f - (float)qw[5])) * ((1.0f - (float)qw[6]) * (1.0f - (float)qw[7]))))
        gpr[wave * 64 + (tid0 & 63)] = GPROD();
        WBAR();
        h16 qg[16];
        float cv[32];
        ConvItem2 ci = conv_item2(((pass * 32 + 0) * 2 + 0) * G + blk, wave, tid0 & 63, a.layer_pair, a.wgu, a.wdn, a.gu8);
        conv_issue2(ci, cv, tid0 & 63);
#define OUT_STAGE(gp_) do { const int gp = (gp_); LAS float* red = (LAS float*)(lds + O_RED) + wave * 32; const LAS float* syo = (const LAS float*)(lds + O_SY) + (gp & 1) * (64 * 65); \
            const LAS h16* voo = (const LAS h16*)(lds + O_VO) + (gp & 1) * 4096; const LAS float* srko = (const LAS float*)(lds + O_SRKO) + (gp & 1) * 64; \
            _Pragma("unroll") for (int bt = 0; bt < 2; ++bt) { const int t0 = (wave - 4) * 16 + 8 * bt; float yv[8], q[16]; \
                _Pragma("unroll") for (int p = 0; p < 8; ++p) { yv[p] = syo[(t0 + p) * 65 + lane]; q[p] = yv[p]; q[8 + p] = yv[p] * yv[p]; } \
                float x = row16_reduce_scatter(q, lane); x += swz16f(x); \
                if ((lane & 16) == 0) red[(lane >> 5) * 16 + l16] = x; \
                LDS_WAIT(); \
                f32x4 s1[2], s2[2]; \
                _Pragma("unroll") for (int hq = 0; hq < 2; ++hq) { s1[hq] = *(const LAS f32x4*)(red + 4 * hq) + *(const LAS f32x4*)(red + 16 + 4 * hq); s2[hq] = *(const LAS f32x4*)(red + 8 + 4 * hq) + *(const LAS f32x4*)(red + 24 + 4 * hq); } \
                _Pragma("unroll") for (int p = 0; p < 8; ++p) { const int tt = t0 + p; \
                    const float mu = s1[p >> 2][p & 3] * (1.0f / 64.0f), var = fmaxf(s2[p >> 2][p & 3] * (1.0f / 64.0f) - mu * mu, 0.0f); \
                    float yn = (yv[p] - mu) * rsqrtf(var + 64e-5f) * lg + lb; yn += srko[tt] * (float)voo[tt * 64 + lane]; \
                    a.YG[((size_t)b * SEQ + gp * 64 + tt) * D + chn] = (h16)(yn * (float)qg[8 * bt + p]); } \
                LDS_WAIT(); } } while (0)
#pragma unroll 1
        for (int grp = 0; grp < SEQ / 64; ++grp) {
            int tid = tid0; OPAQUE(tid);
            const int lane = tid & 63, g4 = lane >> 4, l16 = lane & 15, chn = h * 64 + lane;
            {
                LAS unsigned char* pc = lds + c4w * PCH; LAS unsigned char* tb = lds + TMP0 + c4w * TMPB;
                LAS h16* At = (LAS h16*)(pc + O_AT); LAS h16* Rt = (LAS h16*)(pc + O_RT); LAS h16* BbT = (LAS h16*)(pc + O_BBT); LAS h16* KbT = (LAS h16*)(pc + O_KBT); LAS h16* Vt = (LAS h16*)(pc + O_VT);
                LAS h16* MkT = (LAS h16*)(pc + O_MKT); LAS h16* TmT = (LAS h16*)(pc + O_TMT); LAS h16* NbT = (LAS h16*)(pc + O_NBT); LAS h16* NkT = (LAS h16*)(pc + O_NKT);
                LAS float* gC = (LAS float*)(pc + O_GC); LAS float* srk = (LAS float*)(pc + O_SRK);
                LAS h16* Bh = (LAS h16*)tb; LAS h16* Kh = (LAS h16*)(tb + 2304); LAS float* MbF = (LAS float*)(tb + 4608);
                float wf[8];
#pragma unroll
                for (int i = 0; i < 8; ++i) wf[i] = 1.0f - (float)qw[i];
                if (grp + 1 < SEQ / 64) {
#pragma unroll
                    for (int i = 0; i < 8; ++i) qw[i] = a.WD[((size_t)bh * SEQ + (grp + 1) * 64 + c4w * 16 + 8 * hfw) * 64 + lane + i * 64];
                }
                const float gown = ((wf[0] * wf[1]) * (wf[2] * wf[3])) * ((wf[4] * wf[5]) * (wf[6] * wf[7])), goth = gpr[(wave ^ 1) * 64 + lane];
                const float gall = gown * goth;
                float gam = hfw ? goth : 1.0f, bhr[8], khr[8];
                LAS float* red = (LAS float*)(lds + O_RED) + wave * 32;
                float n2s[8];
                {
                    float q[16];
#pragma unroll
                    for (int i = 0; i < 8; ++i) { const float k = (float)qk[i], kk = k * kkc; q[i] = kk * kk; q[8 + i] = (float)qr[i] * (k * (1.0f + ((float)qa[i] - 1.0f) * kac)) * rkc; }
                    float x = row16_reduce_scatter(q, lane); x += swz16f(x);
                    if ((lane & 16) == 0) red[(lane >> 5) * 16 + l16] = x;
                    LDS_WAIT();
                    const f32x4 r0 = *(const LAS f32x4*)(red), r1 = *(const LAS f32x4*)(red + 4), r2 = *(const LAS f32x4*)(red + 16), r3 = *(const LAS f32x4*)(red + 20);
#pragma unroll
                    for (int i = 0; i < 4; ++i) { n2s[i] = r0[i] + r2[i]; n2s[4 + i] = r1[i] + r3[i]; }
                    const float rks = red[8 + (lane & 7)] + red[24 + (lane & 7)];
                    if (lane < 8) ((LAS float*)(lds + O_SRKO))[(grp & 1) * 64 + 16 * c4w + 8 * hfw + lane] = rks;
                }
#pragma unroll
                for (int i = 0; i < 8; ++i) {
                    const int tt = 8 * hfw + i;
                    const float r = (float)qr[i], k = (float)qk[i], v = (float)qv[i], w = wf[i], aa = (float)qa[i];
                    const float kk = k * kkc; const float kkn = kk * __builtin_amdgcn_rsqf(fmaxf(n2s[i], 1e-24f));
                    const float kmod = k * (1.0f + (aa - 1.0f) * kac);
                    At[tt * 72 + lane] = (h16)(gam * -kkn);
                    gam *= w; const float rg = __builtin_amdgcn_rcpf(gam);
                    bhr[i] = fminf(fmaxf(kkn * aa * rg, -6.0e4f), 6.0e4f); khr[i] = fminf(fmaxf(kmod * rg, -6.0e4f), 6.0e4f);
                    Bh[tt * 72 + lane] = (h16)bhr[i]; Kh[tt * 72 + lane] = (h16)khr[i];
                    Rt[tt * 72 + lane] = (h16)(gam * r); ((LAS h16*)(lds + O_VO))[((grp & 1) * 64 + 16 * c4w + tt) * 64 + lane] = (h16)v;
                }
                if (hfw == 0) gC[lane] = gall;
                {
                    u32x4 pb, pk;
#pragma unroll
                    for (int q = 0; q < 4; ++q) { pb[q] = pkh(bhr[2 * q] * gall, bhr[2 * q + 1] * gall); pk[q] = pkh(khr[2 * q] * gall, khr[2 * q + 1] * gall); }
                    *(LAS u32x4*)(BbT + lane * 16 + 8 * hfw) = pb; *(LAS u32x4*)(KbT + lane * 16 + 8 * hfw) = pk;
                }
                conv_finish2(ci, cv);
                if (grp + 1 < SEQ / 64) {
#pragma unroll
                    for (int i = 0; i < 8; ++i) { const size_t tb = ((size_t)bh * SEQ + (grp + 1) * 64 + c4w * 16 + 8 * hfw) * 64 + lane;
                        qr[i] = a.R[tb + i * 64]; qk[i] = a.K[tb + i * 64]; qv[i] = a.V[tb + i * 64]; qa[i] = a.AA[tb + i * 64]; }
                }
                ci = conv_item2(((pass * 32 + grp) * 2 + 1) * G + blk, wave, lane, a.layer_pair, a.wgu, a.wdn, a.gu8);
                conv_issue2(ci, cv, lane);
                WBAR();
                if (hfw == 0) {
                    f32x4 mb = {0.f, 0.f, 0.f, 0.f}, mt = mb;
#pragma unroll
                    for (int s = 0; s < 2; ++s) { const int fo = l16 * 72 + 32 * s + 8 * g4; const h16x8 fb = *(const LAS h16x8*)(Bh + fo), fa = *(const LAS h16x8*)(At + fo);
                        mb = __builtin_amdgcn_mfma_f32_16x16x32_f16(fb, fa, mb, 0, 0, 0);
                        mt = __builtin_amdgcn_mfma_f32_16x16x32_f16(fa, fb, mt, 0, 0, 0); }
                    f32x4 td, ttd;
#pragma unroll
                    for (int e = 0; e < 4; ++e) { const int i = 4 * g4 + e; mb[e] = (i < l16) ? mb[e] : 0.f; mt[e] = (l16 < i) ? mt[e] : 0.f; const float dg = (i == l16) ? 1.0f : 0.0f; td[e] = mb[e] + dg; ttd[e] = mt[e] + dg; }
                    h16x4 xb = __builtin_convertvector(mb, h16x4), xa = __builtin_convertvector(mt, h16x4);
#pragma unroll
                    for (int s = 0; s < 3; ++s) {
                        const f32x4 z4 = {0.f, 0.f, 0.f, 0.f};
                        const f32x4 sq = __builtin_amdgcn_mfma_f32_16x16x16f16(xa, xb, z4, 0, 0, 0);
                        const f32x4 sqt = __builtin_amdgcn_mfma_f32_16x16x16f16(xb, xa, z4, 0, 0, 0);
                        xb = __builtin_convertvector(sq, h16x4); xa = __builtin_convertvector(sqt, h16x4);
                        const h16x4 ta = __builtin_convertvector(ttd, h16x4);
                        td = __builtin_amdgcn_mfma_f32_16x16x16f16(ta, xb, td, 0, 0, 0);
                        if (s < 2) ttd = __builtin_amdgcn_mfma_f32_16x16x16f16(xb, ta, ttd, 0, 0, 0);
                    }
                    *(LAS u32x2*)(TmT + l16 * 16 + 4 * g4) = pkh4(td);
                } else {
                    f32x4 mk = {0.f, 0.f, 0.f, 0.f}, nb = mk, nk = mk;
#pragma unroll
                    for (int s = 0; s < 2; ++s) {
                        const int fo = l16 * 72 + 32 * s + 8 * g4;
                        const h16x8 fb = *(const LAS h16x8*)(Bh + fo), fk = *(const LAS h16x8*)(Kh + fo), fa = *(const LAS h16x8*)(At + fo), fr = *(const LAS h16x8*)(Rt + fo);
                        mk = __builtin_amdgcn_mfma_f32_16x16x32_f16(fk, fa, mk, 0, 0, 0); nb = __builtin_amdgcn_mfma_f32_16x16x32_f16(fb, fr, nb, 0, 0, 0); nk = __builtin_amdgcn_mfma_f32_16x16x32_f16(fk, fr, nk, 0, 0, 0);
                    }
#pragma unroll
                    for (int e = 0; e < 4; ++e) { const int i = 4 * g4 + e; const bool lt = i < l16, le = i <= l16; mk[e] = lt ? mk[e] : 0.f; nb[e] = le ? nb[e] : 0.f; nk[e] = le ? nk[e] : 0.f; }
                    *(LAS u32x2*)(MkT + l16 * 16 + 4 * g4) = pkh4(mk); *(LAS u32x2*)(NbT + l16 * 16 + 4 * g4) = pkh4(nb); *(LAS u32x2*)(NkT + l16 * 16 + 4 * g4) = pkh4(nk);
                }
            }
            WBAR();
            if (wave < 4) {
                LAS float* sy = (LAS float*)(lds + O_SY) + (grp & 1) * (64 * 65);
#pragma unroll 2
                for (int c4 = 0; c4 < NG; ++c4) {
                    LAS unsigned char* pc = lds + c4 * PCH;
                    const LAS h16* At = (const LAS h16*)(pc + O_AT); const LAS h16* Rt = (const LAS h16*)(pc + O_RT); const LAS h16* BbT = (const LAS h16*)(pc + O_BBT); const LAS h16* KbT = (const LAS h16*)(pc + O_KBT);
                    const LAS h16* Vt = (const LAS h16*)(pc + O_VT); const LAS h16* MkT = (const LAS h16*)(pc + O_MKT); const LAS h16* TmT = (const LAS h16*)(pc + O_TMT);
                    const LAS h16* NbT = (const LAS h16*)(pc + O_NBT); const LAS h16* NkT = (const LAS h16*)(pc + O_NKT); const LAS float* gC = (const LAS float*)(pc + O_GC);
                    h16x4 sb[4];
#pragma unroll
                    for (int kt = 0; kt < 4; ++kt) sb[kt] = __builtin_convertvector(ST[kt], h16x4);
                    h16x4 vb;
                    { const LAS h16* vsrc = (const LAS h16*)(lds + O_VO) + ((grp & 1) * 64 + 16 * c4 + 4 * g4) * 64 + 16 * wave + l16;
#pragma unroll
                      for (int e = 0; e < 4; ++e) vb[e] = vsrc[e * 64]; }
                    f32x4 accW = {0.f, 0.f, 0.f, 0.f}, accY = {0.f, 0.f, 0.f, 0.f};
#pragma unroll
                    for (int kt = 0; kt < 4; ++kt) {
                        accW = __builtin_amdgcn_mfma_f32_16x16x16f16(*(const LAS h16x4*)(At + l16 * 72 + 16 * kt + 4 * g4), sb[kt], accW, 0, 0, 0);
                        accY = __builtin_amdgcn_mfma_f32_16x16x16f16(*(const LAS h16x4*)(Rt + l16 * 72 + 16 * kt + 4 * g4), sb[kt], accY, 0, 0, 0);
                    }
                    accW = __builtin_amdgcn_mfma_f32_16x16x16f16(*(const LAS h16x4*)(MkT + l16 * 16 + 4 * g4), vb, accW, 0, 0, 0);
                    accY = __builtin_amdgcn_mfma_f32_16x16x16f16(*(const LAS h16x4*)(NkT + l16 * 16 + 4 * g4), vb, accY, 0, 0, 0);
                    const h16x4 wb = __builtin_convertvector(accW, h16x4);
                    const f32x4 accU = __builtin_amdgcn_mfma_f32_16x16x16f16(*(const LAS h16x4*)(TmT + l16 * 16 + 4 * g4), wb, (f32x4){0.f, 0.f, 0.f, 0.f}, 0, 0, 0);
                    const h16x4 ub = __builtin_convertvector(accU, h16x4);
                    accY = __builtin_amdgcn_mfma_f32_16x16x16f16(*(const LAS h16x4*)(NbT + l16 * 16 + 4 * g4), ub, accY, 0, 0, 0);
#pragma unroll
                    for (int kt = 0; kt < 4; ++kt) {
                        ST[kt] = ST[kt] * *(const LAS f32x4*)(gC + 16 * kt + 4 * g4);
                        ST[kt] = __builtin_amdgcn_mfma_f32_16x16x16f16(*(const LAS h16x4*)(BbT + (16 * kt + l16) * 16 + 4 * g4), ub, ST[kt], 0, 0, 0);
                        ST[kt] = __builtin_amdgcn_mfma_f32_16x16x16f16(*(const LAS h16x4*)(KbT + (16 * kt + l16) * 16 + 4 * g4), vb, ST[kt], 0, 0, 0);
                    }
#pragma unroll
                    for (int e = 0; e < 4; ++e) sy[(16 * c4 + 4 * g4 + e) * 65 + 16 * wave + l16] = accY[e];
                }
            }
            else {
                if (grp > 0) OUT_STAGE(grp - 1);
#pragma unroll
                for (int j = 0; j < 16; ++j) qg[j] = a.GG[((size_t)bh * SEQ + grp * 64 + (wave - 4) * 16) * 64 + lane + j * 64];
            }
            conv_finish2(ci, cv);
            ci = conv_item2(((pass * 32 + grp + 1) * 2 + 0) * G + blk, wave, lane, a.layer_pair, a.wgu, a.wdn, a.gu8);
            if (grp + 1 < SEQ / 64) { conv_issue2(ci, cv, lane); gpr[wave * 64 + lane] = GPROD(); }
            WBAR();
        }
#undef GPROD
        if (wave >= 4) { const int lane = lane_id(), l16 = lane & 15, chn = h * 64 + lane; OUT_STAGE(SEQ / 64 - 1); }
#undef OUT_STAGE
    }
}

__device__ __forceinline__ float row16_max(float v) { v = fmaxf(v, dppf<0xB1>(v)); v = fmaxf(v, dppf<0x4E>(v)); v = fmaxf(v, dppf<0x141>(v)); v = fmaxf(v, dppf<0x140>(v)); return v; }
struct RouterArgs { const h16* H; const float *g, *b; const h16* WRS; const float* rb; h16* X1; unsigned char* XB; float* TOPG; int* LIST; unsigned* CNT; };
__device__ __forceinline__ void phase_ln_router(const RouterArgs& a, LAS unsigned char* lds, int blk, int G, const int wave) {
    constexpr int WPB = 2064;
    LAS unsigned* hcnt = (LAS unsigned*)(lds + 132096); LAS unsigned* hbase = hcnt + 32; LAS unsigned* pe = hbase + 32; LAS unsigned* pp = pe + 512;
    int tid = wave * 64 + lane_id(); OPAQUE(tid);
    const int lane = tid & 63, ex = lane & 15, kg = lane >> 4;
    for (int c = tid; c < 2 * 32 * 128; c += NTHR) { const int row = c >> 7, ch = c & 127; *(LAS u32x4*)(lds + row * WPB + ch * 16) = *(const u32x4*)((const char*)a.WRS + (size_t)row * 2048 + ch * 16); }
    const float rb0 = a.rb[ex], rb1 = a.rb[16 + ex];
    for (int tb = blk; tb < T / 128; tb += G) {
        if (tid < 32) hcnt[tid] = 0u;
        __syncthreads();
        const size_t tw = (size_t)tb * 128 + wave * 16;
#pragma unroll 1
        for (int ib = 0; ib < 4; ++ib) {
            f32x4 vv[4][4]; h16x4 vh[4][4];
#pragma unroll
            for (int q = 0; q < 4; ++q)
#pragma unroll
                for (int j = 0; j < 4; ++j) vh[q][j] = *(const h16x4*)(a.H + (tw + 4 * ib + q) * D + 256 * j + 4 * lane);
#pragma unroll
            for (int q = 0; q < 4; ++q)
#pragma unroll
                for (int j = 0; j < 4; ++j) vv[q][j] = __builtin_convertvector(vh[q][j], f32x4);
#pragma unroll
            for (int q = 0; q < 4; ++q) {
                const size_t t = tw + 4 * ib + q; float s1 = 0.f;
#pragma unroll
                for (int j = 0; j < 4; ++j) s1 += (vv[q][j].x + vv[q][j].y) + (vv[q][j].z + vv[q][j].w);
                const float mean = wave_sum(s1) * (1.0f / D); float s2 = 0.f;
#pragma unroll
                for (int j = 0; j < 4; ++j) { vv[q][j] = vv[q][j] - mean; s2 += (vv[q][j].x * vv[q][j].x + vv[q][j].y * vv[q][j].y) + (vv[q][j].z * vv[q][j].z + vv[q][j].w * vv[q][j].w); }
                const float rstd = rsqrtf(wave_sum(s2) * (1.0f / D) + LN_EPS);
#pragma unroll
                for (int j = 0; j < 4; ++j) { const f32x4 o = vv[q][j] * rstd * *(const f32x4*)(a.g + 256 * j + 4 * lane) + *(const f32x4*)(a.b + 256 * j + 4 * lane);
                    *(u32x2*)(a.X1 + t * D + 256 * j + 4 * lane) = pkh4(o);
                    int pk_ = __builtin_amdgcn_cvt_pk_fp8_f32(o.x, o.y, 0, false); pk_ = __builtin_amdgcn_cvt_pk_fp8_f32(o.z, o.w, pk_, true);
                    *(unsigned*)(a.XB + t * D + 256 * j + 4 * lane) = (unsigned)pk_; }
            }
        }
        asm volatile("s_waitcnt vmcnt(0)" ::: "memory");
        f32x4 cA[2], cB[2];
        cA[0] = cA[1] = cB[0] = cB[1] = (f32x4){0.f, 0.f, 0.f, 0.f};
        const h16* xrow = a.X1 + (tw + ex) * D + 8 * kg;
        const LAS unsigned char* bh = lds + ex * WPB + kg * 16; const LAS unsigned char* bl = bh + 32 * WPB;
#pragma unroll 8
        for (int ks = 0; ks < 32; ++ks) {
            const h16x8 xh = *(const h16x8*)(xrow + 32 * ks);
#pragma unroll
            for (int tI = 0; tI < 2; ++tI) {
                const h16x8 wh = *(const LAS h16x8*)(bh + tI * 16 * WPB + ks * 64), wl = *(const LAS h16x8*)(bl + tI * 16 * WPB + ks * 64);
                cA[tI] = __builtin_amdgcn_mfma_f32_16x16x32_f16(xh, wh, cA[tI], 0, 0, 0);
                cB[tI] = __builtin_amdgcn_mfma_f32_16x16x32_f16(xh, wl, cB[tI], 0, 0, 0);
            }
        }
#pragma unroll
        for (int e = 0; e < 4; ++e) {
            float c0 = cA[0][e] + cB[0][e] * (1.0f / 4096.0f) + rb0, c1 = cA[1][e] + cB[1][e] * (1.0f / 4096.0f) + rb1;
            int sel[4]; float val[4];
#pragma unroll
            for (int k = 0; k < 4; ++k) {
                const float m = row16_max(fmaxf(c0, c1));
                const unsigned r0 = (unsigned)(__ballot(c0 == m) >> (16 * kg)) & 0xFFFFu, r1 = (unsigned)(__ballot(c1 == m) >> (16 * kg)) & 0xFFFFu;
                const int hit0 = r0 != 0u; const int wl_ = hit0 ? __builtin_ctz(r0) : __builtin_ctz(r1 | 0x10000u);
                sel[k] = hit0 ? wl_ : 16 + wl_; val[k] = m;
                if (ex == wl_) { if (hit0) c0 = -INFINITY; else c1 = -INFINITY; }
            }
            const float e1 = __expf(val[1] - val[0]), e2 = __expf(val[2] - val[0]), e3 = __expf(val[3] - val[0]);
            const float inv = 1.0f / (1.0f + e1 + e2 + e3);
            if (ex < 4) {
                const int tl = wave * 16 + 4 * kg + e; const size_t t = (size_t)tb * 128 + tl;
                const int mysel = ex == 0 ? sel[0] : ex == 1 ? sel[1] : ex == 2 ? sel[2] : sel[3];
                const float myg = (ex == 0 ? 1.0f : ex == 1 ? e1 : ex == 2 ? e2 : e3) * inv;
                a.TOPG[t * 4 + ex] = myg;
                const unsigned pos = __hip_atomic_fetch_add(hcnt + mysel, 1u, __ATOMIC_RELAXED, __HIP_MEMORY_SCOPE_WORKGROUP);
                pe[tl * 4 + ex] = (unsigned)mysel; pp[tl * 4 + ex] = pos;
            }
        }
        __syncthreads();
        if (tid < 32) hbase[tid] = __hip_atomic_fetch_add(a.CNT + tid, hcnt[tid], __ATOMIC_RELAXED, __HIP_MEMORY_SCOPE_AGENT);
        __syncthreads();
        { const unsigned e = pe[tid]; a.LIST[(size_t)e * ECAP + hbase[e] + pp[tid]] = tb * 512 + tid; }
        __syncthreads();
    }
}

__device__ __forceinline__ void phase_combine(const h16* X1, const unsigned char* YS, const float* g, const float* b, float* Xo  , h16* XH  , int gw_, int NGW_, int lane) {
    lane = lane_id(); OPAQUE(lane);
#pragma unroll 1
    for (int t0 = gw_; t0 < T; t0 += 2 * NGW_) {
        h16x4 x[2][4]; unsigned y[2][4][4];
#pragma unroll
        for (int q = 0; q < 2; ++q) { const size_t t = (size_t)t0 + (size_t)q * NGW_;
#pragma unroll
            for (int j = 0; j < 4; ++j) { x[q][j] = *(const h16x4*)(X1 + t * D + 256 * j + 4 * lane);
#pragma unroll
                for (int k = 0; k < 4; ++k) y[q][j][k] = *(const unsigned*)(YS + (t * 4 + k) * D + 256 * j + 4 * lane); } }
#pragma unroll
        for (int q = 0; q < 2; ++q) { const size_t t = (size_t)t0 + (size_t)q * NGW_;
            f32x4 v[4]; float s = 0.f;
#pragma unroll
            for (int j = 0; j < 4; ++j) { f32x4 ysum = (f32x4){0.f, 0.f, 0.f, 0.f};
#pragma unroll
                for (int k = 0; k < 4; ++k) { const f32x2 lo = __builtin_amdgcn_cvt_pk_f32_fp8((int)y[q][j][k], false), hi = __builtin_amdgcn_cvt_pk_f32_fp8((int)y[q][j][k], true); ysum += (f32x4){lo.x, lo.y, hi.x, hi.y}; }
                v[j] = __builtin_convertvector(x[q][j], f32x4) * ALPHA + ysum * (1.0f / YS_SCALE);
                s += (v[j].x + v[j].y) + (v[j].z + v[j].w); }
            const float mean = wave_sum(s) * (1.0f / D); float s2 = 0.f;
#pragma unroll
            for (int j = 0; j < 4; ++j) { v[j] = v[j] - mean; s2 += (v[j].x * v[j].x + v[j].y * v[j].y) + (v[j].z * v[j].z + v[j].w * v[j].w); }
            const float rstd = rsqrtf(wave_sum(s2) * (1.0f / D) + LN_EPS);
#pragma unroll
            for (int j = 0; j < 4; ++j) { v[j] = v[j] * rstd * *(const f32x4*)(g + 256 * j + 4 * lane) + *(const f32x4*)(b + 256 * j + 4 * lane);
                if (Xo) *(f32x4*)(Xo + t * D + 256 * j + 4 * lane) = v[j]; else *(u32x2*)(XH + t * D + 256 * j + 4 * lane) = pkh4(v[j]); }
        }
    }
}

#include <cmath>
namespace attn_body {
using bf16=_Float16;
using bf16x8=__attribute__((ext_vector_type(8)))short;
using s16x4=__attribute__((ext_vector_type(4)))short;
using f32x16=__attribute__((ext_vector_type(16)))float;
using u32x4=__attribute__((ext_vector_type(4)))unsigned;
constexpr int SEQ=2048,D=64,DM=1024,DMO=2048;
constexpr int NW=8,QBLK=32,QB=QBLK*NW,KVBLK=64,NQB=SEQ/QB;
typedef _Float16 f16x8_t __attribute__((ext_vector_type(8)));
#define MFMA32(a,b,c) __builtin_amdgcn_mfma_f32_32x32x16_f16(__builtin_bit_cast(f16x8_t,(a)),__builtin_bit_cast(f16x8_t,(b)),(c),0,0,0)
__device__ __forceinline__ int crow(int r,int hi){return (r&3)+8*(r>>2)+4*hi;}
#define SBAR() __builtin_amdgcn_sched_barrier(0)
__device__ __forceinline__ void cmask(f32x16&p0,f32x16&p1,int jb,int qrel,int hi){
  const float NEG=-INFINITY; int kb=64*jb+4*hi;
  #pragma unroll
  for(int r=0;r<16;++r){int kv=kb+(r&3)+8*(r>>2); if(kv>qrel)p0[r]=NEG; if(kv+32>qrel)p1[r]=NEG;}
}

constexpr int NSLOT=3, SLOTB=8192;
constexpr int LDS_K=0, LDS_V=NSLOT*SLOTB, LDS_WS=2*NSLOT*SLOTB, LDS_OST=LDS_WS+NW*64*4, LDS_BYTES=LDS_OST+NW*4096;
constexpr float C2=0.125f*1.4426950408889634f;
__device__ __forceinline__ void glds16(const void*gsrc,unsigned lds_dst){unsigned keep;
  asm volatile("s_mov_b32 %0, m0\n\ts_mov_b32 m0, %2\n\ts_nop 0\n\tglobal_load_lds_dwordx4 %1, off\n\ts_mov_b32 m0, %0":"=&s"(keep):"v"(gsrc),"s"(lds_dst):"memory");}
__device__ __forceinline__ float max3f(float a,float b,float c){float r;asm("v_max3_f32 %0, %1, %2, %3":"=v"(r):"v"(a),"v"(b),"v"(c));return r;}
__device__ __forceinline__ float max2f(float a,float b){float r;asm("v_max_f32_e32 %0, %1, %2":"=v"(r):"v"(a),"v"(b));return r;}
__device__ __forceinline__ float fadd_s(float a,float b){float r;asm("v_add_f32_e32 %0, %1, %2":"=v"(r):"v"(a),"v"(b));return r;}
__device__ __forceinline__ float fsub_s(float a,float b){float r;asm("v_sub_f32_e32 %0, %1, %2":"=v"(r):"v"(a),"v"(b));return r;}
typedef float f32x2_t __attribute__((ext_vector_type(2))); typedef _Float16 bf16x2_t __attribute__((ext_vector_type(2)));
__device__ __forceinline__ unsigned cvtpk_s(float lo,float hi){f32x2_t v={lo,hi};bf16x2_t b=__builtin_convertvector(v,bf16x2_t);return __builtin_bit_cast(unsigned,b);}
#define WAIT_BAR(N) asm volatile("s_waitcnt vmcnt(" #N ") lgkmcnt(0)\n\ts_barrier":::"memory")

__device__ __forceinline__ void qkt(f32x16&p0,f32x16&p1,const char*Kslot,const bf16x8*qr,const f32x16&negm,int r32,int hi){
  const char*kb=Kslot+hi*1024+r32*16;
  #pragma unroll
  for(int d0=0;d0<4;++d0){
    const bf16x8 b0=*reinterpret_cast<const bf16x8*>(kb+d0*2048);
    const bf16x8 b1=*reinterpret_cast<const bf16x8*>(kb+d0*2048+512);
    if(d0==0){p0=MFMA32(b0,qr[0],negm);p1=MFMA32(b1,qr[0],negm);}
    else{p0=MFMA32(b0,qr[d0],p0);p1=MFMA32(b1,qr[d0],p1);}}
}
typedef __attribute__((address_space(3))) const char* lds_cptr;
typedef short v4i16_t __attribute__((ext_vector_type(4)));
__device__ __forceinline__ void kload8(bf16x8*kf,lds_cptr kp){
  kf[0]=*(const __attribute__((address_space(3))) bf16x8*)(kp);      kf[1]=*(const __attribute__((address_space(3))) bf16x8*)(kp+512);
  kf[2]=*(const __attribute__((address_space(3))) bf16x8*)(kp+2048); kf[3]=*(const __attribute__((address_space(3))) bf16x8*)(kp+2560);
  kf[4]=*(const __attribute__((address_space(3))) bf16x8*)(kp+4096); kf[5]=*(const __attribute__((address_space(3))) bf16x8*)(kp+4608);
  kf[6]=*(const __attribute__((address_space(3))) bf16x8*)(kp+6144); kf[7]=*(const __attribute__((address_space(3))) bf16x8*)(kp+6656);
}
__device__ __forceinline__ void kload2(bf16x8*kf,lds_cptr kp,int j){ kf[2*j]=*(const __attribute__((address_space(3))) bf16x8*)(kp+j*2048); kf[2*j+1]=*(const __attribute__((address_space(3))) bf16x8*)(kp+j*2048+512); }
__device__ __forceinline__ s16x4 vtr(lds_cptr p){ return __builtin_bit_cast(s16x4,__builtin_amdgcn_ds_read_tr16_b64_v4i16((__attribute__((address_space(3))) v4i16_t*)p)); }
__device__ __forceinline__ float rowmax(const f32x16&p0,const f32x16&p1){
  float a=max3f(p0[0],p0[1],p1[0]),b=max3f(p0[2],p0[3],p1[1]);a=max3f(a,p1[2],p1[3]);
  #pragma unroll
  for(int r=4;r<16;r+=4){a=max3f(a,p0[r],p0[r+1]);b=max3f(b,p0[r+2],p0[r+3]);a=max3f(a,p1[r],p1[r+1]);b=max3f(b,p1[r+2],p1[r+3]);}
  const float m=max2f(a,b);
  auto rr=__builtin_amdgcn_permlane32_swap(__float_as_uint(m),__float_as_uint(m),false,false);
  return max2f(__uint_as_float(rr[0]),__uint_as_float(rr[1]));
}
__device__ __forceinline__ void pv(f32x16*o,int vb,bf16x8 pa0,bf16x8 pa1,bf16x8 pa2,bf16x8 pa3){
  #pragma unroll
  for(int d0=0;d0<2;++d0){s16x4 lo[4],hi[4];
    #pragma unroll
    for(int ks=0;ks<4;++ks){
      asm volatile("ds_read_b64_tr_b16 %0,%1 offset:%c2":"=&v"(lo[ks]):"v"(vb),"i"(d0*4096+ks*1024):"memory");
      asm volatile("ds_read_b64_tr_b16 %0,%1 offset:%c2":"=&v"(hi[ks]):"v"(vb),"i"(d0*4096+ks*1024+512):"memory");}
    asm volatile("s_waitcnt lgkmcnt(0)":::"memory");SBAR();
    #define PK(k) (bf16x8){lo[k][0],lo[k][1],lo[k][2],lo[k][3],hi[k][0],hi[k][1],hi[k][2],hi[k][3]}
    o[d0]=MFMA32(pa0,PK(0),o[d0]);
    o[d0]=MFMA32(pa1,PK(1),o[d0]);
    o[d0]=MFMA32(pa2,PK(2),o[d0]);
    o[d0]=MFMA32(pa3,PK(3),o[d0]);
    #undef PK
  }
}

#ifndef ATTN_STORE16
#define ATTN_STORE16(p,v) (*(u32x4*)(p)=(v))
#endif
template<int THRL> __device__ __forceinline__ void attn_unit(int b,int qcol,int vcol,int ocol,float slope2,int qb,int ts,const bf16*Q,const bf16*__restrict__ K,const bf16*__restrict__ V,bf16*O,char*shm,const int wid){
  int lane; asm volatile("v_mbcnt_lo_u32_b32 %0, -1, 0\n\tv_mbcnt_hi_u32_b32 %0, -1, %0":"=v"(lane)); const int r32=lane&31,hi=lane>>5;
  const long rowbase=(long)b*SEQ; const int q0=qb*QB;
  const bf16*Qw=Q+(rowbase+q0+wid*QBLK)*DM+qcol;
  const bf16*Kh=K+(rowbase+(long)ts*KVBLK)*DM+qcol,*Vh=V+(rowbase+(long)ts*KVBLK)*DM+vcol;
  const unsigned lds0=(unsigned)(uintptr_t)shm;
  float*wsf=(float*)(shm+LDS_WS)+wid*64;
  const bf16*ksrc=Kh+(long)lane*DM+wid*8;
  const bf16*vsrc=Vh+(long)(16*(wid&3)+(lane>>2))*DM+(wid>>2)*32+(lane&3)*8;
  const unsigned kdst=lds0+LDS_K+wid*1024, vdst=lds0+LDS_V+wid*1024;
  #define DMA_K(t,slot) glds16(ksrc+(long)(t)*KVBLK*DM,(unsigned)__builtin_amdgcn_readfirstlane(kdst+(slot)))
  #define DMA_V(t,slot) glds16(vsrc+(long)(t)*KVBLK*DM,(unsigned)__builtin_amdgcn_readfirstlane(vdst+(slot)))
  const int vb0=(int)(lds0+LDS_V)+((lane>>4)&1)*32+(lane&3)*8+(4*hi+((lane&15)>>2))*64;
  const char*Kbase=shm+LDS_K; bf16x8 kf[8];
  const lds_cptr shm3=(lds_cptr)shm; const lds_cptr kp0=shm3+LDS_K+hi*1024+r32*16; const lds_cptr vp0=shm3+LDS_V+((lane>>4)&1)*32+(lane&3)*8+(4*hi+((lane&15)>>2))*64;
  const int NT=(q0+QB)/KVBLK-ts;
  DMA_K(0,0);DMA_V(0,0);DMA_K(1,SLOTB);
  bf16x8 qr[4];
  #pragma unroll
  for(int d0=0;d0<4;++d0)qr[d0]=*reinterpret_cast<const bf16x8*>(&Qw[(long)r32*DM+d0*16+hi*8]);
  float mhat=0.f,l_reg=0.f;f32x16 o[2];o[0]=f32x16{};o[1]=f32x16{};f32x16 negm;
  const float delta=64.f*slope2,c32=32.f*slope2;
  _Pragma("unroll") for(int r=0;r<16;++r)negm[r]=slope2*(float)crow(r,hi); asm volatile("":"+v"(negm));
  const int qrel=wid*QBLK+r32;
  #define CMASK(P0,P1,t) do{int jb_=(t)-(NT-4); if(jb_>=0)cmask(P0,P1,jb_,qrel,hi);}while(0)
  bool resc=false;
  #define START(P0,P1) do{ const float rm=rowmax(P0,P1); resc=false; \
    { const float dl=rm; mhat=fadd_s(mhat,dl); \
      _Pragma("unroll") for(int r=0;r<16;++r){P0[r]=fsub_s(P0[r],dl);P1[r]=fsub_s(P1[r],dl);} \
      _Pragma("unroll") for(int r=0;r<16;++r)negm[r]-=dl; asm volatile("":"+v"(negm)); } \
    _Pragma("unroll") for(int r=0;r<16;++r)P0[r]=__builtin_amdgcn_exp2f(P0[r]); }while(0)
  #define RESC() do{ if(resc){ asm volatile("s_waitcnt lgkmcnt(0)":::"memory"); \
      _Pragma("unroll") for(int d_=0;d_<2;++d_) _Pragma("unroll") for(int r=0;r<16;++r)o[d_][r]*=wsf[crow(r,hi)]; } }while(0)
  f32x16 pA0,pA1,pB0,pB1;
  int sl_prev=0,sl_cur=0,sl_next=SLOTB;
  #define ROT() do{sl_prev=sl_cur;sl_cur=sl_next;sl_next=(sl_next==(NSLOT-1)*SLOTB)?0:sl_next+SLOTB;}while(0)
  DMA_K(2,2*SLOTB);
  WAIT_BAR(3);
  qkt(pA0,pA1,Kbase,qr,negm,r32,hi);asm volatile("s_nop 15\n\ts_nop 7":"+v"(pA0),"+v"(pA1)); _Pragma("unroll") for(int r=0;r<16;++r)pA1[r]+=c32; CMASK(pA0,pA1,0);
  START(pA0,pA1);
  _Pragma("unroll") for(int r=0;r<16;++r)pA1[r]=__builtin_amdgcn_exp2f(pA1[r]);
  WAIT_BAR(0);
  DMA_K(3,0);DMA_V(1,SLOTB);
  ROT();
  kload8(kf,kp0+sl_cur);
  WAIT_BAR(2);
  s16x4 vlo[8],vhi[8]; u32x4 pw0,pw1,pw2,pw3;
  #define PKW(P,B) cvtpk_s(P[B],P[B+1])
  #define PAF(k) __builtin_bit_cast(bf16x8,pw##k)
  #define VFR(i) (bf16x8){vlo[i][0],vlo[i][1],vlo[i][2],vlo[i][3],vhi[i][0],vhi[i][1],vhi[i][2],vhi[i][3]}
  #define PIN(x) asm volatile("":"+v"(x))
  #define MX3(a,b,c) __builtin_fmaxf(__builtin_fmaxf((a),(b)),(c))
  #define GAPA(MF,A0,A1,A2,A3,W0,W1,PW) do{ MF; sacc+=A0; sacc+=A1; sacc+=A2; sacc+=A3; PIN(sacc); W0; W1; PIN(PW); SBAR(); }while(0)
  #define EX(v) __builtin_amdgcn_exp2f(v)
  #define GAPB(MF,X,B) do{ MF; X[B]=EX(X[B]); X[B+1]=EX(X[B+1]); X[B+2]=EX(X[B+2]); X[B+3]=EX(X[B+3]); PIN(X); SBAR(); }while(0)
  #define VRD(i) do{ vlo[i]=vtr(vp_+(((i)>>2)*4096+((i)&3)*1024)); vhi[i]=vtr(vp_+(((i)>>2)*4096+((i)&3)*1024+512)); }while(0)
  #define KRD(G,j) do{ if(G){ kload2(kf,kp0+sl_next,j); SBAR(); } }while(0)
  #define STEP(C0,C1,P0,P1,t,GK,GV,GL) do{ SBAR(); \
    _Pragma("unroll") for(int r=0;r<16;++r)negm[r]+=delta; asm volatile("":"+v"(negm)); \
    const lds_cptr vp_=vp0+sl_prev; \
    VRD(0); SBAR(); float sacc=(P0[0]+P0[1]); \
    GAPA(C0=MFMA32(kf[0],qr[0],negm), P0[2],P0[3],P0[4],P0[5],     pw0[0]=PKW(P0,0), pw0[1]=PKW(P0,2), pw0); \
    VRD(4); SBAR(); GAPA(C1=MFMA32(kf[1],qr[0],negm), P0[6],P0[7],P0[8],P0[9],     pw0[2]=PKW(P0,4), pw0[3]=PKW(P0,6), pw0); \
    VRD(1); SBAR(); GAPA(C0=MFMA32(kf[2],qr[1],C0),   P0[10],P0[11],P0[12],P0[13], pw1[0]=PKW(P0,8), pw1[1]=PKW(P0,10), pw1); \
    VRD(5); SBAR(); GAPA(C1=MFMA32(kf[3],qr[1],C1),   P0[14],P0[15],P1[0],P1[1],   pw1[2]=PKW(P0,12),pw1[3]=PKW(P0,14), pw1); \
    VRD(2); SBAR(); GAPA(C0=MFMA32(kf[4],qr[2],C0),   P1[2],P1[3],P1[4],P1[5],     pw2[0]=PKW(P1,0), pw2[1]=PKW(P1,2), pw2); \
    VRD(6); SBAR(); GAPA(C1=MFMA32(kf[5],qr[2],C1),   P1[6],P1[7],P1[8],P1[9],     pw2[2]=PKW(P1,4), pw2[3]=PKW(P1,6), pw2); \
    VRD(3); SBAR(); GAPA(C0=MFMA32(kf[6],qr[3],C0),   P1[10],P1[11],P1[12],P1[13], pw3[0]=PKW(P1,8), pw3[1]=PKW(P1,10), pw3); \
    VRD(7); SBAR(); GAPA(C1=MFMA32(kf[7],qr[3],C1),   P1[14],P1[15],0.f,0.f,       pw3[2]=PKW(P1,12),pw3[3]=PKW(P1,14), pw3); \
    l_reg+=sacc; \
    if(GK){DMA_K((t)+3,sl_cur);} if(GV){DMA_V((t)+1,sl_next);} \
    _Pragma("unroll") for(int r=0;r<16;++r)C1[r]+=c32; \
    CMASK(C0,C1,t); \
    { float a=MX3(C0[0],C0[1],C1[0]),b=MX3(C0[2],C0[3],C1[1]); a=MX3(a,C1[2],C1[3]); \
      _Pragma("unroll") for(int r=4;r<16;r+=4){a=MX3(a,C0[r],C0[r+1]);b=MX3(b,C0[r+2],C0[r+3]);a=MX3(a,C1[r],C1[r+1]);b=MX3(b,C1[r+2],C1[r+3]);} \
      float rm=__builtin_fmaxf(a,b); { auto rr=__builtin_amdgcn_permlane32_swap(__float_as_uint(rm),__float_as_uint(rm),false,false); rm=__builtin_fmaxf(__uint_as_float(rr[0]),__uint_as_float(rr[1])); } \
      resc=false; \
      if(__builtin_expect(__any(rm>(float)THRL),0)){ const float dl=__builtin_fmaxf(rm,0.f); mhat+=dl; \
        _Pragma("unroll") for(int r=0;r<16;++r){C0[r]-=dl;C1[r]-=dl;} \
        _Pragma("unroll") for(int r=0;r<16;++r)negm[r]-=dl; asm volatile("":"+v"(negm)); \
        const float f=__builtin_amdgcn_exp2f(-dl); l_reg*=f; if(hi==0)wsf[r32]=f; resc=true; } } \
    SBAR(); \
    GAPB(o[0]=MFMA32(PAF(0),VFR(0),o[0]), C0,0); \
    GAPB(o[1]=MFMA32(PAF(0),VFR(4),o[1]), C0,4); \
    KRD(GL,0); GAPB(o[0]=MFMA32(PAF(1),VFR(1),o[0]), C0,8); \
    KRD(GL,1); GAPB(o[1]=MFMA32(PAF(1),VFR(5),o[1]), C0,12); \
    KRD(GL,2); GAPB(o[0]=MFMA32(PAF(2),VFR(2),o[0]), C1,0); \
    KRD(GL,3); GAPB(o[1]=MFMA32(PAF(2),VFR(6),o[1]), C1,4); \
    GAPB(o[0]=MFMA32(PAF(3),VFR(3),o[0]), C1,8); \
    GAPB(o[1]=MFMA32(PAF(3),VFR(7),o[1]), C1,12); \
    }while(0)
  int t=1;
  #undef CMASK
  #define CMASK(P0,P1,t) do{}while(0)
  for(;t+5<NT;t+=2){
    STEP(pB0,pB1,pA0,pA1,t,true,true,true);     WAIT_BAR(2); RESC(); ROT();
    STEP(pA0,pA1,pB0,pB1,t+1,true,true,true);   WAIT_BAR(2); RESC(); ROT();
  }
  #undef CMASK
  #define CMASK(P0,P1,t) do{int jb_=(t)-(NT-4); if(jb_>=0)cmask(P0,P1,jb_,qrel,hi);}while(0)
  #define ENDW(tt) do{ if((tt)+3<NT){WAIT_BAR(2);} else if((tt)+2<NT){WAIT_BAR(1);} else {WAIT_BAR(0);} }while(0)
  for(;t+1<NT;t+=2){
    STEP(pB0,pB1,pA0,pA1,t,(t+3<NT),(t+1<NT),(t+1<NT));       ENDW(t);   RESC(); ROT();
    STEP(pA0,pA1,pB0,pB1,t+1,(t+4<NT),(t+2<NT),(t+2<NT));     ENDW(t+1); RESC(); ROT();
  }
  STEP(pB0,pB1,pA0,pA1,NT-1,false,false,false); RESC();
  { float sacc=pB0[0]+pB0[1]; _Pragma("unroll") for(int r=2;r<16;++r)sacc+=pB0[r]; _Pragma("unroll") for(int r=0;r<16;++r)sacc+=pB1[r]; l_reg+=sacc;
    pw0=(u32x4){PKW(pB0,0),PKW(pB0,2),PKW(pB0,4),PKW(pB0,6)};pw1=(u32x4){PKW(pB0,8),PKW(pB0,10),PKW(pB0,12),PKW(pB0,14)};pw2=(u32x4){PKW(pB1,0),PKW(pB1,2),PKW(pB1,4),PKW(pB1,6)};pw3=(u32x4){PKW(pB1,8),PKW(pB1,10),PKW(pB1,12),PKW(pB1,14)};
    SBAR(); pv(o,vb0+sl_cur,PAF(0),PAF(1),PAF(2),PAF(3)); }
  #undef PKW
  #undef PAF
  #undef VFR
  #undef PIN
  #undef MX3
  #undef GAPA
  #undef GAPB
  #undef EX
  #undef VRD
  #undef KRD
  #undef STEP
  #undef ENDW
  {auto rr=__builtin_amdgcn_permlane32_swap(__float_as_uint(l_reg),__float_as_uint(l_reg),false,false);l_reg=__uint_as_float(rr[0])+__uint_as_float(rr[1]);}
  if(hi==0)wsf[32+r32]=l_reg;asm volatile("s_waitcnt lgkmcnt(0)":::"memory");
  float rli[16];
  #pragma unroll
  for(int r=0;r<16;++r)rli[r]=__builtin_amdgcn_rcpf(wsf[32+crow(r,hi)]);
  bf16*Ow=O+(rowbase+q0+wid*QBLK)*DMO+ocol;
  { bf16*stg=(bf16*)(shm+LDS_OST)+wid*2048;
    #pragma unroll
    for(int r=0;r<16;++r){const int orow=crow(r,hi);
      #pragma unroll
      for(int d0=0;d0<2;++d0)stg[orow*64+d0*32+r32]=(bf16)(o[d0][r]*rli[r]);}
    asm volatile("s_waitcnt lgkmcnt(0)":::"memory");
    #pragma unroll
    for(int i=0;i<4;++i){const int row=i*8+(lane>>3),ch=lane&7; const u32x4 v=*(const u32x4*)(stg+row*64+ch*8); ATTN_STORE16(Ow+(long)row*DMO+ch*8,v);} }
  asm volatile("s_waitcnt lgkmcnt(0)\n\ts_barrier":::"memory");
  #undef DMA_K
  #undef DMA_V
  #undef CMASK
  #undef START
  #undef RESC
  #undef ROT
}
}
#undef SBAR
#undef WAIT_BAR
#undef MFMA32
__device__ const unsigned char ATT_H[64] = {5,6,7,5,6,7,5,6,7,4,4,4,4,5,6,7,4,5,6,7,3,3,3,3,3,3,4,5,6,7,2,2,2,2,2,2,1,1,1,1,1,1,1,2,3,4,5,6,7,0,0,0,0,0,0,0,0,1,2,3,4,5,6,7};
__device__ const unsigned char ATT_Q[64] = {7,7,7,6,6,6,5,5,5,5,6,7,4,4,4,4,3,3,3,3,3,4,5,6,7,2,2,2,2,2,2,3,4,5,6,7,1,2,3,4,5,6,7,1,1,1,1,1,1,1,2,3,4,5,6,7,0,0,0,0,0,0,0,0};
__device__ const unsigned char ATT_S[64] = {0,0,0,0,0,0,0,0,0,2,6,10,0,0,0,0,0,0,0,0,2,6,10,14,18,0,0,0,0,0,2,6,10,14,18,22,0,4,8,12,16,20,24,0,0,0,0,0,0,2,6,10,14,18,22,26,0,0,0,0,0,0,0,0};
__device__ __forceinline__ void phase_attn(const h16* Q, const h16* KK, const h16* VV, h16* ORAW, char* lds_generic, int blk, int G, const int wave) {
    const int vcu = (G % 8 == 0) ? (blk % 8) * (G / 8) + blk / 8 : blk;
#pragma unroll 1
    for (int r = 0; r < 16; ++r) {
        const int p = r * 256 + ((r & 1) ? 255 - vcu : vcu), ci = p >> 6, u = p & 63;
        const int hh = ATT_H[ci], qb = ATT_Q[ci], ts = ATT_S[ci], b = u >> 2, c = (u >> 1) & 1, vh = u & 1;
        const float slope2 = exp2f(-(float)(hh + 1)) * LOG2E;
        attn_body::attn_unit<8>(b, hh * 128 + c * 64, hh * 128 + vh * 64, c * 1024 + hh * 128 + vh * 64, slope2, qb, ts, Q, KK, VV, ORAW, lds_generic, wave);
    }
}

__device__ __forceinline__ float row16_sum(float v);
__device__ __forceinline__ void phase_attn_combine(const h16* ORAW, const float* lamv  , const float* subg  , float lambda_init, h16* OB, int gw_, int NGW_, int lane) {
    lane = lane_id(); OPAQUE(lane);
    const float la = wave_sum(lamv[lane] * lamv[64 + lane]), lb = wave_sum(lamv[128 + lane] * lamv[192 + lane]);
    const float lam = __expf(la) - __expf(lb) + lambda_init;
    const int hs = lane >> 5, d = (lane & 31) * 4;
    const f32x4 gsc = *(const f32x4*)(subg + d) * (1.0f - lambda_init);
#pragma unroll 1
    for (int t0 = gw_; t0 < T; t0 += 2 * NGW_) {
        h16x4 a[2][4], b[2][4];
#pragma unroll
        for (int q = 0; q < 2; ++q) { const size_t t = (size_t)t0 + (size_t)q * NGW_;
#pragma unroll
            for (int hp = 0; hp < 4; ++hp) { const int hh = 2 * hp + hs; a[q][hp] = *(const h16x4*)(ORAW + t * 2048 + hh * 128 + d); b[q][hp] = *(const h16x4*)(ORAW + t * 2048 + 1024 + hh * 128 + d); } }
#pragma unroll
        for (int q = 0; q < 2; ++q) { const size_t t = (size_t)t0 + (size_t)q * NGW_;
#pragma unroll
            for (int hp = 0; hp < 4; ++hp) { const int hh = 2 * hp + hs;
                const f32x4 o = __builtin_convertvector(a[q][hp], f32x4) - __builtin_convertvector(b[q][hp], f32x4) * lam;
                float ss = (o.x * o.x + o.y * o.y) + (o.z * o.z + o.w * o.w); ss = row16_sum(ss); ss += swz16f(ss);
                const float r = rsqrtf(ss * (1.0f / 128.0f) + 1e-5f);
                *(u32x2*)(OB + t * 1024 + hh * 128 + d) = pkh4(o * r * gsc); } }
    }
}

struct SchedRkv {
    const char* XM; const char* Wrkv; const char* Wl1; int nk, G, c;
    __device__ __forceinline__ bool next(int i, Unit& u) const {
        int pm, q;
        if (G == 256) { const int L = i * 32 + (c >> 3), pl = L / nk; q = L - pl * nk; pm = pl * 8 + (c & 7); if (pm >= 128) return false; }
        else { const int U = i * G + c; if (U >= 128 * nk) return false; pm = U / nk; q = U - pm * nk; }
        u.pm = pm; u.rows = 256; u.e = 0; u.rbase = 0; u.list = nullptr;
        int xs, pn, kind; const char* B;
        if (q < 12) { kind = q >> 2; pn = q & 3; xs = kind; B = Wrkv + ((size_t)kind * 1024 + pn * 256) * 2048; }
        else { kind = q - 9; pn = 0; xs = (kind == 6) ? 2 : kind; B = Wl1 + (size_t)(kind - 3) * 256 * 2048; }
        u.kind = kind; u.pn = pn; u.B = B; u.A = XM + ((size_t)xs * T + (size_t)pm * 256) * 2048;
        return true;
    }
    __device__ __forceinline__ unsigned a_off(const Unit&, int row) const { return (unsigned)row * 2048u; }
};
struct SchedL2 {
    const char* L1O; const char* Wl2; int kind, G, c;
    __device__ __forceinline__ bool next(int i, Unit& u) const {
        const int U = i * G + c; if (U >= 128 * 4) return false;
        const int pm = U >> 2; u.pm = pm; u.pn = U & 3; u.rows = 256; u.e = 0; u.rbase = 0; u.list = nullptr; u.kind = kind;
        u.A = L1O + ((size_t)kind * T + (size_t)pm * 256) * 512; u.B = Wl2 + ((size_t)kind * 1024 + u.pn * 256) * 512;
        return true;
    }
    __device__ __forceinline__ unsigned a_off(const Unit&, int row) const { return (unsigned)row * 512u; }
};
struct SchedPlain {
    const char* A; const char* B; int npn, G, c;
    __device__ __forceinline__ bool next(int i, Unit& u) const {
        int pm, pn;
        if (G == 256) { const int L = i * 32 + (c >> 3), pl = L / npn; pn = L - pl * npn; pm = pl * 8 + (c & 7); if (pm >= 128) return false; }
        else { const int U = i * G + c; if (U >= 128 * npn) return false; pm = U / npn; pn = U - pm * npn; }
        u.pm = pm; u.rows = 256; u.e = 0; u.rbase = 0; u.list = nullptr;
        u.kind = pn >> 2; u.pn = pn & 3; u.A = A + (size_t)pm * 256 * 2048; u.B = B + (size_t)pn * 256 * 2048;
        return true;
    }
    __device__ __forceinline__ unsigned a_off(const Unit&, int row) const { return (unsigned)row * 2048u; }
};
struct SchedMoe {
    const LAS unsigned* misc; const LAS int* tile_e; const char* A; const char* W; const int* LIST; int npn, gather, G, c; size_t wstride;
    __device__ __forceinline__ bool next(int i, Unit& u) const {
        const int ntile = __builtin_amdgcn_readfirstlane((int)misc[48 + 32]);
        int rtg, pn;
        if (G == 256) { const int x = c & 7, j = c >> 3, rpr = 32 / npn; rtg = (i * rpr + j / npn) * 8 + x; pn = j % npn; if (rtg >= ntile) return false; }
        else { const int U = i * G + c; if (U >= ntile * npn) return false; rtg = U / npn; pn = U - rtg * npn; }
        const int e = __builtin_amdgcn_readfirstlane(tile_e[rtg]);
        const int rt = rtg - __builtin_amdgcn_readfirstlane((int)misc[48 + e]), cnt = __builtin_amdgcn_readfirstlane((int)misc[16 + e]);
        u.pm = rtg; u.pn = pn; u.kind = 0; u.e = e; u.rbase = rtg * 256; u.rows = min(256, cnt - rt * 256);
        u.list = LIST + (size_t)e * ECAP + rt * 256;
        u.A = gather ? A : A + (size_t)rtg * 256 * 1024; u.B = W + (size_t)e * wstride + (size_t)pn * 256 * 1024;
        return true;
    }
    __device__ __forceinline__ unsigned a_off(const Unit& u, int row) const {
        if (!gather) return (unsigned)row * 1024u;
        const int slot = (row < u.rows) ? u.list[row] : 0;
        return (unsigned)(slot >> 2) * 1024u;
    }
};
__device__ __forceinline__ void moe_tables(const unsigned* CNT, volatile LAS unsigned* misc, LAS int* tile_e, const int wave) {
    if (wave == 0 && lane_id() == 0) {
        unsigned acc = 0;
        for (int e = 0; e < 32; ++e) { const unsigned c = __hip_atomic_load(CNT + e, __ATOMIC_RELAXED, __HIP_MEMORY_SCOPE_AGENT); misc[16 + e] = c; misc[48 + e] = acc; acc += (c + 255u) >> 8; }
        misc[48 + 32] = acc;
    }
    __syncthreads();
    { const int ntile = (int)misc[48 + 32];
      for (int i = wave * 64 + lane_id(); i < ntile; i += NTHR) { int e = 0; for (int j = 1; j < 32; ++j) if ((int)misc[48 + j] <= i) e = j; tile_e[i] = e; } }
    __syncthreads();
}

__device__ __forceinline__ size_t hm_off(int row, int col) { return ((size_t)((row >> 11) * 16 + (col >> 6)) * SEQ + (row & 2047)) * 64 + (col & 63); }
struct EpiRkv {
    h16* Rp; h16* Kp; h16* Vp; h16* L1O;
    __device__ __forceinline__ void operator()(const f32x4 (&acc)[2][2][4][2], const Unit& u, int wr, int wc, int fr, int fq) const {
        if (u.kind < 3) {
            h16* C = u.kind == 0 ? Rp : (u.kind == 1 ? Kp : Vp);
            FOR_ACC(ai, bj, m, n) { const int row = u.pm * 256 + 128 * ai + 64 * wr + 16 * m + fr, col = u.pn * 256 + 128 * bj + 32 * wc + 16 * n + 4 * fq;
                *(u32x2*)(C + hm_off(row, col)) = pkh4(acc[ai][bj][m][n]); }
        } else {
            h16* O = L1O + (size_t)(u.kind - 3) * T * 256; const int kd = u.kind;
            FOR_ACC(ai, bj, m, n) { const int row = u.pm * 256 + 128 * ai + 64 * wr + 16 * m + fr, col = 128 * bj + 32 * wc + 16 * n + 4 * fq;
                f32x4 v = acc[ai][bj][m][n];
                if (kd == 3) { v.x = tanhf(v.x); v.y = tanhf(v.y); v.z = tanhf(v.z); v.w = tanhf(v.w); }
                else if (kd == 5) { v.x = sigmoidf_(v.x); v.y = sigmoidf_(v.y); v.z = sigmoidf_(v.z); v.w = sigmoidf_(v.w); }
                *(u32x2*)(O + (size_t)row * 256 + col) = pkh4(v); }
        }
    }
};
template <int KD> struct EpiL2 {
    void* O; const h16* VF; const float* bias;
    __device__ __forceinline__ void operator()(const f32x4 (&acc)[2][2][4][2], const Unit& u, int wr, int wc, int fr, int fq) const {
        f32x4 bv[2][2];
#pragma unroll
        for (int bj = 0; bj < 2; ++bj)
#pragma unroll
            for (int n = 0; n < 2; ++n) bv[bj][n] = (KD != 2) ? *(const f32x4*)(bias + u.pn * 256 + 128 * bj + 32 * wc + 16 * n + 4 * fq) : (f32x4){0.f, 0.f, 0.f, 0.f};
#pragma unroll
        for (int ai = 0; ai < 2; ++ai)
#pragma unroll
            for (int mp = 0; mp < 2; ++mp) {
                h16x4 vc[2][2][2], vf[2][2][2];
                if (KD == 3) {
#pragma unroll
                    for (int mm = 0; mm < 2; ++mm)
#pragma unroll
                        for (int bj = 0; bj < 2; ++bj)
#pragma unroll
                            for (int n = 0; n < 2; ++n) { const size_t o = hm_off(u.pm * 256 + 128 * ai + 64 * wr + 16 * (2 * mp + mm) + fr, u.pn * 256 + 128 * bj + 32 * wc + 16 * n + 4 * fq);
                                vc[mm][bj][n] = *(const h16x4*)((const h16*)O + o); vf[mm][bj][n] = *(const h16x4*)(VF + o); }
                }
#pragma unroll
                for (int mm = 0; mm < 2; ++mm)
#pragma unroll
                    for (int bj = 0; bj < 2; ++bj)
#pragma unroll
                        for (int n = 0; n < 2; ++n) { const int m = 2 * mp + mm; const size_t o = hm_off(u.pm * 256 + 128 * ai + 64 * wr + 16 * m + fr, u.pn * 256 + 128 * bj + 32 * wc + 16 * n + 4 * fq);
                            f32x4 v = acc[ai][bj][m][n] + bv[bj][n];
                            if (KD == 0) { v.x = 1.0f - __expf(-0.6065306597126334f * sigmoidf_(v.x)); v.y = 1.0f - __expf(-0.6065306597126334f * sigmoidf_(v.y)); v.z = 1.0f - __expf(-0.6065306597126334f * sigmoidf_(v.z)); v.w = 1.0f - __expf(-0.6065306597126334f * sigmoidf_(v.w)); }
                            if (KD == 1 || KD == 3) { v.x = sigmoidf_(v.x); v.y = sigmoidf_(v.y); v.z = sigmoidf_(v.z); v.w = sigmoidf_(v.w); }
                            if (KD == 3) { const f32x4 c_ = __builtin_convertvector(vc[mm][bj][n], f32x4), f_ = __builtin_convertvector(vf[mm][bj][n], f32x4); v = c_ + (f_ - c_) * v; }
                            *(u32x2*)((h16*)O + o) = pkh4(v); }
                if (KD == 3) EPI_FENCE();
            }
    }
};
template <bool F16X> struct EpiRes {
    const void* X; h16* H;
    __device__ __forceinline__ void operator()(const f32x4 (&acc)[2][2][4][2], const Unit& u, int wr, int wc, int fr, int fq) const {
        const float* Xf = (const float*)X; const h16* Xh = (const h16*)X;
#pragma unroll
        for (int ai = 0; ai < 2; ++ai)
#pragma unroll
            for (int mp = 0; mp < 2; ++mp) {
                f32x4 xr[2][2][2]; h16x4 xh[2][2][2];
#pragma unroll
                for (int mm = 0; mm < 2; ++mm)
#pragma unroll
                    for (int bj = 0; bj < 2; ++bj)
#pragma unroll
                        for (int n = 0; n < 2; ++n) { const size_t o = (size_t)(u.pm * 256 + 128 * ai + 64 * wr + 16 * (2 * mp + mm) + fr) * D + u.pn * 256 + 128 * bj + 32 * wc + 16 * n + 4 * fq;
                            if (F16X) xh[mm][bj][n] = *(const h16x4*)(Xh + o); else xr[mm][bj][n] = *(const f32x4*)(Xf + o); }
#pragma unroll
                for (int mm = 0; mm < 2; ++mm)
#pragma unroll
                    for (int bj = 0; bj < 2; ++bj)
#pragma unroll
                        for (int n = 0; n < 2; ++n) { const int m = 2 * mp + mm; const f32x4 xv = F16X ? __builtin_convertvector(xh[mm][bj][n], f32x4) : xr[mm][bj][n];
                            *(u32x2*)(H + (size_t)(u.pm * 256 + 128 * ai + 64 * wr + 16 * m + fr) * D + u.pn * 256 + 128 * bj + 32 * wc + 16 * n + 4 * fq) = pkh4(xv * ALPHA + acc[ai][bj][m][n]); }
                EPI_FENCE();
            }
    }
};
struct EpiQkv {
    h16* O0; h16* O1; float sc0;
    __device__ __forceinline__ void operator()(const f32x4 (&acc)[2][2][4][2], const Unit& u, int wr, int wc, int fr, int fq) const {
        h16* O = u.kind == 0 ? O0 : O1; const float sc = u.kind == 0 ? sc0 : 1.0f;
        FOR_ACC(ai, bj, m, n) { const int row = u.pm * 256 + 128 * ai + 64 * wr + 16 * m + fr, col = u.pn * 256 + 128 * bj + 32 * wc + 16 * n + 4 * fq;
            *(u32x2*)(O + (size_t)row * 1024 + col) = pkh4(acc[ai][bj][m][n] * sc); }
    }
};
struct EpiGu {
    unsigned char* ACT; const float* bgu;
    __device__ __forceinline__ void operator()(const f32x4 (&acc)[2][2][4][2], const Unit& u, int wr, int wc, int fr, int fq) const {
        const float* bb = bgu + (size_t)u.e * 2048;
        f32x4 bg[2], bu[2];
        const int colb = u.pn * 128 + 32 * wc + 8 * fq;
#pragma unroll
        for (int n = 0; n < 2; ++n) { bg[n] = *(const f32x4*)(bb + colb + 4 * n); bu[n] = *(const f32x4*)(bb + 1024 + colb + 4 * n); }
#pragma unroll
        for (int ai = 0; ai < 2; ++ai)
#pragma unroll
            for (int m = 0; m < 4; ++m) { const int rl = 128 * ai + 64 * wr + 16 * m + fr;
                if (rl < u.rows) { u32x2 pk2;
#pragma unroll
                    for (int n = 0; n < 2; ++n) {
                        const f32x4 gt = acc[ai][0][m][n] * (1.0f / GU_SCALE) + bg[n], up = acc[ai][1][m][n] * (1.0f / GU_SCALE) + bu[n]; f32x4 r;
#pragma unroll
                        for (int e = 0; e < 4; ++e) { const float g = fminf(gt[e], 7.0f), uu = __builtin_amdgcn_fmed3f(up[e], -7.0f, 7.0f); r[e] = (uu + 1.0f) * (g * __builtin_amdgcn_rcpf(1.0f + __builtin_amdgcn_exp2f((-1.702f * 1.4426950408889634f) * g))); }
                        int pk_ = __builtin_amdgcn_cvt_pk_fp8_f32(r[0], r[1], 0, false); pk_ = __builtin_amdgcn_cvt_pk_fp8_f32(r[2], r[3], pk_, true); pk2[n] = (unsigned)pk_; }
                    *(u32x2*)(ACT + (size_t)(u.rbase + rl) * 1024 + colb) = pk2;
                } }
    }
};
struct EpiDn {
    unsigned char* YS; const float* bdn; const float* TOPG;
    __device__ __forceinline__ void operator()(const f32x4 (&acc)[2][2][4][2], const Unit& u, int wr, int wc, int fr, int fq) const {
        const float* bb = bdn + (size_t)u.e * 1024;
        f32x4 bv[2][2]; int slot[2][4]; float gt[2][4];
#pragma unroll
        for (int bj = 0; bj < 2; ++bj)
#pragma unroll
            for (int n = 0; n < 2; ++n) bv[bj][n] = *(const f32x4*)(bb + u.pn * 256 + 128 * bj + 32 * wc + 8 * fq + 4 * n);
#pragma unroll
        for (int ai = 0; ai < 2; ++ai)
#pragma unroll
            for (int m = 0; m < 4; ++m) { const int rl = 128 * ai + 64 * wr + 16 * m + fr; slot[ai][m] = (rl < u.rows) ? u.list[rl] : -1; }
#pragma unroll
        for (int ai = 0; ai < 2; ++ai)
#pragma unroll
            for (int m = 0; m < 4; ++m) { const float g_ = TOPG[slot[ai][m] >= 0 ? slot[ai][m] : 0]; gt[ai][m] = (slot[ai][m] >= 0) ? g_ * YS_SCALE : 0.f; }
#pragma unroll
        for (int ai = 0; ai < 2; ++ai)
#pragma unroll
            for (int m = 0; m < 4; ++m) {
                if (slot[ai][m] >= 0) {
#pragma unroll
                    for (int bj = 0; bj < 2; ++bj) { u32x2 pk2;
#pragma unroll
                        for (int n = 0; n < 2; ++n) {
                            const f32x4 yv = (acc[ai][bj][m][n] * (1.0f / DN_SCALE) + bv[bj][n]) * gt[ai][m];
                            int pk_ = __builtin_amdgcn_cvt_pk_fp8_f32(yv[0], yv[1], 0, false); pk_ = __builtin_amdgcn_cvt_pk_fp8_f32(yv[2], yv[3], pk_, true); pk2[n] = (unsigned)pk_; }
                        *(u32x2*)(YS + (size_t)slot[ai][m] * 1024 + u.pn * 256 + 128 * bj + 32 * wc + 8 * fq) = pk2; }
                } }
    }
};

struct Args { const float* in[33]; float* out; unsigned char* ws; int ph_lo, ph_hi; };
enum { I_X = 0, I_LNG, I_LNB, I_MIX, I_WRKV, I_WO, I_W0, I_W1, I_W2, I_A0, I_A1, I_A2, I_G1, I_G2, I_KK, I_KA, I_RK, I_LNXG, I_LNXB, I_V0, I_V1, I_V2,
       I_KVW, I_DAQ, I_DAO, I_DALAM, I_DASUB, I_RW, I_RB, I_WGU, I_BGU, I_WDN, I_BDN };

typedef const float* cfptr;
#define KAS __attribute__((address_space(4)))
#define KA_DECL const KAS cfptr* kin = (const KAS cfptr*)__builtin_amdgcn_kernarg_segment_ptr(); asm volatile("" : "+s"(kin))
#define KA_RELOAD asm volatile("" : "+s"(kin))
#define PH_BEGIN KA_RELOAD; asm volatile("" : "+s"(wave), "+s"(G), "+s"(blk)); ws = KWS; ctl = (unsigned*)(ws + WS_CTL)
#define KIN(i) (kin[i])
#define KOUT ((float*)kin[33])
#define KWS ((unsigned char*)kin[34])
__global__ void __launch_bounds__(NTHR, 2) yoco_fwd(Args args) {
    extern __shared__ __attribute__((aligned(16))) unsigned char lds_raw[];
    LAS unsigned char* lds = (LAS unsigned char*)lds_raw;
    volatile LAS unsigned* MISC = (volatile LAS unsigned*)(lds + MISC_OFF);
    int wave = __builtin_amdgcn_readfirstlane((int)threadIdx.x >> 6);
    int G = gridDim.x, blk = blockIdx.x; int lane = 0;
#define gw (blk * NWAVES + wave)
#define NGW (G * NWAVES)
    KA_DECL;
    unsigned char* ws = KWS;
    unsigned* ctl = (unsigned*)(ws + WS_CTL);
    for (int u = wave * 64 + lane_id(); u < (LDS_BYTES - MISC_OFF) / 4; u += NTHR) ((LAS unsigned*)(lds + MISC_OFF))[u] = 0u;
    __syncthreads();
    XcdBarrier bar = xcd_barrier_post(ctl + CW_BAR, MISC + 8, wave);
#define GRID_BAR() xcd_barrier(bar, wave)

    {
        LAS float* scr = (LAS float*)(lds + wave * 16896);
        conv_batch(KIN(I_WRKV), 6, 1024, 1024, (h16*)(ws + WS_W_RKV), 1024, 1024, 0, scr, gw, NGW, lane);
        conv_batch(KIN(I_WO), 2, 1024, 1024, (h16*)(ws + WS_W_RO), 1024, 1024, 0, scr, gw, NGW, lane);
#pragma unroll
        for (int l = 0; l < 2; ++l) {
            conv_batch(KIN(I_W1) + (size_t)l * 1024 * 64, 1, 1024, 64, (h16*)(ws + WS_W_L1) + (size_t)(l * 4 + 0) * 256 * 1024, 1024, 256, 0, scr, gw, NGW, lane);
            conv_batch(KIN(I_A1) + (size_t)l * 1024 * 64, 1, 1024, 64, (h16*)(ws + WS_W_L1) + (size_t)(l * 4 + 1) * 256 * 1024, 1024, 256, 0, scr, gw, NGW, lane);
            conv_batch(KIN(I_G1) + (size_t)l * 1024 * 160, 1, 1024, 160, (h16*)(ws + WS_W_L1) + (size_t)(l * 4 + 2) * 256 * 1024, 1024, 256, 0, scr, gw, NGW, lane);
            conv_batch(KIN(I_W2) + (size_t)l * 64 * 1024, 1, 64, 1024, (h16*)(ws + WS_W_L2) + (size_t)(l * 4 + 0) * 256 * 1024, 256, 1024, 0, scr, gw, NGW, lane);
            conv_batch(KIN(I_A2) + (size_t)l * 64 * 1024, 1, 64, 1024, (h16*)(ws + WS_W_L2) + (size_t)(l * 4 + 1) * 256 * 1024, 256, 1024, 0, scr, gw, NGW, lane);
            conv_batch(KIN(I_G2) + (size_t)l * 160 * 1024, 1, 160, 1024, (h16*)(ws + WS_W_L2) + (size_t)(l * 4 + 2) * 256 * 1024, 256, 1024, 0, scr, gw, NGW, lane);
        }
        conv_batch(KIN(I_V1), 1, 1024, 32, (h16*)(ws + WS_W_L1) + (size_t)(4 + 3) * 256 * 1024, 1024, 256, 0, scr, gw, NGW, lane);
        conv_batch(KIN(I_V2), 1, 32, 1024, (h16*)(ws + WS_W_L2) + (size_t)(4 + 3) * 256 * 1024, 256, 1024, 0, scr, gw, NGW, lane);
        conv_batch(KIN(I_KVW), 1, 1024, 2048, (h16*)(ws + WS_W_KV), 1024, 2048, 0, scr, gw, NGW, lane);
        conv_batch(KIN(I_DAQ), 2, 1024, 1024, (h16*)(ws + WS_W_Q), 1024, 1024, 0, scr, gw, NGW, lane);
        conv_batch(KIN(I_DAO), 2, 1024, 1024, (h16*)(ws + WS_W_AO), 1024, 1024, 0, scr, gw, NGW, lane);
#pragma unroll
        for (int l4 = 0; l4 < 4; ++l4) { conv_batch(KIN(I_RW) + (size_t)l4 * D * NEXP, 1, 1024, 32, (h16*)(ws + WS_WR) + (size_t)(l4 * 2 + 0) * 32 * 1024, 1024, 32, 0, scr, gw, NGW, lane);
                                        conv_batch(KIN(I_RW) + (size_t)l4 * D * NEXP, 1, 1024, 32, (h16*)(ws + WS_WR) + (size_t)(l4 * 2 + 1) * 32 * 1024, 1024, 32, 2, scr, gw, NGW, lane); }
    }

#pragma unroll 1
    for (int l = 0; l < 4; ++l) {
        if (l < 2) {
            PH_BEGIN;
            if (l == 0) phase_prep<false>(KIN(I_X), KIN(I_MIX), (h16*)(ws + WS_XM), gw, NGW, lane);
            else phase_prep<true>(ws + WS_XH, KIN(I_MIX) + (size_t)l * 6 * D, (h16*)(ws + WS_XM), gw, NGW, lane);
            GRID_BAR();
            PH_BEGIN;
            {
                SchedRkv S{(const char*)(ws + WS_XM), (const char*)(ws + WS_W_RKV) + (size_t)l * 3 * 1024 * 2048, (const char*)(ws + WS_W_L1) + (size_t)l * 4 * 256 * 2048, l == 0 ? 15 : 16, G, blk};
                EpiRkv E{(h16*)(ws + WS_R), (h16*)(ws + WS_K), (h16*)(ws + (l == 0 ? WS_VF : WS_V)), (h16*)(ws + WS_L1O)};
                GEMM_PHASE(S, E, 1024);
            }
            GRID_BAR();
            PH_BEGIN;
            {
                const char* l1o = (const char*)(ws + WS_L1O); const char* wl2 = (const char*)(ws + WS_W_L2) + (size_t)l * 4 * 1024 * 512;
                { SchedL2 S{l1o, wl2, 0, G, blk}; EpiL2<0> E{(void*)(ws + WS_WD), nullptr, KIN(I_W0) + (size_t)l * D}; GEMM_PHASE(S, E, 256); }
                { SchedL2 S{l1o, wl2, 1, G, blk}; EpiL2<1> E{(void*)(ws + WS_AA), nullptr, KIN(I_A0) + (size_t)l * D}; GEMM_PHASE(S, E, 256); }
                { SchedL2 S{l1o, wl2, 2, G, blk}; EpiL2<2> E{(void*)(ws + WS_GG), nullptr, nullptr}; GEMM_PHASE(S, E, 256); }
                if (l == 1) { SchedL2 S{l1o, wl2, 3, G, blk}; EpiL2<3> E{(void*)(ws + WS_V), (const h16*)(ws + WS_VF), KIN(I_V0)}; GEMM_PHASE(S, E, 256); }
            }
            GRID_BAR();
            PH_BEGIN;
            {
                const float* wgu_ = KIN(I_WGU); const float* wdn_ = KIN(I_WDN); asm volatile("" : "+s"(wgu_), "+s"(wdn_));
                ScanArgs sa{(const h16*)(ws + WS_R), (const h16*)(ws + WS_K), (const h16*)(ws + (l == 0 ? WS_VF : WS_V)), (const h16*)(ws + WS_WD), (const h16*)(ws + WS_AA), (const h16*)(ws + WS_GG),
                            KIN(I_KK) + (size_t)l * D, KIN(I_KA) + (size_t)l * D, KIN(I_RK) + (size_t)l * D, KIN(I_LNXG) + (size_t)l * D, KIN(I_LNXB) + (size_t)l * D, (h16*)(ws + WS_YG), wgu_, wdn_, ws + WS_W_GU, ws + WS_W_DN, l};
                phase_scan_mm(sa, lds, blk, G, wave);
            }
            GRID_BAR();
            PH_BEGIN;
            {
                SchedPlain S{(const char*)(ws + WS_YG), (const char*)(ws + WS_W_RO) + (size_t)l * 1024 * 2048, 4, G, blk};
                if (l == 0) { EpiRes<false> E{KIN(I_X), (h16*)(ws + WS_H)}; GEMM_PHASE(S, E, 1024); }
                else { EpiRes<true> E{ws + WS_XH, (h16*)(ws + WS_H)}; GEMM_PHASE(S, E, 1024); }
            }
            GRID_BAR();
        } else {
            const int j = l - 2;
            PH_BEGIN;
            if (l == 2) {
                { SchedPlain S{(const char*)(ws + WS_XH), (const char*)(ws + WS_W_Q), 4, G, blk}; EpiQkv E{(h16*)(ws + WS_Q), nullptr, QSCALE}; GEMM_PHASE(S, E, 1024); }
                { SchedPlain S{(const char*)(ws + WS_XH), (const char*)(ws + WS_W_KV), 8, G, blk}; EpiQkv E{(h16*)(ws + WS_KK), (h16*)(ws + WS_VV), 1.0f}; GEMM_PHASE(S, E, 1024); }
            } else {
                SchedPlain S{(const char*)(ws + WS_XH), (const char*)(ws + WS_W_Q) + (size_t)j * 1024 * 2048, 4, G, blk}; EpiQkv E{(h16*)(ws + WS_Q), nullptr, QSCALE}; GEMM_PHASE(S, E, 1024);
            }
            GRID_BAR();
            PH_BEGIN;
            phase_attn((const h16*)(ws + WS_Q), (const h16*)(ws + WS_KK), (const h16*)(ws + WS_VV), (h16*)(ws + WS_ORAW), (char*)lds_raw, blk, G, wave);
            GRID_BAR();
            PH_BEGIN;
            phase_attn_combine((const h16*)(ws + WS_ORAW), KIN(I_DALAM) + (size_t)j * 256, KIN(I_DASUB) + (size_t)j * 128, 0.8f - 0.6f * expf(-0.3f * (float)l), (h16*)(ws + WS_OB), gw, NGW, lane);
            GRID_BAR();
            PH_BEGIN;
            {
                SchedPlain S{(const char*)(ws + WS_OB), (const char*)(ws + WS_W_AO) + (size_t)j * 1024 * 2048, 4, G, blk};
                EpiRes<true> E{ws + WS_XH, (h16*)(ws + WS_H)};
                GEMM_PHASE(S, E, 1024);
            }
            GRID_BAR();
        }
        PH_BEGIN;
        {
            RouterArgs ra{(const h16*)(ws + WS_H), KIN(I_LNG) + (size_t)(l * 2) * D, KIN(I_LNB) + (size_t)(l * 2) * D, (const h16*)(ws + WS_WR) + (size_t)l * 2 * 32 * 1024, KIN(I_RB) + (size_t)l * NEXP,
                          (h16*)(ws + WS_X1), (unsigned char*)(ws + WS_XB), (float*)(ws + WS_TOPG), (int*)(ws + WS_LIST), ctl + CW_CNT + l * 32};
            phase_ln_router(ra, lds, blk, G, wave);
        }
        GRID_BAR();
        PH_BEGIN;
        moe_tables(ctl + CW_CNT + l * 32, MISC, (LAS int*)(lds + TILE_E_OFF), wave);
        {
            SchedMoe S{(const LAS unsigned*)MISC, (const LAS int*)(lds + TILE_E_OFF), (const char*)(ws + WS_XB), (const char*)(ws + WS_W_GU) + (size_t)l * 32 * 2048 * 1024, (const int*)(ws + WS_LIST), 8, 1, G, blk, (size_t)2048 * 1024};
            EpiGu E{(unsigned char*)(ws + WS_ACT), KIN(I_BGU) + (size_t)l * 32 * 2048};
            GEMM_PHASE8(S, E, 1024);
        }
        GRID_BAR();
        PH_BEGIN;
        {
            SchedMoe S{(const LAS unsigned*)MISC, (const LAS int*)(lds + TILE_E_OFF), (const char*)(ws + WS_ACT), (const char*)(ws + WS_W_DN) + (size_t)l * 32 * 1024 * 1024, (const int*)(ws + WS_LIST), 4, 0, G, blk, (size_t)1024 * 1024};
            EpiDn E{(unsigned char*)(ws + WS_YS), KIN(I_BDN) + (size_t)l * 32 * 1024, (const float*)(ws + WS_TOPG)};
            GEMM_PHASE8(S, E, 1024);
        }
        GRID_BAR();
        PH_BEGIN;
        phase_combine((const h16*)(ws + WS_X1), (const unsigned char*)(ws + WS_YS), KIN(I_LNG) + (size_t)(l * 2 + 1) * D, KIN(I_LNB) + (size_t)(l * 2 + 1) * D,
                      l == 3 ? KOUT : (float*)nullptr, (h16*)(ws + WS_XH), gw, NGW, lane);
        if (l < 3) GRID_BAR();
    }
    if (xb_ld(ctl + CW_BAR + XB_TMO) != 0u && wave == 0 && lane_id() == 0) KOUT[(size_t)blk * D] = __builtin_nanf("");
}

extern "C" void kernel_launch(void* const* d_in, const int* in_sizes, int n_in, void* d_out, int out_size, void* d_ws, size_t ws_size, hipStream_t stream) {
    static int grid = 0;
    if (grid == 0) {
        if (n_in != 33 || out_size != T * D || ws_size < WS_END) { fprintf(stderr, "kernel_launch: unexpected shapes (n_in %d out %d ws %zu)\n", n_in, out_size, ws_size); grid = -1; return; }
        if (hipFuncSetAttribute((const void*)yoco_fwd, hipFuncAttributeMaxDynamicSharedMemorySize, LDS_BYTES) != hipSuccess) { fprintf(stderr, "kernel_launch: hipFuncSetAttribute failed\n"); grid = -1; return; }
        int dev = 0, cus = 0, per_cu = 0;
        hipGetDevice(&dev); hipDeviceGetAttribute(&cus, hipDeviceAttributeMultiprocessorCount, dev);
        hipOccupancyMaxActiveBlocksPerMultiprocessor(&per_cu, (const void*)yoco_fwd, NTHR, LDS_BYTES);
        (void)hipGetLastError();
        if (per_cu < 1) fprintf(stderr, "kernel_launch: occupancy query reports %d\n", per_cu);
        grid = cus < 256 ? cus : 256;
    }
    if (grid < 0) return;
    hipMemsetAsync((char*)d_ws + WS_CTL, 0, CTL_ZERO_BYTES, stream);
    Args a{};
    for (int i = 0; i < 33; ++i) a.in[i] = (const float*)d_in[i];
    a.out = (float*)d_out; a.ws = (unsigned char*)d_ws; a.ph_lo = 0; a.ph_hi = 0;
    hipLaunchKernelGGL(yoco_fwd, dim3(grid), dim3(NTHR), LDS_BYTES, stream, a);
}
```

```cpp
#include <hip/hip_runtime.h>
#include <cstdio>
#include <cstdint>
#include <cmath>

#define LAS __attribute__((address_space(3)))
#define GAS __attribute__((address_space(1)))
typedef _Float16 h16;
typedef _Float16 h16x8 __attribute__((ext_vector_type(8)));
typedef _Float16 h16x4 __attribute__((ext_vector_type(4)));
typedef _Float16 h16x2 __attribute__((ext_vector_type(2)));
typedef float f32x4 __attribute__((ext_vector_type(4)));
typedef float f32x2 __attribute__((ext_vector_type(2)));
typedef unsigned u32x4 __attribute__((ext_vector_type(4)));
typedef unsigned u32x2 __attribute__((ext_vector_type(2)));

constexpr int D = 1024, NBATCH = 16, SEQ = 2048, T = NBATCH * SEQ;
constexpr int NEXP = 32, TOPK = 4, ECAP = T;
constexpr int NWAVES = 8, NTHR = NWAVES * 64;
constexpr float ALPHA = 1.6817928305074290f;
constexpr float LN_EPS = 1e-5f;
constexpr float QSCALE = 0.125f * 1.4426950408889634f;
constexpr float LOG2E = 1.4426950408889634f;
constexpr float GU_SCALE = 64.0f, DN_SCALE = 128.0f, YS_SCALE = 16.0f;

constexpr size_t MiB = 1u << 20;
constexpr size_t WS_CTL = 0, CTL_ZERO_BYTES = 1 * MiB;
constexpr size_t WS_W_RKV = 2 * MiB;
constexpr size_t WS_W_RO = 14 * MiB;
constexpr size_t WS_W_L1 = 18 * MiB;
constexpr size_t WS_W_L2 = 22 * MiB;
constexpr size_t WS_W_KV = 26 * MiB;
constexpr size_t WS_W_Q = 30 * MiB;
constexpr size_t WS_W_AO = 34 * MiB;
constexpr size_t WS_WR = 38 * MiB;
constexpr size_t WS_W_GU = 40 * MiB;
constexpr size_t WS_W_DN = 552 * MiB;
constexpr size_t WS_X = 808 * MiB;
constexpr size_t WS_X1 = 936 * MiB;
constexpr size_t WS_H = 1064 * MiB;
constexpr size_t WS_XB = 1192 * MiB;
constexpr size_t WS_XH = 1256 * MiB;
constexpr size_t WS_TOPG = 1320 * MiB;
constexpr size_t WS_LIST = 1321 * MiB;
constexpr size_t WS_ACT = 1328 * MiB;
constexpr size_t WS_YS = 1616 * MiB;
constexpr size_t WS_XM = 1872 * MiB;
constexpr size_t WS_R = 2256 * MiB, WS_K = 2384 * MiB, WS_V = 2512 * MiB, WS_VF = 2640 * MiB;
constexpr size_t WS_L1O = 2768 * MiB;
constexpr size_t WS_WD = 2832 * MiB, WS_AA = 2960 * MiB, WS_GG = 3088 * MiB;
constexpr size_t WS_YG = 3216 * MiB;
constexpr size_t WS_END = 3280 * MiB;
constexpr size_t WS_Q = 1872 * MiB, WS_KK = 1936 * MiB, WS_VV = 2000 * MiB;
constexpr size_t WS_ORAW = 2064 * MiB;
constexpr size_t WS_OB = 2192 * MiB;
constexpr int CW_BAR = 4096;
constexpr int CW_CNT = 16384;

constexpr int LDS_BYTES = 147456;
constexpr int MISC_OFF = 146432;
constexpr int TILE_E_OFF = 143360;

template <int CTRL> __device__ __forceinline__ float dppf(float v) { return __builtin_bit_cast(float, __builtin_amdgcn_mov_dpp(__builtin_bit_cast(int, v), CTRL, 0xF, 0xF, true)); }
__device__ __forceinline__ float swz16f(float v) { return __builtin_bit_cast(float, __builtin_amdgcn_ds_swizzle(__builtin_bit_cast(int, v), (16 << 10) | 0x1F)); }
__device__ __forceinline__ float grp8_sum(float v) { v += dppf<0xB1>(v); v += dppf<0x4E>(v); v += dppf<0x141>(v); return v; }
__device__ __forceinline__ float wave_sum(float v) {
    v += dppf<0xB1>(v); v += dppf<0x4E>(v); v += dppf<0x141>(v); v += dppf<0x140>(v); v += swz16f(v);
    return __builtin_bit_cast(float, __builtin_amdgcn_readlane(__builtin_bit_cast(int, v), 0)) + __builtin_bit_cast(float, __builtin_amdgcn_readlane(__builtin_bit_cast(int, v), 32));
}
__device__ __forceinline__ float wave_max(float v) {
    v = fmaxf(v, dppf<0xB1>(v)); v = fmaxf(v, dppf<0x4E>(v)); v = fmaxf(v, dppf<0x141>(v)); v = fmaxf(v, dppf<0x140>(v)); v = fmaxf(v, swz16f(v));
    return fmaxf(__builtin_bit_cast(float, __builtin_amdgcn_readlane(__builtin_bit_cast(int, v), 0)), __builtin_bit_cast(float, __builtin_amdgcn_readlane(__builtin_bit_cast(int, v), 32)));
}
__device__ __forceinline__ unsigned pkh(float a, float b) { h16x2 v = {(h16)a, (h16)b}; return __builtin_bit_cast(unsigned, v); }
__device__ __forceinline__ u32x2 pkh4(f32x4 v) { u32x2 r; r.x = pkh(v.x, v.y); r.y = pkh(v.z, v.w); return r; }
__device__ __forceinline__ f32x4 ldh4(const h16* p) { const h16x4 v = *(const h16x4*)p; return __builtin_convertvector(v, f32x4); }
__device__ __forceinline__ float sigmoidf_(float x) { return __builtin_amdgcn_rcpf(1.0f + __builtin_amdgcn_exp2f(-1.4426950408889634f * x)); }
__device__ __forceinline__ int lane_id() { int l; asm volatile("v_mbcnt_lo_u32_b32 %0, -1, 0\n\tv_mbcnt_hi_u32_b32 %0, -1, %0" : "=v"(l)); return l; }
#define LDS_WAIT() asm volatile("s_waitcnt lgkmcnt(0)" ::: "memory")
#define OPAQUE(x) asm volatile("" : "+v"(x))

#define XB_TMO      128
#define XB_XCNT(j)  (256  + 64 * (j))
#define XB_XSUB(j)  (1280 + 64 * (j))
#define XB_XGEN(j)  (2304 + 64 * (j))
#define XB_TOP      3328
#define XB_TOPGEN   3392
#define XCD_BAR_WORDS 3456
#define XB_SPIN_CAP (1u << 21)

__device__ __forceinline__ unsigned xb_ld(unsigned* p)              { return __hip_atomic_load((GAS unsigned*)p, __ATOMIC_RELAXED, __HIP_MEMORY_SCOPE_AGENT); }
__device__ __forceinline__ unsigned xb_add(unsigned* p, unsigned v) { return __hip_atomic_fetch_add((GAS unsigned*)p, v, __ATOMIC_RELAXED, __HIP_MEMORY_SCOPE_AGENT); }
__device__ __forceinline__ unsigned xb_xcc_id() { return (unsigned)__builtin_amdgcn_s_getreg((3 << 11) | 20) & 0xFu; }
#define XB_SPIN(cond, bar) do { unsigned _sp = 0; while (cond) { __builtin_amdgcn_s_sleep(1); \
    if ((++_sp & 255u) == 0u) { if (xb_ld(&(bar)[XB_TMO])) break; if (_sp > XB_SPIN_CAP) { (void)xb_add(&(bar)[XB_TMO], 1u); break; } } } } while (0)

struct XcdBarrier { unsigned* bar; unsigned x; volatile LAS unsigned* st; };

__device__ __forceinline__ XcdBarrier xcd_barrier_post(unsigned* bar, volatile LAS unsigned* st, const int wave) {
    XcdBarrier b; b.bar = bar; b.x = xb_xcc_id(); b.st = st;
    if (wave == 0 && lane_id() == 0) (void)xb_add(&bar[XB_XCNT(b.x)], 1u);
    return b;
}
__device__ __forceinline__ void xcd_barrier_complete(unsigned* bar, unsigned x, unsigned& nloc, unsigned& nx) {
    const unsigned G = gridDim.x * gridDim.y * gridDim.z;
    unsigned sum, cnt, mine, sp = 0u;
    for (;;) {
        sum = 0u; cnt = 0u; mine = 0u;
#pragma unroll
        for (unsigned j = 0; j < 16; ++j) { const unsigned c = xb_ld(&bar[XB_XCNT(j)]); sum += c; cnt += (c > 0u) ? 1u : 0u; mine = (j == x) ? c : mine; }
        if (sum == G) break;
        __builtin_amdgcn_s_sleep(1);
        if ((++sp & 255u) == 0u) { if (xb_ld(&bar[XB_TMO])) break; if (sp > XB_SPIN_CAP) { (void)xb_add(&bar[XB_TMO], 1u); break; } }
    }
    nloc = mine > 0u ? mine : 1u; nx = cnt > 0u ? cnt : 1u;
}
__device__ __forceinline__ void xcd_barrier(const XcdBarrier& b, const int wave) {
    asm volatile("s_waitcnt vmcnt(0)" ::: "memory");
    __syncthreads();
    if (wave == 0 && lane_id() == 0) {
        unsigned* bar = b.bar; unsigned bx = b.x;
        asm volatile("" : "+s"(bar), "+s"(bx));
        __builtin_amdgcn_s_waitcnt(0);
        unsigned nloc = b.st[0], nx = b.st[1];
        if (nloc == 0u) { xcd_barrier_complete(bar, bx, nloc, nx); b.st[0] = nloc; b.st[1] = nx; }
        const unsigned old = xb_add(&bar[XB_XSUB(bx)], 1u);
        const unsigned gen = old / nloc;
        if (old + 1u == (gen + 1u) * nloc) {
            __builtin_amdgcn_fence(__ATOMIC_RELEASE, "agent");
            asm volatile("s_waitcnt vmcnt(0)" ::: "memory");
            const unsigned og = xb_add(&bar[XB_TOP], 1u);
            const unsigned tg = og / nx;
            if (og + 1u == (tg + 1u) * nx) xb_add(&bar[XB_TOPGEN], 1u);
            else XB_SPIN(xb_ld(&bar[XB_TOPGEN]) == tg, bar);
            __builtin_amdgcn_fence(__ATOMIC_ACQUIRE, "agent");
            xb_add(&bar[XB_XGEN(bx)], 1u);
            asm volatile("s_waitcnt vmcnt(0)" ::: "memory");
        } else {
            XB_SPIN(xb_ld(&bar[XB_XGEN(bx)]) == gen, bar);
            __builtin_amdgcn_fence(__ATOMIC_ACQUIRE, "agent");
            asm volatile("s_waitcnt vmcnt(0)" ::: "memory");
        }
    }
    __syncthreads();
}

__device__ __forceinline__ void conv_batch(const float* src, int batch, int Kr, int Nr, h16* dst, int Kp, int Np, int perm, LAS float* scr, int gw, int NGW, int lane) {
    lane = lane_id(); OPAQUE(lane);
    const int kbn = Kp / 64, nbn = Np / 32, per = kbn * nbn, total = batch * per;
    for (int it = gw; it < total; it += NGW) {
        const int bi = it / per, r = it - bi * per, kb = r / nbn, nb = r - kb * nbn, k0 = 64 * kb, n0 = 32 * nb;
        const float* W = src + (size_t)bi * Kr * Nr; h16* WT = dst + (size_t)bi * Np * Kp;
        float vals[32];
#pragma unroll
        for (int i = 0; i < 32; ++i) { const int k = k0 + 2 * i + (lane >> 5), n = n0 + (lane & 31); vals[i] = (k < Kr && n < Nr) ? W[(size_t)k * Nr + n] : 0.f; }
#pragma unroll
        for (int i = 0; i < 32; ++i) { float x = vals[i]; if (perm == 2) x = (x - (float)(h16)x) * 4096.0f; scr[(2 * i + (lane >> 5)) * 33 + (lane & 31)] = x; }
        LDS_WAIT();
        const int c = lane & 7;
#pragma unroll
        for (int j = 0; j < 4; ++j) { const int nl = (lane >> 3) + 8 * j; const LAS float* s = scr + (8 * c) * 33 + nl;
            u32x4 o; o.x = pkh(s[0 * 33], s[1 * 33]); o.y = pkh(s[2 * 33], s[3 * 33]); o.z = pkh(s[4 * 33], s[5 * 33]); o.w = pkh(s[6 * 33], s[7 * 33]);
            int n = n0 + nl; if (perm == 1) n = ((n & 1023) >> 7) * 256 + (n >> 10) * 128 + (n & 127);
            if (perm == 3) { const int c5 = n & 31; n = (n & ~31) | (16 * ((c5 >> 2) & 1) + 4 * (c5 >> 3) + (c5 & 3)); }
            *(u32x4*)(WT + (size_t)n * Kp + k0 + 8 * c) = o; }
        LDS_WAIT();
    }
}


__device__ __forceinline__ void conv_batch8(const float* src, int batch, int Kr, int Nr, unsigned char* dst, int Kp, int Np, int perm, float scale, LAS float* scr, int gw_, int NGW_, int lane) {
    lane = lane_id(); OPAQUE(lane);
    const int kbn = Kp / 128, nbn = Np / 32, per = kbn * nbn, total = batch * per;
    for (int it = gw_; it < total; it += NGW_) {
        const int bi = it / per, r = it - bi * per, kb = r / nbn, nb = r - kb * nbn, k0 = 128 * kb, n0 = 32 * nb;
        const float* W = src + (size_t)bi * Kr * Nr; unsigned char* WT = dst + (size_t)bi * Np * Kp;
        float vals[64];
#pragma unroll
        for (int i = 0; i < 64; ++i) { const int k = k0 + 2 * i + (lane >> 5), n = n0 + (lane & 31); vals[i] = (k < Kr && n < Nr) ? W[(size_t)k * Nr + n] : 0.f; }
#pragma unroll
        for (int i = 0; i < 64; ++i) scr[(2 * i + (lane >> 5)) * 33 + (lane & 31)] = vals[i] * scale;
        LDS_WAIT();
        const int c = lane & 7;
#pragma unroll
        for (int j = 0; j < 4; ++j) { const int nl = (lane >> 3) + 8 * j; const LAS float* sp = scr + (16 * c) * 33 + nl; u32x4 o;
#pragma unroll
            for (int q = 0; q < 4; ++q) { int w_ = __builtin_amdgcn_cvt_pk_fp8_f32(sp[(4 * q) * 33], sp[(4 * q + 1) * 33], 0, false); w_ = __builtin_amdgcn_cvt_pk_fp8_f32(sp[(4 * q + 2) * 33], sp[(4 * q + 3) * 33], w_, true); o[q] = (unsigned)w_; }
            int n = n0 + nl; if (perm) n = ((n & 1023) >> 7) * 256 + (n >> 10) * 128 + (n & 127);
            *(u32x4*)(WT + (size_t)n * Kp + k0 + 16 * c) = o; }
        LDS_WAIT();
    }
}

struct Unit { int pm, pn, kind, e, rows, rbase; const char* A; const char* B; const int* list; };

struct DenseDesc { const char* A; const char* B; int kind, pn; };

namespace pg8 {
constexpr int BM = 256, BK = 64, HALF = 128, HTB = HALF * BK * 2, STAGE_BYTES = 8 * HTB;
__device__ __forceinline__ int lds_byte(int r, int c) { const int st = (r >> 4) * 2 + (c >> 5), rr = r & 15, cc = c & 31, ob = rr * 64 + cc * 2; return st * 1024 + (ob ^ (((ob >> 9) & 1) << 5)); }
__device__ __forceinline__ void stage_rc(int b, int& R, int& C) { const int st = b / 1024, sb = b % 1024, swz = sb ^ (((sb >> 9) & 1) << 5); R = (st >> 1) * 16 + swz / 64; C = (st & 1) * 32 + (swz % 64) / 2; }
}
typedef int i32x4 __attribute__((ext_vector_type(4)));
typedef int i32x8 __attribute__((ext_vector_type(8)));
template <bool FP8, class Sched, class Epi>
__device__ __forceinline__ void gemm_phase_pg8(LAS unsigned char* lds, const Sched& S, const Epi& E, const int Kb, const int wave) {
    using namespace pg8;
    int tid = wave * 64 + lane_id(); OPAQUE(tid);
    const int wid = wave, lane = tid & 63, wr = wid >> 2, wc = wid & 3, fr = lane & 15, fq = lane >> 4;
    const int nt = Kb / 128;
    int Rs[2], Cs[2]; unsigned voffB[2];
#pragma unroll
    for (int i = 0; i < 2; ++i) { stage_rc(tid * 16 + i * 8192, Rs[i], Cs[i]); voffB[i] = (unsigned)(Rs[i] * Kb + Cs[i] * 2); }
    const size_t kstep = (size_t)128;
    const size_t hstepB = (size_t)HALF * Kb;
    const unsigned ldsw = (unsigned)wid * 1024u;
    const int aoff = lds_byte(wr * 64 + fr, fq * 8), boff = lds_byte(wc * 32 + fr, fq * 8);
#define PG8_SA(b, h) (((b) * 2 + (h)) * HTB)
#define PG8_SB(b, h) ((4 + (b) * 2 + (h)) * HTB)
#define PG8_STAGE(bufoff, gbase, voff) do { _Pragma("unroll") for (int _i = 0; _i < 2; ++_i) \
        __builtin_amdgcn_global_load_lds((const unsigned*)((const char*)(gbase) + (voff)[_i]), (LAS unsigned*)(lds + (bufoff) + ldsw + _i * 8192), 16, 0, 0); } while (0)
#define PG8_LDA(dst, b, h) do { _Pragma("unroll") for (int m = 0; m < 4; ++m) _Pragma("unroll") for (int k = 0; k < 2; ++k) dst[m][k] = *(const LAS h16x8*)(lds + PG8_SA(b, h) + aoff + m * 2048 + k * 1024); } while (0)
#define PG8_LDB(dst, b, h) do { _Pragma("unroll") for (int n = 0; n < 2; ++n) _Pragma("unroll") for (int k = 0; k < 2; ++k) dst[n][k] = *(const LAS h16x8*)(lds + PG8_SB(b, h) + boff + n * 2048 + k * 1024); } while (0)
#define PG8_MMA(ai, bj, At, Bt) do { __builtin_amdgcn_s_setprio(1); \
        if (FP8) { _Pragma("unroll") for (int m = 0; m < 4; ++m) _Pragma("unroll") for (int n = 0; n < 2; ++n) { \
            const i32x4 b0_ = __builtin_bit_cast(i32x4, Bt[n][0]), b1_ = __builtin_bit_cast(i32x4, Bt[n][1]), a0_ = __builtin_bit_cast(i32x4, At[m][0]), a1_ = __builtin_bit_cast(i32x4, At[m][1]); \
            acc[ai][bj][m][n] = __builtin_amdgcn_mfma_scale_f32_16x16x128_f8f6f4(__builtin_shufflevector(b0_, b1_, 0, 1, 2, 3, 4, 5, 6, 7), __builtin_shufflevector(a0_, a1_, 0, 1, 2, 3, 4, 5, 6, 7), acc[ai][bj][m][n], 0, 0, 0, 0, 0, 0); } } \
        else { _Pragma("unroll") for (int m = 0; m < 4; ++m) _Pragma("unroll") for (int n = 0; n < 2; ++n) _Pragma("unroll") for (int k = 0; k < 2; ++k) \
            acc[ai][bj][m][n] = __builtin_amdgcn_mfma_f32_16x16x32_f16(Bt[n][k], At[m][k], acc[ai][bj][m][n], 0, 0, 0); } \
        __builtin_amdgcn_s_setprio(0); } while (0)
#define PG8_WAIT_V(n) asm volatile("s_waitcnt vmcnt(" #n ")" ::: "memory")
#define PG8_WAIT_L(n) asm volatile("s_waitcnt lgkmcnt(" #n ")" ::: "memory")
#define PG8_BAR __builtin_amdgcn_s_barrier()
#define PG8_SCHED __builtin_amdgcn_sched_barrier(0)
    Unit cur, nxt; int ui = 0;
    if (!S.next(0, cur)) return;
    f32x4 acc[2][2][4][2];
#pragma unroll
    for (int a = 0; a < 2; ++a)
#pragma unroll
        for (int b = 0; b < 2; ++b)
#pragma unroll
            for (int m = 0; m < 4; ++m)
#pragma unroll
                for (int n = 0; n < 2; ++n) acc[a][b][m][n] = (f32x4){0.f, 0.f, 0.f, 0.f};
    h16x8 At[4][2], B0[2][2], B1[2][2];
    unsigned vA[2][2], vAn[2][2];
#pragma unroll
    for (int h = 0; h < 2; ++h)
#pragma unroll
        for (int i = 0; i < 2; ++i) vA[h][i] = S.a_off(cur, 128 * h + Rs[i]) + (unsigned)Cs[i] * 2u;
    const char* cA = cur.A; const char* cB = cur.B;
    PG8_STAGE(PG8_SB(0, 0), cB, voffB); PG8_STAGE(PG8_SB(0, 1), cB + hstepB, voffB); PG8_STAGE(PG8_SA(0, 0), cA, vA[0]); PG8_STAGE(PG8_SA(0, 1), cA, vA[1]);
    if (wr == 1) PG8_BAR;
    PG8_WAIT_V(2); PG8_BAR;
    PG8_STAGE(PG8_SB(1, 0), cB + kstep, voffB); PG8_STAGE(PG8_SA(1, 0), cA + kstep, vA[0]); PG8_STAGE(PG8_SB(1, 1), cB + hstepB + kstep, voffB);
    PG8_WAIT_V(6); PG8_BAR;
    for (;;) {
        const bool has_next = S.next(ui + 1, nxt);
        const char* nA = has_next ? nxt.A : cA; const char* nB = has_next ? nxt.B : cB;
#pragma unroll
        for (int h = 0; h < 2; ++h)
#pragma unroll
            for (int i = 0; i < 2; ++i) vAn[h][i] = has_next ? (S.a_off(nxt, 128 * h + Rs[i]) + (unsigned)Cs[i] * 2u) : vA[h][i];
#pragma unroll 1
        for (int t = 0; t < nt; t += 2) {
            const bool last = (t == nt - 2);
            const char* a1 = cA + (size_t)(t + 1) * kstep;
            const char* a2 = last ? nA : cA + (size_t)(t + 2) * kstep; const char* b2 = last ? nB : cB + (size_t)(t + 2) * kstep;
            const char* a3 = a2 + kstep; const char* b3 = b2 + kstep;
            PG8_LDB(B0, 0, 0); PG8_LDB(B1, 0, 1); PG8_SCHED; PG8_LDA(At, 0, 0); PG8_STAGE(PG8_SA(1, 1), a1, vA[1]);
            if (last) { vA[0][0] = vAn[0][0]; vA[0][1] = vAn[0][1]; vA[1][0] = vAn[1][0]; vA[1][1] = vAn[1][1]; }
            PG8_WAIT_V(8); PG8_WAIT_L(0); PG8_BAR; PG8_MMA(0, 0, At, B0); PG8_MMA(0, 1, At, B1); PG8_BAR; PG8_SCHED;
            PG8_LDA(At, 0, 1); PG8_STAGE(PG8_SB(0, 0), b2, voffB); PG8_STAGE(PG8_SB(0, 1), b2 + hstepB, voffB); PG8_STAGE(PG8_SA(0, 0), a2, vA[0]);
            PG8_WAIT_V(8); PG8_WAIT_L(0); PG8_BAR; PG8_MMA(1, 0, At, B0); PG8_MMA(1, 1, At, B1); PG8_BAR; PG8_SCHED;
            PG8_LDB(B0, 1, 0); PG8_LDB(B1, 1, 1); PG8_SCHED; PG8_LDA(At, 1, 0); PG8_STAGE(PG8_SA(0, 1), a2, vA[1]);
            PG8_WAIT_V(8); PG8_WAIT_L(0); PG8_BAR; PG8_MMA(0, 0, At, B0); PG8_MMA(0, 1, At, B1); PG8_BAR; PG8_SCHED;
            PG8_LDA(At, 1, 1); PG8_STAGE(PG8_SB(1, 0), b3, voffB); PG8_STAGE(PG8_SB(1, 1), b3 + hstepB, voffB); PG8_STAGE(PG8_SA(1, 0), a3, vA[0]);
            PG8_WAIT_V(8); PG8_WAIT_L(0); PG8_BAR; PG8_MMA(1, 0, At, B0); PG8_MMA(1, 1, At, B1); PG8_BAR; PG8_SCHED;
        }
        if (wr == 0) PG8_BAR;
        { int fr_e = fr, fq_e = fq; OPAQUE(fr_e); OPAQUE(fq_e);
          E(acc, cur, wr, wc, fr_e, fq_e); }
        if (!has_next) break;
#pragma unroll
        for (int a = 0; a < 2; ++a)
#pragma unroll
            for (int b = 0; b < 2; ++b)
#pragma unroll
                for (int m = 0; m < 4; ++m)
#pragma unroll
                    for (int n = 0; n < 2; ++n) acc[a][b][m][n] = (f32x4){0.f, 0.f, 0.f, 0.f};
        cur = nxt; cA = nA; cB = nB; ++ui;
        if (wr == 1) PG8_BAR;
    }
    PG8_WAIT_V(0);
    PG8_BAR;
#undef PG8_SA
#undef PG8_SB
#undef PG8_STAGE
#undef PG8_LDA
#undef PG8_LDB
#undef PG8_MMA
#undef PG8_WAIT_V
#undef PG8_WAIT_L
#undef PG8_BAR
#undef PG8_SCHED
}
#define GEMM_PHASE(S, E, K) gemm_phase_pg8<false>(lds, S, E, (K) * 2, wave)
#define GEMM_PHASE8(S, E, K) gemm_phase_pg8<true>(lds, S, E, (K), wave)

#define FOR_ACC2(ai, bj, m) _Pragma("unroll") for (int ai = 0; ai < 2; ++ai) _Pragma("unroll") for (int m = 0; m < 4; ++m) _Pragma("unroll") for (int bj = 0; bj < 2; ++bj)
#define FOR_ACC(ai, bj, m, n) _Pragma("unroll") for (int ai = 0; ai < 2; ++ai) _Pragma("unroll") for (int m = 0; m < 4; ++m) _Pragma("unroll") for (int bj = 0; bj < 2; ++bj) _Pragma("unroll") for (int n = 0; n < 2; ++n)
#define EPI_FENCE() asm volatile("" ::: "memory")

template <bool F16IN>
__device__ __forceinline__ void phase_prep(const void* Xv, const float* mix, h16* XM, int gw_, int NGW_, int lane) {
    lane = lane_id(); OPAQUE(lane);
    const float* Xf = (const float*)Xv; const h16* Xh = (const h16*)Xv;
    for (int ch = gw_; ch < T / 16; ch += NGW_) {
        const int t0 = ch * 16;
        f32x4 prev[4];
        if ((t0 % SEQ) == 0) {
#pragma unroll
            for (int j = 0; j < 4; ++j) prev[j] = (f32x4){0.f, 0.f, 0.f, 0.f};
        } else {
#pragma unroll
            for (int j = 0; j < 4; ++j) prev[j] = F16IN ? ldh4(Xh + (size_t)(t0 - 1) * D + 256 * j + 4 * lane) : *(const f32x4*)(Xf + (size_t)(t0 - 1) * D + 256 * j + 4 * lane);
        }
#pragma unroll 1
        for (int ib = 0; ib < 4; ++ib) {
            f32x4 cur[4][4]; h16x4 curh[4][4];
#pragma unroll
            for (int q = 0; q < 4; ++q)
#pragma unroll
                for (int j = 0; j < 4; ++j) { if (F16IN) curh[q][j] = *(const h16x4*)(Xh + (size_t)(t0 + 4 * ib + q) * D + 256 * j + 4 * lane); else cur[q][j] = *(const f32x4*)(Xf + (size_t)(t0 + 4 * ib + q) * D + 256 * j + 4 * lane); }
            if (F16IN) {
#pragma unroll
                for (int q = 0; q < 4; ++q)
#pragma unroll
                    for (int j = 0; j < 4; ++j) cur[q][j] = __builtin_convertvector(curh[q][j], f32x4);
            }
#pragma unroll
            for (int q = 0; q < 4; ++q) {
                const int t = t0 + 4 * ib + q;
#pragma unroll
                for (int s = 0; s < 6; ++s) {
#pragma unroll
                    for (int j = 0; j < 4; ++j) { const f32x4 mx = *(const f32x4*)(mix + s * D + 256 * j + 4 * lane);
                        const f32x4 pv = (q == 0) ? prev[j] : cur[q == 0 ? 0 : q - 1][j];
                        const f32x4 v = cur[q][j] + (pv - cur[q][j]) * mx;
                        *(u32x2*)(XM + ((size_t)s * T + t) * D + 256 * j + 4 * lane) = pkh4(v); }
                }
            }
#pragma unroll
            for (int j = 0; j < 4; ++j) prev[j] = cur[3][j];
        }
    }
}

struct ScanArgs { const h16 *R, *K, *V; const h16* WD; const h16 *AA, *GG; const float *k_k, *k_a, *r_k, *lnx_g, *lnx_b; h16* YG; const float *wgu, *wdn; unsigned char *gu8, *dn8; int layer_pair; };
__device__ __forceinline__ float row16_sum(float v) { v += dppf<0xB1>(v); v += dppf<0x4E>(v); v += dppf<0x141>(v); v += dppf<0x140>(v); return v; }
struct ConvItem2 { const float* Wrow; unsigned char* WTp; int Nr; float scale; bool valid; };
__device__ __forceinline__ ConvItem2 conv_item2(int sit, int wave, int lane, int layer_pair, const float* wgu, const float* wdn, unsigned char* gu8) {
    ConvItem2 ci; ci.valid = sit < 12288;
    const int s = ci.valid ? sit : 0, ls = s / 6144, r = s - ls * 6144, e = r / 192, q = r - e * 192, le = (layer_pair * 2 + ls) * 32 + e;
    const bool gu = q < 128; const int q2 = gu ? q : q - 128, nb = gu ? (q2 & 31) : (q2 & 15), kq = gu ? (q2 >> 5) : (q2 >> 4), Nr = gu ? 2048 : 1024;
    const int k0 = kq * 256 + wave * 32, n = nb * 64 + lane, c5 = n & 31, p5 = 16 * ((c5 >> 2) & 1) + 4 * (c5 >> 3) + (c5 & 3), np = (n & ~31) | p5;
    const int c8 = n & 255, pdn = (n & ~255) | (128 * ((c8 >> 3) & 1) + 32 * (c8 >> 6) + 16 * ((c8 >> 2) & 1) + 4 * ((c8 >> 4) & 3) + (c8 & 3));
    const int nrow = gu ? ((np & 1023) >> 7) * 256 + (np >> 10) * 128 + (np & 127) : pdn;
    size_t wb; { const int gi = __builtin_amdgcn_readfirstlane(gu ? 1 : 0); asm("s_cmp_lg_u32 %1, 0\n\ts_cselect_b64 %0, %2, %3" : "=s"(wb) : "s"(gi), "s"(wgu), "s"(wdn) : "scc"); }
    const size_t ob = (size_t)gu8 + (gu ? (size_t)0 : (size_t)(WS_W_DN - WS_W_GU));
    ci.Wrow = (const float*)wb + (size_t)le * 1024 * Nr + (size_t)k0 * Nr + nb * 64; ci.WTp = (unsigned char*)ob + (size_t)le * Nr * 1024 + (size_t)nrow * 1024 + k0; ci.Nr = Nr; ci.scale = gu ? GU_SCALE : DN_SCALE;
    return ci;
}
__device__ __forceinline__ void conv_issue2(const ConvItem2& ci, float (&vals)[32], int lane) {
    if (ci.valid) {
        const GAS char* p = (const GAS char*)ci.Wrow; const unsigned lo = (unsigned)lane * 4u; const size_t stride = (size_t)ci.Nr * 4;
#pragma unroll
        for (int i = 0; i < 32; ++i) { vals[i] = __builtin_nontemporal_load((const GAS float*)(p + lo)); p += stride; }
    }
}
__device__ __forceinline__ void conv_finish2(const ConvItem2& ci, const float (&vals)[32]) {
    if (ci.valid) {
#pragma unroll
        for (int j = 0; j < 2; ++j) { u32x4 o;
#pragma unroll
            for (int q = 0; q < 4; ++q) { int pk_ = __builtin_amdgcn_cvt_pk_fp8_f32(vals[16 * j + 4 * q] * ci.scale, vals[16 * j + 4 * q + 1] * ci.scale, 0, false);
                pk_ = __builtin_amdgcn_cvt_pk_fp8_f32(vals[16 * j + 4 * q + 2] * ci.scale, vals[16 * j + 4 * q + 3] * ci.scale, pk_, true); o[q] = (unsigned)pk_; }
            *(u32x4*)(ci.WTp + 16 * j) = o; }
    }
}
__device__ __forceinline__ float row16_reduce_scatter(const float (&q)[16], int lane) {
    const bool b0 = lane & 1, b1 = lane & 2, b2 = lane & 4, b3 = lane & 8;
    float v[16], a[8], c[4], d[2];
#pragma unroll
    for (int s = 0; s < 16; ++s) v[s] = q[((s & 1) << 3) | ((s & 2) << 1) | ((s & 4) >> 1) | ((s & 8) >> 3)];
#pragma unroll
    for (int j = 0; j < 8; ++j) a[j] = (b0 ? v[j + 8] : v[j]) + dppf<0xB1>(b0 ? v[j] : v[j + 8]);
#pragma unroll
    for (int j = 0; j < 4; ++j) c[j] = (b1 ? a[j + 4] : a[j]) + dppf<0x4E>(b1 ? a[j] : a[j + 4]);
#pragma unroll
    for (int j = 0; j < 2; ++j) d[j] = (b2 ? c[j + 2] : c[j]) + dppf<0x124>(b2 ? c[j] : c[j + 2]);
    return (b3 ? d[1] : d[0]) + dppf<0x128>(b3 ? d[0] : d[1]);
}
#define WBAR() do { asm volatile("s_waitcnt lgkmcnt(0)" ::: "memory"); __builtin_amdgcn_s_barrier(); asm volatile("" ::: "memory"); } while (0)
__device__ __forceinline__ void phase_scan_mm(const ScanArgs& a, LAS unsigned char* lds, int blk, int G, const int wave) {
    constexpr int NG = 4, PCH = 13120;
    constexpr int O_AT = 0, O_RT = 2304, O_BBT = 4608, O_KBT = 6656, O_VT = 8704, O_MKT = 10752, O_TMT = 11264, O_NBT = 11776, O_NKT = 12288, O_GC = 12800, O_SRK = 13056;
    constexpr int TMP0 = NG * PCH, TMPB = 5632;
    constexpr int O_SY = TMP0 + 4 * TMPB, O_VO = O_SY + 2 * 16640, O_SRKO = O_VO + 2 * 8192, O_RED = O_SRKO + 512;
    int pass = 0;
    for (int bh = blk; bh < NBATCH * 16; bh += G, ++pass) {
        int tid0 = wave * 64 + lane_id(); OPAQUE(tid0);
        const int b = bh >> 4, h = bh & 15, chn0 = h * 64 + (tid0 & 63);
        const float kkc = a.k_k[chn0], kac = a.k_a[chn0], rkc = a.r_k[chn0], lg = a.lnx_g[chn0], lb = a.lnx_b[chn0];
        f32x4 ST[4];
#pragma unroll
        for (int kt = 0; kt < 4; ++kt) ST[kt] = (f32x4){0.f, 0.f, 0.f, 0.f};
        h16 qr[8], qk[8], qv[8], qa[8], qw[8];
        const int c4w = wave >> 1, hfw = wave & 1;
#pragma unroll
        for (int i = 0; i < 8; ++i) { const size_t tb = ((size_t)bh * SEQ + c4w * 16 + 8 * hfw) * 64 + (tid0 & 63);
            qr[i] = a.R[tb + i * 64]; qk[i] = a.K[tb + i * 64]; qv[i] = a.V[tb + i * 64]; qa[i] = a.AA[tb + i * 64]; qw[i] = a.WD[tb + i * 64]; }
        LAS float* gpr = (LAS float*)(lds + O_RED + 1024);
#define GPROD() ((((1.0f - (float)qw[0]) * (1.0f - (float)qw[1])) * ((1.0f - (float)qw[2]) * (1.0f - (float)qw[3]))) * (((1.0f - (float)qw[4]) * (1.0f - (float)qw[5])) * ((1.0f - (float)qw[6]) * (1.0f - (float)qw[7]))))
        gpr[wave * 64 + (tid0 & 63)] = GPROD();
        WBAR();
        h16 qg[16];
        float cv[32];
        ConvItem2 ci = conv_item2(((pass * 32 + 0) * 2 + 0) * G + blk, wave, tid0 & 63, a.layer_pair, a.wgu, a.wdn, a.gu8);
        conv_issue2(ci, cv, tid0 & 63);
#define OUT_STAGE(gp_) do { const int gp = (gp_); LAS float* red = (LAS float*)(lds + O_RED) + wave * 32; const LAS float* syo = (const LAS float*)(lds + O_SY) + (gp & 1) * (64 * 65); \
            const LAS h16* voo = (const LAS h16*)(lds + O_VO) + (gp & 1) * 4096; const LAS float* srko = (const LAS float*)(lds + O_SRKO) + (gp & 1) * 64; \
            _Pragma("unroll") for (int bt = 0; bt < 2; ++bt) { const int t0 = (wave - 4) * 16 + 8 * bt; float yv[8], q[16]; \
                _Pragma("unroll") for (int p = 0; p < 8; ++p) { yv[p] = syo[(t0 + p) * 65 + lane]; q[p] = yv[p]; q[8 + p] = yv[p] * yv[p]; } \
                float x = row16_reduce_scatter(q, lane); x += swz16f(x); \
                if ((lane & 16) == 0) red[(lane >> 5) * 16 + l16] = x; \
                LDS_WAIT(); \
                f32x4 s1[2], s2[2]; \
                _Pragma("unroll") for (int hq = 0; hq < 2; ++hq) { s1[hq] = *(const LAS f32x4*)(red + 4 * hq) + *(const LAS f32x4*)(red + 16 + 4 * hq); s2[hq] = *(const LAS f32x4*)(red + 8 + 4 * hq) + *(const LAS f32x4*)(red + 24 + 4 * hq); } \
                _Pragma("unroll") for (int p = 0; p < 8; ++p) { const int tt = t0 + p; \
                    const float mu = s1[p >> 2][p & 3] * (1.0f / 64.0f), var = fmaxf(s2[p >> 2][p & 3] * (1.0f / 64.0f) - mu * mu, 0.0f); \
                    float yn = (yv[p] - mu) * rsqrtf(var + 64e-5f) * lg + lb; yn += srko[tt] * (float)voo[tt * 64 + lane]; \
                    a.YG[((size_t)b * SEQ + gp * 64 + tt) * D + chn] = (h16)(yn * (float)qg[8 * bt + p]); } \
                LDS_WAIT(); } } while (0)
#pragma unroll 1
        for (int grp = 0; grp < SEQ / 64; ++grp) {
            int tid = tid0; OPAQUE(tid);
            const int lane = tid & 63, g4 = lane >> 4, l16 = lane & 15, chn = h * 64 + lane;
            {
                LAS unsigned char* pc = lds + c4w * PCH; LAS unsigned char* tb = lds + TMP0 + c4w * TMPB;
                LAS h16* At = (LAS h16*)(pc + O_AT); LAS h16* Rt = (LAS h16*)(pc + O_RT); LAS h16* BbT = (LAS h16*)(pc + O_BBT); LAS h16* KbT = (LAS h16*)(pc + O_KBT); LAS h16* Vt = (LAS h16*)(pc + O_VT);
                LAS h16* MkT = (LAS h16*)(pc + O_MKT); LAS h16* TmT = (LAS h16*)(pc + O_TMT); LAS h16* NbT = (LAS h16*)(pc + O_NBT); LAS h16* NkT = (LAS h16*)(pc + O_NKT);
                LAS float* gC = (LAS float*)(pc + O_GC); LAS float* srk = (LAS float*)(pc + O_SRK);
                LAS h16* Bh = (LAS h16*)tb; LAS h16* Kh = (LAS h16*)(tb + 2304); LAS float* MbF = (LAS float*)(tb + 4608);
                float wf[8];
#pragma unroll
                for (int i = 0; i < 8; ++i) wf[i] = 1.0f - (float)qw[i];
                if (grp + 1 < SEQ / 64) {
#pragma unroll
                    for (int i = 0; i < 8; ++i) qw[i] = a.WD[((size_t)bh * SEQ + (grp + 1) * 64 + c4w * 16 + 8 * hfw) * 64 + lane + i * 64];
                }
                const float gown = ((wf[0] * wf[1]) * (wf[2] * wf[3])) * ((wf[4] * wf[5]) * (wf[6] * wf[7])), goth = gpr[(wave ^ 1) * 64 + lane];
                const float gall = gown * goth;
                float gam = hfw ? goth : 1.0f, bhr[8], khr[8];
                LAS float* red = (LAS float*)(lds + O_RED) + wave * 32;
                float n2s[8];
                {
                    float q[16];
#pragma unroll
                    for (int i = 0; i < 8; ++i) { const float k = (float)qk[i], kk = k * kkc; q[i] = kk * kk; q[8 + i] = (float)qr[i] * (k * (1.0f + ((float)qa[i] - 1.0f) * kac)) * rkc; }
                    float x = row16_reduce_scatter(q, lane); x += swz16f(x);
                    if ((lane & 16) == 0) red[(lane >> 5) * 16 + l16] = x;
                    LDS_WAIT();
                    const f32x4 r0 = *(const LAS f32x4*)(red), r1 = *(const LAS f32x4*)(red + 4), r2 = *(const LAS f32x4*)(red + 16), r3 = *(const LAS f32x4*)(red + 20);
#pragma unroll
                    for (int i = 0; i < 4; ++i) { n2s[i] = r0[i] + r2[i]; n2s[4 + i] = r1[i] + r3[i]; }
                    const float rks = red[8 + (lane & 7)] + red[24 + (lane & 7)];
                    if (lane < 8) ((LAS float*)(lds + O_SRKO))[(grp & 1) * 64 + 16 * c4w + 8 * hfw + lane] = rks;
                }
#pragma unroll
                for (int i = 0; i < 8; ++i) {
                    const int tt = 8 * hfw + i;
                    const float r = (float)qr[i], k = (float)qk[i], v = (float)qv[i], w = wf[i], aa = (float)qa[i];
                    const float kk = k * kkc; const float kkn = kk * __builtin_amdgcn_rsqf(fmaxf(n2s[i], 1e-24f));
                    const float kmod = k * (1.0f + (aa - 1.0f) * kac);
                    At[tt * 72 + lane] = (h16)(gam * -kkn);
                    gam *= w; const float rg = __builtin_amdgcn_rcpf(gam);
                    bhr[i] = fminf(fmaxf(kkn * aa * rg, -6.0e4f), 6.0e4f); khr[i] = fminf(fmaxf(kmod * rg, -6.0e4f), 6.0e4f);
                    Bh[tt * 72 + lane] = (h16)bhr[i]; Kh[tt * 72 + lane] = (h16)khr[i];
                    Rt[tt * 72 + lane] = (h16)(gam * r); ((LAS h16*)(lds + O_VO))[((grp & 1) * 64 + 16 * c4w + tt) * 64 + lane] = (h16)v;
                }
                if (hfw == 0) gC[lane] = gall;
                {
                    u32x4 pb, pk;
#pragma unroll
                    for (int q = 0; q < 4; ++q) { pb[q] = pkh(bhr[2 * q] * gall, bhr[2 * q + 1] * gall); pk[q] = pkh(khr[2 * q] * gall, khr[2 * q + 1] * gall); }
                    *(LAS u32x4*)(BbT + lane * 16 + 8 * hfw) = pb; *(LAS u32x4*)(KbT + lane * 16 + 8 * hfw) = pk;
                }
                conv_finish2(ci, cv);
                if (grp + 1 < SEQ / 64) {
#pragma unroll
                    for (int i = 0; i < 8; ++i) { const size_t tb = ((size_t)bh * SEQ + (grp + 1) * 64 + c4w * 16 + 8 * hfw) * 64 + lane;
                        qr[i] = a.R[tb + i * 64]; qk[i] = a.K[tb + i * 64]; qv[i] = a.V[tb + i * 64]; qa[i] = a.AA[tb + i * 64]; }
                }
                ci = conv_item2(((pass * 32 + grp) * 2 + 1) * G + blk, wave, lane, a.layer_pair, a.wgu, a.wdn, a.gu8);
                conv_issue2(ci, cv, lane);
                WBAR();
                if (hfw == 0) {
                    f32x4 mb = {0.f, 0.f, 0.f, 0.f}, mt = mb;
#pragma unroll
                    for (int s = 0; s < 2; ++s) { const int fo = l16 * 72 + 32 * s + 8 * g4; const h16x8 fb = *(const LAS h16x8*)(Bh + fo), fa = *(const LAS h16x8*)(At + fo);
                        mb = __builtin_amdgcn_mfma_f32_16x16x32_f16(fb, fa, mb, 0, 0, 0);
                        mt = __builtin_amdgcn_mfma_f32_16x16x32_f16(fa, fb, mt, 0, 0, 0); }
                    f32x4 td, ttd;
#pragma unroll
                    for (int e = 0; e < 4; ++e) { const int i = 4 * g4 + e; mb[e] = (i < l16) ? mb[e] : 0.f; mt[e] = (l16 < i) ? mt[e] : 0.f; const float dg = (i == l16) ? 1.0f : 0.0f; td[e] = mb[e] + dg; ttd[e] = mt[e] + dg; }
                    h16x4 xb = __builtin_convertvector(mb, h16x4), xa = __builtin_convertvector(mt, h16x4);
#pragma unroll
                    for (int s = 0; s < 3; ++s) {
                        const f32x4 z4 = {0.f, 0.f, 0.f, 0.f};
                        const f32x4 sq = __builtin_amdgcn_mfma_f32_16x16x16f16(xa, xb, z4, 0, 0, 0);
                        const f32x4 sqt = __builtin_amdgcn_mfma_f32_16x16x16f16(xb, xa, z4, 0, 0, 0);
                        xb = __builtin_convertvector(sq, h16x4); xa = __builtin_convertvector(sqt, h16x4);
                        const h16x4 ta = __builtin_convertvector(ttd, h16x4);
                        td = __builtin_amdgcn_mfma_f32_16x16x16f16(ta, xb, td, 0, 0, 0);
                        if (s < 2) ttd = __builtin_amdgcn_mfma_f32_16x16x16f16(xb, ta, ttd, 0, 0, 0);
                    }
                    *(LAS u32x2*)(TmT + l16 * 16 + 4 * g4) = pkh4(td);
                } else {
                    f32x4 mk = {0.f, 0.f, 0.f, 0.f}, nb = mk, nk = mk;
#pragma unroll
                    for (int s = 0; s < 2; ++s) {
                        const int fo = l16 * 72 + 32 * s + 8 * g4;
                        const h16x8 fb = *(const LAS h16x8*)(Bh + fo), fk = *(const LAS h16x8*)(Kh + fo), fa = *(const LAS h16x8*)(At + fo), fr = *(const LAS h16x8*)(Rt + fo);
                        mk = __builtin_amdgcn_mfma_f32_16x16x32_f16(fk, fa, mk, 0, 0, 0); nb = __builtin_amdgcn_mfma_f32_16x16x32_f16(fb, fr, nb, 0, 0, 0); nk = __builtin_amdgcn_mfma_f32_16x16x32_f16(fk, fr, nk, 0, 0, 0);
                    }
#pragma unroll
                    for (int e = 0; e < 4; ++e) { const int i = 4 * g4 + e; const bool lt = i < l16, le = i <= l16; mk[e] = lt ? mk[e] : 0.f; nb[e] = le ? nb[e] : 0.f; nk[e] = le ? nk[e] : 0.f; }
                    *(LAS u32x2*)(MkT + l16 * 16 + 4 * g4) = pkh4(mk); *(LAS u32x2*)(NbT + l16 * 16 + 4 * g4) = pkh4(nb); *(LAS u32x2*)(NkT + l16 * 16 + 4 * g4) = pkh4(nk);
                }
            }
            WBAR();
            if (wave < 4) {
                LAS float* sy = (LAS float*)(lds + O_SY) + (grp & 1) * (64 * 65);
#pragma unroll 2
                for (int c4 = 0; c4 < NG; ++c4) {
                    LAS unsigned char* pc = lds + c4 * PCH;
                    const LAS h16* At = (const LAS h16*)(pc + O_AT); const LAS h16* Rt = (const LAS h16*)(pc + O_RT); const LAS h16* BbT = (const LAS h16*)(pc + O_BBT); const LAS h16* KbT = (const LAS h16*)(pc + O_KBT);
                    const LAS h16* Vt = (const LAS h16*)(pc + O_VT); const LAS h16* MkT = (const LAS h16*)(pc + O_MKT); const LAS h16* TmT = (const LAS h16*)(pc + O_TMT);
                    const LAS h16* NbT = (const LAS h16*)(pc + O_NBT); const LAS h16* NkT = (const LAS h16*)(pc + O_NKT); const LAS float* gC = (const LAS float*)(pc + O_GC);
                    h16x4 sb[4];
#pragma unroll
                    for (int kt = 0; kt < 4; ++kt) sb[kt] = __builtin_convertvector(ST[kt], h16x4);
                    h16x4 vb;
                    { const LAS h16* vsrc = (const LAS h16*)(lds + O_VO) + ((grp & 1) * 64 + 16 * c4 + 4 * g4) * 64 + 16 * wave + l16;
#pragma unroll
                      for (int e = 0; e < 4; ++e) vb[e] = vsrc[e * 64]; }
                    f32x4 accW = {0.f, 0.f, 0.f, 0.f}, accY = {0.f, 0.f, 0.f, 0.f};
#pragma unroll
                    for (int kt = 0; kt < 4; ++kt) {
                        accW = __builtin_amdgcn_mfma_f32_16x16x16f16(*(const LAS h16x4*)(At + l16 * 72 + 16 * kt + 4 * g4), sb[kt], accW, 0, 0, 0);
                        accY = __builtin_amdgcn_mfma_f32_16x16x16f16(*(const LAS h16x4*)(Rt + l16 * 72 + 16 * kt + 4 * g4), sb[kt], accY, 0, 0, 0);
                    }
                    accW = __builtin_amdgcn_mfma_f32_16x16x16f16(*(const LAS h16x4*)(MkT + l16 * 16 + 4 * g4), vb, accW, 0, 0, 0);
                    accY = __builtin_amdgcn_mfma_f32_16x16x16f16(*(const LAS h16x4*)(NkT + l16 * 16 + 4 * g4), vb, accY, 0, 0, 0);
                    const h16x4 wb = __builtin_convertvector(accW, h16x4);
                    const f32x4 accU = __builtin_amdgcn_mfma_f32_16x16x16f16(*(const LAS h16x4*)(TmT + l16 * 16 + 4 * g4), wb, (f32x4){0.f, 0.f, 0.f, 0.f}, 0, 0, 0);
                    const h16x4 ub = __builtin_convertvector(accU, h16x4);
                    accY = __builtin_amdgcn_mfma_f32_16x16x16f16(*(const LAS h16x4*)(NbT + l16 * 16 + 4 * g4), ub, accY, 0, 0, 0);
#pragma unroll
                    for (int kt = 0; kt < 4; ++kt) {
                        ST[kt] = ST[kt] * *(const LAS f32x4*)(gC + 16 * kt + 4 * g4);
                        ST[kt] = __builtin_amdgcn_mfma_f32_16x16x16f16(*(const LAS h16x4*)(BbT + (16 * kt + l16) * 16 + 4 * g4), ub, ST[kt], 0, 0, 0);
                        ST[kt] = __builtin_amdgcn_mfma_f32_16x16x16f16(*(const LAS h16x4*)(KbT + (16 * kt + l16) * 16 + 4 * g4), vb, ST[kt], 0, 0, 0);
                    }
#pragma unroll
                    for (int e = 0; e < 4; ++e) sy[(16 * c4 + 4 * g4 + e) * 65 + 16 * wave + l16] = accY[e];
                }
            }
            else {
                if (grp > 0) OUT_STAGE(grp - 1);
#pragma unroll
                for (int j = 0; j < 16; ++j) qg[j] = a.GG[((size_t)bh * SEQ + grp * 64 + (wave - 4) * 16) * 64 + lane + j * 64];
            }
            conv_finish2(ci, cv);
            ci = conv_item2(((pass * 32 + grp + 1) * 2 + 0) * G + blk, wave, lane, a.layer_pair, a.wgu, a.wdn, a.gu8);
            if (grp + 1 < SEQ / 64) { conv_issue2(ci, cv, lane); gpr[wave * 64 + lane] = GPROD(); }
            WBAR();
        }
#undef GPROD
        if (wave >= 4) { const int lane = lane_id(), l16 = lane & 15, chn = h * 64 + lane; OUT_STAGE(SEQ / 64 - 1); }
#undef OUT_STAGE
    }
}

__device__ __forceinline__ float row16_max(float v) { v = fmaxf(v, dppf<0xB1>(v)); v = fmaxf(v, dppf<0x4E>(v)); v = fmaxf(v, dppf<0x141>(v)); v = fmaxf(v, dppf<0x140>(v)); return v; }
struct RouterArgs { const h16* H; const float *g, *b; const h16* WRS; const float* rb; h16* X1; unsigned char* XB; float* TOPG; int* LIST; unsigned* CNT; };
__device__ __forceinline__ void phase_ln_router(const RouterArgs& a, LAS unsigned char* lds, int blk, int G, const int wave) {
    constexpr int WPB = 2064;
    LAS unsigned* hcnt = (LAS unsigned*)(lds + 132096); LAS unsigned* hbase = hcnt + 32; LAS unsigned* pe = hbase + 32; LAS unsigned* pp = pe + 512;
    int tid = wave * 64 + lane_id(); OPAQUE(tid);
    const int lane = tid & 63, ex = lane & 15, kg = lane >> 4;
    for (int c = tid; c < 2 * 32 * 128; c += NTHR) { const int row = c >> 7, ch = c & 127; *(LAS u32x4*)(lds + row * WPB + ch * 16) = *(const u32x4*)((const char*)a.WRS + (size_t)row * 2048 + ch * 16); }
    const float rb0 = a.rb[ex], rb1 = a.rb[16 + ex];
    for (int tb = blk; tb < T / 128; tb += G) {
        if (tid < 32) hcnt[tid] = 0u;
        __syncthreads();
        const size_t tw = (size_t)tb * 128 + wave * 16;
#pragma unroll 1
        for (int ib = 0; ib < 4; ++ib) {
            f32x4 vv[4][4]; h16x4 vh[4][4];
#pragma unroll
            for (int q = 0; q < 4; ++q)
#pragma unroll
                for (int j = 0; j < 4; ++j) vh[q][j] = *(const h16x4*)(a.H + (tw + 4 * ib + q) * D + 256 * j + 4 * lane);
#pragma unroll
            for (int q = 0; q < 4; ++q)
#pragma unroll
                for (int j = 0; j < 4; ++j) vv[q][j] = __builtin_convertvector(vh[q][j], f32x4);
#pragma unroll
            for (int q = 0; q < 4; ++q) {
                const size_t t = tw + 4 * ib + q; float s1 = 0.f;
#pragma unroll
                for (int j = 0; j < 4; ++j) s1 += (vv[q][j].x + vv[q][j].y) + (vv[q][j].z + vv[q][j].w);
                const float mean = wave_sum(s1) * (1.0f / D); float s2 = 0.f;
#pragma unroll
                for (int j = 0; j < 4; ++j) { vv[q][j] = vv[q][j] - mean; s2 += (vv[q][j].x * vv[q][j].x + vv[q][j].y * vv[q][j].y) + (vv[q][j].z * vv[q][j].z + vv[q][j].w * vv[q][j].w); }
                const float rstd = rsqrtf(wave_sum(s2) * (1.0f / D) + LN_EPS);
#pragma unroll
                for (int j = 0; j < 4; ++j) { const f32x4 o = vv[q][j] * rstd * *(const f32x4*)(a.g + 256 * j + 4 * lane) + *(const f32x4*)(a.b + 256 * j + 4 * lane);
                    *(u32x2*)(a.X1 + t * D + 256 * j + 4 * lane) = pkh4(o);
                    int pk_ = __builtin_amdgcn_cvt_pk_fp8_f32(o.x, o.y, 0, false); pk_ = __builtin_amdgcn_cvt_pk_fp8_f32(o.z, o.w, pk_, true);
                    *(unsigned*)(a.XB + t * D + 256 * j + 4 * lane) = (unsigned)pk_; }
            }
        }
        asm volatile("s_waitcnt vmcnt(0)" ::: "memory");
        f32x4 cA[2], cB[2];
        cA[0] = cA[1] = cB[0] = cB[1] = (f32x4){0.f, 0.f, 0.f, 0.f};
        const h16* xrow = a.X1 + (tw + ex) * D + 8 * kg;
        const LAS unsigned char* bh = lds + ex * WPB + kg * 16; const LAS unsigned char* bl = bh + 32 * WPB;
#pragma unroll 8
        for (int ks = 0; ks < 32; ++ks) {
            const h16x8 xh = *(const h16x8*)(xrow + 32 * ks);
#pragma unroll
            for (int tI = 0; tI < 2; ++tI) {
                const h16x8 wh = *(const LAS h16x8*)(bh + tI * 16 * WPB + ks * 64), wl = *(const LAS h16x8*)(bl + tI * 16 * WPB + ks * 64);
                cA[tI] = __builtin_amdgcn_mfma_f32_16x16x32_f16(xh, wh, cA[tI], 0, 0, 0);
                cB[tI] = __builtin_amdgcn_mfma_f32_16x16x32_f16(xh, wl, cB[tI], 0, 0, 0);
            }
        }
#pragma unroll
        for (int e = 0; e < 4; ++e) {
            float c0 = cA[0][e] + cB[0][e] * (1.0f / 4096.0f) + rb0, c1 = cA[1][e] + cB[1][e] * (1.0f / 4096.0f) + rb1;
            int sel[4]; float val[4];
#pragma unroll
            for (int k = 0; k < 4; ++k) {
                const float m = row16_max(fmaxf(c0, c1));
                const unsigned r0 = (unsigned)(__ballot(c0 == m) >> (16 * kg)) & 0xFFFFu, r1 = (unsigned)(__ballot(c1 == m) >> (16 * kg)) & 0xFFFFu;
                const int hit0 = r0 != 0u; const int wl_ = hit0 ? __builtin_ctz(r0) : __builtin_ctz(r1 | 0x10000u);
                sel[k] = hit0 ? wl_ : 16 + wl_; val[k] = m;
                if (ex == wl_) { if (hit0) c0 = -INFINITY; else c1 = -INFINITY; }
            }
            const float e1 = __expf(val[1] - val[0]), e2 = __expf(val[2] - val[0]), e3 = __expf(val[3] - val[0]);
            const float inv = 1.0f / (1.0f + e1 + e2 + e3);
            if (ex < 4) {
                const int tl = wave * 16 + 4 * kg + e; const size_t t = (size_t)tb * 128 + tl;
                const int mysel = ex == 0 ? sel[0] : ex == 1 ? sel[1] : ex == 2 ? sel[2] : sel[3];
                const float myg = (ex == 0 ? 1.0f : ex == 1 ? e1 : ex == 2 ? e2 : e3) * inv;
                a.TOPG[t * 4 + ex] = myg;
                const unsigned pos = __hip_atomic_fetch_add(hcnt + mysel, 1u, __ATOMIC_RELAXED, __HIP_MEMORY_SCOPE_WORKGROUP);
                pe[tl * 4 + ex] = (unsigned)mysel; pp[tl * 4 + ex] = pos;
            }
        }
        __syncthreads();
        if (tid < 32) hbase[tid] = __hip_atomic_fetch_add(a.CNT + tid, hcnt[tid], __ATOMIC_RELAXED, __HIP_MEMORY_SCOPE_AGENT);
        __syncthreads();
        { const unsigned e = pe[tid]; a.LIST[(size_t)e * ECAP + hbase[e] + pp[tid]] = tb * 512 + tid; }
        __syncthreads();
    }
}

__device__ __forceinline__ void phase_combine(const h16* X1, const unsigned char* YS, const float* g, const float* b, float* Xo  , h16* XH  , int gw_, int NGW_, int lane) {
    lane = lane_id(); OPAQUE(lane);
#pragma unroll 1
    for (int t0 = gw_; t0 < T; t0 += 2 * NGW_) {
        h16x4 x[2][4]; unsigned y[2][4][4];
#pragma unroll
        for (int q = 0; q < 2; ++q) { const size_t t = (size_t)t0 + (size_t)q * NGW_;
#pragma unroll
            for (int j = 0; j < 4; ++j) { x[q][j] = *(const h16x4*)(X1 + t * D + 256 * j + 4 * lane);
#pragma unroll
                for (int k = 0; k < 4; ++k) y[q][j][k] = *(const unsigned*)(YS + (t * 4 + k) * D + 256 * j + 4 * lane); } }
#pragma unroll
        for (int q = 0; q < 2; ++q) { const size_t t = (size_t)t0 + (size_t)q * NGW_;
            f32x4 v[4]; float s = 0.f;
#pragma unroll
            for (int j = 0; j < 4; ++j) { f32x4 ysum = (f32x4){0.f, 0.f, 0.f, 0.f};
#pragma unroll
                for (int k = 0; k < 4; ++k) { const f32x2 lo = __builtin_amdgcn_cvt_pk_f32_fp8((int)y[q][j][k], false), hi = __builtin_amdgcn_cvt_pk_f32_fp8((int)y[q][j][k], true); ysum += (f32x4){lo.x, lo.y, hi.x, hi.y}; }
                v[j] = __builtin_convertvector(x[q][j], f32x4) * ALPHA + ysum * (1.0f / YS_SCALE);
                s += (v[j].x + v[j].y) + (v[j].z + v[j].w); }
            const float mean = wave_sum(s) * (1.0f / D); float s2 = 0.f;
#pragma unroll
            for (int j = 0; j < 4; ++j) { v[j] = v[j] - mean; s2 += (v[j].x * v[j].x + v[j].y * v[j].y) + (v[j].z * v[j].z + v[j].w * v[j].w); }
            const float rstd = rsqrtf(wave_sum(s2) * (1.0f / D) + LN_EPS);
#pragma unroll
            for (int j = 0; j < 4; ++j) { v[j] = v[j] * rstd * *(const f32x4*)(g + 256 * j + 4 * lane) + *(const f32x4*)(b + 256 * j + 4 * lane);
                if (Xo) *(f32x4*)(Xo + t * D + 256 * j + 4 * lane) = v[j]; else *(u32x2*)(XH + t * D + 256 * j + 4 * lane) = pkh4(v[j]); }
        }
    }
}

#include <cmath>
namespace attn_body {
using bf16=_Float16;
using bf16x8=__attribute__((ext_vector_type(8)))short;
using s16x4=__attribute__((ext_vector_type(4)))short;
using f32x16=__attribute__((ext_vector_type(16)))float;
using u32x4=__attribute__((ext_vector_type(4)))unsigned;
constexpr int SEQ=2048,D=64,DM=1024,DMO=2048;
constexpr int NW=8,QBLK=32,QB=QBLK*NW,KVBLK=64,NQB=SEQ/QB;
typedef _Float16 f16x8_t __attribute__((ext_vector_type(8)));
#define MFMA32(a,b,c) __builtin_amdgcn_mfma_f32_32x32x16_f16(__builtin_bit_cast(f16x8_t,(a)),__builtin_bit_cast(f16x8_t,(b)),(c),0,0,0)
__device__ __forceinline__ int crow(int r,int hi){return (r&3)+8*(r>>2)+4*hi;}
#define SBAR() __builtin_amdgcn_sched_barrier(0)
__device__ __forceinline__ void cmask(f32x16&p0,f32x16&p1,int jb,int qrel,int hi){
  const float NEG=-INFINITY; int kb=64*jb+4*hi;
  #pragma unroll
  for(int r=0;r<16;++r){int kv=kb+(r&3)+8*(r>>2); if(kv>qrel)p0[r]=NEG; if(kv+32>qrel)p1[r]=NEG;}
}

constexpr int NSLOT=3, SLOTB=8192;
constexpr int LDS_K=0, LDS_V=NSLOT*SLOTB, LDS_WS=2*NSLOT*SLOTB, LDS_OST=LDS_WS+NW*64*4, LDS_BYTES=LDS_OST+NW*4096;
constexpr float C2=0.125f*1.4426950408889634f;
__device__ __forceinline__ void glds16(const void*gsrc,unsigned lds_dst){unsigned keep;
  asm volatile("s_mov_b32 %0, m0\n\ts_mov_b32 m0, %2\n\ts_nop 0\n\tglobal_load_lds_dwordx4 %1, off\n\ts_mov_b32 m0, %0":"=&s"(keep):"v"(gsrc),"s"(lds_dst):"memory");}
__device__ __forceinline__ float max3f(float a,float b,float c){float r;asm("v_max3_f32 %0, %1, %2, %3":"=v"(r):"v"(a),"v"(b),"v"(c));return r;}
__device__ __forceinline__ float max2f(float a,float b){float r;asm("v_max_f32_e32 %0, %1, %2":"=v"(r):"v"(a),"v"(b));return r;}
__device__ __forceinline__ float fadd_s(float a,float b){float r;asm("v_add_f32_e32 %0, %1, %2":"=v"(r):"v"(a),"v"(b));return r;}
__device__ __forceinline__ float fsub_s(float a,float b){float r;asm("v_sub_f32_e32 %0, %1, %2":"=v"(r):"v"(a),"v"(b));return r;}
typedef float f32x2_t __attribute__((ext_vector_type(2))); typedef _Float16 bf16x2_t __attribute__((ext_vector_type(2)));
__device__ __forceinline__ unsigned cvtpk_s(float lo,float hi){f32x2_t v={lo,hi};bf16x2_t b=__builtin_convertvector(v,bf16x2_t);return __builtin_bit_cast(unsigned,b);}
#define WAIT_BAR(N) asm volatile("s_waitcnt vmcnt(" #N ") lgkmcnt(0)\n\ts_barrier":::"memory")

__device__ __forceinline__ void qkt(f32x16&p0,f32x16&p1,const char*Kslot,const bf16x8*qr,const f32x16&negm,int r32,int hi){
  const char*kb=Kslot+hi*1024+r32*16;
  #pragma unroll
  for(int d0=0;d0<4;++d0){
    const bf16x8 b0=*reinterpret_cast<const bf16x8*>(kb+d0*2048);
    const bf16x8 b1=*reinterpret_cast<const bf16x8*>(kb+d0*2048+512);
    if(d0==0){p0=MFMA32(b0,qr[0],negm);p1=MFMA32(b1,qr[0],negm);}
    else{p0=MFMA32(b0,qr[d0],p0);p1=MFMA32(b1,qr[d0],p1);}}
}
typedef __attribute__((address_space(3))) const char* lds_cptr;
typedef short v4i16_t __attribute__((ext_vector_type(4)));
__device__ __forceinline__ void kload8(bf16x8*kf,lds_cptr kp){
  kf[0]=*(const __attribute__((address_space(3))) bf16x8*)(kp);      kf[1]=*(const __attribute__((address_space(3))) bf16x8*)(kp+512);
  kf[2]=*(const __attribute__((address_space(3))) bf16x8*)(kp+2048); kf[3]=*(const __attribute__((address_space(3))) bf16x8*)(kp+2560);
  kf[4]=*(const __attribute__((address_space(3))) bf16x8*)(kp+4096); kf[5]=*(const __attribute__((address_space(3))) bf16x8*)(kp+4608);
  kf[6]=*(const __attribute__((address_space(3))) bf16x8*)(kp+6144); kf[7]=*(const __attribute__((address_space(3))) bf16x8*)(kp+6656);
}
__device__ __forceinline__ void kload2(bf16x8*kf,lds_cptr kp,int j){ kf[2*j]=*(const __attribute__((address_space(3))) bf16x8*)(kp+j*2048); kf[2*j+1]=*(const __attribute__((address_space(3))) bf16x8*)(kp+j*2048+512); }
__device__ __forceinline__ s16x4 vtr(lds_cptr p){ return __builtin_bit_cast(s16x4,__builtin_amdgcn_ds_read_tr16_b64_v4i16((__attribute__((address_space(3))) v4i16_t*)p)); }
__device__ __forceinline__ float rowmax(const f32x16&p0,const f32x16&p1){
  float a=max3f(p0[0],p0[1],p1[0]),b=max3f(p0[2],p0[3],p1[1]);a=max3f(a,p1[2],p1[3]);
  #pragma unroll
  for(int r=4;r<16;r+=4){a=max3f(a,p0[r],p0[r+1]);b=max3f(b,p0[r+2],p0[r+3]);a=max3f(a,p1[r],p1[r+1]);b=max3f(b,p1[r+2],p1[r+3]);}
  const float m=max2f(a,b);
  auto rr=__builtin_amdgcn_permlane32_swap(__float_as_uint(m),__float_as_uint(m),false,false);
  return max2f(__uint_as_float(rr[0]),__uint_as_float(rr[1]));
}
__device__ __forceinline__ void pv(f32x16*o,int vb,bf16x8 pa0,bf16x8 pa1,bf16x8 pa2,bf16x8 pa3){
  #pragma unroll
  for(int d0=0;d0<2;++d0){s16x4 lo[4],hi[4];
    #pragma unroll
    for(int ks=0;ks<4;++ks){
      asm volatile("ds_read_b64_tr_b16 %0,%1 offset:%c2":"=&v"(lo[ks]):"v"(vb),"i"(d0*4096+ks*1024):"memory");
      asm volatile("ds_read_b64_tr_b16 %0,%1 offset:%c2":"=&v"(hi[ks]):"v"(vb),"i"(d0*4096+ks*1024+512):"memory");}
    asm volatile("s_waitcnt lgkmcnt(0)":::"memory");SBAR();
    #define PK(k) (bf16x8){lo[k][0],lo[k][1],lo[k][2],lo[k][3],hi[k][0],hi[k][1],hi[k][2],hi[k][3]}
    o[d0]=MFMA32(pa0,PK(0),o[d0]);
    o[d0]=MFMA32(pa1,PK(1),o[d0]);
    o[d0]=MFMA32(pa2,PK(2),o[d0]);
    o[d0]=MFMA32(pa3,PK(3),o[d0]);
    #undef PK
  }
}

#ifndef ATTN_STORE16
#define ATTN_STORE16(p,v) (*(u32x4*)(p)=(v))
#endif
template<int THRL> __device__ __forceinline__ void attn_unit(int b,int qcol,int vcol,int ocol,float slope2,int qb,int ts,const bf16*Q,const bf16*__restrict__ K,const bf16*__restrict__ V,bf16*O,char*shm,const int wid){
  int lane; asm volatile("v_mbcnt_lo_u32_b32 %0, -1, 0\n\tv_mbcnt_hi_u32_b32 %0, -1, %0":"=v"(lane)); const int r32=lane&31,hi=lane>>5;
  const long rowbase=(long)b*SEQ; const int q0=qb*QB;
  const bf16*Qw=Q+(rowbase+q0+wid*QBLK)*DM+qcol;
  const bf16*Kh=K+(rowbase+(long)ts*KVBLK)*DM+qcol,*Vh=V+(rowbase+(long)ts*KVBLK)*DM+vcol;
  const unsigned lds0=(unsigned)(uintptr_t)shm;
  float*wsf=(float*)(shm+LDS_WS)+wid*64;
  const bf16*ksrc=Kh+(long)lane*DM+wid*8;
  const bf16*vsrc=Vh+(long)(16*(wid&3)+(lane>>2))*DM+(wid>>2)*32+(lane&3)*8;
  const unsigned kdst=lds0+LDS_K+wid*1024, vdst=lds0+LDS_V+wid*1024;
  #define DMA_K(t,slot) glds16(ksrc+(long)(t)*KVBLK*DM,(unsigned)__builtin_amdgcn_readfirstlane(kdst+(slot)))
  #define DMA_V(t,slot) glds16(vsrc+(long)(t)*KVBLK*DM,(unsigned)__builtin_amdgcn_readfirstlane(vdst+(slot)))
  const int vb0=(int)(lds0+LDS_V)+((lane>>4)&1)*32+(lane&3)*8+(4*hi+((lane&15)>>2))*64;
  const char*Kbase=shm+LDS_K; bf16x8 kf[8];
  const lds_cptr shm3=(lds_cptr)shm; const lds_cptr kp0=shm3+LDS_K+hi*1024+r32*16; const lds_cptr vp0=shm3+LDS_V+((lane>>4)&1)*32+(lane&3)*8+(4*hi+((lane&15)>>2))*64;
  const int NT=(q0+QB)/KVBLK-ts;
  DMA_K(0,0);DMA_V(0,0);DMA_K(1,SLOTB);
  bf16x8 qr[4];
  #pragma unroll
  for(int d0=0;d0<4;++d0)qr[d0]=*reinterpret_cast<const bf16x8*>(&Qw[(long)r32*DM+d0*16+hi*8]);
  float mhat=0.f,l_reg=0.f;f32x16 o[2];o[0]=f32x16{};o[1]=f32x16{};f32x16 negm;
  const float delta=64.f*slope2,c32=32.f*slope2;
  _Pragma("unroll") for(int r=0;r<16;++r)negm[r]=slope2*(float)crow(r,hi); asm volatile("":"+v"(negm));
  const int qrel=wid*QBLK+r32;
  #define CMASK(P0,P1,t) do{int jb_=(t)-(NT-4); if(jb_>=0)cmask(P0,P1,jb_,qrel,hi);}while(0)
  bool resc=false;
  #define START(P0,P1) do{ const float rm=rowmax(P0,P1); resc=false; \
    { const float dl=rm; mhat=fadd_s(mhat,dl); \
      _Pragma("unroll") for(int r=0;r<16;++r){P0[r]=fsub_s(P0[r],dl);P1[r]=fsub_s(P1[r],dl);} \
      _Pragma("unroll") for(int r=0;r<16;++r)negm[r]-=dl; asm volatile("":"+v"(negm)); } \
    _Pragma("unroll") for(int r=0;r<16;++r)P0[r]=__builtin_amdgcn_exp2f(P0[r]); }while(0)
  #define RESC() do{ if(resc){ asm volatile("s_waitcnt lgkmcnt(0)":::"memory"); \
      _Pragma("unroll") for(int d_=0;d_<2;++d_) _Pragma("unroll") for(int r=0;r<16;++r)o[d_][r]*=wsf[crow(r,hi)]; } }while(0)
  f32x16 pA0,pA1,pB0,pB1;
  int sl_prev=0,sl_cur=0,sl_next=SLOTB;
  #define ROT() do{sl_prev=sl_cur;sl_cur=sl_next;sl_next=(sl_next==(NSLOT-1)*SLOTB)?0:sl_next+SLOTB;}while(0)
  DMA_K(2,2*SLOTB);
  WAIT_BAR(3);
  qkt(pA0,pA1,Kbase,qr,negm,r32,hi);asm volatile("s_nop 15\n\ts_nop 7":"+v"(pA0),"+v"(pA1)); _Pragma("unroll") for(int r=0;r<16;++r)pA1[r]+=c32; CMASK(pA0,pA1,0);
  START(pA0,pA1);
  _Pragma("unroll") for(int r=0;r<16;++r)pA1[r]=__builtin_amdgcn_exp2f(pA1[r]);
  WAIT_BAR(0);
  DMA_K(3,0);DMA_V(1,SLOTB);
  ROT();
  kload8(kf,kp0+sl_cur);
  WAIT_BAR(2);
  s16x4 vlo[8],vhi[8]; u32x4 pw0,pw1,pw2,pw3;
  #define PKW(P,B) cvtpk_s(P[B],P[B+1])
  #define PAF(k) __builtin_bit_cast(bf16x8,pw##k)
  #define VFR(i) (bf16x8){vlo[i][0],vlo[i][1],vlo[i][2],vlo[i][3],vhi[i][0],vhi[i][1],vhi[i][2],vhi[i][3]}
  #define PIN(x) asm volatile("":"+v"(x))
  #define MX3(a,b,c) __builtin_fmaxf(__builtin_fmaxf((a),(b)),(c))
  #define GAPA(MF,A0,A1,A2,A3,W0,W1,PW) do{ MF; sacc+=A0; sacc+=A1; sacc+=A2; sacc+=A3; PIN(sacc); W0; W1; PIN(PW); SBAR(); }while(0)
  #define EX(v) __builtin_amdgcn_exp2f(v)
  #define GAPB(MF,X,B) do{ MF; X[B]=EX(X[B]); X[B+1]=EX(X[B+1]); X[B+2]=EX(X[B+2]); X[B+3]=EX(X[B+3]); PIN(X); SBAR(); }while(0)
  #define VRD(i) do{ vlo[i]=vtr(vp_+(((i)>>2)*4096+((i)&3)*1024)); vhi[i]=vtr(vp_+(((i)>>2)*4096+((i)&3)*1024+512)); }while(0)
  #define KRD(G,j) do{ if(G){ kload2(kf,kp0+sl_next,j); SBAR(); } }while(0)
  #define STEP(C0,C1,P0,P1,t,GK,GV,GL) do{ SBAR(); \
    _Pragma("unroll") for(int r=0;r<16;++r)negm[r]+=delta; asm volatile("":"+v"(negm)); \
    const lds_cptr vp_=vp0+sl_prev; \
    VRD(0); SBAR(); float sacc=(P0[0]+P0[1]); \
    GAPA(C0=MFMA32(kf[0],qr[0],negm), P0[2],P0[3],P0[4],P0[5],     pw0[0]=PKW(P0,0), pw0[1]=PKW(P0,2), pw0); \
    VRD(4); SBAR(); GAPA(C1=MFMA32(kf[1],qr[0],negm), P0[6],P0[7],P0[8],P0[9],     pw0[2]=PKW(P0,4), pw0[3]=PKW(P0,6), pw0); \
    VRD(1); SBAR(); GAPA(C0=MFMA32(kf[2],qr[1],C0),   P0[10],P0[11],P0[12],P0[13], pw1[0]=PKW(P0,8), pw1[1]=PKW(P0,10), pw1); \
    VRD(5); SBAR(); GAPA(C1=MFMA32(kf[3],qr[1],C1),   P0[14],P0[15],P1[0],P1[1],   pw1[2]=PKW(P0,12),pw1[3]=PKW(P0,14), pw1); \
    VRD(2); SBAR(); GAPA(C0=MFMA32(kf[4],qr[2],C0),   P1[2],P1[3],P1[4],P1[5],     pw2[0]=PKW(P1,0), pw2[1]=PKW(P1,2), pw2); \
    VRD(6); SBAR(); GAPA(C1=MFMA32(kf[5],qr[2],C1),   P1[6],P1[7],P1[8],P1[9],     pw2[2]=PKW(P1,4), pw2[3]=PKW(P1,6), pw2); \
    VRD(3); SBAR(); GAPA(C0=MFMA32(kf[6],qr[3],C0),   P1[10],P1[11],P1[12],P1[13], pw3[0]=PKW(P1,8), pw3[1]=PKW(P1,10), pw3); \
    VRD(7); SBAR(); GAPA(C1=MFMA32(kf[7],qr[3],C1),   P1[14],P1[15],0.f,0.f,       pw3[2]=PKW(P1,12),pw3[3]=PKW(P1,14), pw3); \
    l_reg+=sacc; \
    if(GK){DMA_K((t)+3,sl_cur);} if(GV){DMA_V((t)+1,sl_next);} \
    _Pragma("unroll") for(int r=0;r<16;++r)C1[r]+=c32; \
    CMASK(C0,C1,t); \
    { float a=MX3(C0[0],C0[1],C1[0]),b=MX3(C0[2],C0[3],C1[1]); a=MX3(a,C1[2],C1[3]); \
      _Pragma("unroll") for(int r=4;r<16;r+=4){a=MX3(a,C0[r],C0[r+1]);b=MX3(b,C0[r+2],C0[r+3]);a=MX3(a,C1[r],C1[r+1]);b=MX3(b,C1[r+2],C1[r+3]);} \
      float rm=__builtin_fmaxf(a,b); { auto rr=__builtin_amdgcn_permlane32_swap(__float_as_uint(rm),__float_as_uint(rm),false,false); rm=__builtin_fmaxf(__uint_as_float(rr[0]),__uint_as_float(rr[1])); } \
      resc=false; \
      if(__builtin_expect(__any(rm>(float)THRL),0)){ const float dl=__builtin_fmaxf(rm,0.f); mhat+=dl; \
        _Pragma("unroll") for(int r=0;r<16;++r){C0[r]-=dl;C1[r]-=dl;} \
        _Pragma("unroll") for(int r=0;r<16;++r)negm[r]-=dl; asm volatile("":"+v"(negm)); \
        const float f=__builtin_amdgcn_exp2f(-dl); l_reg*=f; if(hi==0)wsf[r32]=f; resc=true; } } \
    SBAR(); \
    GAPB(o[0]=MFMA32(PAF(0),VFR(0),o[0]), C0,0); \
    GAPB(o[1]=MFMA32(PAF(0),VFR(4),o[1]), C0,4); \
    KRD(GL,0); GAPB(o[0]=MFMA32(PAF(1),VFR(1),o[0]), C0,8); \
    KRD(GL,1); GAPB(o[1]=MFMA32(PAF(1),VFR(5),o[1]), C0,12); \
    KRD(GL,2); GAPB(o[0]=MFMA32(PAF(2),VFR(2),o[0]), C1,0); \
    KRD(GL,3); GAPB(o[1]=MFMA32(PAF(2),VFR(6),o[1]), C1,4); \
    GAPB(o[0]=MFMA32(PAF(3),VFR(3),o[0]), C1,8); \
    GAPB(o[1]=MFMA32(PAF(3),VFR(7),o[1]), C1,12); \
    }while(0)
  int t=1;
  #undef CMASK
  #define CMASK(P0,P1,t) do{}while(0)
  for(;t+5<NT;t+=2){
    STEP(pB0,pB1,pA0,pA1,t,true,true,true);     WAIT_BAR(2); RESC(); ROT();
    STEP(pA0,pA1,pB0,pB1,t+1,true,true,true);   WAIT_BAR(2); RESC(); ROT();
  }
  #undef CMASK
  #define CMASK(P0,P1,t) do{int jb_=(t)-(NT-4); if(jb_>=0)cmask(P0,P1,jb_,qrel,hi);}while(0)
  #define ENDW(tt) do{ if((tt)+3<NT){WAIT_BAR(2);} else if((tt)+2<NT){WAIT_BAR(1);} else {WAIT_BAR(0);} }while(0)
  for(;t+1<NT;t+=2){
    STEP(pB0,pB1,pA0,pA1,t,(t+3<NT),(t+1<NT),(t+1<NT));       ENDW(t);   RESC(); ROT();
    STEP(pA0,pA1,pB0,pB1,t+1,(t+4<NT),(t+2<NT),(t+2<NT));     ENDW(t+1); RESC(); ROT();
  }
  STEP(pB0,pB1,pA0,pA1,NT-1,false,false,false); RESC();
  { float sacc=pB0[0]+pB0[1]; _Pragma("unroll") for(int r=2;r<16;++r)sacc+=pB0[r]; _Pragma("unroll") for(int r=0;r<16;++r)sacc+=pB1[r]; l_reg+=sacc;
    pw0=(u32x4){PKW(pB0,0),PKW(pB0,2),PKW(pB0,4),PKW(pB0,6)};pw1=(u32x4){PKW(pB0,8),PKW(pB0,10),PKW(pB0,12),PKW(pB0,14)};pw2=(u32x4){PKW(pB1,0),PKW(pB1,2),PKW(pB1,4),PKW(pB1,6)};pw3=(u32x4){PKW(pB1,8),PKW(pB1,10),PKW(pB1,12),PKW(pB1,14)};
    SBAR(); pv(o,vb0+sl_cur,PAF(0),PAF(1),PAF(2),PAF(3)); }
  #undef PKW
  #undef PAF
  #undef VFR
  #undef PIN
  #undef MX3
  #undef GAPA
  #undef GAPB
  #undef EX
  #undef VRD
  #undef KRD
  #undef STEP
  #undef ENDW
  {auto rr=__builtin_amdgcn_permlane32_swap(__float_as_uint(l_reg),__float_as_uint(l_reg),false,false);l_reg=__uint_as_float(rr[0])+__uint_as_float(rr[1]);}
  if(hi==0)wsf[32+r32]=l_reg;asm volatile("s_waitcnt lgkmcnt(0)":::"memory");
  float rli[16];
  #pragma unroll
  for(int r=0;r<16;++r)rli[r]=__builtin_amdgcn_rcpf(wsf[32+crow(r,hi)]);
  bf16*Ow=O+(rowbase+q0+wid*QBLK)*DMO+ocol;
  { bf16*stg=(bf16*)(shm+LDS_OST)+wid*2048;
    #pragma unroll
    for(int r=0;r<16;++r){const int orow=crow(r,hi);
      #pragma unroll
      for(int d0=0;d0<2;++d0)stg[orow*64+d0*32+r32]=(bf16)(o[d0][r]*rli[r]);}
    asm volatile("s_waitcnt lgkmcnt(0)":::"memory");
    #pragma unroll
    for(int i=0;i<4;++i){const int row=i*8+(lane>>3),ch=lane&7; const u32x4 v=*(const u32x4*)(stg+row*64+ch*8); ATTN_STORE16(Ow+(long)row*DMO+ch*8,v);} }
  asm volatile("s_waitcnt lgkmcnt(0)\n\ts_barrier":::"memory");
  #undef DMA_K
  #undef DMA_V
  #undef CMASK
  #undef START
  #undef RESC
  #undef ROT
}
}
#undef SBAR
#undef WAIT_BAR
#undef MFMA32
__device__ const unsigned char ATT_H[64] = {5,6,7,5,6,7,5,6,7,4,4,4,4,5,6,7,4,5,6,7,3,3,3,3,3,3,4,5,6,7,2,2,2,2,2,2,1,1,1,1,1,1,1,2,3,4,5,6,7,0,0,0,0,0,0,0,0,1,2,3,4,5,6,7};
__device__ const unsigned char ATT_Q[64] = {7,7,7,6,6,6,5,5,5,5,6,7,4,4,4,4,3,3,3,3,3,4,5,6,7,2,2,2,2,2,2,3,4,5,6,7,1,2,3,4,5,6,7,1,1,1,1,1,1,1,2,3,4,5,6,7,0,0,0,0,0,0,0,0};
__device__ const unsigned char ATT_S[64] = {0,0,0,0,0,0,0,0,0,2,6,10,0,0,0,0,0,0,0,0,2,6,10,14,18,0,0,0,0,0,2,6,10,14,18,22,0,4,8,12,16,20,24,0,0,0,0,0,0,2,6,10,14,18,22,26,0,0,0,0,0,0,0,0};
__device__ __forceinline__ void phase_attn(const h16* Q, const h16* KK, const h16* VV, h16* ORAW, char* lds_generic, int blk, int G, const int wave) {
    const int vcu = (G % 8 == 0) ? (blk % 8) * (G / 8) + blk / 8 : blk;
#pragma unroll 1
    for (int r = 0; r < 16; ++r) {
        const int p = r * 256 + ((r & 1) ? 255 - vcu : vcu), ci = p >> 6, u = p & 63;
        const int hh = ATT_H[ci], qb = ATT_Q[ci], ts = ATT_S[ci], b = u >> 2, c = (u >> 1) & 1, vh = u & 1;
        const float slope2 = exp2f(-(float)(hh + 1)) * LOG2E;
        attn_body::attn_unit<8>(b, hh * 128 + c * 64, hh * 128 + vh * 64, c * 1024 + hh * 128 + vh * 64, slope2, qb, ts, Q, KK, VV, ORAW, lds_generic, wave);
    }
}

__device__ __forceinline__ float row16_sum(float v);
__device__ __forceinline__ void phase_attn_combine(const h16* ORAW, const float* lamv  , const float* subg  , float lambda_init, h16* OB, int gw_, int NGW_, int lane) {
    lane = lane_id(); OPAQUE(lane);
    const float la = wave_sum(lamv[lane] * lamv[64 + lane]), lb = wave_sum(lamv[128 + lane] * lamv[192 + lane]);
    const float lam = __expf(la) - __expf(lb) + lambda_init;
    const int hs = lane >> 5, d = (lane & 31) * 4;
    const f32x4 gsc = *(const f32x4*)(subg + d) * (1.0f - lambda_init);
#pragma unroll 1
    for (int t0 = gw_; t0 < T; t0 += 2 * NGW_) {
        h16x4 a[2][4], b[2][4];
#pragma unroll
        for (int q = 0; q < 2; ++q) { const size_t t = (size_t)t0 + (size_t)q * NGW_;
#pragma unroll
            for (int hp = 0; hp < 4; ++hp) { const int hh = 2 * hp + hs; a[q][hp] = *(const h16x4*)(ORAW + t * 2048 + hh * 128 + d); b[q][hp] = *(const h16x4*)(ORAW + t * 2048 + 1024 + hh * 128 + d); } }
#pragma unroll
        for (int q = 0; q < 2; ++q) { const size_t t = (size_t)t0 + (size_t)q * NGW_;
#pragma unroll
            for (int hp = 0; hp < 4; ++hp) { const int hh = 2 * hp + hs;
                const f32x4 o = __builtin_convertvector(a[q][hp], f32x4) - __builtin_convertvector(b[q][hp], f32x4) * lam;
                float ss = (o.x * o.x + o.y * o.y) + (o.z * o.z + o.w * o.w); ss = row16_sum(ss); ss += swz16f(ss);
                const float r = rsqrtf(ss * (1.0f / 128.0f) + 1e-5f);
                *(u32x2*)(OB + t * 1024 + hh * 128 + d) = pkh4(o * r * gsc); } }
    }
}

struct SchedRkv {
    const char* XM; const char* Wrkv; const char* Wl1; int nk, G, c;
    __device__ __forceinline__ bool next(int i, Unit& u) const {
        int pm, q;
        if (G == 256) { const int L = i * 32 + (c >> 3), pl = L / nk; q = L - pl * nk; pm = pl * 8 + (c & 7); if (pm >= 128) return false; }
        else { const int U = i * G + c; if (U >= 128 * nk) return false; pm = U / nk; q = U - pm * nk; }
        u.pm = pm; u.rows = 256; u.e = 0; u.rbase = 0; u.list = nullptr;
        int xs, pn, kind; const char* B;
        if (q < 12) { kind = q >> 2; pn = q & 3; xs = kind; B = Wrkv + ((size_t)kind * 1024 + pn * 256) * 2048; }
        else { kind = q - 9; pn = 0; xs = (kind == 6) ? 2 : kind; B = Wl1 + (size_t)(kind - 3) * 256 * 2048; }
        u.kind = kind; u.pn = pn; u.B = B; u.A = XM + ((size_t)xs * T + (size_t)pm * 256) * 2048;
        return true;
    }
    __device__ __forceinline__ unsigned a_off(const Unit&, int row) const { return (unsigned)row * 2048u; }
};
struct SchedL2 {
    const char* L1O; const char* Wl2; int kind, G, c;
    __device__ __forceinline__ bool next(int i, Unit& u) const {
        const int U = i * G + c; if (U >= 128 * 4) return false;
        const int pm = U >> 2; u.pm = pm; u.pn = U & 3; u.rows = 256; u.e = 0; u.rbase = 0; u.list = nullptr; u.kind = kind;
        u.A = L1O + ((size_t)kind * T + (size_t)pm * 256) * 512; u.B = Wl2 + ((size_t)kind * 1024 + u.pn * 256) * 512;
        return true;
    }
    __device__ __forceinline__ unsigned a_off(const Unit&, int row) const { return (unsigned)row * 512u; }
};
struct SchedPlain {
    const char* A; const char* B; int npn, G, c;
    __device__ __forceinline__ bool next(int i, Unit& u) const {
        int pm, pn;
        if (G == 256) { const int L = i * 32 + (c >> 3), pl = L / npn; pn = L - pl * npn; pm = pl * 8 + (c & 7); if (pm >= 128) return false; }
        else { const int U = i * G + c; if (U >= 128 * npn) return false; pm = U / npn; pn = U - pm * npn; }
        u.pm = pm; u.rows = 256; u.e = 0; u.rbase = 0; u.list = nullptr;
        u.kind = pn >> 2; u.pn = pn & 3; u.A = A + (size_t)pm * 256 * 2048; u.B = B + (size_t)pn * 256 * 2048;
        return true;
    }
    __device__ __forceinline__ unsigned a_off(const Unit&, int row) const { return (unsigned)row * 2048u; }
};
struct SchedMoe {
    const LAS unsigned* misc; const LAS int* tile_e; const char* A; const char* W; const int* LIST; int npn, gather, G, c; size_t wstride;
    __device__ __forceinline__ bool next(int i, Unit& u) const {
        const int ntile = __builtin_amdgcn_readfirstlane((int)misc[48 + 32]);
        int rtg, pn;
        if (G == 256) { const int x = c & 7, j = c >> 3, rpr = 32 / npn; rtg = (i * rpr + j / npn) * 8 + x; pn = j % npn; if (rtg >= ntile) return false; }
        else { const int U = i * G + c; if (U >= ntile * npn) return false; rtg = U / npn; pn = U - rtg * npn; }
        const int e = __builtin_amdgcn_readfirstlane(tile_e[rtg]);
        const int rt = rtg - __builtin_amdgcn_readfirstlane((int)misc[48 + e]), cnt = __builtin_amdgcn_readfirstlane((int)misc[16 + e]);
        u.pm = rtg; u.pn = pn; u.kind = 0; u.e = e; u.rbase = rtg * 256; u.rows = min(256, cnt - rt * 256);
        u.list = LIST + (size_t)e * ECAP + rt * 256;
        u.A = gather ? A : A + (size_t)rtg * 256 * 1024; u.B = W + (size_t)e * wstride + (size_t)pn * 256 * 1024;
        return true;
    }
    __device__ __forceinline__ unsigned a_off(const Unit& u, int row) const {
        if (!gather) return (unsigned)row * 1024u;
        const int slot = (row < u.rows) ? u.list[row] : 0;
        return (unsigned)(slot >> 2) * 1024u;
    }
};
__device__ __forceinline__ void moe_tables(const unsigned* CNT, volatile LAS unsigned* misc, LAS int* tile_e, const int wave) {
    if (wave == 0 && lane_id() == 0) {
        unsigned acc = 0;
        for (int e = 0; e < 32; ++e) { const unsigned c = __hip_atomic_load(CNT + e, __ATOMIC_RELAXED, __HIP_MEMORY_SCOPE_AGENT); misc[16 + e] = c; misc[48 + e] = acc; acc += (c + 255u) >> 8; }
        misc[48 + 32] = acc;
    }
    __syncthreads();
    { const int ntile = (int)misc[48 + 32];
      for (int i = wave * 64 + lane_id(); i < ntile; i += NTHR) { int e = 0; for (int j = 1; j < 32; ++j) if ((int)misc[48 + j] <= i) e = j; tile_e[i] = e; } }
    __syncthreads();
}

__device__ __forceinline__ size_t hm_off(int row, int col) { return ((size_t)((row >> 11) * 16 + (col >> 6)) * SEQ + (row & 2047)) * 64 + (col & 63); }
struct EpiRkv {
    h16* Rp; h16* Kp; h16* Vp; h16* L1O;
    __device__ __forceinline__ void operator()(const f32x4 (&acc)[2][2][4][2], const Unit& u, int wr, int wc, int fr, int fq) const {
        if (u.kind < 3) {
            h16* C = u.kind == 0 ? Rp : (u.kind == 1 ? Kp : Vp);
            FOR_ACC2(ai, bj, m) { const int row = u.pm * 256 + 128 * ai + 64 * wr + 16 * m + fr, col = u.pn * 256 + 128 * bj + 32 * wc + 8 * fq;
                const u32x2 lo = pkh4(acc[ai][bj][m][0]), hi = pkh4(acc[ai][bj][m][1]); *(u32x4*)(C + hm_off(row, col)) = (u32x4){lo.x, lo.y, hi.x, hi.y}; }
        } else {
            h16* O = L1O + (size_t)(u.kind - 3) * T * 256; const int kd = u.kind;
            FOR_ACC2(ai, bj, m) { const int row = u.pm * 256 + 128 * ai + 64 * wr + 16 * m + fr, col = 128 * bj + 32 * wc + 8 * fq; u32x2 pk2[2];
#pragma unroll
                for (int n = 0; n < 2; ++n) { f32x4 v = acc[ai][bj][m][n];
                    if (kd == 3) { v.x = tanhf(v.x); v.y = tanhf(v.y); v.z = tanhf(v.z); v.w = tanhf(v.w); }
                    else if (kd == 5) { v.x = sigmoidf_(v.x); v.y = sigmoidf_(v.y); v.z = sigmoidf_(v.z); v.w = sigmoidf_(v.w); }
                    pk2[n] = pkh4(v); }
                *(u32x4*)(O + (size_t)row * 256 + col) = (u32x4){pk2[0].x, pk2[0].y, pk2[1].x, pk2[1].y}; }
        }
    }
};
template <int KD> struct EpiL2 {
    void* O; const h16* VF; const float* bias;
    __device__ __forceinline__ void operator()(const f32x4 (&acc)[2][2][4][2], const Unit& u, int wr, int wc, int fr, int fq) const {
        f32x4 bv[2][2];
#pragma unroll
        for (int bj = 0; bj < 2; ++bj)
#pragma unroll
            for (int n = 0; n < 2; ++n) bv[bj][n] = (KD != 2) ? *(const f32x4*)(bias + u.pn * 256 + 128 * bj + 32 * wc + 8 * fq + 4 * n) : (f32x4){0.f, 0.f, 0.f, 0.f};
#pragma unroll
        for (int ai = 0; ai < 2; ++ai)
#pragma unroll
            for (int mp = 0; mp < 2; ++mp) {
                h16x4 vc[2][2][2], vf[2][2][2];
                if (KD == 3) {
#pragma unroll
                    for (int mm = 0; mm < 2; ++mm)
#pragma unroll
                        for (int bj = 0; bj < 2; ++bj)
#pragma unroll
                            for (int n = 0; n < 2; ++n) { const size_t o = hm_off(u.pm * 256 + 128 * ai + 64 * wr + 16 * (2 * mp + mm) + fr, u.pn * 256 + 128 * bj + 32 * wc + 8 * fq + 4 * n);
                                vc[mm][bj][n] = *(const h16x4*)((const h16*)O + o); vf[mm][bj][n] = *(const h16x4*)(VF + o); }
                }
#pragma unroll
                for (int mm = 0; mm < 2; ++mm)
#pragma unroll
                    for (int bj = 0; bj < 2; ++bj) { const int m = 2 * mp + mm; const size_t o = hm_off(u.pm * 256 + 128 * ai + 64 * wr + 16 * m + fr, u.pn * 256 + 128 * bj + 32 * wc + 8 * fq); u32x2 pk2[2];
#pragma unroll
                        for (int n = 0; n < 2; ++n) {
                            f32x4 v = acc[ai][bj][m][n] + bv[bj][n];
                            if (KD == 0) { v.x = 1.0f - __expf(-0.6065306597126334f * sigmoidf_(v.x)); v.y = 1.0f - __expf(-0.6065306597126334f * sigmoidf_(v.y)); v.z = 1.0f - __expf(-0.6065306597126334f * sigmoidf_(v.z)); v.w = 1.0f - __expf(-0.6065306597126334f * sigmoidf_(v.w)); }
                            if (KD == 1 || KD == 3) { v.x = sigmoidf_(v.x); v.y = sigmoidf_(v.y); v.z = sigmoidf_(v.z); v.w = sigmoidf_(v.w); }
                            if (KD == 3) { const f32x4 c_ = __builtin_convertvector(vc[mm][bj][n], f32x4), f_ = __builtin_convertvector(vf[mm][bj][n], f32x4); v = c_ + (f_ - c_) * v; }
                            pk2[n] = pkh4(v); }
                        *(u32x4*)((h16*)O + o) = (u32x4){pk2[0].x, pk2[0].y, pk2[1].x, pk2[1].y}; }
                if (KD == 3) EPI_FENCE();
            }
    }
};
template <bool F16X> struct EpiRes {
    const void* X; h16* H;
    __device__ __forceinline__ void operator()(const f32x4 (&acc)[2][2][4][2], const Unit& u, int wr, int wc, int fr, int fq) const {
        const float* Xf = (const float*)X; const h16* Xh = (const h16*)X;
#pragma unroll
        for (int ai = 0; ai < 2; ++ai)
#pragma unroll
            for (int mp = 0; mp < 2; ++mp) {
                f32x4 xr[2][2][2]; h16x4 xh[2][2][2];
#pragma unroll
                for (int mm = 0; mm < 2; ++mm)
#pragma unroll
                    for (int bj = 0; bj < 2; ++bj)
#pragma unroll
                        for (int n = 0; n < 2; ++n) { const size_t o = (size_t)(u.pm * 256 + 128 * ai + 64 * wr + 16 * (2 * mp + mm) + fr) * D + u.pn * 256 + 128 * bj + 32 * wc + 8 * fq + 4 * n;
                            if (F16X) xh[mm][bj][n] = *(const h16x4*)(Xh + o); else xr[mm][bj][n] = *(const f32x4*)(Xf + o); }
#pragma unroll
                for (int mm = 0; mm < 2; ++mm)
#pragma unroll
                    for (int bj = 0; bj < 2; ++bj) { const int m = 2 * mp + mm; u32x2 pk2[2];
#pragma unroll
                        for (int n = 0; n < 2; ++n) { const f32x4 xv = F16X ? __builtin_convertvector(xh[mm][bj][n], f32x4) : xr[mm][bj][n]; pk2[n] = pkh4(xv * ALPHA + acc[ai][bj][m][n]); }
                        *(u32x4*)(H + (size_t)(u.pm * 256 + 128 * ai + 64 * wr + 16 * m + fr) * D + u.pn * 256 + 128 * bj + 32 * wc + 8 * fq) = (u32x4){pk2[0].x, pk2[0].y, pk2[1].x, pk2[1].y}; }
                EPI_FENCE();
            }
    }
};
struct EpiQkv {
    h16* O0; h16* O1; float sc0;
    __device__ __forceinline__ void operator()(const f32x4 (&acc)[2][2][4][2], const Unit& u, int wr, int wc, int fr, int fq) const {
        h16* O = u.kind == 0 ? O0 : O1; const float sc = u.kind == 0 ? sc0 : 1.0f;
        FOR_ACC2(ai, bj, m) { const int row = u.pm * 256 + 128 * ai + 64 * wr + 16 * m + fr, col = u.pn * 256 + 128 * bj + 32 * wc + 8 * fq;
            const u32x2 lo = pkh4(acc[ai][bj][m][0] * sc), hi = pkh4(acc[ai][bj][m][1] * sc); *(u32x4*)(O + (size_t)row * 1024 + col) = (u32x4){lo.x, lo.y, hi.x, hi.y}; }
    }
};
struct EpiGu {
    unsigned char* ACT; const float* bgu;
    __device__ __forceinline__ void operator()(const f32x4 (&acc)[2][2][4][2], const Unit& u, int wr, int wc, int fr, int fq) const {
        const float* bb = bgu + (size_t)u.e * 2048;
        f32x4 bg[2], bu[2];
        const int colb = u.pn * 128 + 32 * wc + 8 * fq;
#pragma unroll
        for (int n = 0; n < 2; ++n) { bg[n] = *(const f32x4*)(bb + colb + 4 * n); bu[n] = *(const f32x4*)(bb + 1024 + colb + 4 * n); }
#pragma unroll
        for (int ai = 0; ai < 2; ++ai)
#pragma unroll
            for (int m = 0; m < 4; ++m) { const int rl = 128 * ai + 64 * wr + 16 * m + fr;
                if (rl < u.rows) { u32x2 pk2;
#pragma unroll
                    for (int n = 0; n < 2; ++n) {
                        const f32x4 gt = acc[ai][0][m][n] * (1.0f / GU_SCALE) + bg[n], up = acc[ai][1][m][n] * (1.0f / GU_SCALE) + bu[n]; f32x4 r;
#pragma unroll
                        for (int e = 0; e < 4; ++e) { const float g = fminf(gt[e], 7.0f), uu = __builtin_amdgcn_fmed3f(up[e], -7.0f, 7.0f); r[e] = (uu + 1.0f) * (g * __builtin_amdgcn_rcpf(1.0f + __builtin_amdgcn_exp2f((-1.702f * 1.4426950408889634f) * g))); }
                        int pk_ = __builtin_amdgcn_cvt_pk_fp8_f32(r[0], r[1], 0, false); pk_ = __builtin_amdgcn_cvt_pk_fp8_f32(r[2], r[3], pk_, true); pk2[n] = (unsigned)pk_; }
                    *(u32x2*)(ACT + (size_t)(u.rbase + rl) * 1024 + colb) = pk2;
                } }
    }
};
struct EpiDn {
    unsigned char* YS; const float* bdn; const float* TOPG;
    __device__ __forceinline__ void operator()(const f32x4 (&acc)[2][2][4][2], const Unit& u, int wr, int wc, int fr, int fq) const {
        const float* bb = bdn + (size_t)u.e * 1024;
        f32x4 bv[2][2]; int slot[2][4]; float gt[2][4];
#pragma unroll
        for (int bj = 0; bj < 2; ++bj)
#pragma unroll
            for (int n = 0; n < 2; ++n) bv[bj][n] = *(const f32x4*)(bb + u.pn * 256 + 64 * wc + 16 * fq + 8 * bj + 4 * n);
#pragma unroll
        for (int ai = 0; ai < 2; ++ai)
#pragma unroll
            for (int m = 0; m < 4; ++m) { const int rl = 128 * ai + 64 * wr + 16 * m + fr; slot[ai][m] = (rl < u.rows) ? u.list[rl] : -1; }
#pragma unroll
        for (int ai = 0; ai < 2; ++ai)
#pragma unroll
            for (int m = 0; m < 4; ++m) { const float g_ = TOPG[slot[ai][m] >= 0 ? slot[ai][m] : 0]; gt[ai][m] = (slot[ai][m] >= 0) ? g_ * YS_SCALE : 0.f; }
#pragma unroll
        for (int ai = 0; ai < 2; ++ai)
#pragma unroll
            for (int m = 0; m < 4; ++m) {
                if (slot[ai][m] >= 0) {
                    u32x4 pk4;
#pragma unroll
                    for (int bj = 0; bj < 2; ++bj)
#pragma unroll
                        for (int n = 0; n < 2; ++n) {
                            const f32x4 yv = (acc[ai][bj][m][n] * (1.0f / DN_SCALE) + bv[bj][n]) * gt[ai][m];
                            int pk_ = __builtin_amdgcn_cvt_pk_fp8_f32(yv[0], yv[1], 0, false); pk_ = __builtin_amdgcn_cvt_pk_fp8_f32(yv[2], yv[3], pk_, true); pk4[2 * bj + n] = (unsigned)pk_; }
                    *(u32x4*)(YS + (size_t)slot[ai][m] * 1024 + u.pn * 256 + 64 * wc + 16 * fq) = pk4;
                } }
    }
};

struct Args { const float* in[33]; float* out; unsigned char* ws; int ph_lo, ph_hi; };
enum { I_X = 0, I_LNG, I_LNB, I_MIX, I_WRKV, I_WO, I_W0, I_W1, I_W2, I_A0, I_A1, I_A2, I_G1, I_G2, I_KK, I_KA, I_RK, I_LNXG, I_LNXB, I_V0, I_V1, I_V2,
       I_KVW, I_DAQ, I_DAO, I_DALAM, I_DASUB, I_RW, I_RB, I_WGU, I_BGU, I_WDN, I_BDN };

typedef const float* cfptr;
#define KAS __attribute__((address_space(4)))
#define KA_DECL const KAS cfptr* kin = (const KAS cfptr*)__builtin_amdgcn_kernarg_segment_ptr(); asm volatile("" : "+s"(kin))
#define KA_RELOAD asm volatile("" : "+s"(kin))
#define PH_BEGIN KA_RELOAD; asm volatile("" : "+s"(wave), "+s"(G), "+s"(blk)); ws = KWS; ctl = (unsigned*)(ws + WS_CTL)
#define KIN(i) (kin[i])
#define KOUT ((float*)kin[33])
#define KWS ((unsigned char*)kin[34])
__global__ void __launch_bounds__(NTHR, 2) yoco_fwd(Args args) {
    extern __shared__ __attribute__((aligned(16))) unsigned char lds_raw[];
    LAS unsigned char* lds = (LAS unsigned char*)lds_raw;
    volatile LAS unsigned* MISC = (volatile LAS unsigned*)(lds + MISC_OFF);
    int wave = __builtin_amdgcn_readfirstlane((int)threadIdx.x >> 6);
    int G = gridDim.x, blk = blockIdx.x; int lane = 0;
#define gw (blk * NWAVES + wave)
#define NGW (G * NWAVES)
    KA_DECL;
    unsigned char* ws = KWS;
    unsigned* ctl = (unsigned*)(ws + WS_CTL);
    for (int u = wave * 64 + lane_id(); u < (LDS_BYTES - MISC_OFF) / 4; u += NTHR) ((LAS unsigned*)(lds + MISC_OFF))[u] = 0u;
    __syncthreads();
    XcdBarrier bar = xcd_barrier_post(ctl + CW_BAR, MISC + 8, wave);
#define GRID_BAR() xcd_barrier(bar, wave)

    {
        LAS float* scr = (LAS float*)(lds + wave * 16896);
        conv_batch(KIN(I_WRKV), 6, 1024, 1024, (h16*)(ws + WS_W_RKV), 1024, 1024, 3, scr, gw, NGW, lane);
        conv_batch(KIN(I_WO), 2, 1024, 1024, (h16*)(ws + WS_W_RO), 1024, 1024, 3, scr, gw, NGW, lane);
#pragma unroll
        for (int l = 0; l < 2; ++l) {
            conv_batch(KIN(I_W1) + (size_t)l * 1024 * 64, 1, 1024, 64, (h16*)(ws + WS_W_L1) + (size_t)(l * 4 + 0) * 256 * 1024, 1024, 256, 3, scr, gw, NGW, lane);
            conv_batch(KIN(I_A1) + (size_t)l * 1024 * 64, 1, 1024, 64, (h16*)(ws + WS_W_L1) + (size_t)(l * 4 + 1) * 256 * 1024, 1024, 256, 3, scr, gw, NGW, lane);
            conv_batch(KIN(I_G1) + (size_t)l * 1024 * 160, 1, 1024, 160, (h16*)(ws + WS_W_L1) + (size_t)(l * 4 + 2) * 256 * 1024, 1024, 256, 3, scr, gw, NGW, lane);
            conv_batch(KIN(I_W2) + (size_t)l * 64 * 1024, 1, 64, 1024, (h16*)(ws + WS_W_L2) + (size_t)(l * 4 + 0) * 256 * 1024, 256, 1024, 3, scr, gw, NGW, lane);
            conv_batch(KIN(I_A2) + (size_t)l * 64 * 1024, 1, 64, 1024, (h16*)(ws + WS_W_L2) + (size_t)(l * 4 + 1) * 256 * 1024, 256, 1024, 3, scr, gw, NGW, lane);
            conv_batch(KIN(I_G2) + (size_t)l * 160 * 1024, 1, 160, 1024, (h16*)(ws + WS_W_L2) + (size_t)(l * 4 + 2) * 256 * 1024, 256, 1024, 3, scr, gw, NGW, lane);
        }
        conv_batch(KIN(I_V1), 1, 1024, 32, (h16*)(ws + WS_W_L1) + (size_t)(4 + 3) * 256 * 1024, 1024, 256, 3, scr, gw, NGW, lane);
        conv_batch(KIN(I_V2), 1, 32, 1024, (h16*)(ws + WS_W_L2) + (size_t)(4 + 3) * 256 * 1024, 256, 1024, 3, scr, gw, NGW, lane);
        conv_batch(KIN(I_KVW), 1, 1024, 2048, (h16*)(ws + WS_W_KV), 1024, 2048, 3, scr, gw, NGW, lane);
        conv_batch(KIN(I_DAQ), 2, 1024, 1024, (h16*)(ws + WS_W_Q), 1024, 1024, 3, scr, gw, NGW, lane);
        conv_batch(KIN(I_DAO), 2, 1024, 1024, (h16*)(ws + WS_W_AO), 1024, 1024, 3, scr, gw, NGW, lane);
#pragma unroll
        for (int l4 = 0; l4 < 4; ++l4) { conv_batch(KIN(I_RW) + (size_t)l4 * D * NEXP, 1, 1024, 32, (h16*)(ws + WS_WR) + (size_t)(l4 * 2 + 0) * 32 * 1024, 1024, 32, 0, scr, gw, NGW, lane);
                                        conv_batch(KIN(I_RW) + (size_t)l4 * D * NEXP, 1, 1024, 32, (h16*)(ws + WS_WR) + (size_t)(l4 * 2 + 1) * 32 * 1024, 1024, 32, 2, scr, gw, NGW, lane); }
    }

#pragma unroll 1
    for (int l = 0; l < 4; ++l) {
        if (l < 2) {
            PH_BEGIN;
            if (l == 0) phase_prep<false>(KIN(I_X), KIN(I_MIX), (h16*)(ws + WS_XM), gw, NGW, lane);
            else phase_prep<true>(ws + WS_XH, KIN(I_MIX) + (size_t)l * 6 * D, (h16*)(ws + WS_XM), gw, NGW, lane);
            GRID_BAR();
            PH_BEGIN;
            {
                SchedRkv S{(const char*)(ws + WS_XM), (const char*)(ws + WS_W_RKV) + (size_t)l * 3 * 1024 * 2048, (const char*)(ws + WS_W_L1) + (size_t)l * 4 * 256 * 2048, l == 0 ? 15 : 16, G, blk};
                EpiRkv E{(h16*)(ws + WS_R), (h16*)(ws + WS_K), (h16*)(ws + (l == 0 ? WS_VF : WS_V)), (h16*)(ws + WS_L1O)};
                GEMM_PHASE(S, E, 1024);
            }
            GRID_BAR();
            PH_BEGIN;
            {
                const char* l1o = (const char*)(ws + WS_L1O); const char* wl2 = (const char*)(ws + WS_W_L2) + (size_t)l * 4 * 1024 * 512;
                { SchedL2 S{l1o, wl2, 0, G, blk}; EpiL2<0> E{(void*)(ws + WS_WD), nullptr, KIN(I_W0) + (size_t)l * D}; GEMM_PHASE(S, E, 256); }
                { SchedL2 S{l1o, wl2, 1, G, blk}; EpiL2<1> E{(void*)(ws + WS_AA), nullptr, KIN(I_A0) + (size_t)l * D}; GEMM_PHASE(S, E, 256); }
                { SchedL2 S{l1o, wl2, 2, G, blk}; EpiL2<2> E{(void*)(ws + WS_GG), nullptr, nullptr}; GEMM_PHASE(S, E, 256); }
                if (l == 1) { SchedL2 S{l1o, wl2, 3, G, blk}; EpiL2<3> E{(void*)(ws + WS_V), (const h16*)(ws + WS_VF), KIN(I_V0)}; GEMM_PHASE(S, E, 256); }
            }
            GRID_BAR();
            PH_BEGIN;
            {
                const float* wgu_ = KIN(I_WGU); const float* wdn_ = KIN(I_WDN); asm volatile("" : "+s"(wgu_), "+s"(wdn_));
                ScanArgs sa{(const h16*)(ws + WS_R), (const h16*)(ws + WS_K), (const h16*)(ws + (l == 0 ? WS_VF : WS_V)), (const h16*)(ws + WS_WD), (const h16*)(ws + WS_AA), (const h16*)(ws + WS_GG),
                            KIN(I_KK) + (size_t)l * D, KIN(I_KA) + (size_t)l * D, KIN(I_RK) + (size_t)l * D, KIN(I_LNXG) + (size_t)l * D, KIN(I_LNXB) + (size_t)l * D, (h16*)(ws + WS_YG), wgu_, wdn_, ws + WS_W_GU, ws + WS_W_DN, l};
                phase_scan_mm(sa, lds, blk, G, wave);
            }
            GRID_BAR();
            PH_BEGIN;
            {
                SchedPlain S{(const char*)(ws + WS_YG), (const char*)(ws + WS_W_RO) + (size_t)l * 1024 * 2048, 4, G, blk};
                if (l == 0) { EpiRes<false> E{KIN(I_X), (h16*)(ws + WS_H)}; GEMM_PHASE(S, E, 1024); }
                else { EpiRes<true> E{ws + WS_XH, (h16*)(ws + WS_H)}; GEMM_PHASE(S, E, 1024); }
            }
            GRID_BAR();
        } else {
            const int j = l - 2;
            PH_BEGIN;
            if (l == 2) {
                { SchedPlain S{(const char*)(ws + WS_XH), (const char*)(ws + WS_W_Q), 4, G, blk}; EpiQkv E{(h16*)(ws + WS_Q), nullptr, QSCALE}; GEMM_PHASE(S, E, 1024); }
                { SchedPlain S{(const char*)(ws + WS_XH), (const char*)(ws + WS_W_KV), 8, G, blk}; EpiQkv E{(h16*)(ws + WS_KK), (h16*)(ws + WS_VV), 1.0f}; GEMM_PHASE(S, E, 1024); }
            } else {
                SchedPlain S{(const char*)(ws + WS_XH), (const char*)(ws + WS_W_Q) + (size_t)j * 1024 * 2048, 4, G, blk}; EpiQkv E{(h16*)(ws + WS_Q), nullptr, QSCALE}; GEMM_PHASE(S, E, 1024);
            }
            GRID_BAR();
            PH_BEGIN;
            phase_attn((const h16*)(ws + WS_Q), (const h16*)(ws + WS_KK), (const h16*)(ws + WS_VV), (h16*)(ws + WS_ORAW), (char*)lds_raw, blk, G, wave);
            GRID_BAR();
            PH_BEGIN;
            phase_attn_combine((const h16*)(ws + WS_ORAW), KIN(I_DALAM) + (size_t)j * 256, KIN(I_DASUB) + (size_t)j * 128, 0.8f - 0.6f * expf(-0.3f * (float)l), (h16*)(ws + WS_OB), gw, NGW, lane);
            GRID_BAR();
            PH_BEGIN;
            {
                SchedPlain S{(const char*)(ws + WS_OB), (const char*)(ws + WS_W_AO) + (size_t)j * 1024 * 2048, 4, G, blk};
                EpiRes<true> E{ws + WS_XH, (h16*)(ws + WS_H)};
                GEMM_PHASE(S, E, 1024);
            }
            GRID_BAR();
        }
        PH_BEGIN;
        {
            RouterArgs ra{(const h16*)(ws + WS_H), KIN(I_LNG) + (size_t)(l * 2) * D, KIN(I_LNB) + (size_t)(l * 2) * D, (const h16*)(ws + WS_WR) + (size_t)l * 2 * 32 * 1024, KIN(I_RB) + (size_t)l * NEXP,
                          (h16*)(ws + WS_X1), (unsigned char*)(ws + WS_XB), (float*)(ws + WS_TOPG), (int*)(ws + WS_LIST), ctl + CW_CNT + l * 32};
            phase_ln_router(ra, lds, blk, G, wave);
        }
        GRID_BAR();
        PH_BEGIN;
        moe_tables(ctl + CW_CNT + l * 32, MISC, (LAS int*)(lds + TILE_E_OFF), wave);
        {
            SchedMoe S{(const LAS unsigned*)MISC, (const LAS int*)(lds + TILE_E_OFF), (const char*)(ws + WS_XB), (const char*)(ws + WS_W_GU) + (size_t)l * 32 * 2048 * 1024, (const int*)(ws + WS_LIST), 8, 1, G, blk, (size_t)2048 * 1024};
            EpiGu E{(unsigned char*)(ws + WS_ACT), KIN(I_BGU) + (size_t)l * 32 * 2048};
            GEMM_PHASE8(S, E, 1024);
        }
        GRID_BAR();
        PH_BEGIN;
        {
            SchedMoe S{(const LAS unsigned*)MISC, (const LAS int*)(lds + TILE_E_OFF), (const char*)(ws + WS_ACT), (const char*)(ws + WS_W_DN) + (size_t)l * 32 * 1024 * 1024, (const int*)(ws + WS_LIST), 4, 0, G, blk, (size_t)1024 * 1024};
            EpiDn E{(unsigned char*)(ws + WS_YS), KIN(I_BDN) + (size_t)l * 32 * 1024, (const float*)(ws + WS_TOPG)};
            GEMM_PHASE8(S, E, 1024);
        }
        GRID_BAR();
        PH_BEGIN;
        phase_combine((const h16*)(ws + WS_X1), (const unsigned char*)(ws + WS_YS), KIN(I_LNG) + (size_t)(l * 2 + 1) * D, KIN(I_LNB) + (size_t)(l * 2 + 1) * D,
                      l == 3 ? KOUT : (float*)nullptr, (h16*)(ws + WS_XH), gw, NGW, lane);
        if (l < 3) GRID_BAR();
    }
    if (xb_ld(ctl + CW_BAR + XB_TMO) != 0u && wave == 0 && lane_id() == 0) KOUT[(size_t)blk * D] = __builtin_nanf("");
}

extern "C" void kernel_launch(void* const* d_in, const int* in_sizes, int n_in, void* d_out, int out_size, void* d_ws, size_t ws_size, hipStream_t stream) {
    static int grid = 0;
    if (grid == 0) {
        if (n_in != 33 || out_size != T * D || ws_size < WS_END) { fprintf(stderr, "kernel_launch: unexpected shapes (n_in %d out %d ws %zu)\n", n_in, out_size, ws_size); grid = -1; return; }
        if (hipFuncSetAttribute((const void*)yoco_fwd, hipFuncAttributeMaxDynamicSharedMemorySize, LDS_BYTES) != hipSuccess) { fprintf(stderr, "kernel_launch: hipFuncSetAttribute failed\n"); grid = -1; return; }
        int dev = 0, cus = 0, per_cu = 0;
        hipGetDevice(&dev); hipDeviceGetAttribute(&cus, hipDeviceAttributeMultiprocessorCount, dev);
        hipOccupancyMaxActiveBlocksPerMultiprocessor(&per_cu, (const void*)yoco_fwd, NTHR, LDS_BYTES);
        (void)hipGetLastError();
        if (per_cu < 1) fprintf(stderr, "kernel_launch: occupancy query reports %d\n", per_cu);
        grid = cus < 256 ? cus : 256;
    }
    if (grid < 0) return;
    hipMemsetAsync((char*)d_ws + WS_CTL, 0, CTL_ZERO_BYTES, stream);
    Args a{};
    for (int i = 0; i < 33; ++i) a.in[i] = (const float*)d_in[i];
    a.out = (float*)d_out; a.ws = (unsigned char*)d_ws; a.ph_lo = 0; a.ph_hi = 0;
    hipLaunchKernelGGL(yoco_fwd, dim3(grid), dim3(NTHR), LDS_BYTES, stream, a);
}
```

```cpp
#include <hip/hip_runtime.h>
#include <cstdio>
#include <cstdint>
#include <cmath>

#define LAS __attribute__((address_space(3)))
#define GAS __attribute__((address_space(1)))
typedef _Float16 h16;
typedef _Float16 h16x8 __attribute__((ext_vector_type(8)));
typedef _Float16 h16x4 __attribute__((ext_vector_type(4)));
typedef _Float16 h16x2 __attribute__((ext_vector_type(2)));
typedef float f32x4 __attribute__((ext_vector_type(4)));
typedef float f32x2 __attribute__((ext_vector_type(2)));
typedef unsigned u32x4 __attribute__((ext_vector_type(4)));
typedef unsigned u32x2 __attribute__((ext_vector_type(2)));

constexpr int D = 1024, NBATCH = 16, SEQ = 2048, T = NBATCH * SEQ;
constexpr int NEXP = 32, TOPK = 4, ECAP = T;
constexpr int NWAVES = 8, NTHR = NWAVES * 64;
constexpr float ALPHA = 1.6817928305074290f;
constexpr float LN_EPS = 1e-5f;
constexpr float QSCALE = 0.125f * 1.4426950408889634f;
constexpr float LOG2E = 1.4426950408889634f;
constexpr float GU_SCALE = 64.0f, DN_SCALE = 128.0f, YS_SCALE = 16.0f;

constexpr size_t MiB = 1u << 20;
constexpr size_t WS_CTL = 0, CTL_ZERO_BYTES = 1 * MiB;
constexpr size_t WS_W_RKV = 2 * MiB;
constexpr size_t WS_W_RO = 14 * MiB;
constexpr size_t WS_W_L1 = 18 * MiB;
constexpr size_t WS_W_L2 = 22 * MiB;
constexpr size_t WS_W_KV = 26 * MiB;
constexpr size_t WS_W_Q = 30 * MiB;
constexpr size_t WS_W_AO = 34 * MiB;
constexpr size_t WS_WR = 38 * MiB;
constexpr size_t WS_W_GU = 40 * MiB;
constexpr size_t WS_W_DN = 552 * MiB;
constexpr size_t WS_X = 808 * MiB;
constexpr size_t WS_X1 = 936 * MiB;
constexpr size_t WS_H = 1064 * MiB;
constexpr size_t WS_XB = 1192 * MiB;
constexpr size_t WS_XH = 1256 * MiB;
constexpr size_t WS_TOPG = 1320 * MiB;
constexpr size_t WS_LIST = 1321 * MiB;
constexpr size_t WS_ACT = 1328 * MiB;
constexpr size_t WS_YS = 1616 * MiB;
constexpr size_t WS_XM = 1872 * MiB;
constexpr size_t WS_R = 2256 * MiB, WS_K = 2384 * MiB, WS_V = 2512 * MiB, WS_VF = 2640 * MiB;
constexpr size_t WS_L1O = 2768 * MiB;
constexpr size_t WS_WD = 2832 * MiB, WS_AA = 2960 * MiB, WS_GG = 3088 * MiB;
constexpr size_t WS_YG = 3216 * MiB;
constexpr size_t WS_END = 3280 * MiB;
constexpr size_t WS_Q = 1872 * MiB, WS_KK = 1936 * MiB, WS_VV = 2000 * MiB;
constexpr size_t WS_ORAW = 2064 * MiB;
constexpr size_t WS_OB = 2192 * MiB;
constexpr int CW_BAR = 4096;
constexpr int CW_CNT = 16384;

constexpr int LDS_BYTES = 147456;
constexpr int MISC_OFF = 146432;
constexpr int TILE_E_OFF = 143360;

template <int CTRL> __device__ __forceinline__ float dppf(float v) { return __builtin_bit_cast(float, __builtin_amdgcn_mov_dpp(__builtin_bit_cast(int, v), CTRL, 0xF, 0xF, true)); }
__device__ __forceinline__ float swz16f(float v) { return __builtin_bit_cast(float, __builtin_amdgcn_ds_swizzle(__builtin_bit_cast(int, v), (16 << 10) | 0x1F)); }
__device__ __forceinline__ float grp8_sum(float v) { v += dppf<0xB1>(v); v += dppf<0x4E>(v); v += dppf<0x141>(v); return v; }
__device__ __forceinline__ float wave_sum(float v) {
    v += dppf<0xB1>(v); v += dppf<0x4E>(v); v += dppf<0x141>(v); v += dppf<0x140>(v); v += swz16f(v);
    return __builtin_bit_cast(float, __builtin_amdgcn_readlane(__builtin_bit_cast(int, v), 0)) + __builtin_bit_cast(float, __builtin_amdgcn_readlane(__builtin_bit_cast(int, v), 32));
}
__device__ __forceinline__ float wave_max(float v) {
    v = fmaxf(v, dppf<0xB1>(v)); v = fmaxf(v, dppf<0x4E>(v)); v = fmaxf(v, dppf<0x141>(v)); v = fmaxf(v, dppf<0x140>(v)); v = fmaxf(v, swz16f(v));
    return fmaxf(__builtin_bit_cast(float, __builtin_amdgcn_readlane(__builtin_bit_cast(int, v), 0)), __builtin_bit_cast(float, __builtin_amdgcn_readlane(__builtin_bit_cast(int, v), 32)));
}
__device__ __forceinline__ unsigned pkh(float a, float b) { h16x2 v = {(h16)a, (h16)b}; return __builtin_bit_cast(unsigned, v); }
__device__ __forceinline__ u32x2 pkh4(f32x4 v) { u32x2 r; r.x = pkh(v.x, v.y); r.y = pkh(v.z, v.w); return r; }
__device__ __forceinline__ f32x4 ldh4(const h16* p) { const h16x4 v = *(const h16x4*)p; return __builtin_convertvector(v, f32x4); }
__device__ __forceinline__ float sigmoidf_(float x) { return __builtin_amdgcn_rcpf(1.0f + __builtin_amdgcn_exp2f(-1.4426950408889634f * x)); }
__device__ __forceinline__ int lane_id() { int l; asm volatile("v_mbcnt_lo_u32_b32 %0, -1, 0\n\tv_mbcnt_hi_u32_b32 %0, -1, %0" : "=v"(l)); return l; }
#define LDS_WAIT() asm volatile("s_waitcnt lgkmcnt(0)" ::: "memory")
#define OPAQUE(x) asm volatile("" : "+v"(x))

#define XB_TMO      128
#define XB_XCNT(j)  (256  + 64 * (j))
#define XB_XSUB(j)  (1280 + 64 * (j))
#define XB_XGEN(j)  (2304 + 64 * (j))
#define XB_TOP      3328
#define XB_TOPGEN   3392
#define XCD_BAR_WORDS 3456
#define XB_SPIN_CAP (1u << 21)

__device__ __forceinline__ unsigned xb_ld(unsigned* p)              { return __hip_atomic_load((GAS unsigned*)p, __ATOMIC_RELAXED, __HIP_MEMORY_SCOPE_AGENT); }
__device__ __forceinline__ unsigned xb_add(unsigned* p, unsigned v) { return __hip_atomic_fetch_add((GAS unsigned*)p, v, __ATOMIC_RELAXED, __HIP_MEMORY_SCOPE_AGENT); }
__device__ __forceinline__ unsigned xb_xcc_id() { return (unsigned)__builtin_amdgcn_s_getreg((3 << 11) | 20) & 0xFu; }
#define XB_SPIN(cond, bar) do { unsigned _sp = 0; while (cond) { __builtin_amdgcn_s_sleep(1); \
    if ((++_sp & 255u) == 0u) { if (xb_ld(&(bar)[XB_TMO])) break; if (_sp > XB_SPIN_CAP) { (void)xb_add(&(bar)[XB_TMO], 1u); break; } } } } while (0)

struct XcdBarrier { unsigned* bar; unsigned x; volatile LAS unsigned* st; };

__device__ __forceinline__ XcdBarrier xcd_barrier_post(unsigned* bar, volatile LAS unsigned* st, const int wave) {
    XcdBarrier b; b.bar = bar; b.x = xb_xcc_id(); b.st = st;
    if (wave == 0 && lane_id() == 0) (void)xb_add(&bar[XB_XCNT(b.x)], 1u);
    return b;
}
__device__ __forceinline__ void xcd_barrier_complete(unsigned* bar, unsigned x, unsigned& nloc, unsigned& nx) {
    const unsigned G = gridDim.x * gridDim.y * gridDim.z;
    unsigned sum, cnt, mine, sp = 0u;
    for (;;) {
        sum = 0u; cnt = 0u; mine = 0u;
#pragma unroll
        for (unsigned j = 0; j < 16; ++j) { const unsigned c = xb_ld(&bar[XB_XCNT(j)]); sum += c; cnt += (c > 0u) ? 1u : 0u; mine = (j == x) ? c : mine; }
        if (sum == G) break;
        __builtin_amdgcn_s_sleep(1);
        if ((++sp & 255u) == 0u) { if (xb_ld(&bar[XB_TMO])) break; if (sp > XB_SPIN_CAP) { (void)xb_add(&bar[XB_TMO], 1u); break; } }
    }
    nloc = mine > 0u ? mine : 1u; nx = cnt > 0u ? cnt : 1u;
}
__device__ __forceinline__ void xcd_barrier(const XcdBarrier& b, const int wave) {
    asm volatile("s_waitcnt vmcnt(0)" ::: "memory");
    __syncthreads();
    if (wave == 0 && lane_id() == 0) {
        unsigned* bar = b.bar; unsigned bx = b.x;
        asm volatile("" : "+s"(bar), "+s"(bx));
        __builtin_amdgcn_s_waitcnt(0);
        unsigned nloc = b.st[0], nx = b.st[1];
        if (nloc == 0u) { xcd_barrier_complete(bar, bx, nloc, nx); b.st[0] = nloc; b.st[1] = nx; }
        const unsigned old = xb_add(&bar[XB_XSUB(bx)], 1u);
        const unsigned gen = old / nloc;
        if (old + 1u == (gen + 1u) * nloc) {
            __builtin_amdgcn_fence(__ATOMIC_RELEASE, "agent");
            asm volatile("s_waitcnt vmcnt(0)" ::: "memory");
            const unsigned og = xb_add(&bar[XB_TOP], 1u);
            const unsigned tg = og / nx;
            if (og + 1u == (tg + 1u) * nx) xb_add(&bar[XB_TOPGEN], 1u);
            else XB_SPIN(xb_ld(&bar[XB_TOPGEN]) == tg, bar);
            __builtin_amdgcn_fence(__ATOMIC_ACQUIRE, "agent");
            xb_add(&bar[XB_XGEN(bx)], 1u);
            asm volatile("s_waitcnt vmcnt(0)" ::: "memory");
        } else {
            XB_SPIN(xb_ld(&bar[XB_XGEN(bx)]) == gen, bar);
            __builtin_amdgcn_fence(__ATOMIC_ACQUIRE, "agent");
            asm volatile("s_waitcnt vmcnt(0)" ::: "memory");
        }
    }
    __syncthreads();
}

__device__ __forceinline__ void conv_batch(const float* src, int batch, int Kr, int Nr, h16* dst, int Kp, int Np, int perm, LAS float* scr, int gw, int NGW, int lane) {
    lane = lane_id(); OPAQUE(lane);
    const int kbn = Kp / 64, nbn = Np / 32, per = kbn * nbn, total = batch * per;
    for (int it = gw; it < total; it += NGW) {
        const int bi = it / per, r = it - bi * per, kb = r / nbn, nb = r - kb * nbn, k0 = 64 * kb, n0 = 32 * nb;
        const float* W = src + (size_t)bi * Kr * Nr; h16* WT = dst + (size_t)bi * Np * Kp;
        float vals[32];
#pragma unroll
        for (int i = 0; i < 32; ++i) { const int k = k0 + 2 * i + (lane >> 5), n = n0 + (lane & 31); vals[i] = (k < Kr && n < Nr) ? W[(size_t)k * Nr + n] : 0.f; }
#pragma unroll
        for (int i = 0; i < 32; ++i) { float x = vals[i]; if (perm == 2) x = (x - (float)(h16)x) * 4096.0f; scr[(2 * i + (lane >> 5)) * 33 + (lane & 31)] = x; }
        LDS_WAIT();
        const int c = lane & 7;
#pragma unroll
        for (int j = 0; j < 4; ++j) { const int nl = (lane >> 3) + 8 * j; const LAS float* s = scr + (8 * c) * 33 + nl;
            u32x4 o; o.x = pkh(s[0 * 33], s[1 * 33]); o.y = pkh(s[2 * 33], s[3 * 33]); o.z = pkh(s[4 * 33], s[5 * 33]); o.w = pkh(s[6 * 33], s[7 * 33]);
            int n = n0 + nl; if (perm == 1) n = ((n & 1023) >> 7) * 256 + (n >> 10) * 128 + (n & 127);
            if (perm == 3) { const int c5 = n & 31; n = (n & ~31) | (16 * ((c5 >> 2) & 1) + 4 * (c5 >> 3) + (c5 & 3)); }
            *(u32x4*)(WT + (size_t)n * Kp + k0 + 8 * c) = o; }
        LDS_WAIT();
    }
}


__device__ __forceinline__ void conv_batch8(const float* src, int batch, int Kr, int Nr, unsigned char* dst, int Kp, int Np, int perm, float scale, LAS float* scr, int gw_, int NGW_, int lane) {
    lane = lane_id(); OPAQUE(lane);
    const int kbn = Kp / 128, nbn = Np / 32, per = kbn * nbn, total = batch * per;
    for (int it = gw_; it < total; it += NGW_) {
        const int bi = it / per, r = it - bi * per, kb = r / nbn, nb = r - kb * nbn, k0 = 128 * kb, n0 = 32 * nb;
        const float* W = src + (size_t)bi * Kr * Nr; unsigned char* WT = dst + (size_t)bi * Np * Kp;
        float vals[64];
#pragma unroll
        for (int i = 0; i < 64; ++i) { const int k = k0 + 2 * i + (lane >> 5), n = n0 + (lane & 31); vals[i] = (k < Kr && n < Nr) ? W[(size_t)k * Nr + n] : 0.f; }
#pragma unroll
        for (int i = 0; i < 64; ++i) scr[(2 * i + (lane >> 5)) * 33 + (lane & 31)] = vals[i] * scale;
        LDS_WAIT();
        const int c = lane & 7;
#pragma unroll
        for (int j = 0; j < 4; ++j) { const int nl = (lane >> 3) + 8 * j; const LAS float* sp = scr + (16 * c) * 33 + nl; u32x4 o;
#pragma unroll
            for (int q = 0; q < 4; ++q) { int w_ = __builtin_amdgcn_cvt_pk_fp8_f32(sp[(4 * q) * 33], sp[(4 * q + 1) * 33], 0, false); w_ = __builtin_amdgcn_cvt_pk_fp8_f32(sp[(4 * q + 2) * 33], sp[(4 * q + 3) * 33], w_, true); o[q] = (unsigned)w_; }
            int n = n0 + nl; if (perm) n = ((n & 1023) >> 7) * 256 + (n >> 10) * 128 + (n & 127);
            *(u32x4*)(WT + (size_t)n * Kp + k0 + 16 * c) = o; }
        LDS_WAIT();
    }
}

struct Unit { int pm, pn, kind, e, rows, rbase; const char* A; const char* B; const int* list; };

struct DenseDesc { const char* A; const char* B; int kind, pn; };

namespace pg8 {
constexpr int BM = 256, BK = 64, HALF = 128, HTB = HALF * BK * 2, STAGE_BYTES = 8 * HTB;
__device__ __forceinline__ int lds_byte(int r, int c) { const int st = (r >> 4) * 2 + (c >> 5), rr = r & 15, cc = c & 31, ob = rr * 64 + cc * 2; return st * 1024 + (ob ^ (((ob >> 9) & 1) << 5)); }
__device__ __forceinline__ void stage_rc(int b, int& R, int& C) { const int st = b / 1024, sb = b % 1024, swz = sb ^ (((sb >> 9) & 1) << 5); R = (st >> 1) * 16 + swz / 64; C = (st & 1) * 32 + (swz % 64) / 2; }
}
typedef int i32x4 __attribute__((ext_vector_type(4)));
typedef int i32x8 __attribute__((ext_vector_type(8)));
template <bool FP8, class Sched, class Epi>
__device__ __forceinline__ void gemm_phase_pg8(LAS unsigned char* lds, const Sched& S, const Epi& E, const int Kb, const int wave) {
    using namespace pg8;
    int tid = wave * 64 + lane_id(); OPAQUE(tid);
    const int wid = wave, lane = tid & 63, wr = wid >> 2, wc = wid & 3, fr = lane & 15, fq = lane >> 4;
    const int nt = Kb / 128;
    int Rs[2], Cs[2]; unsigned voffB[2];
#pragma unroll
    for (int i = 0; i < 2; ++i) { stage_rc(tid * 16 + i * 8192, Rs[i], Cs[i]); voffB[i] = (unsigned)(Rs[i] * Kb + Cs[i] * 2); }
    const size_t kstep = (size_t)128;
    const size_t hstepB = (size_t)HALF * Kb;
    const unsigned ldsw = (unsigned)wid * 1024u;
    const int aoff = lds_byte(wr * 64 + fr, fq * 8), boff = lds_byte(wc * 32 + fr, fq * 8);
#define PG8_SA(b, h) (((b) * 2 + (h)) * HTB)
#define PG8_SB(b, h) ((4 + (b) * 2 + (h)) * HTB)
#define PG8_STAGE(bufoff, gbase, voff) do { _Pragma("unroll") for (int _i = 0; _i < 2; ++_i) \
        __builtin_amdgcn_global_load_lds((const unsigned*)((const char*)(gbase) + (voff)[_i]), (LAS unsigned*)(lds + (bufoff) + ldsw + _i * 8192), 16, 0, 0); } while (0)
#define PG8_LDA(dst, b, h) do { _Pragma("unroll") for (int m = 0; m < 4; ++m) _Pragma("unroll") for (int k = 0; k < 2; ++k) dst[m][k] = *(const LAS h16x8*)(lds + PG8_SA(b, h) + aoff + m * 2048 + k * 1024); } while (0)
#define PG8_LDB(dst, b, h) do { _Pragma("unroll") for (int n = 0; n < 2; ++n) _Pragma("unroll") for (int k = 0; k < 2; ++k) dst[n][k] = *(const LAS h16x8*)(lds + PG8_SB(b, h) + boff + n * 2048 + k * 1024); } while (0)
#define PG8_MMA(ai, bj, At, Bt) do { __builtin_amdgcn_s_setprio(1); \
        if (FP8) { _Pragma("unroll") for (int m = 0; m < 4; ++m) _Pragma("unroll") for (int n = 0; n < 2; ++n) { \
            const i32x4 b0_ = __builtin_bit_cast(i32x4, Bt[n][0]), b1_ = __builtin_bit_cast(i32x4, Bt[n][1]), a0_ = __builtin_bit_cast(i32x4, At[m][0]), a1_ = __builtin_bit_cast(i32x4, At[m][1]); \
            acc[ai][bj][m][n] = __builtin_amdgcn_mfma_scale_f32_16x16x128_f8f6f4(__builtin_shufflevector(b0_, b1_, 0, 1, 2, 3, 4, 5, 6, 7), __builtin_shufflevector(a0_, a1_, 0, 1, 2, 3, 4, 5, 6, 7), acc[ai][bj][m][n], 0, 0, 0, 0, 0, 0); } } \
        else { _Pragma("unroll") for (int m = 0; m < 4; ++m) _Pragma("unroll") for (int n = 0; n < 2; ++n) _Pragma("unroll") for (int k = 0; k < 2; ++k) \
            acc[ai][bj][m][n] = __builtin_amdgcn_mfma_f32_16x16x32_f16(Bt[n][k], At[m][k], acc[ai][bj][m][n], 0, 0, 0); } \
        __builtin_amdgcn_s_setprio(0); } while (0)
#define PG8_WAIT_V(n) asm volatile("s_waitcnt vmcnt(" #n ")" ::: "memory")
#define PG8_WAIT_L(n) asm volatile("s_waitcnt lgkmcnt(" #n ")" ::: "memory")
#define PG8_BAR __builtin_amdgcn_s_barrier()
#define PG8_SCHED __builtin_amdgcn_sched_barrier(0)
    Unit cur, nxt; int ui = 0;
    if (!S.next(0, cur)) return;
    f32x4 acc[2][2][4][2];
#pragma unroll
    for (int a = 0; a < 2; ++a)
#pragma unroll
        for (int b = 0; b < 2; ++b)
#pragma unroll
            for (int m = 0; m < 4; ++m)
#pragma unroll
                for (int n = 0; n < 2; ++n) acc[a][b][m][n] = (f32x4){0.f, 0.f, 0.f, 0.f};
    h16x8 At[4][2], B0[2][2], B1[2][2];
    unsigned vA[2][2], vAn[2][2];
#pragma unroll
    for (int h = 0; h < 2; ++h)
#pragma unroll
        for (int i = 0; i < 2; ++i) vA[h][i] = S.a_off(cur, 128 * h + Rs[i]) + (unsigned)Cs[i] * 2u;
    const char* cA = cur.A; const char* cB = cur.B;
    PG8_STAGE(PG8_SB(0, 0), cB, voffB); PG8_STAGE(PG8_SB(0, 1), cB + hstepB, voffB); PG8_STAGE(PG8_SA(0, 0), cA, vA[0]); PG8_STAGE(PG8_SA(0, 1), cA, vA[1]);
    if (wr == 1) PG8_BAR;
    PG8_WAIT_V(2); PG8_BAR;
    PG8_STAGE(PG8_SB(1, 0), cB + kstep, voffB); PG8_STAGE(PG8_SA(1, 0), cA + kstep, vA[0]); PG8_STAGE(PG8_SB(1, 1), cB + hstepB + kstep, voffB);
    PG8_WAIT_V(6); PG8_BAR;
    for (;;) {
        const bool has_next = S.next(ui + 1, nxt);
        const char* nA = has_next ? nxt.A : cA; const char* nB = has_next ? nxt.B : cB;
#pragma unroll
        for (int h = 0; h < 2; ++h)
#pragma unroll
            for (int i = 0; i < 2; ++i) vAn[h][i] = has_next ? (S.a_off(nxt, 128 * h + Rs[i]) + (unsigned)Cs[i] * 2u) : vA[h][i];
#pragma unroll 1
        for (int t = 0; t < nt; t += 2) {
            const bool last = (t == nt - 2);
            const char* a1 = cA + (size_t)(t + 1) * kstep;
            const char* a2 = last ? nA : cA + (size_t)(t + 2) * kstep; const char* b2 = last ? nB : cB + (size_t)(t + 2) * kstep;
            const char* a3 = a2 + kstep; const char* b3 = b2 + kstep;
            PG8_LDB(B0, 0, 0); PG8_LDB(B1, 0, 1); PG8_SCHED; PG8_LDA(At, 0, 0); PG8_STAGE(PG8_SA(1, 1), a1, vA[1]);
            if (last) { vA[0][0] = vAn[0][0]; vA[0][1] = vAn[0][1]; vA[1][0] = vAn[1][0]; vA[1][1] = vAn[1][1]; }
            PG8_WAIT_V(8); PG8_WAIT_L(0); PG8_BAR; PG8_MMA(0, 0, At, B0); PG8_MMA(0, 1, At, B1); PG8_BAR; PG8_SCHED;
            PG8_LDA(At, 0, 1); PG8_STAGE(PG8_SB(0, 0), b2, voffB); PG8_STAGE(PG8_SB(0, 1), b2 + hstepB, voffB); PG8_STAGE(PG8_SA(0, 0), a2, vA[0]);
            PG8_WAIT_V(8); PG8_WAIT_L(0); PG8_BAR; PG8_MMA(1, 0, At, B0); PG8_MMA(1, 1, At, B1); PG8_BAR; PG8_SCHED;
            PG8_LDB(B0, 1, 0); PG8_LDB(B1, 1, 1); PG8_SCHED; PG8_LDA(At, 1, 0); PG8_STAGE(PG8_SA(0, 1), a2, vA[1]);
            PG8_WAIT_V(8); PG8_WAIT_L(0); PG8_BAR; PG8_MMA(0, 0, At, B0); PG8_MMA(0, 1, At, B1); PG8_BAR; PG8_SCHED;
            PG8_LDA(At, 1, 1); PG8_STAGE(PG8_SB(1, 0), b3, voffB); PG8_STAGE(PG8_SB(1, 1), b3 + hstepB, voffB); PG8_STAGE(PG8_SA(1, 0), a3, vA[0]);
            PG8_WAIT_V(8); PG8_WAIT_L(0); PG8_BAR; PG8_MMA(1, 0, At, B0); PG8_MMA(1, 1, At, B1); PG8_BAR; PG8_SCHED;
        }
        if (wr == 0) PG8_BAR;
        { int fr_e = fr, fq_e = fq; OPAQUE(fr_e); OPAQUE(fq_e);
          E(acc, cur, wr, wc, fr_e, fq_e); }
        if (!has_next) break;
#pragma unroll
        for (int a = 0; a < 2; ++a)
#pragma unroll
            for (int b = 0; b < 2; ++b)
#pragma unroll
                for (int m = 0; m < 4; ++m)
#pragma unroll
                    for (int n = 0; n < 2; ++n) acc[a][b][m][n] = (f32x4){0.f, 0.f, 0.f, 0.f};
        cur = nxt; cA = nA; cB = nB; ++ui;
        if (wr == 1) PG8_BAR;
    }
    PG8_WAIT_V(0);
    PG8_BAR;
#undef PG8_SA
#undef PG8_SB
#undef PG8_STAGE
#undef PG8_LDA
#undef PG8_LDB
#undef PG8_MMA
#undef PG8_WAIT_V
#undef PG8_WAIT_L
#undef PG8_BAR
#undef PG8_SCHED
}
#define GEMM_PHASE(S, E, K) gemm_phase_pg8<false>(lds, S, E, (K) * 2, wave)
#define GEMM_PHASE8(S, E, K) gemm_phase_pg8<true>(lds, S, E, (K), wave)

#define FOR_ACC2(ai, bj, m) _Pragma("unroll") for (int ai = 0; ai < 2; ++ai) _Pragma("unroll") for (int m = 0; m < 4; ++m) _Pragma("unroll") for (int bj = 0; bj < 2; ++bj)
#define FOR_ACC(ai, bj, m, n) _Pragma("unroll") for (int ai = 0; ai < 2; ++ai) _Pragma("unroll") for (int m = 0; m < 4; ++m) _Pragma("unroll") for (int bj = 0; bj < 2; ++bj) _Pragma("unroll") for (int n = 0; n < 2; ++n)
#define EPI_FENCE() asm volatile("" ::: "memory")

template <bool F16IN>
__device__ __forceinline__ void phase_prep(const void* Xv, const float* mix, h16* XM, int gw_, int NGW_, int lane) {
    lane = lane_id(); OPAQUE(lane);
    const float* Xf = (const float*)Xv; const h16* Xh = (const h16*)Xv;
    for (int ch = gw_; ch < T / 16; ch += NGW_) {
        const int t0 = ch * 16;
        f32x4 prev[4];
        if ((t0 % SEQ) == 0) {
#pragma unroll
            for (int j = 0; j < 4; ++j) prev[j] = (f32x4){0.f, 0.f, 0.f, 0.f};
        } else {
#pragma unroll
            for (int j = 0; j < 4; ++j) prev[j] = F16IN ? ldh4(Xh + (size_t)(t0 - 1) * D + 256 * j + 4 * lane) : *(const f32x4*)(Xf + (size_t)(t0 - 1) * D + 256 * j + 4 * lane);
        }
#pragma unroll 1
        for (int ib = 0; ib < 4; ++ib) {
            f32x4 cur[4][4]; h16x4 curh[4][4];
#pragma unroll
            for (int q = 0; q < 4; ++q)
#pragma unroll
                for (int j = 0; j < 4; ++j) { if (F16IN) curh[q][j] = *(const h16x4*)(Xh + (size_t)(t0 + 4 * ib + q) * D + 256 * j + 4 * lane); else cur[q][j] = *(const f32x4*)(Xf + (size_t)(t0 + 4 * ib + q) * D + 256 * j + 4 * lane); }
            if (F16IN) {
#pragma unroll
                for (int q = 0; q < 4; ++q)
#pragma unroll
                    for (int j = 0; j < 4; ++j) cur[q][j] = __builtin_convertvector(curh[q][j], f32x4);
            }
#pragma unroll
            for (int q = 0; q < 4; ++q) {
                const int t = t0 + 4 * ib + q;
#pragma unroll
                for (int s = 0; s < 6; ++s) {
#pragma unroll
                    for (int j = 0; j < 4; ++j) { const f32x4 mx = *(const f32x4*)(mix + s * D + 256 * j + 4 * lane);
                        const f32x4 pv = (q == 0) ? prev[j] : cur[q == 0 ? 0 : q - 1][j];
                        const f32x4 v = cur[q][j] + (pv - cur[q][j]) * mx;
                        __builtin_nontemporal_store(pkh4(v), (u32x2*)(XM + ((size_t)s * T + t) * D + 256 * j + 4 * lane)); }
                }
            }
#pragma unroll
            for (int j = 0; j < 4; ++j) prev[j] = cur[3][j];
        }
    }
}

struct ScanArgs { const h16 *R, *K, *V; const h16* WD; const h16 *AA, *GG; const float *k_k, *k_a, *r_k, *lnx_g, *lnx_b; h16* YG; const float *wgu, *wdn; unsigned char *gu8, *dn8; int layer_pair; };
__device__ __forceinline__ float row16_sum(float v) { v += dppf<0xB1>(v); v += dppf<0x4E>(v); v += dppf<0x141>(v); v += dppf<0x140>(v); return v; }
struct ConvItem2 { const float* Wrow; unsigned char* WTp; int Nr; float scale; bool valid; };
__device__ __forceinline__ ConvItem2 conv_item2(int sit, int wave, int lane, int layer_pair, const float* wgu, const float* wdn, unsigned char* gu8) {
    ConvItem2 ci; ci.valid = sit < 12288;
    const int s = ci.valid ? sit : 0, ls = s / 6144, r = s - ls * 6144, e = r / 192, q = r - e * 192, le = (layer_pair * 2 + ls) * 32 + e;
    const bool gu = q < 128; const int q2 = gu ? q : q - 128, nb = gu ? (q2 & 31) : (q2 & 15), kq = gu ? (q2 >> 5) : (q2 >> 4), Nr = gu ? 2048 : 1024;
    const int k0 = kq * 256 + wave * 32, n = nb * 64 + lane, c5 = n & 31, p5 = 16 * ((c5 >> 2) & 1) + 4 * (c5 >> 3) + (c5 & 3), np = (n & ~31) | p5;
    const int c8 = n & 255, pdn = (n & ~255) | (128 * ((c8 >> 3) & 1) + 32 * (c8 >> 6) + 16 * ((c8 >> 2) & 1) + 4 * ((c8 >> 4) & 3) + (c8 & 3));
    const int nrow = gu ? ((np & 1023) >> 7) * 256 + (np >> 10) * 128 + (np & 127) : pdn;
    size_t wb; { const int gi = __builtin_amdgcn_readfirstlane(gu ? 1 : 0); asm("s_cmp_lg_u32 %1, 0\n\ts_cselect_b64 %0, %2, %3" : "=s"(wb) : "s"(gi), "s"(wgu), "s"(wdn) : "scc"); }
    const size_t ob = (size_t)gu8 + (gu ? (size_t)0 : (size_t)(WS_W_DN - WS_W_GU));
    ci.Wrow = (const float*)wb + (size_t)le * 1024 * Nr + (size_t)k0 * Nr + nb * 64; ci.WTp = (unsigned char*)ob + (size_t)le * Nr * 1024 + (size_t)nrow * 1024 + k0; ci.Nr = Nr; ci.scale = gu ? GU_SCALE : DN_SCALE;
    return ci;
}
__device__ __forceinline__ void conv_issue2(const ConvItem2& ci, float (&vals)[32], int lane) {
    if (ci.valid) {
        const GAS char* p = (const GAS char*)ci.Wrow; const unsigned lo = (unsigned)lane * 4u; const size_t stride = (size_t)ci.Nr * 4;
#pragma unroll
        for (int i = 0; i < 32; ++i) { vals[i] = __builtin_nontemporal_load((const GAS float*)(p + lo)); p += stride; }
    }
}
__device__ __forceinline__ void conv_finish2(const ConvItem2& ci, const float (&vals)[32]) {
    if (ci.valid) {
#pragma unroll
        for (int j = 0; j < 2; ++j) { u32x4 o;
#pragma unroll
            for (int q = 0; q < 4; ++q) { int pk_ = __builtin_amdgcn_cvt_pk_fp8_f32(vals[16 * j + 4 * q] * ci.scale, vals[16 * j + 4 * q + 1] * ci.scale, 0, false);
                pk_ = __builtin_amdgcn_cvt_pk_fp8_f32(vals[16 * j + 4 * q + 2] * ci.scale, vals[16 * j + 4 * q + 3] * ci.scale, pk_, true); o[q] = (unsigned)pk_; }
            *(u32x4*)(ci.WTp + 16 * j) = o; }
    }
}
__device__ __forceinline__ float row16_reduce_scatter(const float (&q)[16], int lane) {
    const bool b0 = lane & 1, b1 = lane & 2, b2 = lane & 4, b3 = lane & 8;
    float v[16], a[8], c[4], d[2];
#pragma unroll
    for (int s = 0; s < 16; ++s) v[s] = q[((s & 1) << 3) | ((s & 2) << 1) | ((s & 4) >> 1) | ((s & 8) >> 3)];
#pragma unroll
    for (int j = 0; j < 8; ++j) a[j] = (b0 ? v[j + 8] : v[j]) + dppf<0xB1>(b0 ? v[j] : v[j + 8]);
#pragma unroll
    for (int j = 0; j < 4; ++j) c[j] = (b1 ? a[j + 4] : a[j]) + dppf<0x4E>(b1 ? a[j] : a[j + 4]);
#pragma unroll
    for (int j = 0; j < 2; ++j) d[j] = (b2 ? c[j + 2] : c[j]) + dppf<0x124>(b2 ? c[j] : c[j + 2]);
    return (b3 ? d[1] : d[0]) + dppf<0x128>(b3 ? d[0] : d[1]);
}
#define WBAR() do { asm volatile("s_waitcnt lgkmcnt(0)" ::: "memory"); __builtin_amdgcn_s_barrier(); asm volatile("" ::: "memory"); } while (0)
__device__ __forceinline__ void phase_scan_mm(const ScanArgs& a, LAS unsigned char* lds, int blk, int G, const int wave) {
    constexpr int NG = 4, PCH = 13120;
    constexpr int O_AT = 0, O_RT = 2304, O_BBT = 4608, O_KBT = 6656, O_VT = 8704, O_MKT = 10752, O_TMT = 11264, O_NBT = 11776, O_NKT = 12288, O_GC = 12800, O_SRK = 13056;
    constexpr int TMP0 = NG * PCH, TMPB = 5632;
    constexpr int O_SY = TMP0 + 4 * TMPB, O_VO = O_SY + 2 * 16640, O_SRKO = O_VO + 2 * 8192, O_RED = O_SRKO + 512;
    int pass = 0;
    for (int bh = blk; bh < NBATCH * 16; bh += G, ++pass) {
        int tid0 = wave * 64 + lane_id(); OPAQUE(tid0);
        const int b = bh >> 4, h = bh & 15, chn0 = h * 64 + (tid0 & 63);
        const float kkc = a.k_k[chn0], kac = a.k_a[chn0], rkc = a.r_k[chn0], lg = a.lnx_g[chn0], lb = a.lnx_b[chn0];
        f32x4 ST[4];
#pragma unroll
        for (int kt = 0; kt < 4; ++kt) ST[kt] = (f32x4){0.f, 0.f, 0.f, 0.f};
        h16 qr[8], qk[8], qv[8], qa[8], qw[8];
        const int c4w = wave >> 1, hfw = wave & 1;
#pragma unroll
        for (int i = 0; i < 8; ++i) { const size_t tb = ((size_t)bh * SEQ + c4w * 16 + 8 * hfw) * 64 + (tid0 & 63);
            qr[i] = a.R[tb + i * 64]; qk[i] = a.K[tb + i * 64]; qv[i] = a.V[tb + i * 64]; qa[i] = a.AA[tb + i * 64]; qw[i] = a.WD[tb + i * 64]; }
        LAS float* gpr = (LAS float*)(lds + O_RED + 1024);
#define GPROD() ((((1.0f - (float)qw[0]) * (1.0f - (float)qw[1])) * ((1.0f - (float)qw[2]) * (1.0f - (float)qw[3]))) * (((1.0f - (float)qw[4]) * (1.0f - (float)qw[5])) * ((1.0f - (float)qw[6]) * (1.0f - (float)qw[7]))))
        gpr[wave * 64 + (tid0 & 63)] = GPROD();
        WBAR();
        h16 qg[16];
        float cv[32];
        ConvItem2 ci = conv_item2(((pass * 32 + 0) * 2 + 0) * G + blk, wave, tid0 & 63, a.layer_pair, a.wgu, a.wdn, a.gu8);
        conv_issue2(ci, cv, tid0 & 63);
#define OUT_STAGE(gp_) do { const int gp = (gp_); LAS float* red = (LAS float*)(lds + O_RED) + wave * 32; const LAS float* syo = (const LAS float*)(lds + O_SY) + (gp & 1) * (64 * 65); \
            const LAS h16* voo = (const LAS h16*)(lds + O_VO) + (gp & 1) * 4096; const LAS float* srko = (const LAS float*)(lds + O_SRKO) + (gp & 1) * 64; \
            _Pragma("unroll") for (int bt = 0; bt < 2; ++bt) { const int t0 = (wave - 4) * 16 + 8 * bt; float yv[8], q[16]; \
                _Pragma("unroll") for (int p = 0; p < 8; ++p) { yv[p] = syo[(t0 + p) * 65 + lane]; q[p] = yv[p]; q[8 + p] = yv[p] * yv[p]; } \
                float x = row16_reduce_scatter(q, lane); x += swz16f(x); \
                if ((lane & 16) == 0) red[(lane >> 5) * 16 + l16] = x; \
                LDS_WAIT(); \
                f32x4 s1[2], s2[2]; \
                _Pragma("unroll") for (int hq = 0; hq < 2; ++hq) { s1[hq] = *(const LAS f32x4*)(red + 4 * hq) + *(const LAS f32x4*)(red + 16 + 4 * hq); s2[hq] = *(const LAS f32x4*)(red + 8 + 4 * hq) + *(const LAS f32x4*)(red + 24 + 4 * hq); } \
                _Pragma("unroll") for (int p = 0; p < 8; ++p) { const int tt = t0 + p; \
                    const float mu = s1[p >> 2][p & 3] * (1.0f / 64.0f), var = fmaxf(s2[p >> 2][p & 3] * (1.0f / 64.0f) - mu * mu, 0.0f); \
                    float yn = (yv[p] - mu) * rsqrtf(var + 64e-5f) * lg + lb; yn += srko[tt] * (float)voo[tt * 64 + lane]; \
                    a.YG[((size_t)b * SEQ + gp * 64 + tt) * D + chn] = (h16)(yn * (float)qg[8 * bt + p]); } \
                LDS_WAIT(); } } while (0)
#pragma unroll 1
        for (int grp = 0; grp < SEQ / 64; ++grp) {
            int tid = tid0; OPAQUE(tid);
            const int lane = tid & 63, g4 = lane >> 4, l16 = lane & 15, chn = h * 64 + lane;
            {
                LAS unsigned char* pc = lds + c4w * PCH; LAS unsigned char* tb = lds + TMP0 + c4w * TMPB;
                LAS h16* At = (LAS h16*)(pc + O_AT); LAS h16* Rt = (LAS h16*)(pc + O_RT); LAS h16* BbT = (LAS h16*)(pc + O_BBT); LAS h16* KbT = (LAS h16*)(pc + O_KBT); LAS h16* Vt = (LAS h16*)(pc + O_VT);
                LAS h16* MkT = (LAS h16*)(pc + O_MKT); LAS h16* TmT = (LAS h16*)(pc + O_TMT); LAS h16* NbT = (LAS h16*)(pc + O_NBT); LAS h16* NkT = (LAS h16*)(pc + O_NKT);
                LAS float* gC = (LAS float*)(pc + O_GC); LAS float* srk = (LAS float*)(pc + O_SRK);
                LAS h16* Bh = (LAS h16*)tb; LAS h16* Kh = (LAS h16*)(tb + 2304); LAS float* MbF = (LAS float*)(tb + 4608);
                float wf[8];
#pragma unroll
                for (int i = 0; i < 8; ++i) wf[i] = 1.0f - (float)qw[i];
                if (grp + 1 < SEQ / 64) {
#pragma unroll
                    for (int i = 0; i < 8; ++i) qw[i] = a.WD[((size_t)bh * SEQ + (grp + 1) * 64 + c4w * 16 + 8 * hfw) * 64 + lane + i * 64];
                }
                const float gown = ((wf[0] * wf[1]) * (wf[2] * wf[3])) * ((wf[4] * wf[5]) * (wf[6] * wf[7])), goth = gpr[(wave ^ 1) * 64 + lane];
                const float gall = gown * goth;
                float gam = hfw ? goth : 1.0f, bhr[8], khr[8];
                LAS float* red = (LAS float*)(lds + O_RED) + wave * 32;
                float n2s[8];
                {
                    float q[16];
#pragma unroll
                    for (int i = 0; i < 8; ++i) { const float k = (float)qk[i], kk = k * kkc; q[i] = kk * kk; q[8 + i] = (float)qr[i] * (k * (1.0f + ((float)qa[i] - 1.0f) * kac)) * rkc; }
                    float x = row16_reduce_scatter(q, lane); x += swz16f(x);
                    if ((lane & 16) == 0) red[(lane >> 5) * 16 + l16] = x;
                    LDS_WAIT();
                    const f32x4 r0 = *(const LAS f32x4*)(red), r1 = *(const LAS f32x4*)(red + 4), r2 = *(const LAS f32x4*)(red + 16), r3 = *(const LAS f32x4*)(red + 20);
#pragma unroll
                    for (int i = 0; i < 4; ++i) { n2s[i] = r0[i] + r2[i]; n2s[4 + i] = r1[i] + r3[i]; }
                    const float rks = red[8 + (lane & 7)] + red[24 + (lane & 7)];
                    if (lane < 8) ((LAS float*)(lds + O_SRKO))[(grp & 1) * 64 + 16 * c4w + 8 * hfw + lane] = rks;
                }
#pragma unroll
                for (int i = 0; i < 8; ++i) {
                    const int tt = 8 * hfw + i;
                    const float r = (float)qr[i], k = (float)qk[i], v = (float)qv[i], w = wf[i], aa = (float)qa[i];
                    const float kk = k * kkc; const float kkn = kk * __builtin_amdgcn_rsqf(fmaxf(n2s[i], 1e-24f));
                    const float kmod = k * (1.0f + (aa - 1.0f) * kac);
                    At[tt * 72 + lane] = (h16)(gam * -kkn);
                    gam *= w; const float rg = __builtin_amdgcn_rcpf(gam);
                    bhr[i] = fminf(fmaxf(kkn * aa * rg, -6.0e4f), 6.0e4f); khr[i] = fminf(fmaxf(kmod * rg, -6.0e4f), 6.0e4f);
                    Bh[tt * 72 + lane] = (h16)bhr[i]; Kh[tt * 72 + lane] = (h16)khr[i];
                    Rt[tt * 72 + lane] = (h16)(gam * r); ((LAS h16*)(lds + O_VO))[((grp & 1) * 64 + 16 * c4w + tt) * 64 + lane] = (h16)v;
                }
                if (hfw == 0) gC[lane] = gall;
                {
                    u32x4 pb, pk;
#pragma unroll
                    for (int q = 0; q < 4; ++q) { pb[q] = pkh(bhr[2 * q] * gall, bhr[2 * q + 1] * gall); pk[q] = pkh(khr[2 * q] * gall, khr[2 * q + 1] * gall); }
                    *(LAS u32x4*)(BbT + lane * 16 + 8 * hfw) = pb; *(LAS u32x4*)(KbT + lane * 16 + 8 * hfw) = pk;
                }
                conv_finish2(ci, cv);
                if (grp + 1 < SEQ / 64) {
#pragma unroll
                    for (int i = 0; i < 8; ++i) { const size_t tb = ((size_t)bh * SEQ + (grp + 1) * 64 + c4w * 16 + 8 * hfw) * 64 + lane;
                        qr[i] = a.R[tb + i * 64]; qk[i] = a.K[tb + i * 64]; qv[i] = a.V[tb + i * 64]; qa[i] = a.AA[tb + i * 64]; }
                }
                ci = conv_item2(((pass * 32 + grp) * 2 + 1) * G + blk, wave, lane, a.layer_pair, a.wgu, a.wdn, a.gu8);
                conv_issue2(ci, cv, lane);
                WBAR();
                if (hfw == 0) {
                    f32x4 mb = {0.f, 0.f, 0.f, 0.f}, mt = mb;
#pragma unroll
                    for (int s = 0; s < 2; ++s) { const int fo = l16 * 72 + 32 * s + 8 * g4; const h16x8 fb = *(const LAS h16x8*)(Bh + fo), fa = *(const LAS h16x8*)(At + fo);
                        mb = __builtin_amdgcn_mfma_f32_16x16x32_f16(fb, fa, mb, 0, 0, 0);
                        mt = __builtin_amdgcn_mfma_f32_16x16x32_f16(fa, fb, mt, 0, 0, 0); }
                    f32x4 td, ttd;
#pragma unroll
                    for (int e = 0; e < 4; ++e) { const int i = 4 * g4 + e; mb[e] = (i < l16) ? mb[e] : 0.f; mt[e] = (l16 < i) ? mt[e] : 0.f; const float dg = (i == l16) ? 1.0f : 0.0f; td[e] = mb[e] + dg; ttd[e] = mt[e] + dg; }
                    h16x4 xb = __builtin_convertvector(mb, h16x4), xa = __builtin_convertvector(mt, h16x4);
#pragma unroll
                    for (int s = 0; s < 3; ++s) {
                        const f32x4 z4 = {0.f, 0.f, 0.f, 0.f};
                        const f32x4 sq = __builtin_amdgcn_mfma_f32_16x16x16f16(xa, xb, z4, 0, 0, 0);
                        const f32x4 sqt = __builtin_amdgcn_mfma_f32_16x16x16f16(xb, xa, z4, 0, 0, 0);
                        xb = __builtin_convertvector(sq, h16x4); xa = __builtin_convertvector(sqt, h16x4);
                        const h16x4 ta = __builtin_convertvector(ttd, h16x4);
                        td = __builtin_amdgcn_mfma_f32_16x16x16f16(ta, xb, td, 0, 0, 0);
                        if (s < 2) ttd = __builtin_amdgcn_mfma_f32_16x16x16f16(xb, ta, ttd, 0, 0, 0);
                    }
                    *(LAS u32x2*)(TmT + l16 * 16 + 4 * g4) = pkh4(td);
                } else {
                    f32x4 mk = {0.f, 0.f, 0.f, 0.f}, nb = mk, nk = mk;
#pragma unroll
                    for (int s = 0; s < 2; ++s) {
                        const int fo = l16 * 72 + 32 * s + 8 * g4;
                        const h16x8 fb = *(const LAS h16x8*)(Bh + fo), fk = *(const LAS h16x8*)(Kh + fo), fa = *(const LAS h16x8*)(At + fo), fr = *(const LAS h16x8*)(Rt + fo);
                        mk = __builtin_amdgcn_mfma_f32_16x16x32_f16(fk, fa, mk, 0, 0, 0); nb = __builtin_amdgcn_mfma_f32_16x16x32_f16(fb, fr, nb, 0, 0, 0); nk = __builtin_amdgcn_mfma_f32_16x16x32_f16(fk, fr, nk, 0, 0, 0);
                    }
#pragma unroll
                    for (int e = 0; e < 4; ++e) { const int i = 4 * g4 + e; const bool lt = i < l16, le = i <= l16; mk[e] = lt ? mk[e] : 0.f; nb[e] = le ? nb[e] : 0.f; nk[e] = le ? nk[e] : 0.f; }
                    *(LAS u32x2*)(MkT + l16 * 16 + 4 * g4) = pkh4(mk); *(LAS u32x2*)(NbT + l16 * 16 + 4 * g4) = pkh4(nb); *(LAS u32x2*)(NkT + l16 * 16 + 4 * g4) = pkh4(nk);
                }
            }
            WBAR();
            if (wave < 4) {
                LAS float* sy = (LAS float*)(lds + O_SY) + (grp & 1) * (64 * 65);
#pragma unroll 2
                for (int c4 = 0; c4 < NG; ++c4) {
                    LAS unsigned char* pc = lds + c4 * PCH;
                    const LAS h16* At = (const LAS h16*)(pc + O_AT); const LAS h16* Rt = (const LAS h16*)(pc + O_RT); const LAS h16* BbT = (const LAS h16*)(pc + O_BBT); const LAS h16* KbT = (const LAS h16*)(pc + O_KBT);
                    const LAS h16* Vt = (const LAS h16*)(pc + O_VT); const LAS h16* MkT = (const LAS h16*)(pc + O_MKT); const LAS h16* TmT = (const LAS h16*)(pc + O_TMT);
                    const LAS h16* NbT = (const LAS h16*)(pc + O_NBT); const LAS h16* NkT = (const LAS h16*)(pc + O_NKT); const LAS float* gC = (const LAS float*)(pc + O_GC);
                    h16x4 sb[4];
#pragma unroll
                    for (int kt = 0; kt < 4; ++kt) sb[kt] = __builtin_convertvector(ST[kt], h16x4);
                    h16x4 vb;
                    { const LAS h16* vsrc = (const LAS h16*)(lds + O_VO) + ((grp & 1) * 64 + 16 * c4 + 4 * g4) * 64 + 16 * wave + l16;
#pragma unroll
                      for (int e = 0; e < 4; ++e) vb[e] = vsrc[e * 64]; }
                    f32x4 accW = {0.f, 0.f, 0.f, 0.f}, accY = {0.f, 0.f, 0.f, 0.f};
#pragma unroll
                    for (int kt = 0; kt < 4; ++kt) {
                        accW = __builtin_amdgcn_mfma_f32_16x16x16f16(*(const LAS h16x4*)(At + l16 * 72 + 16 * kt + 4 * g4), sb[kt], accW, 0, 0, 0);
                        accY = __builtin_amdgcn_mfma_f32_16x16x16f16(*(const LAS h16x4*)(Rt + l16 * 72 + 16 * kt + 4 * g4), sb[kt], accY, 0, 0, 0);
                    }
                    accW = __builtin_amdgcn_mfma_f32_16x16x16f16(*(const LAS h16x4*)(MkT + l16 * 16 + 4 * g4), vb, accW, 0, 0, 0);
                    accY = __builtin_amdgcn_mfma_f32_16x16x16f16(*(const LAS h16x4*)(NkT + l16 * 16 + 4 * g4), vb, accY, 0, 0, 0);
                    const h16x4 wb = __builtin_convertvector(accW, h16x4);
                    const f32x4 accU = __builtin_amdgcn_mfma_f32_16x16x16f16(*(const LAS h16x4*)(TmT + l16 * 16 + 4 * g4), wb, (f32x4){0.f, 0.f, 0.f, 0.f}, 0, 0, 0);
                    const h16x4 ub = __builtin_convertvector(accU, h16x4);
                    accY = __builtin_amdgcn_mfma_f32_16x16x16f16(*(const LAS h16x4*)(NbT + l16 * 16 + 4 * g4), ub, accY, 0, 0, 0);
#pragma unroll
                    for (int kt = 0; kt < 4; ++kt) {
                        ST[kt] = ST[kt] * *(const LAS f32x4*)(gC + 16 * kt + 4 * g4);
                        ST[kt] = __builtin_amdgcn_mfma_f32_16x16x16f16(*(const LAS h16x4*)(BbT + (16 * kt + l16) * 16 + 4 * g4), ub, ST[kt], 0, 0, 0);
                        ST[kt] = __builtin_amdgcn_mfma_f32_16x16x16f16(*(const LAS h16x4*)(KbT + (16 * kt + l16) * 16 + 4 * g4), vb, ST[kt], 0, 0, 0);
                    }
#pragma unroll
                    for (int e = 0; e < 4; ++e) sy[(16 * c4 + 4 * g4 + e) * 65 + 16 * wave + l16] = accY[e];
                }
            }
            else {
                if (grp > 0) OUT_STAGE(grp - 1);
#pragma unroll
                for (int j = 0; j < 16; ++j) qg[j] = a.GG[((size_t)bh * SEQ + grp * 64 + (wave - 4) * 16) * 64 + lane + j * 64];
            }
            conv_finish2(ci, cv);
            ci = conv_item2(((pass * 32 + grp + 1) * 2 + 0) * G + blk, wave, lane, a.layer_pair, a.wgu, a.wdn, a.gu8);
            if (grp + 1 < SEQ / 64) { conv_issue2(ci, cv, lane); gpr[wave * 64 + lane] = GPROD(); }
            WBAR();
        }
#undef GPROD
        if (wave >= 4) { const int lane = lane_id(), l16 = lane & 15, chn = h * 64 + lane; OUT_STAGE(SEQ / 64 - 1); }
#undef OUT_STAGE
    }
}

__device__ __forceinline__ float row16_max(float v) { v = fmaxf(v, dppf<0xB1>(v)); v = fmaxf(v, dppf<0x4E>(v)); v = fmaxf(v, dppf<0x141>(v)); v = fmaxf(v, dppf<0x140>(v)); return v; }
struct RouterArgs { const h16* H; const float *g, *b; const h16* WRS; const float* rb; h16* X1; unsigned char* XB; float* TOPG; int* LIST; unsigned* CNT; };
__device__ __forceinline__ void phase_ln_router(const RouterArgs& a, LAS unsigned char* lds, int blk, int G, const int wave) {
    constexpr int WPB = 2064;
    LAS unsigned* hcnt = (LAS unsigned*)(lds + 132096); LAS unsigned* hbase = hcnt + 32; LAS unsigned* pe = hbase + 32; LAS unsigned* pp = pe + 512;
    int tid = wave * 64 + lane_id(); OPAQUE(tid);
    const int lane = tid & 63, ex = lane & 15, kg = lane >> 4;
    for (int c = tid; c < 2 * 32 * 128; c += NTHR) { const int row = c >> 7, ch = c & 127; *(LAS u32x4*)(lds + row * WPB + ch * 16) = *(const u32x4*)((const char*)a.WRS + (size_t)row * 2048 + ch * 16); }
    const float rb0 = a.rb[ex], rb1 = a.rb[16 + ex];
    for (int tb = blk; tb < T / 128; tb += G) {
        if (tid < 32) hcnt[tid] = 0u;
        __syncthreads();
        const size_t tw = (size_t)tb * 128 + wave * 16;
#pragma unroll 1
        for (int ib = 0; ib < 4; ++ib) {
            f32x4 vv[4][4]; h16x4 vh[4][4];
#pragma unroll
            for (int q = 0; q < 4; ++q)
#pragma unroll
                for (int j = 0; j < 4; ++j) vh[q][j] = *(const h16x4*)(a.H + (tw + 4 * ib + q) * D + 256 * j + 4 * lane);
#pragma unroll
            for (int q = 0; q < 4; ++q)
#pragma unroll
                for (int j = 0; j < 4; ++j) vv[q][j] = __builtin_convertvector(vh[q][j], f32x4);
#pragma unroll
            for (int q = 0; q < 4; ++q) {
                const size_t t = tw + 4 * ib + q; float s1 = 0.f;
#pragma unroll
                for (int j = 0; j < 4; ++j) s1 += (vv[q][j].x + vv[q][j].y) + (vv[q][j].z + vv[q][j].w);
                const float mean = wave_sum(s1) * (1.0f / D); float s2 = 0.f;
#pragma unroll
                for (int j = 0; j < 4; ++j) { vv[q][j] = vv[q][j] - mean; s2 += (vv[q][j].x * vv[q][j].x + vv[q][j].y * vv[q][j].y) + (vv[q][j].z * vv[q][j].z + vv[q][j].w * vv[q][j].w); }
                const float rstd = rsqrtf(wave_sum(s2) * (1.0f / D) + LN_EPS);
#pragma unroll
                for (int j = 0; j < 4; ++j) { const f32x4 o = vv[q][j] * rstd * *(const f32x4*)(a.g + 256 * j + 4 * lane) + *(const f32x4*)(a.b + 256 * j + 4 * lane);
                    *(u32x2*)(a.X1 + t * D + 256 * j + 4 * lane) = pkh4(o);
                    int pk_ = __builtin_amdgcn_cvt_pk_fp8_f32(o.x, o.y, 0, false); pk_ = __builtin_amdgcn_cvt_pk_fp8_f32(o.z, o.w, pk_, true);
                    *(unsigned*)(a.XB + t * D + 256 * j + 4 * lane) = (unsigned)pk_; }
            }
        }
        asm volatile("s_waitcnt vmcnt(0)" ::: "memory");
        f32x4 cA[2], cB[2];
        cA[0] = cA[1] = cB[0] = cB[1] = (f32x4){0.f, 0.f, 0.f, 0.f};
        const h16* xrow = a.X1 + (tw + ex) * D + 8 * kg;
        const LAS unsigned char* bh = lds + ex * WPB + kg * 16; const LAS unsigned char* bl = bh + 32 * WPB;
#pragma unroll 8
        for (int ks = 0; ks < 32; ++ks) {
            const h16x8 xh = *(const h16x8*)(xrow + 32 * ks);
#pragma unroll
            for (int tI = 0; tI < 2; ++tI) {
                const h16x8 wh = *(const LAS h16x8*)(bh + tI * 16 * WPB + ks * 64), wl = *(const LAS h16x8*)(bl + tI * 16 * WPB + ks * 64);
                cA[tI] = __builtin_amdgcn_mfma_f32_16x16x32_f16(xh, wh, cA[tI], 0, 0, 0);
                cB[tI] = __builtin_amdgcn_mfma_f32_16x16x32_f16(xh, wl, cB[tI], 0, 0, 0);
            }
        }
#pragma unroll
        for (int e = 0; e < 4; ++e) {
            float c0 = cA[0][e] + cB[0][e] * (1.0f / 4096.0f) + rb0, c1 = cA[1][e] + cB[1][e] * (1.0f / 4096.0f) + rb1;
            int sel[4]; float val[4];
#pragma unroll
            for (int k = 0; k < 4; ++k) {
                const float m = row16_max(fmaxf(c0, c1));
                const unsigned r0 = (unsigned)(__ballot(c0 == m) >> (16 * kg)) & 0xFFFFu, r1 = (unsigned)(__ballot(c1 == m) >> (16 * kg)) & 0xFFFFu;
                const int hit0 = r0 != 0u; const int wl_ = hit0 ? __builtin_ctz(r0) : __builtin_ctz(r1 | 0x10000u);
                sel[k] = hit0 ? wl_ : 16 + wl_; val[k] = m;
                if (ex == wl_) { if (hit0) c0 = -INFINITY; else c1 = -INFINITY; }
            }
            const float e1 = __expf(val[1] - val[0]), e2 = __expf(val[2] - val[0]), e3 = __expf(val[3] - val[0]);
            const float inv = 1.0f / (1.0f + e1 + e2 + e3);
            if (ex < 4) {
                const int tl = wave * 16 + 4 * kg + e; const size_t t = (size_t)tb * 128 + tl;
                const int mysel = ex == 0 ? sel[0] : ex == 1 ? sel[1] : ex == 2 ? sel[2] : sel[3];
                const float myg = (ex == 0 ? 1.0f : ex == 1 ? e1 : ex == 2 ? e2 : e3) * inv;
                a.TOPG[t * 4 + ex] = myg;
                const unsigned pos = __hip_atomic_fetch_add(hcnt + mysel, 1u, __ATOMIC_RELAXED, __HIP_MEMORY_SCOPE_WORKGROUP);
                pe[tl * 4 + ex] = (unsigned)mysel; pp[tl * 4 + ex] = pos;
            }
        }
        __syncthreads();
        if (tid < 32) hbase[tid] = __hip_atomic_fetch_add(a.CNT + tid, hcnt[tid], __ATOMIC_RELAXED, __HIP_MEMORY_SCOPE_AGENT);
        __syncthreads();
        { const unsigned e = pe[tid]; a.LIST[(size_t)e * ECAP + hbase[e] + pp[tid]] = tb * 512 + tid; }
        __syncthreads();
    }
}

__device__ __forceinline__ void phase_combine(const h16* X1, const unsigned char* YS, const float* g, const float* b, float* Xo  , h16* XH  , int gw_, int NGW_, int lane) {
    lane = lane_id(); OPAQUE(lane);
#pragma unroll 1
    for (int t0 = gw_; t0 < T; t0 += 2 * NGW_) {
        h16x4 x[2][4]; unsigned y[2][4][4];
#pragma unroll
        for (int q = 0; q < 2; ++q) { const size_t t = (size_t)t0 + (size_t)q * NGW_;
#pragma unroll
            for (int j = 0; j < 4; ++j) { x[q][j] = *(const h16x4*)(X1 + t * D + 256 * j + 4 * lane);
#pragma unroll
                for (int k = 0; k < 4; ++k) y[q][j][k] = *(const unsigned*)(YS + (t * 4 + k) * D + 256 * j + 4 * lane); } }
#pragma unroll
        for (int q = 0; q < 2; ++q) { const size_t t = (size_t)t0 + (size_t)q * NGW_;
            f32x4 v[4]; float s = 0.f;
#pragma unroll
            for (int j = 0; j < 4; ++j) { f32x4 ysum = (f32x4){0.f, 0.f, 0.f, 0.f};
#pragma unroll
                for (int k = 0; k < 4; ++k) { const f32x2 lo = __builtin_amdgcn_cvt_pk_f32_fp8((int)y[q][j][k], false), hi = __builtin_amdgcn_cvt_pk_f32_fp8((int)y[q][j][k], true); ysum += (f32x4){lo.x, lo.y, hi.x, hi.y}; }
                v[j] = __builtin_convertvector(x[q][j], f32x4) * ALPHA + ysum * (1.0f / YS_SCALE);
                s += (v[j].x + v[j].y) + (v[j].z + v[j].w); }
            const float mean = wave_sum(s) * (1.0f / D); float s2 = 0.f;
#pragma unroll
            for (int j = 0; j < 4; ++j) { v[j] = v[j] - mean; s2 += (v[j].x * v[j].x + v[j].y * v[j].y) + (v[j].z * v[j].z + v[j].w * v[j].w); }
            const float rstd = rsqrtf(wave_sum(s2) * (1.0f / D) + LN_EPS);
#pragma unroll
            for (int j = 0; j < 4; ++j) { v[j] = v[j] * rstd * *(const f32x4*)(g + 256 * j + 4 * lane) + *(const f32x4*)(b + 256 * j + 4 * lane);
                if (Xo) *(f32x4*)(Xo + t * D + 256 * j + 4 * lane) = v[j]; else *(u32x2*)(XH + t * D + 256 * j + 4 * lane) = pkh4(v[j]); }
        }
    }
}

#include <cmath>
namespace attn_body {
using bf16=_Float16;
using bf16x8=__attribute__((ext_vector_type(8)))short;
using s16x4=__attribute__((ext_vector_type(4)))short;
using f32x16=__attribute__((ext_vector_type(16)))float;
using u32x4=__attribute__((ext_vector_type(4)))unsigned;
constexpr int SEQ=2048,D=64,DM=1024,DMO=2048;
constexpr int NW=8,QBLK=32,QB=QBLK*NW,KVBLK=64,NQB=SEQ/QB;
typedef _Float16 f16x8_t __attribute__((ext_vector_type(8)));
#define MFMA32(a,b,c) __builtin_amdgcn_mfma_f32_32x32x16_f16(__builtin_bit_cast(f16x8_t,(a)),__builtin_bit_cast(f16x8_t,(b)),(c),0,0,0)
__device__ __forceinline__ int crow(int r,int hi){return (r&3)+8*(r>>2)+4*hi;}
#define SBAR() __builtin_amdgcn_sched_barrier(0)
__device__ __forceinline__ void cmask(f32x16&p0,f32x16&p1,int jb,int qrel,int hi){
  const float NEG=-INFINITY; int kb=64*jb+4*hi;
  #pragma unroll
  for(int r=0;r<16;++r){int kv=kb+(r&3)+8*(r>>2); if(kv>qrel)p0[r]=NEG; if(kv+32>qrel)p1[r]=NEG;}
}

constexpr int NSLOT=3, SLOTB=8192;
constexpr int LDS_K=0, LDS_V=NSLOT*SLOTB, LDS_WS=2*NSLOT*SLOTB, LDS_OST=LDS_WS+NW*64*4, LDS_BYTES=LDS_OST+NW*4096;
constexpr float C2=0.125f*1.4426950408889634f;
__device__ __forceinline__ void glds16(const void*gsrc,unsigned lds_dst){unsigned keep;
  asm volatile("s_mov_b32 %0, m0\n\ts_mov_b32 m0, %2\n\ts_nop 0\n\tglobal_load_lds_dwordx4 %1, off\n\ts_mov_b32 m0, %0":"=&s"(keep):"v"(gsrc),"s"(lds_dst):"memory");}
__device__ __forceinline__ float max3f(float a,float b,float c){float r;asm("v_max3_f32 %0, %1, %2, %3":"=v"(r):"v"(a),"v"(b),"v"(c));return r;}
__device__ __forceinline__ float max2f(float a,float b){float r;asm("v_max_f32_e32 %0, %1, %2":"=v"(r):"v"(a),"v"(b));return r;}
__device__ __forceinline__ float fadd_s(float a,float b){float r;asm("v_add_f32_e32 %0, %1, %2":"=v"(r):"v"(a),"v"(b));return r;}
__device__ __forceinline__ float fsub_s(float a,float b){float r;asm("v_sub_f32_e32 %0, %1, %2":"=v"(r):"v"(a),"v"(b));return r;}
typedef float f32x2_t __attribute__((ext_vector_type(2))); typedef _Float16 bf16x2_t __attribute__((ext_vector_type(2)));
__device__ __forceinline__ unsigned cvtpk_s(float lo,float hi){f32x2_t v={lo,hi};bf16x2_t b=__builtin_convertvector(v,bf16x2_t);return __builtin_bit_cast(unsigned,b);}
#define WAIT_BAR(N) asm volatile("s_waitcnt vmcnt(" #N ") lgkmcnt(0)\n\ts_barrier":::"memory")

__device__ __forceinline__ void qkt(f32x16&p0,f32x16&p1,const char*Kslot,const bf16x8*qr,const f32x16&negm,int r32,int hi){
  const char*kb=Kslot+hi*1024+r32*16;
  #pragma unroll
  for(int d0=0;d0<4;++d0){
    const bf16x8 b0=*reinterpret_cast<const bf16x8*>(kb+d0*2048);
    const bf16x8 b1=*reinterpret_cast<const bf16x8*>(kb+d0*2048+512);
    if(d0==0){p0=MFMA32(b0,qr[0],negm);p1=MFMA32(b1,qr[0],negm);}
    else{p0=MFMA32(b0,qr[d0],p0);p1=MFMA32(b1,qr[d0],p1);}}
}
typedef __attribute__((address_space(3))) const char* lds_cptr;
typedef short v4i16_t __attribute__((ext_vector_type(4)));
__device__ __forceinline__ void kload8(bf16x8*kf,lds_cptr kp){
  kf[0]=*(const __attribute__((address_space(3))) bf16x8*)(kp);      kf[1]=*(const __attribute__((address_space(3))) bf16x8*)(kp+512);
  kf[2]=*(const __attribute__((address_space(3))) bf16x8*)(kp+2048); kf[3]=*(const __attribute__((address_space(3))) bf16x8*)(kp+2560);
  kf[4]=*(const __attribute__((address_space(3))) bf16x8*)(kp+4096); kf[5]=*(const __attribute__((address_space(3))) bf16x8*)(kp+4608);
  kf[6]=*(const __attribute__((address_space(3))) bf16x8*)(kp+6144); kf[7]=*(const __attribute__((address_space(3))) bf16x8*)(kp+6656);
}
__device__ __forceinline__ void kload2(bf16x8*kf,lds_cptr kp,int j){ kf[2*j]=*(const __attribute__((address_space(3))) bf16x8*)(kp+j*2048); kf[2*j+1]=*(const __attribute__((address_space(3))) bf16x8*)(kp+j*2048+512); }
__device__ __forceinline__ s16x4 vtr(lds_cptr p){ return __builtin_bit_cast(s16x4,__builtin_amdgcn_ds_read_tr16_b64_v4i16((__attribute__((address_space(3))) v4i16_t*)p)); }
__device__ __forceinline__ float rowmax(const f32x16&p0,const f32x16&p1){
  float a=max3f(p0[0],p0[1],p1[0]),b=max3f(p0[2],p0[3],p1[1]);a=max3f(a,p1[2],p1[3]);
  #pragma unroll
  for(int r=4;r<16;r+=4){a=max3f(a,p0[r],p0[r+1]);b=max3f(b,p0[r+2],p0[r+3]);a=max3f(a,p1[r],p1[r+1]);b=max3f(b,p1[r+2],p1[r+3]);}
  const float m=max2f(a,b);
  auto rr=__builtin_amdgcn_permlane32_swap(__float_as_uint(m),__float_as_uint(m),false,false);
  return max2f(__uint_as_float(rr[0]),__uint_as_float(rr[1]));
}
__device__ __forceinline__ void pv(f32x16*o,int vb,bf16x8 pa0,bf16x8 pa1,bf16x8 pa2,bf16x8 pa3){
  #pragma unroll
  for(int d0=0;d0<2;++d0){s16x4 lo[4],hi[4];
    #pragma unroll
    for(int ks=0;ks<4;++ks){
      asm volatile("ds_read_b64_tr_b16 %0,%1 offset:%c2":"=&v"(lo[ks]):"v"(vb),"i"(d0*4096+ks*1024):"memory");
      asm volatile("ds_read_b64_tr_b16 %0,%1 offset:%c2":"=&v"(hi[ks]):"v"(vb),"i"(d0*4096+ks*1024+512):"memory");}
    asm volatile("s_waitcnt lgkmcnt(0)":::"memory");SBAR();
    #define PK(k) (bf16x8){lo[k][0],lo[k][1],lo[k][2],lo[k][3],hi[k][0],hi[k][1],hi[k][2],hi[k][3]}
    o[d0]=MFMA32(pa0,PK(0),o[d0]);
    o[d0]=MFMA32(pa1,PK(1),o[d0]);
    o[d0]=MFMA32(pa2,PK(2),o[d0]);
    o[d0]=MFMA32(pa3,PK(3),o[d0]);
    #undef PK
  }
}

#ifndef ATTN_STORE16
#define ATTN_STORE16(p,v) (*(u32x4*)(p)=(v))
#endif
template<int THRL> __device__ __forceinline__ void attn_unit(int b,int qcol,int vcol,int ocol,float slope2,int qb,int ts,const bf16*Q,const bf16*__restrict__ K,const bf16*__restrict__ V,bf16*O,char*shm,const int wid){
  int lane; asm volatile("v_mbcnt_lo_u32_b32 %0, -1, 0\n\tv_mbcnt_hi_u32_b32 %0, -1, %0":"=v"(lane)); const int r32=lane&31,hi=lane>>5;
  const long rowbase=(long)b*SEQ; const int q0=qb*QB;
  const bf16*Qw=Q+(rowbase+q0+wid*QBLK)*DM+qcol;
  const bf16*Kh=K+(rowbase+(long)ts*KVBLK)*DM+qcol,*Vh=V+(rowbase+(long)ts*KVBLK)*DM+vcol;
  const unsigned lds0=(unsigned)(uintptr_t)shm;
  float*wsf=(float*)(shm+LDS_WS)+wid*64;
  const bf16*ksrc=Kh+(long)lane*DM+wid*8;
  const bf16*vsrc=Vh+(long)(16*(wid&3)+(lane>>2))*DM+(wid>>2)*32+(lane&3)*8;
  const unsigned kdst=lds0+LDS_K+wid*1024, vdst=lds0+LDS_V+wid*1024;
  #define DMA_K(t,slot) glds16(ksrc+(long)(t)*KVBLK*DM,(unsigned)__builtin_amdgcn_readfirstlane(kdst+(slot)))
  #define DMA_V(t,slot) glds16(vsrc+(long)(t)*KVBLK*DM,(unsigned)__builtin_amdgcn_readfirstlane(vdst+(slot)))
  const int vb0=(int)(lds0+LDS_V)+((lane>>4)&1)*32+(lane&3)*8+(4*hi+((lane&15)>>2))*64;
  const char*Kbase=shm+LDS_K; bf16x8 kf[8];
  const lds_cptr shm3=(lds_cptr)shm; const lds_cptr kp0=shm3+LDS_K+hi*1024+r32*16; const lds_cptr vp0=shm3+LDS_V+((lane>>4)&1)*32+(lane&3)*8+(4*hi+((lane&15)>>2))*64;
  const int NT=(q0+QB)/KVBLK-ts;
  DMA_K(0,0);DMA_V(0,0);DMA_K(1,SLOTB);
  bf16x8 qr[4];
  #pragma unroll
  for(int d0=0;d0<4;++d0)qr[d0]=*reinterpret_cast<const bf16x8*>(&Qw[(long)r32*DM+d0*16+hi*8]);
  float mhat=0.f,l_reg=0.f;f32x16 o[2];o[0]=f32x16{};o[1]=f32x16{};f32x16 negm;
  const float delta=64.f*slope2,c32=32.f*slope2;
  _Pragma("unroll") for(int r=0;r<16;++r)negm[r]=slope2*(float)crow(r,hi); asm volatile("":"+v"(negm));
  const int qrel=wid*QBLK+r32;
  #define CMASK(P0,P1,t) do{int jb_=(t)-(NT-4); if(jb_>=0)cmask(P0,P1,jb_,qrel,hi);}while(0)
  bool resc=false;
  #define START(P0,P1) do{ const float rm=rowmax(P0,P1); resc=false; \
    { const float dl=rm; mhat=fadd_s(mhat,dl); \
      _Pragma("unroll") for(int r=0;r<16;++r){P0[r]=fsub_s(P0[r],dl);P1[r]=fsub_s(P1[r],dl);} \
      _Pragma("unroll") for(int r=0;r<16;++r)negm[r]-=dl; asm volatile("":"+v"(negm)); } \
    _Pragma("unroll") for(int r=0;r<16;++r)P0[r]=__builtin_amdgcn_exp2f(P0[r]); }while(0)
  #define RESC() do{ if(resc){ asm volatile("s_waitcnt lgkmcnt(0)":::"memory"); \
      _Pragma("unroll") for(int d_=0;d_<2;++d_) _Pragma("unroll") for(int r=0;r<16;++r)o[d_][r]*=wsf[crow(r,hi)]; } }while(0)
  f32x16 pA0,pA1,pB0,pB1;
  int sl_prev=0,sl_cur=0,sl_next=SLOTB;
  #define ROT() do{sl_prev=sl_cur;sl_cur=sl_next;sl_next=(sl_next==(NSLOT-1)*SLOTB)?0:sl_next+SLOTB;}while(0)
  DMA_K(2,2*SLOTB);
  WAIT_BAR(3);
  qkt(pA0,pA1,Kbase,qr,negm,r32,hi);asm volatile("s_nop 15\n\ts_nop 7":"+v"(pA0),"+v"(pA1)); _Pragma("unroll") for(int r=0;r<16;++r)pA1[r]+=c32; CMASK(pA0,pA1,0);
  START(pA0,pA1);
  _Pragma("unroll") for(int r=0;r<16;++r)pA1[r]=__builtin_amdgcn_exp2f(pA1[r]);
  WAIT_BAR(0);
  DMA_K(3,0);DMA_V(1,SLOTB);
  ROT();
  kload8(kf,kp0+sl_cur);
  WAIT_BAR(2);
  s16x4 vlo[8],vhi[8]; u32x4 pw0,pw1,pw2,pw3;
  #define PKW(P,B) cvtpk_s(P[B],P[B+1])
  #define PAF(k) __builtin_bit_cast(bf16x8,pw##k)
  #define VFR(i) (bf16x8){vlo[i][0],vlo[i][1],vlo[i][2],vlo[i][3],vhi[i][0],vhi[i][1],vhi[i][2],vhi[i][3]}
  #define PIN(x) asm volatile("":"+v"(x))
  #define MX3(a,b,c) __builtin_fmaxf(__builtin_fmaxf((a),(b)),(c))
  #define GAPA(MF,A0,A1,A2,A3,W0,W1,PW) do{ MF; sacc+=A0; sacc+=A1; sacc+=A2; sacc+=A3; PIN(sacc); W0; W1; PIN(PW); SBAR(); }while(0)
  #define EX(v) __builtin_amdgcn_exp2f(v)
  #define GAPB(MF,X,B) do{ MF; X[B]=EX(X[B]); X[B+1]=EX(X[B+1]); X[B+2]=EX(X[B+2]); X[B+3]=EX(X[B+3]); PIN(X); SBAR(); }while(0)
  #define VRD(i) do{ vlo[i]=vtr(vp_+(((i)>>2)*4096+((i)&3)*1024)); vhi[i]=vtr(vp_+(((i)>>2)*4096+((i)&3)*1024+512)); }while(0)
  #define KRD(G,j) do{ if(G){ kload2(kf,kp0+sl_next,j); SBAR(); } }while(0)
  #define STEP(C0,C1,P0,P1,t,GK,GV,GL) do{ SBAR(); \
    _Pragma("unroll") for(int r=0;r<16;++r)negm[r]+=delta; asm volatile("":"+v"(negm)); \
    const lds_cptr vp_=vp0+sl_prev; \
    VRD(0); SBAR(); float sacc=(P0[0]+P0[1]); \
    GAPA(C0=MFMA32(kf[0],qr[0],negm), P0[2],P0[3],P0[4],P0[5],     pw0[0]=PKW(P0,0), pw0[1]=PKW(P0,2), pw0); \
    VRD(4); SBAR(); GAPA(C1=MFMA32(kf[1],qr[0],negm), P0[6],P0[7],P0[8],P0[9],     pw0[2]=PKW(P0,4), pw0[3]=PKW(P0,6), pw0); \
    VRD(1); SBAR(); GAPA(C0=MFMA32(kf[2],qr[1],C0),   P0[10],P0[11],P0[12],P0[13], pw1[0]=PKW(P0,8), pw1[1]=PKW(P0,10), pw1); \
    VRD(5); SBAR(); GAPA(C1=MFMA32(kf[3],qr[1],C1),   P0[14],P0[15],P1[0],P1[1],   pw1[2]=PKW(P0,12),pw1[3]=PKW(P0,14), pw1); \
    VRD(2); SBAR(); GAPA(C0=MFMA32(kf[4],qr[2],C0),   P1[2],P1[3],P1[4],P1[5],     pw2[0]=PKW(P1,0), pw2[1]=PKW(P1,2), pw2); \
    VRD(6); SBAR(); GAPA(C1=MFMA32(kf[5],qr[2],C1),   P1[6],P1[7],P1[8],P1[9],     pw2[2]=PKW(P1,4), pw2[3]=PKW(P1,6), pw2); \
    VRD(3); SBAR(); GAPA(C0=MFMA32(kf[6],qr[3],C0),   P1[10],P1[11],P1[12],P1[13], pw3[0]=PKW(P1,8), pw3[1]=PKW(P1,10), pw3); \
    VRD(7); SBAR(); GAPA(C1=MFMA32(kf[7],qr[3],C1),   P1[14],P1[15],0.f,0.f,       pw3[2]=PKW(P1,12),pw3[3]=PKW(P1,14), pw3); \
    l_reg+=sacc; \
    if(GK){DMA_K((t)+3,sl_cur);} if(GV){DMA_V((t)+1,sl_next);} \
    _Pragma("unroll") for(int r=0;r<16;++r)C1[r]+=c32; \
    CMASK(C0,C1,t); \
    { float a=MX3(C0[0],C0[1],C1[0]),b=MX3(C0[2],C0[3],C1[1]); a=MX3(a,C1[2],C1[3]); \
      _Pragma("unroll") for(int r=4;r<16;r+=4){a=MX3(a,C0[r],C0[r+1]);b=MX3(b,C0[r+2],C0[r+3]);a=MX3(a,C1[r],C1[r+1]);b=MX3(b,C1[r+2],C1[r+3]);} \
      float rm=__builtin_fmaxf(a,b); { auto rr=__builtin_amdgcn_permlane32_swap(__float_as_uint(rm),__float_as_uint(rm),false,false); rm=__builtin_fmaxf(__uint_as_float(rr[0]),__uint_as_float(rr[1])); } \
      resc=false; \
      if(__builtin_expect(__any(rm>(float)THRL),0)){ const float dl=__builtin_fmaxf(rm,0.f); mhat+=dl; \
        _Pragma("unroll") for(int r=0;r<16;++r){C0[r]-=dl;C1[r]-=dl;} \
        _Pragma("unroll") for(int r=0;r<16;++r)negm[r]-=dl; asm volatile("":"+v"(negm)); \
        const float f=__builtin_amdgcn_exp2f(-dl); l_reg*=f; if(hi==0)wsf[r32]=f; resc=true; } } \
    SBAR(); \
    GAPB(o[0]=MFMA32(PAF(0),VFR(0),o[0]), C0,0); \
    GAPB(o[1]=MFMA32(PAF(0),VFR(4),o[1]), C0,4); \
    KRD(GL,0); GAPB(o[0]=MFMA32(PAF(1),VFR(1),o[0]), C0,8); \
    KRD(GL,1); GAPB(o[1]=MFMA32(PAF(1),VFR(5),o[1]), C0,12); \
    KRD(GL,2); GAPB(o[0]=MFMA32(PAF(2),VFR(2),o[0]), C1,0); \
    KRD(GL,3); GAPB(o[1]=MFMA32(PAF(2),VFR(6),o[1]), C1,4); \
    GAPB(o[0]=MFMA32(PAF(3),VFR(3),o[0]), C1,8); \
    GAPB(o[1]=MFMA32(PAF(3),VFR(7),o[1]), C1,12); \
    }while(0)
  int t=1;
  #undef CMASK
  #define CMASK(P0,P1,t) do{}while(0)
  for(;t+5<NT;t+=2){
    STEP(pB0,pB1,pA0,pA1,t,true,true,true);     WAIT_BAR(2); RESC(); ROT();
    STEP(pA0,pA1,pB0,pB1,t+1,true,true,true);   WAIT_BAR(2); RESC(); ROT();
  }
  #undef CMASK
  #define CMASK(P0,P1,t) do{int jb_=(t)-(NT-4); if(jb_>=0)cmask(P0,P1,jb_,qrel,hi);}while(0)
  #define ENDW(tt) do{ if((tt)+3<NT){WAIT_BAR(2);} else if((tt)+2<NT){WAIT_BAR(1);} else {WAIT_BAR(0);} }while(0)
  for(;t+1<NT;t+=2){
    STEP(pB0,pB1,pA0,pA1,t,(t+3<NT),(t+1<NT),(t+1<NT));       ENDW(t);   RESC(); ROT();
    STEP(pA0,pA1,pB0,pB1,t+1,(t+4<NT),(t+2<NT),(t+2<NT));     ENDW(t+1); RESC(); ROT();
  }
  STEP(pB0,pB1,pA0,pA1,NT-1,false,false,false); RESC();
  { float sacc=pB0[0]+pB0[1]; _Pragma("unroll") for(int r=2;r<16;++r)sacc+=pB0[r]; _Pragma("unroll") for(int r=0;r<16;++r)sacc+=pB1[r]; l_reg+=sacc;
    pw0=(u32x4){PKW(pB0,0),PKW(pB0,2),PKW(pB0,4),PKW(pB0,6)};pw1=(u32x4){PKW(pB0,8),PKW(pB0,10),PKW(pB0,12),PKW(pB0,14)};pw2=(u32x4){PKW(pB1,0),PKW(pB1,2),PKW(pB1,4),PKW(pB1,6)};pw3=(u32x4){PKW(pB1,8),PKW(pB1,10),PKW(pB1,12),PKW(pB1,14)};
    SBAR(); pv(o,vb0+sl_cur,PAF(0),PAF(1),PAF(2),PAF(3)); }
  #undef PKW
  #undef PAF
  #undef VFR
  #undef PIN
  #undef MX3
  #undef GAPA
  #undef GAPB
  #undef EX
  #undef VRD
  #undef KRD
  #undef STEP
  #undef ENDW
  {auto rr=__builtin_amdgcn_permlane32_swap(__float_as_uint(l_reg),__float_as_uint(l_reg),false,false);l_reg=__uint_as_float(rr[0])+__uint_as_float(rr[1]);}
  if(hi==0)wsf[32+r32]=l_reg;asm volatile("s_waitcnt lgkmcnt(0)":::"memory");
  float rli[16];
  #pragma unroll
  for(int r=0;r<16;++r)rli[r]=__builtin_amdgcn_rcpf(wsf[32+crow(r,hi)]);
  bf16*Ow=O+(rowbase+q0+wid*QBLK)*DMO+ocol;
  { bf16*stg=(bf16*)(shm+LDS_OST)+wid*2048;
    #pragma unroll
    for(int r=0;r<16;++r){const int orow=crow(r,hi);
      #pragma unroll
      for(int d0=0;d0<2;++d0)stg[orow*64+d0*32+r32]=(bf16)(o[d0][r]*rli[r]);}
    asm volatile("s_waitcnt lgkmcnt(0)":::"memory");
    #pragma unroll
    for(int i=0;i<4;++i){const int row=i*8+(lane>>3),ch=lane&7; const u32x4 v=*(const u32x4*)(stg+row*64+ch*8); ATTN_STORE16(Ow+(long)row*DMO+ch*8,v);} }
  asm volatile("s_waitcnt lgkmcnt(0)\n\ts_barrier":::"memory");
  #undef DMA_K
  #undef DMA_V
  #undef CMASK
  #undef START
  #undef RESC
  #undef ROT
}
}
#undef SBAR
#undef WAIT_BAR
#undef MFMA32
__device__ const unsigned char ATT_H[64] = {5,6,7,5,6,7,5,6,7,4,4,4,4,5,6,7,4,5,6,7,3,3,3,3,3,3,4,5,6,7,2,2,2,2,2,2,1,1,1,1,1,1,1,2,3,4,5,6,7,0,0,0,0,0,0,0,0,1,2,3,4,5,6,7};
__device__ const unsigned char ATT_Q[64] = {7,7,7,6,6,6,5,5,5,5,6,7,4,4,4,4,3,3,3,3,3,4,5,6,7,2,2,2,2,2,2,3,4,5,6,7,1,2,3,4,5,6,7,1,1,1,1,1,1,1,2,3,4,5,6,7,0,0,0,0,0,0,0,0};
__device__ const unsigned char ATT_S[64] = {0,0,0,0,0,0,0,0,0,2,6,10,0,0,0,0,0,0,0,0,2,6,10,14,18,0,0,0,0,0,2,6,10,14,18,22,0,4,8,12,16,20,24,0,0,0,0,0,0,2,6,10,14,18,22,26,0,0,0,0,0,0,0,0};
__device__ __forceinline__ void phase_attn(const h16* Q, const h16* KK, const h16* VV, h16* ORAW, char* lds_generic, int blk, int G, const int wave) {
    const int vcu = (G % 8 == 0) ? (blk % 8) * (G / 8) + blk / 8 : blk;
#pragma unroll 1
    for (int r = 0; r < 16; ++r) {
        const int p = r * 256 + ((r & 1) ? 255 - vcu : vcu), ci = p >> 6, u = p & 63;
        const int hh = ATT_H[ci], qb = ATT_Q[ci], ts = ATT_S[ci], b = u >> 2, c = (u >> 1) & 1, vh = u & 1;
        const float slope2 = exp2f(-(float)(hh + 1)) * LOG2E;
        attn_body::attn_unit<8>(b, hh * 128 + c * 64, hh * 128 + vh * 64, c * 1024 + hh * 128 + vh * 64, slope2, qb, ts, Q, KK, VV, ORAW, lds_generic, wave);
    }
}

__device__ __forceinline__ float row16_sum(float v);
__device__ __forceinline__ void phase_attn_combine(const h16* ORAW, const float* lamv  , const float* subg  , float lambda_init, h16* OB, int gw_, int NGW_, int lane) {
    lane = lane_id(); OPAQUE(lane);
    const float la = wave_sum(lamv[lane] * lamv[64 + lane]), lb = wave_sum(lamv[128 + lane] * lamv[192 + lane]);
    const float lam = __expf(la) - __expf(lb) + lambda_init;
    const int hs = lane >> 5, d = (lane & 31) * 4;
    const f32x4 gsc = *(const f32x4*)(subg + d) * (1.0f - lambda_init);
#pragma unroll 1
    for (int t0 = gw_; t0 < T; t0 += 2 * NGW_) {
        h16x4 a[2][4], b[2][4];
#pragma unroll
        for (int q = 0; q < 2; ++q) { const size_t t = (size_t)t0 + (size_t)q * NGW_;
#pragma unroll
            for (int hp = 0; hp < 4; ++hp) { const int hh = 2 * hp + hs; a[q][hp] = *(const h16x4*)(ORAW + t * 2048 + hh * 128 + d); b[q][hp] = *(const h16x4*)(ORAW + t * 2048 + 1024 + hh * 128 + d); } }
#pragma unroll
        for (int q = 0; q < 2; ++q) { const size_t t = (size_t)t0 + (size_t)q * NGW_;
#pragma unroll
            for (int hp = 0; hp < 4; ++hp) { const int hh = 2 * hp + hs;
                const f32x4 o = __builtin_convertvector(a[q][hp], f32x4) - __builtin_convertvector(b[q][hp], f32x4) * lam;
                float ss = (o.x * o.x + o.y * o.y) + (o.z * o.z + o.w * o.w); ss = row16_sum(ss); ss += swz16f(ss);
                const float r = rsqrtf(ss * (1.0f / 128.0f) + 1e-5f);
                *(u32x2*)(OB + t * 1024 + hh * 128 + d) = pkh4(o * r * gsc); } }
    }
}

struct SchedRkv {
    const char* XM; const char* Wrkv; const char* Wl1; int nk, G, c;
    __device__ __forceinline__ bool next(int i, Unit& u) const {
        int pm, q;
        if (G == 256) { const int L = i * 32 + (c >> 3), pl = L / nk; q = L - pl * nk; pm = pl * 8 + (c & 7); if (pm >= 128) return false; }
        else { const int U = i * G + c; if (U >= 128 * nk) return false; pm = U / nk; q = U - pm * nk; }
        u.pm = pm; u.rows = 256; u.e = 0; u.rbase = 0; u.list = nullptr;
        int xs, pn, kind; const char* B;
        if (q < 12) { kind = q >> 2; pn = q & 3; xs = kind; B = Wrkv + ((size_t)kind * 1024 + pn * 256) * 2048; }
        else { kind = q - 9; pn = 0; xs = (kind == 6) ? 2 : kind; B = Wl1 + (size_t)(kind - 3) * 256 * 2048; }
        u.kind = kind; u.pn = pn; u.B = B; u.A = XM + ((size_t)xs * T + (size_t)pm * 256) * 2048;
        return true;
    }
    __device__ __forceinline__ unsigned a_off(const Unit&, int row) const { return (unsigned)row * 2048u; }
};
struct SchedL2 {
    const char* L1O; const char* Wl2; int kind, G, c;
    __device__ __forceinline__ bool next(int i, Unit& u) const {
        const int U = i * G + c; if (U >= 128 * 4) return false;
        const int pm = U >> 2; u.pm = pm; u.pn = U & 3; u.rows = 256; u.e = 0; u.rbase = 0; u.list = nullptr; u.kind = kind;
        u.A = L1O + ((size_t)kind * T + (size_t)pm * 256) * 512; u.B = Wl2 + ((size_t)kind * 1024 + u.pn * 256) * 512;
        return true;
    }
    __device__ __forceinline__ unsigned a_off(const Unit&, int row) const { return (unsigned)row * 512u; }
};
struct SchedPlain {
    const char* A; const char* B; int npn, G, c;
    __device__ __forceinline__ bool next(int i, Unit& u) const {
        int pm, pn;
        if (G == 256) { const int L = i * 32 + (c >> 3), pl = L / npn; pn = L - pl * npn; pm = pl * 8 + (c & 7); if (pm >= 128) return false; }
        else { const int U = i * G + c; if (U >= 128 * npn) return false; pm = U / npn; pn = U - pm * npn; }
        u.pm = pm; u.rows = 256; u.e = 0; u.rbase = 0; u.list = nullptr;
        u.kind = pn >> 2; u.pn = pn & 3; u.A = A + (size_t)pm * 256 * 2048; u.B = B + (size_t)pn * 256 * 2048;
        return true;
    }
    __device__ __forceinline__ unsigned a_off(const Unit&, int row) const { return (unsigned)row * 2048u; }
};
struct SchedMoe {
    const LAS unsigned* misc; const LAS int* tile_e; const char* A; const char* W; const int* LIST; int npn, gather, G, c; size_t wstride;
    __device__ __forceinline__ bool next(int i, Unit& u) const {
        const int ntile = __builtin_amdgcn_readfirstlane((int)misc[48 + 32]);
        int rtg, pn;
        if (G == 256) { const int x = c & 7, j = c >> 3, rpr = 32 / npn; rtg = (i * rpr + j / npn) * 8 + x; pn = j % npn; if (rtg >= ntile) return false; }
        else { const int U = i * G + c; if (U >= ntile * npn) return false; rtg = U / npn; pn = U - rtg * npn; }
        const int e = __builtin_amdgcn_readfirstlane(tile_e[rtg]);
        const int rt = rtg - __builtin_amdgcn_readfirstlane((int)misc[48 + e]), cnt = __builtin_amdgcn_readfirstlane((int)misc[16 + e]);
        u.pm = rtg; u.pn = pn; u.kind = 0; u.e = e; u.rbase = rtg * 256; u.rows = min(256, cnt - rt * 256);
        u.list = LIST + (size_t)e * ECAP + rt * 256;
        u.A = gather ? A : A + (size_t)rtg * 256 * 1024; u.B = W + (size_t)e * wstride + (size_t)pn * 256 * 1024;
        return true;
    }
    __device__ __forceinline__ unsigned a_off(const Unit& u, int row) const {
        if (!gather) return (unsigned)row * 1024u;
        const int slot = (row < u.rows) ? u.list[row] : 0;
        return (unsigned)(slot >> 2) * 1024u;
    }
};
__device__ __forceinline__ void moe_tables(const unsigned* CNT, volatile LAS unsigned* misc, LAS int* tile_e, const int wave) {
    if (wave == 0 && lane_id() == 0) {
        unsigned acc = 0;
        for (int e = 0; e < 32; ++e) { const unsigned c = __hip_atomic_load(CNT + e, __ATOMIC_RELAXED, __HIP_MEMORY_SCOPE_AGENT); misc[16 + e] = c; misc[48 + e] = acc; acc += (c + 255u) >> 8; }
        misc[48 + 32] = acc;
    }
    __syncthreads();
    { const int ntile = (int)misc[48 + 32];
      for (int i = wave * 64 + lane_id(); i < ntile; i += NTHR) { int e = 0; for (int j = 1; j < 32; ++j) if ((int)misc[48 + j] <= i) e = j; tile_e[i] = e; } }
    __syncthreads();
}

__device__ __forceinline__ size_t hm_off(int row, int col) { return ((size_t)((row >> 11) * 16 + (col >> 6)) * SEQ + (row & 2047)) * 64 + (col & 63); }
struct EpiRkv {
    h16* Rp; h16* Kp; h16* Vp; h16* L1O;
    __device__ __forceinline__ void operator()(const f32x4 (&acc)[2][2][4][2], const Unit& u, int wr, int wc, int fr, int fq) const {
        if (u.kind < 3) {
            h16* C = u.kind == 0 ? Rp : (u.kind == 1 ? Kp : Vp);
            FOR_ACC2(ai, bj, m) { const int row = u.pm * 256 + 128 * ai + 64 * wr + 16 * m + fr, col = u.pn * 256 + 128 * bj + 32 * wc + 8 * fq;
                const u32x2 lo = pkh4(acc[ai][bj][m][0]), hi = pkh4(acc[ai][bj][m][1]); *(u32x4*)(C + hm_off(row, col)) = (u32x4){lo.x, lo.y, hi.x, hi.y}; }
        } else {
            h16* O = L1O + (size_t)(u.kind - 3) * T * 256; const int kd = u.kind;
            FOR_ACC2(ai, bj, m) { const int row = u.pm * 256 + 128 * ai + 64 * wr + 16 * m + fr, col = 128 * bj + 32 * wc + 8 * fq; u32x2 pk2[2];
#pragma unroll
                for (int n = 0; n < 2; ++n) { f32x4 v = acc[ai][bj][m][n];
                    if (kd == 3) { v.x = tanhf(v.x); v.y = tanhf(v.y); v.z = tanhf(v.z); v.w = tanhf(v.w); }
                    else if (kd == 5) { v.x = sigmoidf_(v.x); v.y = sigmoidf_(v.y); v.z = sigmoidf_(v.z); v.w = sigmoidf_(v.w); }
                    pk2[n] = pkh4(v); }
                *(u32x4*)(O + (size_t)row * 256 + col) = (u32x4){pk2[0].x, pk2[0].y, pk2[1].x, pk2[1].y}; }
        }
    }
};
template <int KD> struct EpiL2 {
    void* O; const h16* VF; const float* bias;
    __device__ __forceinline__ void operator()(const f32x4 (&acc)[2][2][4][2], const Unit& u, int wr, int wc, int fr, int fq) const {
        f32x4 bv[2][2];
#pragma unroll
        for (int bj = 0; bj < 2; ++bj)
#pragma unroll
            for (int n = 0; n < 2; ++n) bv[bj][n] = (KD != 2) ? *(const f32x4*)(bias + u.pn * 256 + 128 * bj + 32 * wc + 8 * fq + 4 * n) : (f32x4){0.f, 0.f, 0.f, 0.f};
#pragma unroll
        for (int ai = 0; ai < 2; ++ai)
#pragma unroll
            for (int mp = 0; mp < 2; ++mp) {
                h16x4 vc[2][2][2], vf[2][2][2];
                if (KD == 3) {
#pragma unroll
                    for (int mm = 0; mm < 2; ++mm)
#pragma unroll
                        for (int bj = 0; bj < 2; ++bj)
#pragma unroll
                            for (int n = 0; n < 2; ++n) { const size_t o = hm_off(u.pm * 256 + 128 * ai + 64 * wr + 16 * (2 * mp + mm) + fr, u.pn * 256 + 128 * bj + 32 * wc + 8 * fq + 4 * n);
                                vc[mm][bj][n] = *(const h16x4*)((const h16*)O + o); vf[mm][bj][n] = *(const h16x4*)(VF + o); }
                }
#pragma unroll
                for (int mm = 0; mm < 2; ++mm)
#pragma unroll
                    for (int bj = 0; bj < 2; ++bj) { const int m = 2 * mp + mm; const size_t o = hm_off(u.pm * 256 + 128 * ai + 64 * wr + 16 * m + fr, u.pn * 256 + 128 * bj + 32 * wc + 8 * fq); u32x2 pk2[2];
#pragma unroll
                        for (int n = 0; n < 2; ++n) {
                            f32x4 v = acc[ai][bj][m][n] + bv[bj][n];
                            if (KD == 0) { v.x = 1.0f - __expf(-0.6065306597126334f * sigmoidf_(v.x)); v.y = 1.0f - __expf(-0.6065306597126334f * sigmoidf_(v.y)); v.z = 1.0f - __expf(-0.6065306597126334f * sigmoidf_(v.z)); v.w = 1.0f - __expf(-0.6065306597126334f * sigmoidf_(v.w)); }
                            if (KD == 1 || KD == 3) { v.x = sigmoidf_(v.x); v.y = sigmoidf_(v.y); v.z = sigmoidf_(v.z); v.w = sigmoidf_(v.w); }
                            if (KD == 3) { const f32x4 c_ = __builtin_convertvector(vc[mm][bj][n], f32x4), f_ = __builtin_convertvector(vf[mm][bj][n], f32x4); v = c_ + (f_ - c_) * v; }
                            pk2[n] = pkh4(v); }
                        *(u32x4*)((h16*)O + o) = (u32x4){pk2[0].x, pk2[0].y, pk2[1].x, pk2[1].y}; }
                if (KD == 3) EPI_FENCE();
            }
    }
};
template <bool F16X> struct EpiRes {
    const void* X; h16* H;
    __device__ __forceinline__ void operator()(const f32x4 (&acc)[2][2][4][2], const Unit& u, int wr, int wc, int fr, int fq) const {
        const float* Xf = (const float*)X; const h16* Xh = (const h16*)X;
#pragma unroll
        for (int ai = 0; ai < 2; ++ai)
#pragma unroll
            for (int mp = 0; mp < 2; ++mp) {
                f32x4 xr[2][2][2]; h16x4 xh[2][2][2];
#pragma unroll
                for (int mm = 0; mm < 2; ++mm)
#pragma unroll
                    for (int bj = 0; bj < 2; ++bj)
#pragma unroll
                        for (int n = 0; n < 2; ++n) { const size_t o = (size_t)(u.pm * 256 + 128 * ai + 64 * wr + 16 * (2 * mp + mm) + fr) * D + u.pn * 256 + 128 * bj + 32 * wc + 8 * fq + 4 * n;
                            if (F16X) xh[mm][bj][n] = *(const h16x4*)(Xh + o); else xr[mm][bj][n] = *(const f32x4*)(Xf + o); }
#pragma unroll
                for (int mm = 0; mm < 2; ++mm)
#pragma unroll
                    for (int bj = 0; bj < 2; ++bj) { const int m = 2 * mp + mm; u32x2 pk2[2];
#pragma unroll
                        for (int n = 0; n < 2; ++n) { const f32x4 xv = F16X ? __builtin_convertvector(xh[mm][bj][n], f32x4) : xr[mm][bj][n]; pk2[n] = pkh4(xv * ALPHA + acc[ai][bj][m][n]); }
                        *(u32x4*)(H + (size_t)(u.pm * 256 + 128 * ai + 64 * wr + 16 * m + fr) * D + u.pn * 256 + 128 * bj + 32 * wc + 8 * fq) = (u32x4){pk2[0].x, pk2[0].y, pk2[1].x, pk2[1].y}; }
                EPI_FENCE();
            }
    }
};
struct EpiQkv {
    h16* O0; h16* O1; float sc0;
    __device__ __forceinline__ void operator()(const f32x4 (&acc)[2][2][4][2], const Unit& u, int wr, int wc, int fr, int fq) const {
        h16* O = u.kind == 0 ? O0 : O1; const float sc = u.kind == 0 ? sc0 : 1.0f;
        FOR_ACC2(ai, bj, m) { const int row = u.pm * 256 + 128 * ai + 64 * wr + 16 * m + fr, col = u.pn * 256 + 128 * bj + 32 * wc + 8 * fq;
            const u32x2 lo = pkh4(acc[ai][bj][m][0] * sc), hi = pkh4(acc[ai][bj][m][1] * sc); *(u32x4*)(O + (size_t)row * 1024 + col) = (u32x4){lo.x, lo.y, hi.x, hi.y}; }
    }
};
struct EpiGu {
    unsigned char* ACT; const float* bgu;
    __device__ __forceinline__ void operator()(const f32x4 (&acc)[2][2][4][2], const Unit& u, int wr, int wc, int fr, int fq) const {
        const float* bb = bgu + (size_t)u.e * 2048;
        f32x4 bg[2], bu[2];
        const int colb = u.pn * 128 + 32 * wc + 8 * fq;
#pragma unroll
        for (int n = 0; n < 2; ++n) { bg[n] = *(const f32x4*)(bb + colb + 4 * n); bu[n] = *(const f32x4*)(bb + 1024 + colb + 4 * n); }
#pragma unroll
        for (int ai = 0; ai < 2; ++ai)
#pragma unroll
            for (int m = 0; m < 4; ++m) { const int rl = 128 * ai + 64 * wr + 16 * m + fr;
                if (rl < u.rows) { u32x2 pk2;
#pragma unroll
                    for (int n = 0; n < 2; ++n) {
                        const f32x4 gt = acc[ai][0][m][n] * (1.0f / GU_SCALE) + bg[n], up = acc[ai][1][m][n] * (1.0f / GU_SCALE) + bu[n]; f32x4 r;
#pragma unroll
                        for (int e = 0; e < 4; ++e) { const float g = fminf(gt[e], 7.0f), uu = __builtin_amdgcn_fmed3f(up[e], -7.0f, 7.0f); r[e] = (uu + 1.0f) * (g * __builtin_amdgcn_rcpf(1.0f + __builtin_amdgcn_exp2f((-1.702f * 1.4426950408889634f) * g))); }
                        int pk_ = __builtin_amdgcn_cvt_pk_fp8_f32(r[0], r[1], 0, false); pk_ = __builtin_amdgcn_cvt_pk_fp8_f32(r[2], r[3], pk_, true); pk2[n] = (unsigned)pk_; }
                    *(u32x2*)(ACT + (size_t)(u.rbase + rl) * 1024 + colb) = pk2;
                } }
    }
};
struct EpiDn {
    unsigned char* YS; const float* bdn; const float* TOPG;
    __device__ __forceinline__ void operator()(const f32x4 (&acc)[2][2][4][2], const Unit& u, int wr, int wc, int fr, int fq) const {
        const float* bb = bdn + (size_t)u.e * 1024;
        f32x4 bv[2][2]; int slot[2][4]; float gt[2][4];
#pragma unroll
        for (int bj = 0; bj < 2; ++bj)
#pragma unroll
            for (int n = 0; n < 2; ++n) bv[bj][n] = *(const f32x4*)(bb + u.pn * 256 + 64 * wc + 16 * fq + 8 * bj + 4 * n);
#pragma unroll
        for (int ai = 0; ai < 2; ++ai)
#pragma unroll
            for (int m = 0; m < 4; ++m) { const int rl = 128 * ai + 64 * wr + 16 * m + fr; slot[ai][m] = (rl < u.rows) ? u.list[rl] : -1; }
#pragma unroll
        for (int ai = 0; ai < 2; ++ai)
#pragma unroll
            for (int m = 0; m < 4; ++m) { const float g_ = TOPG[slot[ai][m] >= 0 ? slot[ai][m] : 0]; gt[ai][m] = (slot[ai][m] >= 0) ? g_ * YS_SCALE : 0.f; }
#pragma unroll
        for (int ai = 0; ai < 2; ++ai)
#pragma unroll
            for (int m = 0; m < 4; ++m) {
                if (slot[ai][m] >= 0) {
                    u32x4 pk4;
#pragma unroll
                    for (int bj = 0; bj < 2; ++bj)
#pragma unroll
                        for (int n = 0; n < 2; ++n) {
                            const f32x4 yv = (acc[ai][bj][m][n] * (1.0f / DN_SCALE) + bv[bj][n]) * gt[ai][m];
                            int pk_ = __builtin_amdgcn_cvt_pk_fp8_f32(yv[0], yv[1], 0, false); pk_ = __builtin_amdgcn_cvt_pk_fp8_f32(yv[2], yv[3], pk_, true); pk4[2 * bj + n] = (unsigned)pk_; }
                    __builtin_nontemporal_store(pk4, (u32x4*)(YS + (size_t)slot[ai][m] * 1024 + u.pn * 256 + 64 * wc + 16 * fq));
                } }
    }
};

struct Args { const float* in[33]; float* out; unsigned char* ws; int ph_lo, ph_hi; };
enum { I_X = 0, I_LNG, I_LNB, I_MIX, I_WRKV, I_WO, I_W0, I_W1, I_W2, I_A0, I_A1, I_A2, I_G1, I_G2, I_KK, I_KA, I_RK, I_LNXG, I_LNXB, I_V0, I_V1, I_V2,
       I_KVW, I_DAQ, I_DAO, I_DALAM, I_DASUB, I_RW, I_RB, I_WGU, I_BGU, I_WDN, I_BDN };

typedef const float* cfptr;
#define KAS __attribute__((address_space(4)))
#define KA_DECL const KAS cfptr* kin = (const KAS cfptr*)__builtin_amdgcn_kernarg_segment_ptr(); asm volatile("" : "+s"(kin))
#define KA_RELOAD asm volatile("" : "+s"(kin))
#define PH_BEGIN KA_RELOAD; asm volatile("" : "+s"(wave), "+s"(G), "+s"(blk)); ws = KWS; ctl = (unsigned*)(ws + WS_CTL)
#define KIN(i) (kin[i])
#define KOUT ((float*)kin[33])
#define KWS ((unsigned char*)kin[34])
__global__ void __launch_bounds__(NTHR, 2) yoco_fwd(Args args) {
    extern __shared__ __attribute__((aligned(16))) unsigned char lds_raw[];
    LAS unsigned char* lds = (LAS unsigned char*)lds_raw;
    volatile LAS unsigned* MISC = (volatile LAS unsigned*)(lds + MISC_OFF);
    int wave = __builtin_amdgcn_readfirstlane((int)threadIdx.x >> 6);
    int G = gridDim.x, blk = blockIdx.x; int lane = 0;
#define gw (blk * NWAVES + wave)
#define NGW (G * NWAVES)
    KA_DECL;
    unsigned char* ws = KWS;
    unsigned* ctl = (unsigned*)(ws + WS_CTL);
    for (int u = wave * 64 + lane_id(); u < (LDS_BYTES - MISC_OFF) / 4; u += NTHR) ((LAS unsigned*)(lds + MISC_OFF))[u] = 0u;
    __syncthreads();
    XcdBarrier bar = xcd_barrier_post(ctl + CW_BAR, MISC + 8, wave);
#define GRID_BAR() xcd_barrier(bar, wave)

    {
        LAS float* scr = (LAS float*)(lds + wave * 16896);
        conv_batch(KIN(I_WRKV), 6, 1024, 1024, (h16*)(ws + WS_W_RKV), 1024, 1024, 3, scr, gw, NGW, lane);
        conv_batch(KIN(I_WO), 2, 1024, 1024, (h16*)(ws + WS_W_RO), 1024, 1024, 3, scr, gw, NGW, lane);
#pragma unroll
        for (int l = 0; l < 2; ++l) {
            conv_batch(KIN(I_W1) + (size_t)l * 1024 * 64, 1, 1024, 64, (h16*)(ws + WS_W_L1) + (size_t)(l * 4 + 0) * 256 * 1024, 1024, 256, 3, scr, gw, NGW, lane);
            conv_batch(KIN(I_A1) + (size_t)l * 1024 * 64, 1, 1024, 64, (h16*)(ws + WS_W_L1) + (size_t)(l * 4 + 1) * 256 * 1024, 1024, 256, 3, scr, gw, NGW, lane);
            conv_batch(KIN(I_G1) + (size_t)l * 1024 * 160, 1, 1024, 160, (h16*)(ws + WS_W_L1) + (size_t)(l * 4 + 2) * 256 * 1024, 1024, 256, 3, scr, gw, NGW, lane);
            conv_batch(KIN(I_W2) + (size_t)l * 64 * 1024, 1, 64, 1024, (h16*)(ws + WS_W_L2) + (size_t)(l * 4 + 0) * 256 * 1024, 256, 1024, 3, scr, gw, NGW, lane);
            conv_batch(KIN(I_A2) + (size_t)l * 64 * 1024, 1, 64, 1024, (h16*)(ws + WS_W_L2) + (size_t)(l * 4 + 1) * 256 * 1024, 256, 1024, 3, scr, gw, NGW, lane);
            conv_batch(KIN(I_G2) + (size_t)l * 160 * 1024, 1, 160, 1024, (h16*)(ws + WS_W_L2) + (size_t)(l * 4 + 2) * 256 * 1024, 256, 1024, 3, scr, gw, NGW, lane);
        }
        conv_batch(KIN(I_V1), 1, 1024, 32, (h16*)(ws + WS_W_L1) + (size_t)(4 + 3) * 256 * 1024, 1024, 256, 3, scr, gw, NGW, lane);
        conv_batch(KIN(I_V2), 1, 32, 1024, (h16*)(ws + WS_W_L2) + (size_t)(4 + 3) * 256 * 1024, 256, 1024, 3, scr, gw, NGW, lane);
        conv_batch(KIN(I_KVW), 1, 1024, 2048, (h16*)(ws + WS_W_KV), 1024, 2048, 3, scr, gw, NGW, lane);
        conv_batch(KIN(I_DAQ), 2, 1024, 1024, (h16*)(ws + WS_W_Q), 1024, 1024, 3, scr, gw, NGW, lane);
        conv_batch(KIN(I_DAO), 2, 1024, 1024, (h16*)(ws + WS_W_AO), 1024, 1024, 3, scr, gw, NGW, lane);
#pragma unroll
        for (int l4 = 0; l4 < 4; ++l4) { conv_batch(KIN(I_RW) + (size_t)l4 * D * NEXP, 1, 1024, 32, (h16*)(ws + WS_WR) + (size_t)(l4 * 2 + 0) * 32 * 1024, 1024, 32, 0, scr, gw, NGW, lane);
                                        conv_batch(KIN(I_RW) + (size_t)l4 * D * NEXP, 1, 1024, 32, (h16*)(ws + WS_WR) + (size_t)(l4 * 2 + 1) * 32 * 1024, 1024, 32, 2, scr, gw, NGW, lane); }
    }

#pragma unroll 1
    for (int l = 0; l < 4; ++l) {
        if (l < 2) {
            PH_BEGIN;
            if (l == 0) phase_prep<false>(KIN(I_X), KIN(I_MIX), (h16*)(ws + WS_XM), gw, NGW, lane);
            else phase_prep<true>(ws + WS_XH, KIN(I_MIX) + (size_t)l * 6 * D, (h16*)(ws + WS_XM), gw, NGW, lane);
            GRID_BAR();
            PH_BEGIN;
            {
                SchedRkv S{(const char*)(ws + WS_XM), (const char*)(ws + WS_W_RKV) + (size_t)l * 3 * 1024 * 2048, (const char*)(ws + WS_W_L1) + (size_t)l * 4 * 256 * 2048, l == 0 ? 15 : 16, G, blk};
                EpiRkv E{(h16*)(ws + WS_R), (h16*)(ws + WS_K), (h16*)(ws + (l == 0 ? WS_VF : WS_V)), (h16*)(ws + WS_L1O)};
                GEMM_PHASE(S, E, 1024);
            }
            GRID_BAR();
            PH_BEGIN;
            {
                const char* l1o = (const char*)(ws + WS_L1O); const char* wl2 = (const char*)(ws + WS_W_L2) + (size_t)l * 4 * 1024 * 512;
                { SchedL2 S{l1o, wl2, 0, G, blk}; EpiL2<0> E{(void*)(ws + WS_WD), nullptr, KIN(I_W0) + (size_t)l * D}; GEMM_PHASE(S, E, 256); }
                { SchedL2 S{l1o, wl2, 1, G, blk}; EpiL2<1> E{(void*)(ws + WS_AA), nullptr, KIN(I_A0) + (size_t)l * D}; GEMM_PHASE(S, E, 256); }
                { SchedL2 S{l1o, wl2, 2, G, blk}; EpiL2<2> E{(void*)(ws + WS_GG), nullptr, nullptr}; GEMM_PHASE(S, E, 256); }
                if (l == 1) { SchedL2 S{l1o, wl2, 3, G, blk}; EpiL2<3> E{(void*)(ws + WS_V), (const h16*)(ws + WS_VF), KIN(I_V0)}; GEMM_PHASE(S, E, 256); }
            }
            GRID_BAR();
            PH_BEGIN;
            {
                const float* wgu_ = KIN(I_WGU); const float* wdn_ = KIN(I_WDN); asm volatile("" : "+s"(wgu_), "+s"(wdn_));
                ScanArgs sa{(const h16*)(ws + WS_R), (const h16*)(ws + WS_K), (const h16*)(ws + (l == 0 ? WS_VF : WS_V)), (const h16*)(ws + WS_WD), (const h16*)(ws + WS_AA), (const h16*)(ws + WS_GG),
                            KIN(I_KK) + (size_t)l * D, KIN(I_KA) + (size_t)l * D, KIN(I_RK) + (size_t)l * D, KIN(I_LNXG) + (size_t)l * D, KIN(I_LNXB) + (size_t)l * D, (h16*)(ws + WS_YG), wgu_, wdn_, ws + WS_W_GU, ws + WS_W_DN, l};
                phase_scan_mm(sa, lds, blk, G, wave);
            }
            GRID_BAR();
            PH_BEGIN;
            {
                SchedPlain S{(const char*)(ws + WS_YG), (const char*)(ws + WS_W_RO) + (size_t)l * 1024 * 2048, 4, G, blk};
                if (l == 0) { EpiRes<false> E{KIN(I_X), (h16*)(ws + WS_H)}; GEMM_PHASE(S, E, 1024); }
                else { EpiRes<true> E{ws + WS_XH, (h16*)(ws + WS_H)}; GEMM_PHASE(S, E, 1024); }
            }
            GRID_BAR();
        } else {
            const int j = l - 2;
            PH_BEGIN;
            if (l == 2) {
                { SchedPlain S{(const char*)(ws + WS_XH), (const char*)(ws + WS_W_Q), 4, G, blk}; EpiQkv E{(h16*)(ws + WS_Q), nullptr, QSCALE}; GEMM_PHASE(S, E, 1024); }
                { SchedPlain S{(const char*)(ws + WS_XH), (const char*)(ws + WS_W_KV), 8, G, blk}; EpiQkv E{(h16*)(ws + WS_KK), (h16*)(ws + WS_VV), 1.0f}; GEMM_PHASE(S, E, 1024); }
            } else {
                SchedPlain S{(const char*)(ws + WS_XH), (const char*)(ws + WS_W_Q) + (size_t)j * 1024 * 2048, 4, G, blk}; EpiQkv E{(h16*)(ws + WS_Q), nullptr, QSCALE}; GEMM_PHASE(S, E, 1024);
            }
            GRID_BAR();
            PH_BEGIN;
            phase_attn((const h16*)(ws + WS_Q), (const h16*)(ws + WS_KK), (const h16*)(ws + WS_VV), (h16*)(ws + WS_ORAW), (char*)lds_raw, blk, G, wave);
            GRID_BAR();
            PH_BEGIN;
            phase_attn_combine((const h16*)(ws + WS_ORAW), KIN(I_DALAM) + (size_t)j * 256, KIN(I_DASUB) + (size_t)j * 128, 0.8f - 0.6f * expf(-0.3f * (float)l), (h16*)(ws + WS_OB), gw, NGW, lane);
            GRID_BAR();
            PH_BEGIN;
            {
                SchedPlain S{(const char*)(ws + WS_OB), (const char*)(ws + WS_W_AO) + (size_t)j * 1024 * 2048, 4, G, blk};
                EpiRes<true> E{ws + WS_XH, (h16*)(ws + WS_H)};
                GEMM_PHASE(S, E, 1024);
            }
            GRID_BAR();
        }
        PH_BEGIN;
        {
            RouterArgs ra{(const h16*)(ws + WS_H), KIN(I_LNG) + (size_t)(l * 2) * D, KIN(I_LNB) + (size_t)(l * 2) * D, (const h16*)(ws + WS_WR) + (size_t)l * 2 * 32 * 1024, KIN(I_RB) + (size_t)l * NEXP,
                          (h16*)(ws + WS_X1), (unsigned char*)(ws + WS_XB), (float*)(ws + WS_TOPG), (int*)(ws + WS_LIST), ctl + CW_CNT + l * 32};
            phase_ln_router(ra, lds, blk, G, wave);
        }
        GRID_BAR();
        PH_BEGIN;
        moe_tables(ctl + CW_CNT + l * 32, MISC, (LAS int*)(lds + TILE_E_OFF), wave);
        {
            SchedMoe S{(const LAS unsigned*)MISC, (const LAS int*)(lds + TILE_E_OFF), (const char*)(ws + WS_XB), (const char*)(ws + WS_W_GU) + (size_t)l * 32 * 2048 * 1024, (const int*)(ws + WS_LIST), 8, 1, G, blk, (size_t)2048 * 1024};
            EpiGu E{(unsigned char*)(ws + WS_ACT), KIN(I_BGU) + (size_t)l * 32 * 2048};
            GEMM_PHASE8(S, E, 1024);
        }
        GRID_BAR();
        PH_BEGIN;
        {
            SchedMoe S{(const LAS unsigned*)MISC, (const LAS int*)(lds + TILE_E_OFF), (const char*)(ws + WS_ACT), (const char*)(ws + WS_W_DN) + (size_t)l * 32 * 1024 * 1024, (const int*)(ws + WS_LIST), 4, 0, G, blk, (size_t)1024 * 1024};
            EpiDn E{(unsigned char*)(ws + WS_YS), KIN(I_BDN) + (size_t)l * 32 * 1024, (const float*)(ws + WS_TOPG)};
            GEMM_PHASE8(S, E, 1024);
        }
        GRID_BAR();
        PH_BEGIN;
        phase_combine((const h16*)(ws + WS_X1), (const unsigned char*)(ws + WS_YS), KIN(I_LNG) + (size_t)(l * 2 + 1) * D, KIN(I_LNB) + (size_t)(l * 2 + 1) * D,
                      l == 3 ? KOUT : (float*)nullptr, (h16*)(ws + WS_XH), gw, NGW, lane);
        if (l < 3) GRID_BAR();
    }
    if (xb_ld(ctl + CW_BAR + XB_TMO) != 0u && wave == 0 && lane_id() == 0) KOUT[(size_t)blk * D] = __builtin_nanf("");
}

extern "C" void kernel_launch(void* const* d_in, const int* in_sizes, int n_in, void* d_out, int out_size, void* d_ws, size_t ws_size, hipStream_t stream) {
    static int grid = 0;
    if (grid == 0) {
        if (n_in != 33 || out_size != T * D || ws_size < WS_END) { fprintf(stderr, "kernel_launch: unexpected shapes (n_in %d out %d ws %zu)\n", n_in, out_size, ws_size); grid = -1; return; }
        if (hipFuncSetAttribute((const void*)yoco_fwd, hipFuncAttributeMaxDynamicSharedMemorySize, LDS_BYTES) != hipSuccess) { fprintf(stderr, "kernel_launch: hipFuncSetAttribute failed\n"); grid = -1; return; }
        int dev = 0, cus = 0, per_cu = 0;
        hipGetDevice(&dev); hipDeviceGetAttribute(&cus, hipDeviceAttributeMultiprocessorCount, dev);
        hipOccupancyMaxActiveBlocksPerMultiprocessor(&per_cu, (const void*)yoco_fwd, NTHR, LDS_BYTES);
        (void)hipGetLastError();
        if (per_cu < 1) fprintf(stderr, "kernel_launch: occupancy query reports %d\n", per_cu);
        grid = cus < 256 ? cus : 256;
    }
    if (grid < 0) return;
    hipMemsetAsync((char*)d_ws + WS_CTL, 0, CTL_ZERO_BYTES, stream);
    Args a{};
    for (int i = 0; i < 33; ++i) a.in[i] = (const float*)d_in[i];
    a.out = (float*)d_out; a.ws = (unsigned char*)d_ws; a.ph_lo = 0; a.ph_hi = 0;
    hipLaunchKernelGGL(yoco_fwd, dim3(grid), dim3(NTHR), LDS_BYTES, stream, a);
}
```

```cpp
#include <hip/hip_runtime.h>
#include <cstdio>
#include <cstdint>
#include <cmath>

#define LAS __attribute__((address_space(3)))
#define GAS __attribute__((address_space(1)))
typedef _Float16 h16;
typedef _Float16 h16x8 __attribute__((ext_vector_type(8)));
typedef _Float16 h16x4 __attribute__((ext_vector_type(4)));
typedef _Float16 h16x2 __attribute__((ext_vector_type(2)));
typedef float f32x4 __attribute__((ext_vector_type(4)));
typedef float f32x2 __attribute__((ext_vector_type(2)));
typedef unsigned u32x4 __attribute__((ext_vector_type(4)));
typedef unsigned u32x2 __attribute__((ext_vector_type(2)));

constexpr int D = 1024, NBATCH = 16, SEQ = 2048, T = NBATCH * SEQ;
constexpr int NEXP = 32, TOPK = 4, ECAP = T;
constexpr int NWAVES = 8, NTHR = NWAVES * 64;
constexpr float ALPHA = 1.6817928305074290f;
constexpr float LN_EPS = 1e-5f;
constexpr float QSCALE = 0.125f * 1.4426950408889634f;
constexpr float LOG2E = 1.4426950408889634f;
constexpr float GU_SCALE = 64.0f, DN_SCALE = 128.0f, YS_SCALE = 16.0f;

constexpr size_t MiB = 1u << 20;
constexpr size_t WS_CTL = 0, CTL_ZERO_BYTES = 1 * MiB;
constexpr size_t WS_W_RKV = 2 * MiB;
constexpr size_t WS_W_RO = 14 * MiB;
constexpr size_t WS_W_L1 = 18 * MiB;
constexpr size_t WS_W_L2 = 22 * MiB;
constexpr size_t WS_W_KV = 26 * MiB;
constexpr size_t WS_W_Q = 30 * MiB;
constexpr size_t WS_W_AO = 34 * MiB;
constexpr size_t WS_WR = 38 * MiB;
constexpr size_t WS_W_GU = 40 * MiB;
constexpr size_t WS_W_DN = 552 * MiB;
constexpr size_t WS_X = 808 * MiB;
constexpr size_t WS_X1 = 936 * MiB;
constexpr size_t WS_H = 1064 * MiB;
constexpr size_t WS_XB = 1192 * MiB;
constexpr size_t WS_XH = 1256 * MiB;
constexpr size_t WS_TOPG = 1320 * MiB;
constexpr size_t WS_LIST = 1321 * MiB;
constexpr size_t WS_ACT = 1328 * MiB;
constexpr size_t WS_YS = 1616 * MiB;
constexpr size_t WS_XM = 1872 * MiB;
constexpr size_t WS_R = 2256 * MiB, WS_K = 2384 * MiB, WS_V = 2512 * MiB, WS_VF = 2640 * MiB;
constexpr size_t WS_L1O = 2768 * MiB;
constexpr size_t WS_WD = 2832 * MiB, WS_AA = 2960 * MiB, WS_GG = 3088 * MiB;
constexpr size_t WS_YG = 3216 * MiB;
constexpr size_t WS_END = 3280 * MiB;
constexpr size_t WS_Q = 1872 * MiB, WS_KK = 1936 * MiB, WS_VV = 2000 * MiB;
constexpr size_t WS_ORAW = 2064 * MiB;
constexpr size_t WS_OB = 2192 * MiB;
constexpr int CW_BAR = 4096;
constexpr int CW_CNT = 16384;

constexpr int LDS_BYTES = 147456;
constexpr int MISC_OFF = 146432;
constexpr int TILE_E_OFF = 143360;

template <int CTRL> __device__ __forceinline__ float dppf(float v) { return __builtin_bit_cast(float, __builtin_amdgcn_mov_dpp(__builtin_bit_cast(int, v), CTRL, 0xF, 0xF, true)); }
__device__ __forceinline__ float swz16f(float v) { return __builtin_bit_cast(float, __builtin_amdgcn_ds_swizzle(__builtin_bit_cast(int, v), (16 << 10) | 0x1F)); }
__device__ __forceinline__ float grp8_sum(float v) { v += dppf<0xB1>(v); v += dppf<0x4E>(v); v += dppf<0x141>(v); return v; }
__device__ __forceinline__ float wave_sum(float v) {
    v += dppf<0xB1>(v); v += dppf<0x4E>(v); v += dppf<0x141>(v); v += dppf<0x140>(v); v += swz16f(v);
    return __builtin_bit_cast(float, __builtin_amdgcn_readlane(__builtin_bit_cast(int, v), 0)) + __builtin_bit_cast(float, __builtin_amdgcn_readlane(__builtin_bit_cast(int, v), 32));
}
__device__ __forceinline__ float wave_max(float v) {
    v = fmaxf(v, dppf<0xB1>(v)); v = fmaxf(v, dppf<0x4E>(v)); v = fmaxf(v, dppf<0x141>(v)); v = fmaxf(v, dppf<0x140>(v)); v = fmaxf(v, swz16f(v));
    return fmaxf(__builtin_bit_cast(float, __builtin_amdgcn_readlane(__builtin_bit_cast(int, v), 0)), __builtin_bit_cast(float, __builtin_amdgcn_readlane(__builtin_bit_cast(int, v), 32)));
}
__device__ __forceinline__ unsigned pkh(float a, float b) { h16x2 v = {(h16)a, (h16)b}; return __builtin_bit_cast(unsigned, v); }
__device__ __forceinline__ u32x2 pkh4(f32x4 v) { u32x2 r; r.x = pkh(v.x, v.y); r.y = pkh(v.z, v.w); return r; }
__device__ __forceinline__ f32x4 ldh4(const h16* p) { const h16x4 v = *(const h16x4*)p; return __builtin_convertvector(v, f32x4); }
__device__ __forceinline__ float sigmoidf_(float x) { return __builtin_amdgcn_rcpf(1.0f + __builtin_amdgcn_exp2f(-1.4426950408889634f * x)); }
__device__ __forceinline__ int lane_id() { int l; asm volatile("v_mbcnt_lo_u32_b32 %0, -1, 0\n\tv_mbcnt_hi_u32_b32 %0, -1, %0" : "=v"(l)); return l; }
#define LDS_WAIT() asm volatile("s_waitcnt lgkmcnt(0)" ::: "memory")
#define OPAQUE(x) asm volatile("" : "+v"(x))

#define XB_TMO      128
#define XB_XCNT(j)  (256  + 64 * (j))
#define XB_XSUB(j)  (1280 + 64 * (j))
#define XB_XGEN(j)  (2304 + 64 * (j))
#define XB_TOP      3328
#define XB_TOPGEN   3392
#define XCD_BAR_WORDS 3456
#define XB_SPIN_CAP (1u << 21)

__device__ __forceinline__ unsigned xb_ld(unsigned* p)              { return __hip_atomic_load((GAS unsigned*)p, __ATOMIC_RELAXED, __HIP_MEMORY_SCOPE_AGENT); }
__device__ __forceinline__ unsigned xb_add(unsigned* p, unsigned v) { return __hip_atomic_fetch_add((GAS unsigned*)p, v, __ATOMIC_RELAXED, __HIP_MEMORY_SCOPE_AGENT); }
__device__ __forceinline__ unsigned xb_xcc_id() { return (unsigned)__builtin_amdgcn_s_getreg((3 << 11) | 20) & 0xFu; }
#define XB_SPIN(cond, bar) do { unsigned _sp = 0; while (cond) { __builtin_amdgcn_s_sleep(1); \
    if ((++_sp & 255u) == 0u) { if (xb_ld(&(bar)[XB_TMO])) break; if (_sp > XB_SPIN_CAP) { (void)xb_add(&(bar)[XB_TMO], 1u); break; } } } } while (0)

struct XcdBarrier { unsigned* bar; unsigned x; volatile LAS unsigned* st; };

__device__ __forceinline__ XcdBarrier xcd_barrier_post(unsigned* bar, volatile LAS unsigned* st, const int wave) {
    XcdBarrier b; b.bar = bar; b.x = xb_xcc_id(); b.st = st;
    if (wave == 0 && lane_id() == 0) (void)xb_add(&bar[XB_XCNT(b.x)], 1u);
    return b;
}
__device__ __forceinline__ void xcd_barrier_complete(unsigned* bar, unsigned x, unsigned& nloc, unsigned& nx) {
    const unsigned G = gridDim.x * gridDim.y * gridDim.z;
    unsigned sum, cnt, mine, sp = 0u;
    for (;;) {
        sum = 0u; cnt = 0u; mine = 0u;
#pragma unroll
        for (unsigned j = 0; j < 16; ++j) { const unsigned c = xb_ld(&bar[XB_XCNT(j)]); sum += c; cnt += (c > 0u) ? 1u : 0u; mine = (j == x) ? c : mine; }
        if (sum == G) break;
        __builtin_amdgcn_s_sleep(1);
        if ((++sp & 255u) == 0u) { if (xb_ld(&bar[XB_TMO])) break; if (sp > XB_SPIN_CAP) { (void)xb_add(&bar[XB_TMO], 1u); break; } }
    }
    nloc = mine > 0u ? mine : 1u; nx = cnt > 0u ? cnt : 1u;
}
__device__ __forceinline__ void xcd_barrier(const XcdBarrier& b, const int wave) {
    asm volatile("s_waitcnt vmcnt(0)" ::: "memory");
    __syncthreads();
    if (wave == 0 && lane_id() == 0) {
        unsigned* bar = b.bar; unsigned bx = b.x;
        asm volatile("" : "+s"(bar), "+s"(bx));
        __builtin_amdgcn_s_waitcnt(0);
        unsigned nloc = b.st[0], nx = b.st[1];
        if (nloc == 0u) { xcd_barrier_complete(bar, bx, nloc, nx); b.st[0] = nloc; b.st[1] = nx; }
        const unsigned old = xb_add(&bar[XB_XSUB(bx)], 1u);
        const unsigned gen = old / nloc;
        if (old + 1u == (gen + 1u) * nloc) {
            __builtin_amdgcn_fence(__ATOMIC_RELEASE, "agent");
            asm volatile("s_waitcnt vmcnt(0)" ::: "memory");
            const unsigned og = xb_add(&bar[XB_TOP], 1u);
            const unsigned tg = og / nx;
            if (og + 1u == (tg + 1u) * nx) xb_add(&bar[XB_TOPGEN], 1u);
            else XB_SPIN(xb_ld(&bar[XB_TOPGEN]) == tg, bar);
            __builtin_amdgcn_fence(__ATOMIC_ACQUIRE, "agent");
            xb_add(&bar[XB_XGEN(bx)], 1u);
            asm volatile("s_waitcnt vmcnt(0)" ::: "memory");
        } else {
            XB_SPIN(xb_ld(&bar[XB_XGEN(bx)]) == gen, bar);
            __builtin_amdgcn_fence(__ATOMIC_ACQUIRE, "agent");
            asm volatile("s_waitcnt vmcnt(0)" ::: "memory");
        }
    }
    __syncthreads();
}

__device__ __forceinline__ void conv_batch(const float* src, int batch, int Kr, int Nr, h16* dst, int Kp, int Np, int perm, LAS float* scr, int gw, int NGW, int lane) {
    lane = lane_id(); OPAQUE(lane);
    const int kbn = Kp / 64, nbn = Np / 32, per = kbn * nbn, total = batch * per;
    for (int it = gw; it < total; it += NGW) {
        const int bi = it / per, r = it - bi * per, kb = r / nbn, nb = r - kb * nbn, k0 = 64 * kb, n0 = 32 * nb;
        const float* W = src + (size_t)bi * Kr * Nr; h16* WT = dst + (size_t)bi * Np * Kp;
        float vals[32];
#pragma unroll
        for (int i = 0; i < 32; ++i) { const int k = k0 + 2 * i + (lane >> 5), n = n0 + (lane & 31); vals[i] = (k < Kr && n < Nr) ? W[(size_t)k * Nr + n] : 0.f; }
#pragma unroll
        for (int i = 0; i < 32; ++i) { float x = vals[i]; if (perm == 2) x = (x - (float)(h16)x) * 4096.0f; scr[(2 * i + (lane >> 5)) * 33 + (lane & 31)] = x; }
        LDS_WAIT();
        const int c = lane & 7;
#pragma unroll
        for (int j = 0; j < 4; ++j) { const int nl = (lane >> 3) + 8 * j; const LAS float* s = scr + (8 * c) * 33 + nl;
            u32x4 o; o.x = pkh(s[0 * 33], s[1 * 33]); o.y = pkh(s[2 * 33], s[3 * 33]); o.z = pkh(s[4 * 33], s[5 * 33]); o.w = pkh(s[6 * 33], s[7 * 33]);
            int n = n0 + nl; if (perm == 1) n = ((n & 1023) >> 7) * 256 + (n >> 10) * 128 + (n & 127);
            if (perm == 3) { const int c5 = n & 31; n = (n & ~31) | (16 * ((c5 >> 2) & 1) + 4 * (c5 >> 3) + (c5 & 3)); }
            *(u32x4*)(WT + (size_t)n * Kp + k0 + 8 * c) = o; }
        LDS_WAIT();
    }
}


__device__ __forceinline__ void conv_batch8(const float* src, int batch, int Kr, int Nr, unsigned char* dst, int Kp, int Np, int perm, float scale, LAS float* scr, int gw_, int NGW_, int lane) {
    lane = lane_id(); OPAQUE(lane);
    const int kbn = Kp / 128, nbn = Np / 32, per = kbn * nbn, total = batch * per;
    for (int it = gw_; it < total; it += NGW_) {
        const int bi = it / per, r = it - bi * per, kb = r / nbn, nb = r - kb * nbn, k0 = 128 * kb, n0 = 32 * nb;
        const float* W = src + (size_t)bi * Kr * Nr; unsigned char* WT = dst + (size_t)bi * Np * Kp;
        float vals[64];
#pragma unroll
        for (int i = 0; i < 64; ++i) { const int k = k0 + 2 * i + (lane >> 5), n = n0 + (lane & 31); vals[i] = (k < Kr && n < Nr) ? W[(size_t)k * Nr + n] : 0.f; }
#pragma unroll
        for (int i = 0; i < 64; ++i) scr[(2 * i + (lane >> 5)) * 33 + (lane & 31)] = vals[i] * scale;
        LDS_WAIT();
        const int c = lane & 7;
#pragma unroll
        for (int j = 0; j < 4; ++j) { const int nl = (lane >> 3) + 8 * j; const LAS float* sp = scr + (16 * c) * 33 + nl; u32x4 o;
#pragma unroll
            for (int q = 0; q < 4; ++q) { int w_ = __builtin_amdgcn_cvt_pk_fp8_f32(sp[(4 * q) * 33], sp[(4 * q + 1) * 33], 0, false); w_ = __builtin_amdgcn_cvt_pk_fp8_f32(sp[(4 * q + 2) * 33], sp[(4 * q + 3) * 33], w_, true); o[q] = (unsigned)w_; }
            int n = n0 + nl; if (perm) n = ((n & 1023) >> 7) * 256 + (n >> 10) * 128 + (n & 127);
            *(u32x4*)(WT + (size_t)n * Kp + k0 + 16 * c) = o; }
        LDS_WAIT();
    }
}

struct Unit { int pm, pn, kind, e, rows, rbase; const char* A; const char* B; const int* list; };

struct DenseDesc { const char* A; const char* B; int kind, pn; };

namespace pg8 {
constexpr int BM = 256, BK = 64, HALF = 128, HTB = HALF * BK * 2, STAGE_BYTES = 8 * HTB;
__device__ __forceinline__ int lds_byte(int r, int c) { const int st = (r >> 4) * 2 + (c >> 5), rr = r & 15, cc = c & 31, ob = rr * 64 + cc * 2; return st * 1024 + (ob ^ (((ob >> 9) & 1) << 5)); }
__device__ __forceinline__ void stage_rc(int b, int& R, int& C) { const int st = b / 1024, sb = b % 1024, swz = sb ^ (((sb >> 9) & 1) << 5); R = (st >> 1) * 16 + swz / 64; C = (st & 1) * 32 + (swz % 64) / 2; }
}
typedef int i32x4 __attribute__((ext_vector_type(4)));
typedef int i32x8 __attribute__((ext_vector_type(8)));
template <bool FP8, class Sched, class Epi>
__device__ __forceinline__ void gemm_phase_pg8(LAS unsigned char* lds, const Sched& S, const Epi& E, const int Kb, const int wave) {
    using namespace pg8;
    int tid = wave * 64 + lane_id(); OPAQUE(tid);
    const int wid = wave, lane = tid & 63, wr = wid >> 2, wc = wid & 3, fr = lane & 15, fq = lane >> 4;
    const int nt = Kb / 128;
    int Rs[2], Cs[2]; unsigned voffB[2];
#pragma unroll
    for (int i = 0; i < 2; ++i) { stage_rc(tid * 16 + i * 8192, Rs[i], Cs[i]); voffB[i] = (unsigned)(Rs[i] * Kb + Cs[i] * 2); }
    const size_t kstep = (size_t)128;
    const size_t hstepB = (size_t)HALF * Kb;
    const unsigned ldsw = (unsigned)wid * 1024u;
    const int aoff = lds_byte(wr * 64 + fr, fq * 8), boff = lds_byte(wc * 32 + fr, fq * 8);
#define PG8_SA(b, h) (((b) * 2 + (h)) * HTB)
#define PG8_SB(b, h) ((4 + (b) * 2 + (h)) * HTB)
#define PG8_STAGE(bufoff, gbase, voff) do { _Pragma("unroll") for (int _i = 0; _i < 2; ++_i) \
        __builtin_amdgcn_global_load_lds((const unsigned*)((const char*)(gbase) + (voff)[_i]), (LAS unsigned*)(lds + (bufoff) + ldsw + _i * 8192), 16, 0, 0); } while (0)
#define PG8_LDA(dst, b, h) do { _Pragma("unroll") for (int m = 0; m < 4; ++m) _Pragma("unroll") for (int k = 0; k < 2; ++k) dst[m][k] = *(const LAS h16x8*)(lds + PG8_SA(b, h) + aoff + m * 2048 + k * 1024); } while (0)
#define PG8_LDB(dst, b, h) do { _Pragma("unroll") for (int n = 0; n < 2; ++n) _Pragma("unroll") for (int k = 0; k < 2; ++k) dst[n][k] = *(const LAS h16x8*)(lds + PG8_SB(b, h) + boff + n * 2048 + k * 1024); } while (0)
#define PG8_MMA(ai, bj, At, Bt) do { __builtin_amdgcn_s_setprio(1); \
        if (FP8) { _Pragma("unroll") for (int m = 0; m < 4; ++m) _Pragma("unroll") for (int n = 0; n < 2; ++n) { \
            const i32x4 b0_ = __builtin_bit_cast(i32x4, Bt[n][0]), b1_ = __builtin_bit_cast(i32x4, Bt[n][1]), a0_ = __builtin_bit_cast(i32x4, At[m][0]), a1_ = __builtin_bit_cast(i32x4, At[m][1]); \
            acc[ai][bj][m][n] = __builtin_amdgcn_mfma_scale_f32_16x16x128_f8f6f4(__builtin_shufflevector(b0_, b1_, 0, 1, 2, 3, 4, 5, 6, 7), __builtin_shufflevector(a0_, a1_, 0, 1, 2, 3, 4, 5, 6, 7), acc[ai][bj][m][n], 0, 0, 0, 0, 0, 0); } } \
        else { _Pragma("unroll") for (int m = 0; m < 4; ++m) _Pragma("unroll") for (int n = 0; n < 2; ++n) _Pragma("unroll") for (int k = 0; k < 2; ++k) \
            acc[ai][bj][m][n] = __builtin_amdgcn_mfma_f32_16x16x32_f16(Bt[n][k], At[m][k], acc[ai][bj][m][n], 0, 0, 0); } \
        __builtin_amdgcn_s_setprio(0); } while (0)
#define PG8_WAIT_V(n) asm volatile("s_waitcnt vmcnt(" #n ")" ::: "memory")
#define PG8_WAIT_L(n) asm volatile("s_waitcnt lgkmcnt(" #n ")" ::: "memory")
#define PG8_BAR __builtin_amdgcn_s_barrier()
#define PG8_SCHED __builtin_amdgcn_sched_barrier(0)
    Unit cur, nxt; int ui = 0;
    if (!S.next(0, cur)) return;
    f32x4 acc[2][2][4][2];
#pragma unroll
    for (int a = 0; a < 2; ++a)
#pragma unroll
        for (int b = 0; b < 2; ++b)
#pragma unroll
            for (int m = 0; m < 4; ++m)
#pragma unroll
                for (int n = 0; n < 2; ++n) acc[a][b][m][n] = (f32x4){0.f, 0.f, 0.f, 0.f};
    h16x8 At[4][2], B0[2][2], B1[2][2];
    unsigned vA[2][2], vAn[2][2];
#pragma unroll
    for (int h = 0; h < 2; ++h)
#pragma unroll
        for (int i = 0; i < 2; ++i) vA[h][i] = S.a_off(cur, 128 * h + Rs[i]) + (unsigned)Cs[i] * 2u;
    const char* cA = cur.A; const char* cB = cur.B;
    PG8_STAGE(PG8_SB(0, 0), cB, voffB); PG8_STAGE(PG8_SB(0, 1), cB + hstepB, voffB); PG8_STAGE(PG8_SA(0, 0), cA, vA[0]); PG8_STAGE(PG8_SA(0, 1), cA, vA[1]);
    if (wr == 1) PG8_BAR;
    PG8_WAIT_V(2); PG8_BAR;
    PG8_STAGE(PG8_SB(1, 0), cB + kstep, voffB); PG8_STAGE(PG8_SA(1, 0), cA + kstep, vA[0]); PG8_STAGE(PG8_SB(1, 1), cB + hstepB + kstep, voffB);
    PG8_WAIT_V(6); PG8_BAR;
    for (;;) {
        const bool has_next = S.next(ui + 1, nxt);
        const char* nA = has_next ? nxt.A : cA; const char* nB = has_next ? nxt.B : cB;
#pragma unroll
        for (int h = 0; h < 2; ++h)
#pragma unroll
            for (int i = 0; i < 2; ++i) vAn[h][i] = has_next ? (S.a_off(nxt, 128 * h + Rs[i]) + (unsigned)Cs[i] * 2u) : vA[h][i];
#pragma unroll 1
        for (int t = 0; t < nt; t += 2) {
            const bool last = (t == nt - 2);
            const char* a1 = cA + (size_t)(t + 1) * kstep;
            const char* a2 = last ? nA : cA + (size_t)(t + 2) * kstep; const char* b2 = last ? nB : cB + (size_t)(t + 2) * kstep;
            const char* a3 = a2 + kstep; const char* b3 = b2 + kstep;
            PG8_LDB(B0, 0, 0); PG8_LDB(B1, 0, 1); PG8_SCHED; PG8_LDA(At, 0, 0); PG8_STAGE(PG8_SA(1, 1), a1, vA[1]);
            if (last) { vA[0][0] = vAn[0][0]; vA[0][1] = vAn[0][1]; vA[1][0] = vAn[1][0]; vA[1][1] = vAn[1][1]; }
            PG8_WAIT_V(8); PG8_WAIT_L(0); PG8_BAR; PG8_MMA(0, 0, At, B0); PG8_MMA(0, 1, At, B1); PG8_BAR; PG8_SCHED;
            PG8_LDA(At, 0, 1); PG8_STAGE(PG8_SB(0, 0), b2, voffB); PG8_STAGE(PG8_SB(0, 1), b2 + hstepB, voffB); PG8_STAGE(PG8_SA(0, 0), a2, vA[0]);
            PG8_WAIT_V(8); PG8_WAIT_L(0); PG8_BAR; PG8_MMA(1, 0, At, B0); PG8_MMA(1, 1, At, B1); PG8_BAR; PG8_SCHED;
            PG8_LDB(B0, 1, 0); PG8_LDB(B1, 1, 1); PG8_SCHED; PG8_LDA(At, 1, 0); PG8_STAGE(PG8_SA(0, 1), a2, vA[1]);
            PG8_WAIT_V(8); PG8_WAIT_L(0); PG8_BAR; PG8_MMA(0, 0, At, B0); PG8_MMA(0, 1, At, B1); PG8_BAR; PG8_SCHED;
            PG8_LDA(At, 1, 1); PG8_STAGE(PG8_SB(1, 0), b3, voffB); PG8_STAGE(PG8_SB(1, 1), b3 + hstepB, voffB); PG8_STAGE(PG8_SA(1, 0), a3, vA[0]);
            PG8_WAIT_V(8); PG8_WAIT_L(0); PG8_BAR; PG8_MMA(1, 0, At, B0); PG8_MMA(1, 1, At, B1); PG8_BAR; PG8_SCHED;
        }
        if (wr == 0) PG8_BAR;
        { int fr_e = fr, fq_e = fq; OPAQUE(fr_e); OPAQUE(fq_e);
          E(acc, cur, wr, wc, fr_e, fq_e); }
        if (!has_next) break;
#pragma unroll
        for (int a = 0; a < 2; ++a)
#pragma unroll
            for (int b = 0; b < 2; ++b)
#pragma unroll
                for (int m = 0; m < 4; ++m)
#pragma unroll
                    for (int n = 0; n < 2; ++n) acc[a][b][m][n] = (f32x4){0.f, 0.f, 0.f, 0.f};
        cur = nxt; cA = nA; cB = nB; ++ui;
        if (wr == 1) PG8_BAR;
    }
    PG8_WAIT_V(0);
    PG8_BAR;
#undef PG8_SA
#undef PG8_SB
#undef PG8_STAGE
#undef PG8_LDA
#undef PG8_LDB
#undef PG8_MMA
#undef PG8_WAIT_V
#undef PG8_WAIT_L
#undef PG8_BAR
#undef PG8_SCHED
}
#define GEMM_PHASE(S, E, K) gemm_phase_pg8<false>(lds, S, E, (K) * 2, wave)
#define GEMM_PHASE8(S, E, K) gemm_phase_pg8<true>(lds, S, E, (K), wave)

#define FOR_ACC2(ai, bj, m) _Pragma("unroll") for (int ai = 0; ai < 2; ++ai) _Pragma("unroll") for (int m = 0; m < 4; ++m) _Pragma("unroll") for (int bj = 0; bj < 2; ++bj)
#define FOR_ACC(ai, bj, m, n) _Pragma("unroll") for (int ai = 0; ai < 2; ++ai) _Pragma("unroll") for (int m = 0; m < 4; ++m) _Pragma("unroll") for (int bj = 0; bj < 2; ++bj) _Pragma("unroll") for (int n = 0; n < 2; ++n)
#define EPI_FENCE() asm volatile("" ::: "memory")

template <bool F16IN>
__device__ __forceinline__ void phase_prep(const void* Xv, const float* mix, h16* XM, int gw_, int NGW_, int lane) {
    lane = lane_id(); OPAQUE(lane);
    const float* Xf = (const float*)Xv; const h16* Xh = (const h16*)Xv;
    for (int ch = gw_; ch < T / 16; ch += NGW_) {
        const int t0 = ch * 16;
        f32x4 prev[4];
        if ((t0 % SEQ) == 0) {
#pragma unroll
            for (int j = 0; j < 4; ++j) prev[j] = (f32x4){0.f, 0.f, 0.f, 0.f};
        } else {
#pragma unroll
            for (int j = 0; j < 4; ++j) prev[j] = F16IN ? ldh4(Xh + (size_t)(t0 - 1) * D + 256 * j + 4 * lane) : *(const f32x4*)(Xf + (size_t)(t0 - 1) * D + 256 * j + 4 * lane);
        }
#pragma unroll 1
        for (int ib = 0; ib < 4; ++ib) {
            f32x4 cur[4][4]; h16x4 curh[4][4];
#pragma unroll
            for (int q = 0; q < 4; ++q)
#pragma unroll
                for (int j = 0; j < 4; ++j) { if (F16IN) curh[q][j] = *(const h16x4*)(Xh + (size_t)(t0 + 4 * ib + q) * D + 256 * j + 4 * lane); else cur[q][j] = *(const f32x4*)(Xf + (size_t)(t0 + 4 * ib + q) * D + 256 * j + 4 * lane); }
            if (F16IN) {
#pragma unroll
                for (int q = 0; q < 4; ++q)
#pragma unroll
                    for (int j = 0; j < 4; ++j) cur[q][j] = __builtin_convertvector(curh[q][j], f32x4);
            }
#pragma unroll
            for (int q = 0; q < 4; ++q) {
                const int t = t0 + 4 * ib + q;
#pragma unroll
                for (int s = 0; s < 6; ++s) {
#pragma unroll
                    for (int j = 0; j < 4; ++j) { const f32x4 mx = *(const f32x4*)(mix + s * D + 256 * j + 4 * lane);
                        const f32x4 pv = (q == 0) ? prev[j] : cur[q == 0 ? 0 : q - 1][j];
                        const f32x4 v = cur[q][j] + (pv - cur[q][j]) * mx;
                        __builtin_nontemporal_store(pkh4(v), (u32x2*)(XM + ((size_t)s * T + t) * D + 256 * j + 4 * lane)); }
                }
            }
#pragma unroll
            for (int j = 0; j < 4; ++j) prev[j] = cur[3][j];
        }
    }
}

struct ScanArgs { const h16 *R, *K, *V; const h16* WD; const h16 *AA, *GG; const float *k_k, *k_a, *r_k, *lnx_g, *lnx_b; h16* YG; const float *wgu, *wdn; unsigned char *gu8, *dn8; int layer_pair; };
__device__ __forceinline__ float row16_sum(float v) { v += dppf<0xB1>(v); v += dppf<0x4E>(v); v += dppf<0x141>(v); v += dppf<0x140>(v); return v; }
struct ConvItem2 { const float* Wrow; unsigned char* WTp; int Nr; float scale; bool valid; };
__device__ __forceinline__ ConvItem2 conv_item2(int sit, int wave, int lane, int layer_pair, const float* wgu, const float* wdn, unsigned char* gu8) {
    ConvItem2 ci; ci.valid = sit < 12288;
    const int s = ci.valid ? sit : 0, ls = s / 6144, r = s - ls * 6144, e = r / 192, q = r - e * 192, le = (layer_pair * 2 + ls) * 32 + e;
    const bool gu = q < 128; const int q2 = gu ? q : q - 128, nb = gu ? (q2 & 31) : (q2 & 15), kq = gu ? (q2 >> 5) : (q2 >> 4), Nr = gu ? 2048 : 1024;
    const int k0 = kq * 256 + wave * 32, n = nb * 64 + lane, c5 = n & 31, p5 = 16 * ((c5 >> 2) & 1) + 4 * (c5 >> 3) + (c5 & 3), np = (n & ~31) | p5;
    const int c8 = n & 255, pdn = (n & ~255) | (128 * ((c8 >> 3) & 1) + 32 * (c8 >> 6) + 16 * ((c8 >> 2) & 1) + 4 * ((c8 >> 4) & 3) + (c8 & 3));
    const int nrow = gu ? ((np & 1023) >> 7) * 256 + (np >> 10) * 128 + (np & 127) : pdn;
    size_t wb; { const int gi = __builtin_amdgcn_readfirstlane(gu ? 1 : 0); asm("s_cmp_lg_u32 %1, 0\n\ts_cselect_b64 %0, %2, %3" : "=s"(wb) : "s"(gi), "s"(wgu), "s"(wdn) : "scc"); }
    const size_t ob = (size_t)gu8 + (gu ? (size_t)0 : (size_t)(WS_W_DN - WS_W_GU));
    ci.Wrow = (const float*)wb + (size_t)le * 1024 * Nr + (size_t)k0 * Nr + nb * 64; ci.WTp = (unsigned char*)ob + (size_t)le * Nr * 1024 + (size_t)nrow * 1024 + k0; ci.Nr = Nr; ci.scale = gu ? GU_SCALE : DN_SCALE;
    return ci;
}
__device__ __forceinline__ void conv_issue2(const ConvItem2& ci, float (&vals)[32], int lane) {
    if (ci.valid) {
        const GAS char* p = (const GAS char*)ci.Wrow; const unsigned lo = (unsigned)lane * 4u; const size_t stride = (size_t)ci.Nr * 4;
#pragma unroll
        for (int i = 0; i < 32; ++i) { vals[i] = __builtin_nontemporal_load((const GAS float*)(p + lo)); p += stride; }
    }
}
__device__ __forceinline__ void conv_finish2(const ConvItem2& ci, const float (&vals)[32]) {
    if (ci.valid) {
#pragma unroll
        for (int j = 0; j < 2; ++j) { u32x4 o;
#pragma unroll
            for (int q = 0; q < 4; ++q) { int pk_ = __builtin_amdgcn_cvt_pk_fp8_f32(vals[16 * j + 4 * q] * ci.scale, vals[16 * j + 4 * q + 1] * ci.scale, 0, false);
                pk_ = __builtin_amdgcn_cvt_pk_fp8_f32(vals[16 * j + 4 * q + 2] * ci.scale, vals[16 * j + 4 * q + 3] * ci.scale, pk_, true); o[q] = (unsigned)pk_; }
            *(u32x4*)(ci.WTp + 16 * j) = o; }
    }
}
__device__ __forceinline__ float row16_reduce_scatter(const float (&q)[16], int lane) {
    const bool b0 = lane & 1, b1 = lane & 2, b2 = lane & 4, b3 = lane & 8;
    float v[16], a[8], c[4], d[2];
#pragma unroll
    for (int s = 0; s < 16; ++s) v[s] = q[((s & 1) << 3) | ((s & 2) << 1) | ((s & 4) >> 1) | ((s & 8) >> 3)];
#pragma unroll
    for (int j = 0; j < 8; ++j) a[j] = (b0 ? v[j + 8] : v[j]) + dppf<0xB1>(b0 ? v[j] : v[j + 8]);
#pragma unroll
    for (int j = 0; j < 4; ++j) c[j] = (b1 ? a[j + 4] : a[j]) + dppf<0x4E>(b1 ? a[j] : a[j + 4]);
#pragma unroll
    for (int j = 0; j < 2; ++j) d[j] = (b2 ? c[j + 2] : c[j]) + dppf<0x124>(b2 ? c[j] : c[j + 2]);
    return (b3 ? d[1] : d[0]) + dppf<0x128>(b3 ? d[0] : d[1]);
}
#define WBAR() do { asm volatile("s_waitcnt lgkmcnt(0)" ::: "memory"); __builtin_amdgcn_s_barrier(); asm volatile("" ::: "memory"); } while (0)
__device__ __forceinline__ void phase_scan_mm(const ScanArgs& a, LAS unsigned char* lds, int blk, int G, const int wave) {
    constexpr int NG = 4, PCH = 13120;
    constexpr int O_AT = 0, O_RT = 2304, O_BBT = 4608, O_KBT = 6656, O_VT = 8704, O_MKT = 10752, O_TMT = 11264, O_NBT = 11776, O_NKT = 12288, O_GC = 12800, O_SRK = 13056;
    constexpr int TMP0 = NG * PCH, TMPB = 5632;
    constexpr int O_SY = TMP0 + 4 * TMPB, O_VO = O_SY + 2 * 16640, O_SRKO = O_VO + 2 * 8192, O_RED = O_SRKO + 512;
    int pass = 0;
    for (int bh = blk; bh < NBATCH * 16; bh += G, ++pass) {
        int tid0 = wave * 64 + lane_id(); OPAQUE(tid0);
        const int b = bh >> 4, h = bh & 15, chn0 = h * 64 + (tid0 & 63);
        const float kkc = a.k_k[chn0], kac = a.k_a[chn0], rkc = a.r_k[chn0], lg = a.lnx_g[chn0], lb = a.lnx_b[chn0];
        f32x4 ST[4];
#pragma unroll
        for (int kt = 0; kt < 4; ++kt) ST[kt] = (f32x4){0.f, 0.f, 0.f, 0.f};
        h16 qr[8], qk[8], qv[8], qa[8], qw[8];
        const int c4w = wave >> 1, hfw = wave & 1;
#pragma unroll
        for (int i = 0; i < 8; ++i) { const size_t tb = ((size_t)bh * SEQ + c4w * 16 + 8 * hfw) * 64 + (tid0 & 63);
            qr[i] = a.R[tb + i * 64]; qk[i] = a.K[tb + i * 64]; qv[i] = a.V[tb + i * 64]; qa[i] = a.AA[tb + i * 64]; qw[i] = a.WD[tb + i * 64]; }
        LAS float* gpr = (LAS float*)(lds + O_RED + 1024);
#define GPROD() ((((1.0f - (float)qw[0]) * (1.0f - (float)qw[1])) * ((1.0f - (float)qw[2]) * (1.0f - (float)qw[3]))) * (((1.0f - (float)qw[4]) * (1.0f - (float)qw[5])) * ((1.0f - (float)qw[6]) * (1.0f - (float)qw[7]))))
        gpr[wave * 64 + (tid0 & 63)] = GPROD();
        WBAR();
        h16 qg[16];
        float cv[32];
        ConvItem2 ci = conv_item2(((pass * 32 + 0) * 2 + 0) * G + blk, wave, tid0 & 63, a.layer_pair, a.wgu, a.wdn, a.gu8);
        conv_issue2(ci, cv, tid0 & 63);
#define OUT_STAGE(gp_) do { const int gp = (gp_); LAS float* red = (LAS float*)(lds + O_RED) + wave * 32; const LAS float* syo = (const LAS float*)(lds + O_SY) + (gp & 1) * (64 * 65); \
            const LAS h16* voo = (const LAS h16*)(lds + O_VO) + (gp & 1) * 4096; const LAS float* srko = (const LAS float*)(lds + O_SRKO) + (gp & 1) * 64; \
            _Pragma("unroll") for (int bt = 0; bt < 2; ++bt) { const int t0 = (wave - 4) * 16 + 8 * bt; float yv[8], q[16]; \
                _Pragma("unroll") for (int p = 0; p < 8; ++p) { yv[p] = syo[(t0 + p) * 65 + lane]; q[p] = yv[p]; q[8 + p] = yv[p] * yv[p]; } \
                float x = row16_reduce_scatter(q, lane); x += swz16f(x); \
                if ((lane & 16) == 0) red[(lane >> 5) * 16 + l16] = x; \
                LDS_WAIT(); \
                f32x4 s1[2], s2[2]; \
                _Pragma("unroll") for (int hq = 0; hq < 2; ++hq) { s1[hq] = *(const LAS f32x4*)(red + 4 * hq) + *(const LAS f32x4*)(red + 16 + 4 * hq); s2[hq] = *(const LAS f32x4*)(red + 8 + 4 * hq) + *(const LAS f32x4*)(red + 24 + 4 * hq); } \
                _Pragma("unroll") for (int p = 0; p < 8; ++p) { const int tt = t0 + p; \
                    const float mu = s1[p >> 2][p & 3] * (1.0f / 64.0f), var = fmaxf(s2[p >> 2][p & 3] * (1.0f / 64.0f) - mu * mu, 0.0f); \
                    float yn = (yv[p] - mu) * rsqrtf(var + 64e-5f) * lg + lb; yn += srko[tt] * (float)voo[tt * 64 + lane]; \
                    a.YG[((size_t)b * SEQ + gp * 64 + tt) * D + chn] = (h16)(yn * (float)qg[8 * bt + p]); } \
                LDS_WAIT(); } } while (0)
#pragma unroll 1
        for (int grp = 0; grp < SEQ / 64; ++grp) {
            int tid = tid0; OPAQUE(tid);
            const int lane = tid & 63, g4 = lane >> 4, l16 = lane & 15, chn = h * 64 + lane;
            {
                LAS unsigned char* pc = lds + c4w * PCH; LAS unsigned char* tb = lds + TMP0 + c4w * TMPB;
                LAS h16* At = (LAS h16*)(pc + O_AT); LAS h16* Rt = (LAS h16*)(pc + O_RT); LAS h16* BbT = (LAS h16*)(pc + O_BBT); LAS h16* KbT = (LAS h16*)(pc + O_KBT); LAS h16* Vt = (LAS h16*)(pc + O_VT);
                LAS h16* MkT = (LAS h16*)(pc + O_MKT); LAS h16* TmT = (LAS h16*)(pc + O_TMT); LAS h16* NbT = (LAS h16*)(pc + O_NBT); LAS h16* NkT = (LAS h16*)(pc + O_NKT);
                LAS float* gC = (LAS float*)(pc + O_GC); LAS float* srk = (LAS float*)(pc + O_SRK);
                LAS h16* Bh = (LAS h16*)tb; LAS h16* Kh = (LAS h16*)(tb + 2304); LAS float* MbF = (LAS float*)(tb + 4608);
                float wf[8];
#pragma unroll
                for (int i = 0; i < 8; ++i) wf[i] = 1.0f - (float)qw[i];
                if (grp + 1 < SEQ / 64) {
#pragma unroll
                    for (int i = 0; i < 8; ++i) qw[i] = a.WD[((size_t)bh * SEQ + (grp + 1) * 64 + c4w * 16 + 8 * hfw) * 64 + lane + i * 64];
                }
                const float gown = ((wf[0] * wf[1]) * (wf[2] * wf[3])) * ((wf[4] * wf[5]) * (wf[6] * wf[7])), goth = gpr[(wave ^ 1) * 64 + lane];
                const float gall = gown * goth;
                float gam = hfw ? goth : 1.0f, bhr[8], khr[8];
                LAS float* red = (LAS float*)(lds + O_RED) + wave * 32;
                float n2s[8];
                {
                    float q[16];
#pragma unroll
                    for (int i = 0; i < 8; ++i) { const float k = (float)qk[i], kk = k * kkc; q[i] = kk * kk; q[8 + i] = (float)qr[i] * (k * (1.0f + ((float)qa[i] - 1.0f) * kac)) * rkc; }
                    float x = row16_reduce_scatter(q, lane); x += swz16f(x);
                    if ((lane & 16) == 0) red[(lane >> 5) * 16 + l16] = x;
                    LDS_WAIT();
                    const f32x4 r0 = *(const LAS f32x4*)(red), r1 = *(const LAS f32x4*)(red + 4), r2 = *(const LAS f32x4*)(red + 16), r3 = *(const LAS f32x4*)(red + 20);
#pragma unroll
                    for (int i = 0; i < 4; ++i) { n2s[i] = r0[i] + r2[i]; n2s[4 + i] = r1[i] + r3[i]; }
                    const float rks = red[8 + (lane & 7)] + red[24 + (lane & 7)];
                    if (lane < 8) ((LAS float*)(lds + O_SRKO))[(grp & 1) * 64 + 16 * c4w + 8 * hfw + lane] = rks;
                }
#pragma unroll
                for (int i = 0; i < 8; ++i) {
                    const int tt = 8 * hfw + i;
                    const float r = (float)qr[i], k = (float)qk[i], v = (float)qv[i], w = wf[i], aa = (float)qa[i];
                    const float kk = k * kkc; const float kkn = kk * __builtin_amdgcn_rsqf(fmaxf(n2s[i], 1e-24f));
                    const float kmod = k * (1.0f + (aa - 1.0f) * kac);
                    At[tt * 72 + lane] = (h16)(gam * -kkn);
                    gam *= w; const float rg = __builtin_amdgcn_rcpf(gam);
                    bhr[i] = fminf(fmaxf(kkn * aa * rg, -6.0e4f), 6.0e4f); khr[i] = fminf(fmaxf(kmod * rg, -6.0e4f), 6.0e4f);
                    Bh[tt * 72 + lane] = (h16)bhr[i]; Kh[tt * 72 + lane] = (h16)khr[i];
                    Rt[tt * 72 + lane] = (h16)(gam * r); ((LAS h16*)(lds + O_VO))[((grp & 1) * 64 + 16 * c4w + tt) * 64 + lane] = (h16)v;
                }
                if (hfw == 0) gC[lane] = gall;
                {
                    u32x4 pb, pk;
#pragma unroll
                    for (int q = 0; q < 4; ++q) { pb[q] = pkh(bhr[2 * q] * gall, bhr[2 * q + 1] * gall); pk[q] = pkh(khr[2 * q] * gall, khr[2 * q + 1] * gall); }
                    *(LAS u32x4*)(BbT + lane * 16 + 8 * hfw) = pb; *(LAS u32x4*)(KbT + lane * 16 + 8 * hfw) = pk;
                }
                conv_finish2(ci, cv);
                if (grp + 1 < SEQ / 64) {
#pragma unroll
                    for (int i = 0; i < 8; ++i) { const size_t tb = ((size_t)bh * SEQ + (grp + 1) * 64 + c4w * 16 + 8 * hfw) * 64 + lane;
                        qr[i] = a.R[tb + i * 64]; qk[i] = a.K[tb + i * 64]; qv[i] = a.V[tb + i * 64]; qa[i] = a.AA[tb + i * 64]; }
                }
                ci = conv_item2(((pass * 32 + grp) * 2 + 1) * G + blk, wave, lane, a.layer_pair, a.wgu, a.wdn, a.gu8);
                conv_issue2(ci, cv, lane);
                WBAR();
                if (hfw == 0) {
                    f32x4 mb = {0.f, 0.f, 0.f, 0.f}, mt = mb;
#pragma unroll
                    for (int s = 0; s < 2; ++s) { const int fo = l16 * 72 + 32 * s + 8 * g4; const h16x8 fb = *(const LAS h16x8*)(Bh + fo), fa = *(const LAS h16x8*)(At + fo);
                        mb = __builtin_amdgcn_mfma_f32_16x16x32_f16(fb, fa, mb, 0, 0, 0);
                        mt = __builtin_amdgcn_mfma_f32_16x16x32_f16(fa, fb, mt, 0, 0, 0); }
                    f32x4 td, ttd;
#pragma unroll
                    for (int e = 0; e < 4; ++e) { const int i = 4 * g4 + e; mb[e] = (i < l16) ? mb[e] : 0.f; mt[e] = (l16 < i) ? mt[e] : 0.f; const float dg = (i == l16) ? 1.0f : 0.0f; td[e] = mb[e] + dg; ttd[e] = mt[e] + dg; }
                    h16x4 xb = __builtin_convertvector(mb, h16x4), xa = __builtin_convertvector(mt, h16x4);
#pragma unroll
                    for (int s = 0; s < 3; ++s) {
                        const f32x4 z4 = {0.f, 0.f, 0.f, 0.f};
                        const f32x4 sq = __builtin_amdgcn_mfma_f32_16x16x16f16(xa, xb, z4, 0, 0, 0);
                        const f32x4 sqt = __builtin_amdgcn_mfma_f32_16x16x16f16(xb, xa, z4, 0, 0, 0);
                        xb = __builtin_convertvector(sq, h16x4); xa = __builtin_convertvector(sqt, h16x4);
                        const h16x4 ta = __builtin_convertvector(ttd, h16x4);
                        td = __builtin_amdgcn_mfma_f32_16x16x16f16(ta, xb, td, 0, 0, 0);
                        if (s < 2) ttd = __builtin_amdgcn_mfma_f32_16x16x16f16(xb, ta, ttd, 0, 0, 0);
                    }
                    *(LAS u32x2*)(TmT + l16 * 16 + 4 * g4) = pkh4(td);
                } else {
                    f32x4 mk = {0.f, 0.f, 0.f, 0.f}, nb = mk, nk = mk;
#pragma unroll
                    for (int s = 0; s < 2; ++s) {
                        const int fo = l16 * 72 + 32 * s + 8 * g4;
                        const h16x8 fb = *(const LAS h16x8*)(Bh + fo), fk = *(const LAS h16x8*)(Kh + fo), fa = *(const LAS h16x8*)(At + fo), fr = *(const LAS h16x8*)(Rt + fo);
                        mk = __builtin_amdgcn_mfma_f32_16x16x32_f16(fk, fa, mk, 0, 0, 0); nb = __builtin_amdgcn_mfma_f32_16x16x32_f16(fb, fr, nb, 0, 0, 0); nk = __builtin_amdgcn_mfma_f32_16x16x32_f16(fk, fr, nk, 0, 0, 0);
                    }
#pragma unroll
                    for (int e = 0; e < 4; ++e) { const int i = 4 * g4 + e; const bool lt = i < l16, le = i <= l16; mk[e] = lt ? mk[e] : 0.f; nb[e] = le ? nb[e] : 0.f; nk[e] = le ? nk[e] : 0.f; }
                    *(LAS u32x2*)(MkT + l16 * 16 + 4 * g4) = pkh4(mk); *(LAS u32x2*)(NbT + l16 * 16 + 4 * g4) = pkh4(nb); *(LAS u32x2*)(NkT + l16 * 16 + 4 * g4) = pkh4(nk);
                }
            }
            WBAR();
            if (wave < 4) {
                LAS float* sy = (LAS float*)(lds + O_SY) + (grp & 1) * (64 * 65);
#pragma unroll 2
                for (int c4 = 0; c4 < NG; ++c4) {
                    LAS unsigned char* pc = lds + c4 * PCH;
                    const LAS h16* At = (const LAS h16*)(pc + O_AT); const LAS h16* Rt = (const LAS h16*)(pc + O_RT); const LAS h16* BbT = (const LAS h16*)(pc + O_BBT); const LAS h16* KbT = (const LAS h16*)(pc + O_KBT);
                    const LAS h16* Vt = (const LAS h16*)(pc + O_VT); const LAS h16* MkT = (const LAS h16*)(pc + O_MKT); const LAS h16* TmT = (const LAS h16*)(pc + O_TMT);
                    const LAS h16* NbT = (const LAS h16*)(pc + O_NBT); const LAS h16* NkT = (const LAS h16*)(pc + O_NKT); const LAS float* gC = (const LAS float*)(pc + O_GC);
                    h16x4 sb[4];
#pragma unroll
                    for (int kt = 0; kt < 4; ++kt) sb[kt] = __builtin_convertvector(ST[kt], h16x4);
                    h16x4 vb;
                    { const LAS h16* vsrc = (const LAS h16*)(lds + O_VO) + ((grp & 1) * 64 + 16 * c4 + 4 * g4) * 64 + 16 * wave + l16;
#pragma unroll
                      for (int e = 0; e < 4; ++e) vb[e] = vsrc[e * 64]; }
                    f32x4 accW = {0.f, 0.f, 0.f, 0.f}, accY = {0.f, 0.f, 0.f, 0.f};
#pragma unroll
                    for (int kt = 0; kt < 4; ++kt) {
                        accW = __builtin_amdgcn_mfma_f32_16x16x16f16(*(const LAS h16x4*)(At + l16 * 72 + 16 * kt + 4 * g4), sb[kt], accW, 0, 0, 0);
                        accY = __builtin_amdgcn_mfma_f32_16x16x16f16(*(const LAS h16x4*)(Rt + l16 * 72 + 16 * kt + 4 * g4), sb[kt], accY, 0, 0, 0);
                    }
                    accW = __builtin_amdgcn_mfma_f32_16x16x16f16(*(const LAS h16x4*)(MkT + l16 * 16 + 4 * g4), vb, accW, 0, 0, 0);
                    accY = __builtin_amdgcn_mfma_f32_16x16x16f16(*(const LAS h16x4*)(NkT + l16 * 16 + 4 * g4), vb, accY, 0, 0, 0);
                    const h16x4 wb = __builtin_convertvector(accW, h16x4);
                    const f32x4 accU = __builtin_amdgcn_mfma_f32_16x16x16f16(*(const LAS h16x4*)(TmT + l16 * 16 + 4 * g4), wb, (f32x4){0.f, 0.f, 0.f, 0.f}, 0, 0, 0);
                    const h16x4 ub = __builtin_convertvector(accU, h16x4);
                    accY = __builtin_amdgcn_mfma_f32_16x16x16f16(*(const LAS h16x4*)(NbT + l16 * 16 + 4 * g4), ub, accY, 0, 0, 0);
#pragma unroll
                    for (int kt = 0; kt < 4; ++kt) {
                        ST[kt] = ST[kt] * *(const LAS f32x4*)(gC + 16 * kt + 4 * g4);
                        ST[kt] = __builtin_amdgcn_mfma_f32_16x16x16f16(*(const LAS h16x4*)(BbT + (16 * kt + l16) * 16 + 4 * g4), ub, ST[kt], 0, 0, 0);
                        ST[kt] = __builtin_amdgcn_mfma_f32_16x16x16f16(*(const LAS h16x4*)(KbT + (16 * kt + l16) * 16 + 4 * g4), vb, ST[kt], 0, 0, 0);
                    }
#pragma unroll
                    for (int e = 0; e < 4; ++e) sy[(16 * c4 + 4 * g4 + e) * 65 + 16 * wave + l16] = accY[e];
                }
            }
            else {
                if (grp > 0) OUT_STAGE(grp - 1);
#pragma unroll
                for (int j = 0; j < 16; ++j) qg[j] = a.GG[((size_t)bh * SEQ + grp * 64 + (wave - 4) * 16) * 64 + lane + j * 64];
            }
            conv_finish2(ci, cv);
            ci = conv_item2(((pass * 32 + grp + 1) * 2 + 0) * G + blk, wave, lane, a.layer_pair, a.wgu, a.wdn, a.gu8);
            if (grp + 1 < SEQ / 64) { conv_issue2(ci, cv, lane); gpr[wave * 64 + lane] = GPROD(); }
            WBAR();
        }
#undef GPROD
        if (wave >= 4) { const int lane = lane_id(), l16 = lane & 15, chn = h * 64 + lane; OUT_STAGE(SEQ / 64 - 1); }
#undef OUT_STAGE
    }
}

__device__ __forceinline__ float row16_max(float v) { v = fmaxf(v, dppf<0xB1>(v)); v = fmaxf(v, dppf<0x4E>(v)); v = fmaxf(v, dppf<0x141>(v)); v = fmaxf(v, dppf<0x140>(v)); return v; }
struct RouterArgs { const h16* H; const float *g, *b; const h16* WRS; const float* rb; h16* X1; unsigned char* XB; float* TOPG; int* LIST; unsigned* CNT; };
__device__ __forceinline__ void phase_ln_router(const RouterArgs& a, LAS unsigned char* lds, int blk, int G, const int wave) {
    constexpr int WPB = 2064;
    LAS unsigned* hcnt = (LAS unsigned*)(lds + 132096); LAS unsigned* hbase = hcnt + 32; LAS unsigned* pe = hbase + 32; LAS unsigned* pp = pe + 512;
    int tid = wave * 64 + lane_id(); OPAQUE(tid);
    const int lane = tid & 63, ex = lane & 15, kg = lane >> 4;
    for (int c = tid; c < 2 * 32 * 128; c += NTHR) { const int row = c >> 7, ch = c & 127; *(LAS u32x4*)(lds + row * WPB + ch * 16) = *(const u32x4*)((const char*)a.WRS + (size_t)row * 2048 + ch * 16); }
    const float rb0 = a.rb[ex], rb1 = a.rb[16 + ex];
    for (int tb = blk; tb < T / 128; tb += G) {
        if (tid < 32) hcnt[tid] = 0u;
        __syncthreads();
        const size_t tw = (size_t)tb * 128 + wave * 16;
#pragma unroll 1
        for (int ib = 0; ib < 4; ++ib) {
            f32x4 vv[4][4]; h16x4 vh[4][4];
#pragma unroll
            for (int q = 0; q < 4; ++q)
#pragma unroll
                for (int j = 0; j < 4; ++j) vh[q][j] = __builtin_nontemporal_load((const h16x4*)(a.H + (tw + 4 * ib + q) * D + 256 * j + 4 * lane));
#pragma unroll
            for (int q = 0; q < 4; ++q)
#pragma unroll
                for (int j = 0; j < 4; ++j) vv[q][j] = __builtin_convertvector(vh[q][j], f32x4);
#pragma unroll
            for (int q = 0; q < 4; ++q) {
                const size_t t = tw + 4 * ib + q; float s1 = 0.f;
#pragma unroll
                for (int j = 0; j < 4; ++j) s1 += (vv[q][j].x + vv[q][j].y) + (vv[q][j].z + vv[q][j].w);
                const float mean = wave_sum(s1) * (1.0f / D); float s2 = 0.f;
#pragma unroll
                for (int j = 0; j < 4; ++j) { vv[q][j] = vv[q][j] - mean; s2 += (vv[q][j].x * vv[q][j].x + vv[q][j].y * vv[q][j].y) + (vv[q][j].z * vv[q][j].z + vv[q][j].w * vv[q][j].w); }
                const float rstd = rsqrtf(wave_sum(s2) * (1.0f / D) + LN_EPS);
#pragma unroll
                for (int j = 0; j < 4; ++j) { const f32x4 o = vv[q][j] * rstd * *(const f32x4*)(a.g + 256 * j + 4 * lane) + *(const f32x4*)(a.b + 256 * j + 4 * lane);
                    *(u32x2*)(a.X1 + t * D + 256 * j + 4 * lane) = pkh4(o);
                    int pk_ = __builtin_amdgcn_cvt_pk_fp8_f32(o.x, o.y, 0, false); pk_ = __builtin_amdgcn_cvt_pk_fp8_f32(o.z, o.w, pk_, true);
                    *(unsigned*)(a.XB + t * D + 256 * j + 4 * lane) = (unsigned)pk_; }
            }
        }
        asm volatile("s_waitcnt vmcnt(0)" ::: "memory");
        f32x4 cA[2], cB[2];
        cA[0] = cA[1] = cB[0] = cB[1] = (f32x4){0.f, 0.f, 0.f, 0.f};
        const h16* xrow = a.X1 + (tw + ex) * D + 8 * kg;
        const LAS unsigned char* bh = lds + ex * WPB + kg * 16; const LAS unsigned char* bl = bh + 32 * WPB;
#pragma unroll 8
        for (int ks = 0; ks < 32; ++ks) {
            const h16x8 xh = *(const h16x8*)(xrow + 32 * ks);
#pragma unroll
            for (int tI = 0; tI < 2; ++tI) {
                const h16x8 wh = *(const LAS h16x8*)(bh + tI * 16 * WPB + ks * 64), wl = *(const LAS h16x8*)(bl + tI * 16 * WPB + ks * 64);
                cA[tI] = __builtin_amdgcn_mfma_f32_16x16x32_f16(xh, wh, cA[tI], 0, 0, 0);
                cB[tI] = __builtin_amdgcn_mfma_f32_16x16x32_f16(xh, wl, cB[tI], 0, 0, 0);
            }
        }
#pragma unroll
        for (int e = 0; e < 4; ++e) {
            float c0 = cA[0][e] + cB[0][e] * (1.0f / 4096.0f) + rb0, c1 = cA[1][e] + cB[1][e] * (1.0f / 4096.0f) + rb1;
            int sel[4]; float val[4];
#pragma unroll
            for (int k = 0; k < 4; ++k) {
                const float m = row16_max(fmaxf(c0, c1));
                const unsigned r0 = (unsigned)(__ballot(c0 == m) >> (16 * kg)) & 0xFFFFu, r1 = (unsigned)(__ballot(c1 == m) >> (16 * kg)) & 0xFFFFu;
                const int hit0 = r0 != 0u; const int wl_ = hit0 ? __builtin_ctz(r0) : __builtin_ctz(r1 | 0x10000u);
                sel[k] = hit0 ? wl_ : 16 + wl_; val[k] = m;
                if (ex == wl_) { if (hit0) c0 = -INFINITY; else c1 = -INFINITY; }
            }
            const float e1 = __expf(val[1] - val[0]), e2 = __expf(val[2] - val[0]), e3 = __expf(val[3] - val[0]);
            const float inv = 1.0f / (1.0f + e1 + e2 + e3);
            if (ex < 4) {
                const int tl = wave * 16 + 4 * kg + e; const size_t t = (size_t)tb * 128 + tl;
                const int mysel = ex == 0 ? sel[0] : ex == 1 ? sel[1] : ex == 2 ? sel[2] : sel[3];
                const float myg = (ex == 0 ? 1.0f : ex == 1 ? e1 : ex == 2 ? e2 : e3) * inv;
                a.TOPG[t * 4 + ex] = myg;
                const unsigned pos = __hip_atomic_fetch_add(hcnt + mysel, 1u, __ATOMIC_RELAXED, __HIP_MEMORY_SCOPE_WORKGROUP);
                pe[tl * 4 + ex] = (unsigned)mysel; pp[tl * 4 + ex] = pos;
            }
        }
        __syncthreads();
        if (tid < 32) hbase[tid] = __hip_atomic_fetch_add(a.CNT + tid, hcnt[tid], __ATOMIC_RELAXED, __HIP_MEMORY_SCOPE_AGENT);
        __syncthreads();
        { const unsigned e = pe[tid]; a.LIST[(size_t)e * ECAP + hbase[e] + pp[tid]] = tb * 512 + tid; }
        __syncthreads();
    }
}

__device__ __forceinline__ void phase_combine(const h16* X1, const unsigned char* YS, const float* g, const float* b, float* Xo  , h16* XH  , int gw_, int NGW_, int lane) {
    lane = lane_id(); OPAQUE(lane);
#pragma unroll 1
    for (int t0 = gw_; t0 < T; t0 += 2 * NGW_) {
        h16x4 x[2][4]; unsigned y[2][4][4];
#pragma unroll
        for (int q = 0; q < 2; ++q) { const size_t t = (size_t)t0 + (size_t)q * NGW_;
#pragma unroll
            for (int j = 0; j < 4; ++j) { x[q][j] = *(const h16x4*)(X1 + t * D + 256 * j + 4 * lane);
#pragma unroll
                for (int k = 0; k < 4; ++k) y[q][j][k] = __builtin_nontemporal_load((const unsigned*)(YS + (t * 4 + k) * D + 256 * j + 4 * lane)); } }
#pragma unroll
        for (int q = 0; q < 2; ++q) { const size_t t = (size_t)t0 + (size_t)q * NGW_;
            f32x4 v[4]; float s = 0.f;
#pragma unroll
            for (int j = 0; j < 4; ++j) { f32x4 ysum = (f32x4){0.f, 0.f, 0.f, 0.f};
#pragma unroll
                for (int k = 0; k < 4; ++k) { const f32x2 lo = __builtin_amdgcn_cvt_pk_f32_fp8((int)y[q][j][k], false), hi = __builtin_amdgcn_cvt_pk_f32_fp8((int)y[q][j][k], true); ysum += (f32x4){lo.x, lo.y, hi.x, hi.y}; }
                v[j] = __builtin_convertvector(x[q][j], f32x4) * ALPHA + ysum * (1.0f / YS_SCALE);
                s += (v[j].x + v[j].y) + (v[j].z + v[j].w); }
            const float mean = wave_sum(s) * (1.0f / D); float s2 = 0.f;
#pragma unroll
            for (int j = 0; j < 4; ++j) { v[j] = v[j] - mean; s2 += (v[j].x * v[j].x + v[j].y * v[j].y) + (v[j].z * v[j].z + v[j].w * v[j].w); }
            const float rstd = rsqrtf(wave_sum(s2) * (1.0f / D) + LN_EPS);
#pragma unroll
            for (int j = 0; j < 4; ++j) { v[j] = v[j] * rstd * *(const f32x4*)(g + 256 * j + 4 * lane) + *(const f32x4*)(b + 256 * j + 4 * lane);
                if (Xo) *(f32x4*)(Xo + t * D + 256 * j + 4 * lane) = v[j]; else *(u32x2*)(XH + t * D + 256 * j + 4 * lane) = pkh4(v[j]); }
        }
    }
}

#include <cmath>
namespace attn_body {
using bf16=_Float16;
using bf16x8=__attribute__((ext_vector_type(8)))short;
using s16x4=__attribute__((ext_vector_type(4)))short;
using f32x16=__attribute__((ext_vector_type(16)))float;
using u32x4=__attribute__((ext_vector_type(4)))unsigned;
constexpr int SEQ=2048,D=64,DM=1024,DMO=2048;
constexpr int NW=8,QBLK=32,QB=QBLK*NW,KVBLK=64,NQB=SEQ/QB;
typedef _Float16 f16x8_t __attribute__((ext_vector_type(8)));
#define MFMA32(a,b,c) __builtin_amdgcn_mfma_f32_32x32x16_f16(__builtin_bit_cast(f16x8_t,(a)),__builtin_bit_cast(f16x8_t,(b)),(c),0,0,0)
__device__ __forceinline__ int crow(int r,int hi){return (r&3)+8*(r>>2)+4*hi;}
#define SBAR() __builtin_amdgcn_sched_barrier(0)
__device__ __forceinline__ void cmask(f32x16&p0,f32x16&p1,int jb,int qrel,int hi){
  const float NEG=-INFINITY; int kb=64*jb+4*hi;
  #pragma unroll
  for(int r=0;r<16;++r){int kv=kb+(r&3)+8*(r>>2); if(kv>qrel)p0[r]=NEG; if(kv+32>qrel)p1[r]=NEG;}
}

constexpr int NSLOT=3, SLOTB=8192;
constexpr int LDS_K=0, LDS_V=NSLOT*SLOTB, LDS_WS=2*NSLOT*SLOTB, LDS_OST=LDS_WS+NW*64*4, LDS_BYTES=LDS_OST+NW*4096;
constexpr float C2=0.125f*1.4426950408889634f;
__device__ __forceinline__ void glds16(const void*gsrc,unsigned lds_dst){unsigned keep;
  asm volatile("s_mov_b32 %0, m0\n\ts_mov_b32 m0, %2\n\ts_nop 0\n\tglobal_load_lds_dwordx4 %1, off\n\ts_mov_b32 m0, %0":"=&s"(keep):"v"(gsrc),"s"(lds_dst):"memory");}
__device__ __forceinline__ float max3f(float a,float b,float c){float r;asm("v_max3_f32 %0, %1, %2, %3":"=v"(r):"v"(a),"v"(b),"v"(c));return r;}
__device__ __forceinline__ float max2f(float a,float b){float r;asm("v_max_f32_e32 %0, %1, %2":"=v"(r):"v"(a),"v"(b));return r;}
__device__ __forceinline__ float fadd_s(float a,float b){float r;asm("v_add_f32_e32 %0, %1, %2":"=v"(r):"v"(a),"v"(b));return r;}
__device__ __forceinline__ float fsub_s(float a,float b){float r;asm("v_sub_f32_e32 %0, %1, %2":"=v"(r):"v"(a),"v"(b));return r;}
typedef float f32x2_t __attribute__((ext_vector_type(2))); typedef _Float16 bf16x2_t __attribute__((ext_vector_type(2)));
__device__ __forceinline__ unsigned cvtpk_s(float lo,float hi){f32x2_t v={lo,hi};bf16x2_t b=__builtin_convertvector(v,bf16x2_t);return __builtin_bit_cast(unsigned,b);}
#define WAIT_BAR(N) asm volatile("s_waitcnt vmcnt(" #N ") lgkmcnt(0)\n\ts_barrier":::"memory")

__device__ __forceinline__ void qkt(f32x16&p0,f32x16&p1,const char*Kslot,const bf16x8*qr,const f32x16&negm,int r32,int hi){
  const char*kb=Kslot+hi*1024+r32*16;
  #pragma unroll
  for(int d0=0;d0<4;++d0){
    const bf16x8 b0=*reinterpret_cast<const bf16x8*>(kb+d0*2048);
    const bf16x8 b1=*reinterpret_cast<const bf16x8*>(kb+d0*2048+512);
    if(d0==0){p0=MFMA32(b0,qr[0],negm);p1=MFMA32(b1,qr[0],negm);}
    else{p0=MFMA32(b0,qr[d0],p0);p1=MFMA32(b1,qr[d0],p1);}}
}
typedef __attribute__((address_space(3))) const char* lds_cptr;
typedef short v4i16_t __attribute__((ext_vector_type(4)));
__device__ __forceinline__ void kload8(bf16x8*kf,lds_cptr kp){
  kf[0]=*(const __attribute__((address_space(3))) bf16x8*)(kp);      kf[1]=*(const __attribute__((address_space(3))) bf16x8*)(kp+512);
  kf[2]=*(const __attribute__((address_space(3))) bf16x8*)(kp+2048); kf[3]=*(const __attribute__((address_space(3))) bf16x8*)(kp+2560);
  kf[4]=*(const __attribute__((address_space(3))) bf16x8*)(kp+4096); kf[5]=*(const __attribute__((address_space(3))) bf16x8*)(kp+4608);
  kf[6]=*(const __attribute__((address_space(3))) bf16x8*)(kp+6144); kf[7]=*(const __attribute__((address_space(3))) bf16x8*)(kp+6656);
}
__device__ __forceinline__ void kload2(bf16x8*kf,lds_cptr kp,int j){ kf[2*j]=*(const __attribute__((address_space(3))) bf16x8*)(kp+j*2048); kf[2*j+1]=*(const __attribute__((address_space(3))) bf16x8*)(kp+j*2048+512); }
__device__ __forceinline__ s16x4 vtr(lds_cptr p){ return __builtin_bit_cast(s16x4,__builtin_amdgcn_ds_read_tr16_b64_v4i16((__attribute__((address_space(3))) v4i16_t*)p)); }
__device__ __forceinline__ float rowmax(const f32x16&p0,const f32x16&p1){
  float a=max3f(p0[0],p0[1],p1[0]),b=max3f(p0[2],p0[3],p1[1]);a=max3f(a,p1[2],p1[3]);
  #pragma unroll
  for(int r=4;r<16;r+=4){a=max3f(a,p0[r],p0[r+1]);b=max3f(b,p0[r+2],p0[r+3]);a=max3f(a,p1[r],p1[r+1]);b=max3f(b,p1[r+2],p1[r+3]);}
  const float m=max2f(a,b);
  auto rr=__builtin_amdgcn_permlane32_swap(__float_as_uint(m),__float_as_uint(m),false,false);
  return max2f(__uint_as_float(rr[0]),__uint_as_float(rr[1]));
}
__device__ __forceinline__ void pv(f32x16*o,int vb,bf16x8 pa0,bf16x8 pa1,bf16x8 pa2,bf16x8 pa3){
  #pragma unroll
  for(int d0=0;d0<2;++d0){s16x4 lo[4],hi[4];
    #pragma unroll
    for(int ks=0;ks<4;++ks){
      asm volatile("ds_read_b64_tr_b16 %0,%1 offset:%c2":"=&v"(lo[ks]):"v"(vb),"i"(d0*4096+ks*1024):"memory");
      asm volatile("ds_read_b64_tr_b16 %0,%1 offset:%c2":"=&v"(hi[ks]):"v"(vb),"i"(d0*4096+ks*1024+512):"memory");}
    asm volatile("s_waitcnt lgkmcnt(0)":::"memory");SBAR();
    #define PK(k) (bf16x8){lo[k][0],lo[k][1],lo[k][2],lo[k][3],hi[k][0],hi[k][1],hi[k][2],hi[k][3]}
    o[d0]=MFMA32(pa0,PK(0),o[d0]);
    o[d0]=MFMA32(pa1,PK(1),o[d0]);
    o[d0]=MFMA32(pa2,PK(2),o[d0]);
    o[d0]=MFMA32(pa3,PK(3),o[d0]);
    #undef PK
  }
}

#ifndef ATTN_STORE16
#define ATTN_STORE16(p,v) (*(u32x4*)(p)=(v))
#endif
template<int THRL> __device__ __forceinline__ void attn_unit(int b,int qcol,int vcol,int ocol,float slope2,int qb,int ts,const bf16*Q,const bf16*__restrict__ K,const bf16*__restrict__ V,bf16*O,char*shm,const int wid){
  int lane; asm volatile("v_mbcnt_lo_u32_b32 %0, -1, 0\n\tv_mbcnt_hi_u32_b32 %0, -1, %0":"=v"(lane)); const int r32=lane&31,hi=lane>>5;
  const long rowbase=(long)b*SEQ; const int q0=qb*QB;
  const bf16*Qw=Q+(rowbase+q0+wid*QBLK)*DM+qcol;
  const bf16*Kh=K+(rowbase+(long)ts*KVBLK)*DM+qcol,*Vh=V+(rowbase+(long)ts*KVBLK)*DM+vcol;
  const unsigned lds0=(unsigned)(uintptr_t)shm;
  float*wsf=(float*)(shm+LDS_WS)+wid*64;
  const bf16*ksrc=Kh+(long)lane*DM+wid*8;
  const bf16*vsrc=Vh+(long)(16*(wid&3)+(lane>>2))*DM+(wid>>2)*32+(lane&3)*8;
  const unsigned kdst=lds0+LDS_K+wid*1024, vdst=lds0+LDS_V+wid*1024;
  #define DMA_K(t,slot) glds16(ksrc+(long)(t)*KVBLK*DM,(unsigned)__builtin_amdgcn_readfirstlane(kdst+(slot)))
  #define DMA_V(t,slot) glds16(vsrc+(long)(t)*KVBLK*DM,(unsigned)__builtin_amdgcn_readfirstlane(vdst+(slot)))
  const int vb0=(int)(lds0+LDS_V)+((lane>>4)&1)*32+(lane&3)*8+(4*hi+((lane&15)>>2))*64;
  const char*Kbase=shm+LDS_K; bf16x8 kf[8];
  const lds_cptr shm3=(lds_cptr)shm; const lds_cptr kp0=shm3+LDS_K+hi*1024+r32*16; const lds_cptr vp0=shm3+LDS_V+((lane>>4)&1)*32+(lane&3)*8+(4*hi+((lane&15)>>2))*64;
  const int NT=(q0+QB)/KVBLK-ts;
  DMA_K(0,0);DMA_V(0,0);DMA_K(1,SLOTB);
  bf16x8 qr[4];
  #pragma unroll
  for(int d0=0;d0<4;++d0)qr[d0]=*reinterpret_cast<const bf16x8*>(&Qw[(long)r32*DM+d0*16+hi*8]);
  float mhat=0.f,l_reg=0.f;f32x16 o[2];o[0]=f32x16{};o[1]=f32x16{};f32x16 negm;
  const float delta=64.f*slope2,c32=32.f*slope2;
  _Pragma("unroll") for(int r=0;r<16;++r)negm[r]=slope2*(float)crow(r,hi); asm volatile("":"+v"(negm));
  const int qrel=wid*QBLK+r32;
  #define CMASK(P0,P1,t) do{int jb_=(t)-(NT-4); if(jb_>=0)cmask(P0,P1,jb_,qrel,hi);}while(0)
  bool resc=false;
  #define START(P0,P1) do{ const float rm=rowmax(P0,P1); resc=false; \
    { const float dl=rm; mhat=fadd_s(mhat,dl); \
      _Pragma("unroll") for(int r=0;r<16;++r){P0[r]=fsub_s(P0[r],dl);P1[r]=fsub_s(P1[r],dl);} \
      _Pragma("unroll") for(int r=0;r<16;++r)negm[r]-=dl; asm volatile("":"+v"(negm)); } \
    _Pragma("unroll") for(int r=0;r<16;++r)P0[r]=__builtin_amdgcn_exp2f(P0[r]); }while(0)
  #define RESC() do{ if(resc){ asm volatile("s_waitcnt lgkmcnt(0)":::"memory"); \
      _Pragma("unroll") for(int d_=0;d_<2;++d_) _Pragma("unroll") for(int r=0;r<16;++r)o[d_][r]*=wsf[crow(r,hi)]; } }while(0)
  f32x16 pA0,pA1,pB0,pB1;
  int sl_prev=0,sl_cur=0,sl_next=SLOTB;
  #define ROT() do{sl_prev=sl_cur;sl_cur=sl_next;sl_next=(sl_next==(NSLOT-1)*SLOTB)?0:sl_next+SLOTB;}while(0)
  DMA_K(2,2*SLOTB);
  WAIT_BAR(3);
  qkt(pA0,pA1,Kbase,qr,negm,r32,hi);asm volatile("s_nop 15\n\ts_nop 7":"+v"(pA0),"+v"(pA1)); _Pragma("unroll") for(int r=0;r<16;++r)pA1[r]+=c32; CMASK(pA0,pA1,0);
  START(pA0,pA1);
  _Pragma("unroll") for(int r=0;r<16;++r)pA1[r]=__builtin_amdgcn_exp2f(pA1[r]);
  WAIT_BAR(0);
  DMA_K(3,0);DMA_V(1,SLOTB);
  ROT();
  kload8(kf,kp0+sl_cur);
  WAIT_BAR(2);
  s16x4 vlo[8],vhi[8]; u32x4 pw0,pw1,pw2,pw3;
  #define PKW(P,B) cvtpk_s(P[B],P[B+1])
  #define PAF(k) __builtin_bit_cast(bf16x8,pw##k)
  #define VFR(i) (bf16x8){vlo[i][0],vlo[i][1],vlo[i][2],vlo[i][3],vhi[i][0],vhi[i][1],vhi[i][2],vhi[i][3]}
  #define PIN(x) asm volatile("":"+v"(x))
  #define MX3(a,b,c) __builtin_fmaxf(__builtin_fmaxf((a),(b)),(c))
  #define GAPA(MF,A0,A1,A2,A3,W0,W1,PW) do{ MF; sacc+=A0; sacc+=A1; sacc+=A2; sacc+=A3; PIN(sacc); W0; W1; PIN(PW); SBAR(); }while(0)
  #define EX(v) __builtin_amdgcn_exp2f(v)
  #define GAPB(MF,X,B) do{ MF; X[B]=EX(X[B]); X[B+1]=EX(X[B+1]); X[B+2]=EX(X[B+2]); X[B+3]=EX(X[B+3]); PIN(X); SBAR(); }while(0)
  #define VRD(i) do{ vlo[i]=vtr(vp_+(((i)>>2)*4096+((i)&3)*1024)); vhi[i]=vtr(vp_+(((i)>>2)*4096+((i)&3)*1024+512)); }while(0)
  #define KRD(G,j) do{ if(G){ kload2(kf,kp0+sl_next,j); SBAR(); } }while(0)
  #define STEP(C0,C1,P0,P1,t,GK,GV,GL) do{ SBAR(); \
    _Pragma("unroll") for(int r=0;r<16;++r)negm[r]+=delta; asm volatile("":"+v"(negm)); \
    const lds_cptr vp_=vp0+sl_prev; \
    VRD(0); SBAR(); float sacc=(P0[0]+P0[1]); \
    GAPA(C0=MFMA32(kf[0],qr[0],negm), P0[2],P0[3],P0[4],P0[5],     pw0[0]=PKW(P0,0), pw0[1]=PKW(P0,2), pw0); \
    VRD(4); SBAR(); GAPA(C1=MFMA32(kf[1],qr[0],negm), P0[6],P0[7],P0[8],P0[9],     pw0[2]=PKW(P0,4), pw0[3]=PKW(P0,6), pw0); \
    VRD(1); SBAR(); GAPA(C0=MFMA32(kf[2],qr[1],C0),   P0[10],P0[11],P0[12],P0[13], pw1[0]=PKW(P0,8), pw1[1]=PKW(P0,10), pw1); \
    VRD(5); SBAR(); GAPA(C1=MFMA32(kf[3],qr[1],C1),   P0[14],P0[15],P1[0],P1[1],   pw1[2]=PKW(P0,12),pw1[3]=PKW(P0,14), pw1); \
    VRD(2); SBAR(); GAPA(C0=MFMA32(kf[4],qr[2],C0),   P1[2],P1[3],P1[4],P1[5],     pw2[0]=PKW(P1,0), pw2[1]=PKW(P1,2), pw2); \
    VRD(6); SBAR(); GAPA(C1=MFMA32(kf[5],qr[2],C1),   P1[6],P1[7],P1[8],P1[9],     pw2[2]=PKW(P1,4), pw2[3]=PKW(P1,6), pw2); \
    VRD(3); SBAR(); GAPA(C0=MFMA32(kf[6],qr[3],C0),   P1[10],P1[11],P1[12],P1[13], pw3[0]=PKW(P1,8), pw3[1]=PKW(P1,10), pw3); \
    VRD(7); SBAR(); GAPA(C1=MFMA32(kf[7],qr[3],C1),   P1[14],P1[15],0.f,0.f,       pw3[2]=PKW(P1,12),pw3[3]=PKW(P1,14), pw3); \
    l_reg+=sacc; \
    if(GK){DMA_K((t)+3,sl_cur);} if(GV){DMA_V((t)+1,sl_next);} \
    _Pragma("unroll") for(int r=0;r<16;++r)C1[r]+=c32; \
    CMASK(C0,C1,t); \
    { float a=MX3(C0[0],C0[1],C1[0]),b=MX3(C0[2],C0[3],C1[1]); a=MX3(a,C1[2],C1[3]); \
      _Pragma("unroll") for(int r=4;r<16;r+=4){a=MX3(a,C0[r],C0[r+1]);b=MX3(b,C0[r+2],C0[r+3]);a=MX3(a,C1[r],C1[r+1]);b=MX3(b,C1[r+2],C1[r+3]);} \
      float rm=__builtin_fmaxf(a,b); { auto rr=__builtin_amdgcn_permlane32_swap(__float_as_uint(rm),__float_as_uint(rm),false,false); rm=__builtin_fmaxf(__uint_as_float(rr[0]),__uint_as_float(rr[1])); } \
      resc=false; \
      if(__builtin_expect(__any(rm>(float)THRL),0)){ const float dl=__builtin_fmaxf(rm,0.f); mhat+=dl; \
        _Pragma("unroll") for(int r=0;r<16;++r){C0[r]-=dl;C1[r]-=dl;} \
        _Pragma("unroll") for(int r=0;r<16;++r)negm[r]-=dl; asm volatile("":"+v"(negm)); \
        const float f=__builtin_amdgcn_exp2f(-dl); l_reg*=f; if(hi==0)wsf[r32]=f; resc=true; } } \
    SBAR(); \
    GAPB(o[0]=MFMA32(PAF(0),VFR(0),o[0]), C0,0); \
    GAPB(o[1]=MFMA32(PAF(0),VFR(4),o[1]), C0,4); \
    KRD(GL,0); GAPB(o[0]=MFMA32(PAF(1),VFR(1),o[0]), C0,8); \
    KRD(GL,1); GAPB(o[1]=MFMA32(PAF(1),VFR(5),o[1]), C0,12); \
    KRD(GL,2); GAPB(o[0]=MFMA32(PAF(2),VFR(2),o[0]), C1,0); \
    KRD(GL,3); GAPB(o[1]=MFMA32(PAF(2),VFR(6),o[1]), C1,4); \
    GAPB(o[0]=MFMA32(PAF(3),VFR(3),o[0]), C1,8); \
    GAPB(o[1]=MFMA32(PAF(3),VFR(7),o[1]), C1,12); \
    }while(0)
  int t=1;
  #undef CMASK
  #define CMASK(P0,P1,t) do{}while(0)
  for(;t+5<NT;t+=2){
    STEP(pB0,pB1,pA0,pA1,t,true,true,true);     WAIT_BAR(2); RESC(); ROT();
    STEP(pA0,pA1,pB0,pB1,t+1,true,true,true);   WAIT_BAR(2); RESC(); ROT();
  }
  #undef CMASK
  #define CMASK(P0,P1,t) do{int jb_=(t)-(NT-4); if(jb_>=0)cmask(P0,P1,jb_,qrel,hi);}while(0)
  #define ENDW(tt) do{ if((tt)+3<NT){WAIT_BAR(2);} else if((tt)+2<NT){WAIT_BAR(1);} else {WAIT_BAR(0);} }while(0)
  for(;t+1<NT;t+=2){
    STEP(pB0,pB1,pA0,pA1,t,(t+3<NT),(t+1<NT),(t+1<NT));       ENDW(t);   RESC(); ROT();
    STEP(pA0,pA1,pB0,pB1,t+1,(t+4<NT),(t+2<NT),(t+2<NT));     ENDW(t+1); RESC(); ROT();
  }
  STEP(pB0,pB1,pA0,pA1,NT-1,false,false,false); RESC();
  { float sacc=pB0[0]+pB0[1]; _Pragma("unroll") for(int r=2;r<16;++r)sacc+=pB0[r]; _Pragma("unroll") for(int r=0;r<16;++r)sacc+=pB1[r]; l_reg+=sacc;
    pw0=(u32x4){PKW(pB0,0),PKW(pB0,2),PKW(pB0,4),PKW(pB0,6)};pw1=(u32x4){PKW(pB0,8),PKW(pB0,10),PKW(pB0,12),PKW(pB0,14)};pw2=(u32x4){PKW(pB1,0),PKW(pB1,2),PKW(pB1,4),PKW(pB1,6)};pw3=(u32x4){PKW(pB1,8),PKW(pB1,10),PKW(pB1,12),PKW(pB1,14)};
    SBAR(); pv(o,vb0+sl_cur,PAF(0),PAF(1),PAF(2),PAF(3)); }
  #undef PKW
  #undef PAF
  #undef VFR
  #undef PIN
  #undef MX3
  #undef GAPA
  #undef GAPB
  #undef EX
  #undef VRD
  #undef KRD
  #undef STEP
  #undef ENDW
  {auto rr=__builtin_amdgcn_permlane32_swap(__float_as_uint(l_reg),__float_as_uint(l_reg),false,false);l_reg=__uint_as_float(rr[0])+__uint_as_float(rr[1]);}
  if(hi==0)wsf[32+r32]=l_reg;asm volatile("s_waitcnt lgkmcnt(0)":::"memory");
  float rli[16];
  #pragma unroll
  for(int r=0;r<16;++r)rli[r]=__builtin_amdgcn_rcpf(wsf[32+crow(r,hi)]);
  bf16*Ow=O+(rowbase+q0+wid*QBLK)*DMO+ocol;
  { bf16*stg=(bf16*)(shm+LDS_OST)+wid*2048;
    #pragma unroll
    for(int r=0;r<16;++r){const int orow=crow(r,hi);
      #pragma unroll
      for(int d0=0;d0<2;++d0)stg[orow*64+d0*32+r32]=(bf16)(o[d0][r]*rli[r]);}
    asm volatile("s_waitcnt lgkmcnt(0)":::"memory");
    #pragma unroll
    for(int i=0;i<4;++i){const int row=i*8+(lane>>3),ch=lane&7; const u32x4 v=*(const u32x4*)(stg+row*64+ch*8); ATTN_STORE16(Ow+(long)row*DMO+ch*8,v);} }
  asm volatile("s_waitcnt lgkmcnt(0)\n\ts_barrier":::"memory");
  #undef DMA_K
  #undef DMA_V
  #undef CMASK
  #undef START
  #undef RESC
  #undef ROT
}
}
#undef SBAR
#undef WAIT_BAR
#undef MFMA32
__device__ const unsigned char ATT_H[64] = {5,6,7,5,6,7,5,6,7,4,4,4,4,5,6,7,4,5,6,7,3,3,3,3,3,3,4,5,6,7,2,2,2,2,2,2,1,1,1,1,1,1,1,2,3,4,5,6,7,0,0,0,0,0,0,0,0,1,2,3,4,5,6,7};
__device__ const unsigned char ATT_Q[64] = {7,7,7,6,6,6,5,5,5,5,6,7,4,4,4,4,3,3,3,3,3,4,5,6,7,2,2,2,2,2,2,3,4,5,6,7,1,2,3,4,5,6,7,1,1,1,1,1,1,1,2,3,4,5,6,7,0,0,0,0,0,0,0,0};
__device__ const unsigned char ATT_S[64] = {0,0,0,0,0,0,0,0,0,2,6,10,0,0,0,0,0,0,0,0,2,6,10,14,18,0,0,0,0,0,2,6,10,14,18,22,0,4,8,12,16,20,24,0,0,0,0,0,0,2,6,10,14,18,22,26,0,0,0,0,0,0,0,0};
__device__ __forceinline__ void phase_attn(const h16* Q, const h16* KK, const h16* VV, h16* ORAW, char* lds_generic, int blk, int G, const int wave) {
    const int vcu = (G % 8 == 0) ? (blk % 8) * (G / 8) + blk / 8 : blk;
#pragma unroll 1
    for (int r = 0; r < 16; ++r) {
        const int p = r * 256 + ((r & 1) ? 255 - vcu : vcu), ci = p >> 6, u = p & 63;
        const int hh = ATT_H[ci], qb = ATT_Q[ci], ts = ATT_S[ci], b = u >> 2, c = (u >> 1) & 1, vh = u & 1;
        const float slope2 = exp2f(-(float)(hh + 1)) * LOG2E;
        attn_body::attn_unit<8>(b, hh * 128 + c * 64, hh * 128 + vh * 64, c * 1024 + hh * 128 + vh * 64, slope2, qb, ts, Q, KK, VV, ORAW, lds_generic, wave);
    }
}

__device__ __forceinline__ float row16_sum(float v);
__device__ __forceinline__ void phase_attn_combine(const h16* ORAW, const float* lamv  , const float* subg  , float lambda_init, h16* OB, int gw_, int NGW_, int lane) {
    lane = lane_id(); OPAQUE(lane);
    const float la = wave_sum(lamv[lane] * lamv[64 + lane]), lb = wave_sum(lamv[128 + lane] * lamv[192 + lane]);
    const float lam = __expf(la) - __expf(lb) + lambda_init;
    const int hs = lane >> 5, d = (lane & 31) * 4;
    const f32x4 gsc = *(const f32x4*)(subg + d) * (1.0f - lambda_init);
#pragma unroll 1
    for (int t0 = gw_; t0 < T; t0 += 2 * NGW_) {
        h16x4 a[2][4], b[2][4];
#pragma unroll
        for (int q = 0; q < 2; ++q) { const size_t t = (size_t)t0 + (size_t)q * NGW_;
#pragma unroll
            for (int hp = 0; hp < 4; ++hp) { const int hh = 2 * hp + hs; a[q][hp] = *(const h16x4*)(ORAW + t * 2048 + hh * 128 + d); b[q][hp] = *(const h16x4*)(ORAW + t * 2048 + 1024 + hh * 128 + d); } }
#pragma unroll
        for (int q = 0; q < 2; ++q) { const size_t t = (size_t)t0 + (size_t)q * NGW_;
#pragma unroll
            for (int hp = 0; hp < 4; ++hp) { const int hh = 2 * hp + hs;
                const f32x4 o = __builtin_convertvector(a[q][hp], f32x4) - __builtin_convertvector(b[q][hp], f32x4) * lam;
                float ss = (o.x * o.x + o.y * o.y) + (o.z * o.z + o.w * o.w); ss = row16_sum(ss); ss += swz16f(ss);
                const float r = rsqrtf(ss * (1.0f / 128.0f) + 1e-5f);
                *(u32x2*)(OB + t * 1024 + hh * 128 + d) = pkh4(o * r * gsc); } }
    }
}

struct SchedRkv {
    const char* XM; const char* Wrkv; const char* Wl1; int nk, G, c;
    __device__ __forceinline__ bool next(int i, Unit& u) const {
        int pm, q;
        if (G == 256) { const int L = i * 32 + (c >> 3), pl = L / nk; q = L - pl * nk; pm = pl * 8 + (c & 7); if (pm >= 128) return false; }
        else { const int U = i * G + c; if (U >= 128 * nk) return false; pm = U / nk; q = U - pm * nk; }
        u.pm = pm; u.rows = 256; u.e = 0; u.rbase = 0; u.list = nullptr;
        int xs, pn, kind; const char* B;
        if (q < 12) { kind = q >> 2; pn = q & 3; xs = kind; B = Wrkv + ((size_t)kind * 1024 + pn * 256) * 2048; }
        else { kind = q - 9; pn = 0; xs = (kind == 6) ? 2 : kind; B = Wl1 + (size_t)(kind - 3) * 256 * 2048; }
        u.kind = kind; u.pn = pn; u.B = B; u.A = XM + ((size_t)xs * T + (size_t)pm * 256) * 2048;
        return true;
    }
    __device__ __forceinline__ unsigned a_off(const Unit&, int row) const { return (unsigned)row * 2048u; }
};
struct SchedL2 {
    const char* L1O; const char* Wl2; int kind, G, c;
    __device__ __forceinline__ bool next(int i, Unit& u) const {
        const int U = i * G + c; if (U >= 128 * 4) return false;
        const int pm = U >> 2; u.pm = pm; u.pn = U & 3; u.rows = 256; u.e = 0; u.rbase = 0; u.list = nullptr; u.kind = kind;
        u.A = L1O + ((size_t)kind * T + (size_t)pm * 256) * 512; u.B = Wl2 + ((size_t)kind * 1024 + u.pn * 256) * 512;
        return true;
    }
    __device__ __forceinline__ unsigned a_off(const Unit&, int row) const { return (unsigned)row * 512u; }
};
struct SchedPlain {
    const char* A; const char* B; int npn, G, c;
    __device__ __forceinline__ bool next(int i, Unit& u) const {
        int pm, pn;
        if (G == 256) { const int L = i * 32 + (c >> 3), pl = L / npn; pn = L - pl * npn; pm = pl * 8 + (c & 7); if (pm >= 128) return false; }
        else { const int U = i * G + c; if (U >= 128 * npn) return false; pm = U / npn; pn = U - pm * npn; }
        u.pm = pm; u.rows = 256; u.e = 0; u.rbase = 0; u.list = nullptr;
        u.kind = pn >> 2; u.pn = pn & 3; u.A = A + (size_t)pm * 256 * 2048; u.B = B + (size_t)pn * 256 * 2048;
        return true;
    }
    __device__ __forceinline__ unsigned a_off(const Unit&, int row) const { return (unsigned)row * 2048u; }
};
struct SchedMoe {
    const LAS unsigned* misc; const LAS int* tile_e; const char* A; const char* W; const int* LIST; int npn, gather, G, c; size_t wstride;
    __device__ __forceinline__ bool next(int i, Unit& u) const {
        const int ntile = __builtin_amdgcn_readfirstlane((int)misc[48 + 32]);
        int rtg, pn;
        if (G == 256) { const int x = c & 7, j = c >> 3, rpr = 32 / npn; rtg = (i * rpr + j / npn) * 8 + x; pn = j % npn; if (rtg >= ntile) return false; }
        else { const int U = i * G + c; if (U >= ntile * npn) return false; rtg = U / npn; pn = U - rtg * npn; }
        const int e = __builtin_amdgcn_readfirstlane(tile_e[rtg]);
        const int rt = rtg - __builtin_amdgcn_readfirstlane((int)misc[48 + e]), cnt = __builtin_amdgcn_readfirstlane((int)misc[16 + e]);
        u.pm = rtg; u.pn = pn; u.kind = 0; u.e = e; u.rbase = rtg * 256; u.rows = min(256, cnt - rt * 256);
        u.list = LIST + (size_t)e * ECAP + rt * 256;
        u.A = gather ? A : A + (size_t)rtg * 256 * 1024; u.B = W + (size_t)e * wstride + (size_t)pn * 256 * 1024;
        return true;
    }
    __device__ __forceinline__ unsigned a_off(const Unit& u, int row) const {
        if (!gather) return (unsigned)row * 1024u;
        const int slot = (row < u.rows) ? u.list[row] : 0;
        return (unsigned)(slot >> 2) * 1024u;
    }
};
__device__ __forceinline__ void moe_tables(const unsigned* CNT, volatile LAS unsigned* misc, LAS int* tile_e, const int wave) {
    if (wave == 0 && lane_id() == 0) {
        unsigned acc = 0;
        for (int e = 0; e < 32; ++e) { const unsigned c = __hip_atomic_load(CNT + e, __ATOMIC_RELAXED, __HIP_MEMORY_SCOPE_AGENT); misc[16 + e] = c; misc[48 + e] = acc; acc += (c + 255u) >> 8; }
        misc[48 + 32] = acc;
    }
    __syncthreads();
    { const int ntile = (int)misc[48 + 32];
      for (int i = wave * 64 + lane_id(); i < ntile; i += NTHR) { int e = 0; for (int j = 1; j < 32; ++j) if ((int)misc[48 + j] <= i) e = j; tile_e[i] = e; } }
    __syncthreads();
}

__device__ __forceinline__ size_t hm_off(int row, int col) { return ((size_t)((row >> 11) * 16 + (col >> 6)) * SEQ + (row & 2047)) * 64 + (col & 63); }
struct EpiRkv {
    h16* Rp; h16* Kp; h16* Vp; h16* L1O;
    __device__ __forceinline__ void operator()(const f32x4 (&acc)[2][2][4][2], const Unit& u, int wr, int wc, int fr, int fq) const {
        if (u.kind < 3) {
            h16* C = u.kind == 0 ? Rp : (u.kind == 1 ? Kp : Vp);
            FOR_ACC2(ai, bj, m) { const int row = u.pm * 256 + 128 * ai + 64 * wr + 16 * m + fr, col = u.pn * 256 + 128 * bj + 32 * wc + 8 * fq;
                const u32x2 lo = pkh4(acc[ai][bj][m][0]), hi = pkh4(acc[ai][bj][m][1]); *(u32x4*)(C + hm_off(row, col)) = (u32x4){lo.x, lo.y, hi.x, hi.y}; }
        } else {
            h16* O = L1O + (size_t)(u.kind - 3) * T * 256; const int kd = u.kind;
            FOR_ACC2(ai, bj, m) { const int row = u.pm * 256 + 128 * ai + 64 * wr + 16 * m + fr, col = 128 * bj + 32 * wc + 8 * fq; u32x2 pk2[2];
#pragma unroll
                for (int n = 0; n < 2; ++n) { f32x4 v = acc[ai][bj][m][n];
                    if (kd == 3) { v.x = tanhf(v.x); v.y = tanhf(v.y); v.z = tanhf(v.z); v.w = tanhf(v.w); }
                    else if (kd == 5) { v.x = sigmoidf_(v.x); v.y = sigmoidf_(v.y); v.z = sigmoidf_(v.z); v.w = sigmoidf_(v.w); }
                    pk2[n] = pkh4(v); }
                *(u32x4*)(O + (size_t)row * 256 + col) = (u32x4){pk2[0].x, pk2[0].y, pk2[1].x, pk2[1].y}; }
        }
    }
};
template <int KD> struct EpiL2 {
    void* O; const h16* VF; const float* bias;
    __device__ __forceinline__ void operator()(const f32x4 (&acc)[2][2][4][2], const Unit& u, int wr, int wc, int fr, int fq) const {
        f32x4 bv[2][2];
#pragma unroll
        for (int bj = 0; bj < 2; ++bj)
#pragma unroll
            for (int n = 0; n < 2; ++n) bv[bj][n] = (KD != 2) ? *(const f32x4*)(bias + u.pn * 256 + 128 * bj + 32 * wc + 8 * fq + 4 * n) : (f32x4){0.f, 0.f, 0.f, 0.f};
#pragma unroll
        for (int ai = 0; ai < 2; ++ai)
#pragma unroll
            for (int mp = 0; mp < 2; ++mp) {
                h16x4 vc[2][2][2], vf[2][2][2];
                if (KD == 3) {
#pragma unroll
                    for (int mm = 0; mm < 2; ++mm)
#pragma unroll
                        for (int bj = 0; bj < 2; ++bj)
#pragma unroll
                            for (int n = 0; n < 2; ++n) { const size_t o = hm_off(u.pm * 256 + 128 * ai + 64 * wr + 16 * (2 * mp + mm) + fr, u.pn * 256 + 128 * bj + 32 * wc + 8 * fq + 4 * n);
                                vc[mm][bj][n] = *(const h16x4*)((const h16*)O + o); vf[mm][bj][n] = *(const h16x4*)(VF + o); }
                }
#pragma unroll
                for (int mm = 0; mm < 2; ++mm)
#pragma unroll
                    for (int bj = 0; bj < 2; ++bj) { const int m = 2 * mp + mm; const size_t o = hm_off(u.pm * 256 + 128 * ai + 64 * wr + 16 * m + fr, u.pn * 256 + 128 * bj + 32 * wc + 8 * fq); u32x2 pk2[2];
#pragma unroll
                        for (int n = 0; n < 2; ++n) {
                            f32x4 v = acc[ai][bj][m][n] + bv[bj][n];
                            if (KD == 0) { v.x = 1.0f - __expf(-0.6065306597126334f * sigmoidf_(v.x)); v.y = 1.0f - __expf(-0.6065306597126334f * sigmoidf_(v.y)); v.z = 1.0f - __expf(-0.6065306597126334f * sigmoidf_(v.z)); v.w = 1.0f - __expf(-0.6065306597126334f * sigmoidf_(v.w)); }
                            if (KD == 1 || KD == 3) { v.x = sigmoidf_(v.x); v.y = sigmoidf_(v.y); v.z = sigmoidf_(v.z); v.w = sigmoidf_(v.w); }
                            if (KD == 3) { const f32x4 c_ = __builtin_convertvector(vc[mm][bj][n], f32x4), f_ = __builtin_convertvector(vf[mm][bj][n], f32x4); v = c_ + (f_ - c_) * v; }
                            pk2[n] = pkh4(v); }
                        *(u32x4*)((h16*)O + o) = (u32x4){pk2[0].x, pk2[0].y, pk2[1].x, pk2[1].y}; }
                if (KD == 3) EPI_FENCE();
            }
    }
};
template <bool F16X> struct EpiRes {
    const void* X; h16* H;
    __device__ __forceinline__ void operator()(const f32x4 (&acc)[2][2][4][2], const Unit& u, int wr, int wc, int fr, int fq) const {
        const float* Xf = (const float*)X; const h16* Xh = (const h16*)X;
#pragma unroll
        for (int ai = 0; ai < 2; ++ai)
#pragma unroll
            for (int mp = 0; mp < 2; ++mp) {
                f32x4 xr[2][2][2]; h16x4 xh[2][2][2];
#pragma unroll
                for (int mm = 0; mm < 2; ++mm)
#pragma unroll
                    for (int bj = 0; bj < 2; ++bj)
#pragma unroll
                        for (int n = 0; n < 2; ++n) { const size_t o = (size_t)(u.pm * 256 + 128 * ai + 64 * wr + 16 * (2 * mp + mm) + fr) * D + u.pn * 256 + 128 * bj + 32 * wc + 8 * fq + 4 * n;
                            if (F16X) xh[mm][bj][n] = *(const h16x4*)(Xh + o); else xr[mm][bj][n] = *(const f32x4*)(Xf + o); }
#pragma unroll
                for (int mm = 0; mm < 2; ++mm)
#pragma unroll
                    for (int bj = 0; bj < 2; ++bj) { const int m = 2 * mp + mm; u32x2 pk2[2];
#pragma unroll
                        for (int n = 0; n < 2; ++n) { const f32x4 xv = F16X ? __builtin_convertvector(xh[mm][bj][n], f32x4) : xr[mm][bj][n]; pk2[n] = pkh4(xv * ALPHA + acc[ai][bj][m][n]); }
                        *(u32x4*)(H + (size_t)(u.pm * 256 + 128 * ai + 64 * wr + 16 * m + fr) * D + u.pn * 256 + 128 * bj + 32 * wc + 8 * fq) = (u32x4){pk2[0].x, pk2[0].y, pk2[1].x, pk2[1].y}; }
                EPI_FENCE();
            }
    }
};
struct EpiQkv {
    h16* O0; h16* O1; float sc0;
    __device__ __forceinline__ void operator()(const f32x4 (&acc)[2][2][4][2], const Unit& u, int wr, int wc, int fr, int fq) const {
        h16* O = u.kind == 0 ? O0 : O1; const float sc = u.kind == 0 ? sc0 : 1.0f;
        FOR_ACC2(ai, bj, m) { const int row = u.pm * 256 + 128 * ai + 64 * wr + 16 * m + fr, col = u.pn * 256 + 128 * bj + 32 * wc + 8 * fq;
            const u32x2 lo = pkh4(acc[ai][bj][m][0] * sc), hi = pkh4(acc[ai][bj][m][1] * sc); *(u32x4*)(O + (size_t)row * 1024 + col) = (u32x4){lo.x, lo.y, hi.x, hi.y}; }
    }
};
struct EpiGu {
    unsigned char* ACT; const float* bgu;
    __device__ __forceinline__ void operator()(const f32x4 (&acc)[2][2][4][2], const Unit& u, int wr, int wc, int fr, int fq) const {
        const float* bb = bgu + (size_t)u.e * 2048;
        f32x4 bg[2], bu[2];
        const int colb = u.pn * 128 + 32 * wc + 8 * fq;
#pragma unroll
        for (int n = 0; n < 2; ++n) { bg[n] = *(const f32x4*)(bb + colb + 4 * n); bu[n] = *(const f32x4*)(bb + 1024 + colb + 4 * n); }
#pragma unroll
        for (int ai = 0; ai < 2; ++ai)
#pragma unroll
            for (int m = 0; m < 4; ++m) { const int rl = 128 * ai + 64 * wr + 16 * m + fr;
                if (rl < u.rows) { u32x2 pk2;
#pragma unroll
                    for (int n = 0; n < 2; ++n) {
                        const f32x4 gt = acc[ai][0][m][n] * (1.0f / GU_SCALE) + bg[n], up = acc[ai][1][m][n] * (1.0f / GU_SCALE) + bu[n]; f32x4 r;
#pragma unroll
                        for (int e = 0; e < 4; ++e) { const float g = fminf(gt[e], 7.0f), uu = __builtin_amdgcn_fmed3f(up[e], -7.0f, 7.0f); r[e] = (uu + 1.0f) * (g * __builtin_amdgcn_rcpf(1.0f + __builtin_amdgcn_exp2f((-1.702f * 1.4426950408889634f) * g))); }
                        int pk_ = __builtin_amdgcn_cvt_pk_fp8_f32(r[0], r[1], 0, false); pk_ = __builtin_amdgcn_cvt_pk_fp8_f32(r[2], r[3], pk_, true); pk2[n] = (unsigned)pk_; }
                    *(u32x2*)(ACT + (size_t)(u.rbase + rl) * 1024 + colb) = pk2;
                } }
    }
};
struct EpiDn {
    unsigned char* YS; const float* bdn; const float* TOPG;
    __device__ __forceinline__ void operator()(const f32x4 (&acc)[2][2][4][2], const Unit& u, int wr, int wc, int fr, int fq) const {
        const float* bb = bdn + (size_t)u.e * 1024;
        f32x4 bv[2][2]; int slot[2][4]; float gt[2][4];
#pragma unroll
        for (int bj = 0; bj < 2; ++bj)
#pragma unroll
            for (int n = 0; n < 2; ++n) bv[bj][n] = *(const f32x4*)(bb + u.pn * 256 + 64 * wc + 16 * fq + 8 * bj + 4 * n);
#pragma unroll
        for (int ai = 0; ai < 2; ++ai)
#pragma unroll
            for (int m = 0; m < 4; ++m) { const int rl = 128 * ai + 64 * wr + 16 * m + fr; slot[ai][m] = (rl < u.rows) ? u.list[rl] : -1; }
#pragma unroll
        for (int ai = 0; ai < 2; ++ai)
#pragma unroll
            for (int m = 0; m < 4; ++m) { const float g_ = TOPG[slot[ai][m] >= 0 ? slot[ai][m] : 0]; gt[ai][m] = (slot[ai][m] >= 0) ? g_ * YS_SCALE : 0.f; }
#pragma unroll
        for (int ai = 0; ai < 2; ++ai)
#pragma unroll
            for (int m = 0; m < 4; ++m) {
                if (slot[ai][m] >= 0) {
                    u32x4 pk4;
#pragma unroll
                    for (int bj = 0; bj < 2; ++bj)
#pragma unroll
                        for (int n = 0; n < 2; ++n) {
                            const f32x4 yv = (acc[ai][bj][m][n] * (1.0f / DN_SCALE) + bv[bj][n]) * gt[ai][m];
                            int pk_ = __builtin_amdgcn_cvt_pk_fp8_f32(yv[0], yv[1], 0, false); pk_ = __builtin_amdgcn_cvt_pk_fp8_f32(yv[2], yv[3], pk_, true); pk4[2 * bj + n] = (unsigned)pk_; }
                    __builtin_nontemporal_store(pk4, (u32x4*)(YS + (size_t)slot[ai][m] * 1024 + u.pn * 256 + 64 * wc + 16 * fq));
                } }
    }
};

struct Args { const float* in[33]; float* out; unsigned char* ws; int ph_lo, ph_hi; };
enum { I_X = 0, I_LNG, I_LNB, I_MIX, I_WRKV, I_WO, I_W0, I_W1, I_W2, I_A0, I_A1, I_A2, I_G1, I_G2, I_KK, I_KA, I_RK, I_LNXG, I_LNXB, I_V0, I_V1, I_V2,
       I_KVW, I_DAQ, I_DAO, I_DALAM, I_DASUB, I_RW, I_RB, I_WGU, I_BGU, I_WDN, I_BDN };

typedef const float* cfptr;
#define KAS __attribute__((address_space(4)))
#define KA_DECL const KAS cfptr* kin = (const KAS cfptr*)__builtin_amdgcn_kernarg_segment_ptr(); asm volatile("" : "+s"(kin))
#define KA_RELOAD asm volatile("" : "+s"(kin))
#define PH_BEGIN KA_RELOAD; asm volatile("" : "+s"(wave), "+s"(G), "+s"(blk)); ws = KWS; ctl = (unsigned*)(ws + WS_CTL)
#define KIN(i) (kin[i])
#define KOUT ((float*)kin[33])
#define KWS ((unsigned char*)kin[34])
__global__ void __launch_bounds__(NTHR, 2) yoco_fwd(Args args) {
    extern __shared__ __attribute__((aligned(16))) unsigned char lds_raw[];
    LAS unsigned char* lds = (LAS unsigned char*)lds_raw;
    volatile LAS unsigned* MISC = (volatile LAS unsigned*)(lds + MISC_OFF);
    int wave = __builtin_amdgcn_readfirstlane((int)threadIdx.x >> 6);
    int G = gridDim.x, blk = blockIdx.x; int lane = 0;
#define gw (blk * NWAVES + wave)
#define NGW (G * NWAVES)
    KA_DECL;
    unsigned char* ws = KWS;
    unsigned* ctl = (unsigned*)(ws + WS_CTL);
    for (int u = wave * 64 + lane_id(); u < (LDS_BYTES - MISC_OFF) / 4; u += NTHR) ((LAS unsigned*)(lds + MISC_OFF))[u] = 0u;
    __syncthreads();
    XcdBarrier bar = xcd_barrier_post(ctl + CW_BAR, MISC + 8, wave);
#define GRID_BAR() xcd_barrier(bar, wave)

    {
        LAS float* scr = (LAS float*)(lds + wave * 16896);
        conv_batch(KIN(I_WRKV), 6, 1024, 1024, (h16*)(ws + WS_W_RKV), 1024, 1024, 3, scr, gw, NGW, lane);
        conv_batch(KIN(I_WO), 2, 1024, 1024, (h16*)(ws + WS_W_RO), 1024, 1024, 3, scr, gw, NGW, lane);
#pragma unroll
        for (int l = 0; l < 2; ++l) {
            conv_batch(KIN(I_W1) + (size_t)l * 1024 * 64, 1, 1024, 64, (h16*)(ws + WS_W_L1) + (size_t)(l * 4 + 0) * 256 * 1024, 1024, 256, 3, scr, gw, NGW, lane);
            conv_batch(KIN(I_A1) + (size_t)l * 1024 * 64, 1, 1024, 64, (h16*)(ws + WS_W_L1) + (size_t)(l * 4 + 1) * 256 * 1024, 1024, 256, 3, scr, gw, NGW, lane);
            conv_batch(KIN(I_G1) + (size_t)l * 1024 * 160, 1, 1024, 160, (h16*)(ws + WS_W_L1) + (size_t)(l * 4 + 2) * 256 * 1024, 1024, 256, 3, scr, gw, NGW, lane);
            conv_batch(KIN(I_W2) + (size_t)l * 64 * 1024, 1, 64, 1024, (h16*)(ws + WS_W_L2) + (size_t)(l * 4 + 0) * 256 * 1024, 256, 1024, 3, scr, gw, NGW, lane);
            conv_batch(KIN(I_A2) + (size_t)l * 64 * 1024, 1, 64, 1024, (h16*)(ws + WS_W_L2) + (size_t)(l * 4 + 1) * 256 * 1024, 256, 1024, 3, scr, gw, NGW, lane);
            conv_batch(KIN(I_G2) + (size_t)l * 160 * 1024, 1, 160, 1024, (h16*)(ws + WS_W_L2) + (size_t)(l * 4 + 2) * 256 * 1024, 256, 1024, 3, scr, gw, NGW, lane);
        }
        conv_batch(KIN(I_V1), 1, 1024, 32, (h16*)(ws + WS_W_L1) + (size_t)(4 + 3) * 256 * 1024, 1024, 256, 3, scr, gw, NGW, lane);
        conv_batch(KIN(I_V2), 1, 32, 1024, (h16*)(ws + WS_W_L2) + (size_t)(4 + 3) * 256 * 1024, 256, 1024, 3, scr, gw, NGW, lane);
        conv_batch(KIN(I_KVW), 1, 1024, 2048, (h16*)(ws + WS_W_KV), 1024, 2048, 3, scr, gw, NGW, lane);
        conv_batch(KIN(I_DAQ), 2, 1024, 1024, (h16*)(ws + WS_W_Q), 1024, 1024, 3, scr, gw, NGW, lane);
        conv_batch(KIN(I_DAO), 2, 1024, 1024, (h16*)(ws + WS_W_AO), 1024, 1024, 3, scr, gw, NGW, lane);
#pragma unroll
        for (int l4 = 0; l4 < 4; ++l4) { conv_batch(KIN(I_RW) + (size_t)l4 * D * NEXP, 1, 1024, 32, (h16*)(ws + WS_WR) + (size_t)(l4 * 2 + 0) * 32 * 1024, 1024, 32, 0, scr, gw, NGW, lane);
                                        conv_batch(KIN(I_RW) + (size_t)l4 * D * NEXP, 1, 1024, 32, (h16*)(ws + WS_WR) + (size_t)(l4 * 2 + 1) * 32 * 1024, 1024, 32, 2, scr, gw, NGW, lane); }
    }

#pragma unroll 1
    for (int l = 0; l < 4; ++l) {
        if (l < 2) {
            PH_BEGIN;
            if (l == 0) phase_prep<false>(KIN(I_X), KIN(I_MIX), (h16*)(ws + WS_XM), gw, NGW, lane);
            else phase_prep<true>(ws + WS_XH, KIN(I_MIX) + (size_t)l * 6 * D, (h16*)(ws + WS_XM), gw, NGW, lane);
            GRID_BAR();
            PH_BEGIN;
            {
                SchedRkv S{(const char*)(ws + WS_XM), (const char*)(ws + WS_W_RKV) + (size_t)l * 3 * 1024 * 2048, (const char*)(ws + WS_W_L1) + (size_t)l * 4 * 256 * 2048, l == 0 ? 15 : 16, G, blk};
                EpiRkv E{(h16*)(ws + WS_R), (h16*)(ws + WS_K), (h16*)(ws + (l == 0 ? WS_VF : WS_V)), (h16*)(ws + WS_L1O)};
                GEMM_PHASE(S, E, 1024);
            }
            GRID_BAR();
            PH_BEGIN;
            {
                const char* l1o = (const char*)(ws + WS_L1O); const char* wl2 = (const char*)(ws + WS_W_L2) + (size_t)l * 4 * 1024 * 512;
                { SchedL2 S{l1o, wl2, 0, G, blk}; EpiL2<0> E{(void*)(ws + WS_WD), nullptr, KIN(I_W0) + (size_t)l * D}; GEMM_PHASE(S, E, 256); }
                { SchedL2 S{l1o, wl2, 1, G, blk}; EpiL2<1> E{(void*)(ws + WS_AA), nullptr, KIN(I_A0) + (size_t)l * D}; GEMM_PHASE(S, E, 256); }
                { SchedL2 S{l1o, wl2, 2, G, blk}; EpiL2<2> E{(void*)(ws + WS_GG), nullptr, nullptr}; GEMM_PHASE(S, E, 256); }
                if (l == 1) { SchedL2 S{l1o, wl2, 3, G, blk}; EpiL2<3> E{(void*)(ws + WS_V), (const h16*)(ws + WS_VF), KIN(I_V0)}; GEMM_PHASE(S, E, 256); }
            }
            GRID_BAR();
            PH_BEGIN;
            {
                const float* wgu_ = KIN(I_WGU); const float* wdn_ = KIN(I_WDN); asm volatile("" : "+s"(wgu_), "+s"(wdn_));
                ScanArgs sa{(const h16*)(ws + WS_R), (const h16*)(ws + WS_K), (const h16*)(ws + (l == 0 ? WS_VF : WS_V)), (const h16*)(ws + WS_WD), (const h16*)(ws + WS_AA), (const h16*)(ws + WS_GG),
                            KIN(I_KK) + (size_t)l * D, KIN(I_KA) + (size_t)l * D, KIN(I_RK) + (size_t)l * D, KIN(I_LNXG) + (size_t)l * D, KIN(I_LNXB) + (size_t)l * D, (h16*)(ws + WS_YG), wgu_, wdn_, ws + WS_W_GU, ws + WS_W_DN, l};
                phase_scan_mm(sa, lds, blk, G, wave);
            }
            GRID_BAR();
            PH_BEGIN;
            {
                SchedPlain S{(const char*)(ws + WS_YG), (const char*)(ws + WS_W_RO) + (size_t)l * 1024 * 2048, 4, G, blk};
                if (l == 0) { EpiRes<false> E{KIN(I_X), (h16*)(ws + WS_H)}; GEMM_PHASE(S, E, 1024); }
                else { EpiRes<true> E{ws + WS_XH, (h16*)(ws + WS_H)}; GEMM_PHASE(S, E, 1024); }
            }
            GRID_BAR();
        } else {
            const int j = l - 2;
            PH_BEGIN;
            if (l == 2) {
                { SchedPlain S{(const char*)(ws + WS_XH), (const char*)(ws + WS_W_Q), 4, G, blk}; EpiQkv E{(h16*)(ws + WS_Q), nullptr, QSCALE}; GEMM_PHASE(S, E, 1024); }
                { SchedPlain S{(const char*)(ws + WS_XH), (const char*)(ws + WS_W_KV), 8, G, blk}; EpiQkv E{(h16*)(ws + WS_KK), (h16*)(ws + WS_VV), 1.0f}; GEMM_PHASE(S, E, 1024); }
            } else {
                SchedPlain S{(const char*)(ws + WS_XH), (const char*)(ws + WS_W_Q) + (size_t)j * 1024 * 2048, 4, G, blk}; EpiQkv E{(h16*)(ws + WS_Q), nullptr, QSCALE}; GEMM_PHASE(S, E, 1024);
            }
            GRID_BAR();
            PH_BEGIN;
            phase_attn((const h16*)(ws + WS_Q), (const h16*)(ws + WS_KK), (const h16*)(ws + WS_VV), (h16*)(ws + WS_ORAW), (char*)lds_raw, blk, G, wave);
            GRID_BAR();
            PH_BEGIN;
            phase_attn_combine((const h16*)(ws + WS_ORAW), KIN(I_DALAM) + (size_t)j * 256, KIN(I_DASUB) + (size_t)j * 128, 0.8f - 0.6f * expf(-0.3f * (float)l), (h16*)(ws + WS_OB), gw, NGW, lane);
            GRID_BAR();
            PH_BEGIN;
            {
                SchedPlain S{(const char*)(ws + WS_OB), (const char*)(ws + WS_W_AO) + (size_t)j * 1024 * 2048, 4, G, blk};
                EpiRes<true> E{ws + WS_XH, (h16*)(ws + WS_H)};
                GEMM_PHASE(S, E, 1024);
            }
            GRID_BAR();
        }
        PH_BEGIN;
        {
            RouterArgs ra{(const h16*)(ws + WS_H), KIN(I_LNG) + (size_t)(l * 2) * D, KIN(I_LNB) + (size_t)(l * 2) * D, (const h16*)(ws + WS_WR) + (size_t)l * 2 * 32 * 1024, KIN(I_RB) + (size_t)l * NEXP,
                          (h16*)(ws + WS_X1), (unsigned char*)(ws + WS_XB), (float*)(ws + WS_TOPG), (int*)(ws + WS_LIST), ctl + CW_CNT + l * 32};
            phase_ln_router(ra, lds, blk, G, wave);
        }
        GRID_BAR();
        PH_BEGIN;
        moe_tables(ctl + CW_CNT + l * 32, MISC, (LAS int*)(lds + TILE_E_OFF), wave);
        {
            SchedMoe S{(const LAS unsigned*)MISC, (const LAS int*)(lds + TILE_E_OFF), (const char*)(ws + WS_XB), (const char*)(ws + WS_W_GU) + (size_t)l * 32 * 2048 * 1024, (const int*)(ws + WS_LIST), 8, 1, G, blk, (size_t)2048 * 1024};
            EpiGu E{(unsigned char*)(ws + WS_ACT), KIN(I_BGU) + (size_t)l * 32 * 2048};
            GEMM_PHASE8(S, E, 1024);
        }
        GRID_BAR();
        PH_BEGIN;
        {
            SchedMoe S{(const LAS unsigned*)MISC, (const LAS int*)(lds + TILE_E_OFF), (const char*)(ws + WS_ACT), (const char*)(ws + WS_W_DN) + (size_t)l * 32 * 1024 * 1024, (const int*)(ws + WS_LIST), 4, 0, G, blk, (size_t)1024 * 1024};
            EpiDn E{(unsigned char*)(ws + WS_YS), KIN(I_BDN) + (size_t)l * 32 * 1024, (const float*)(ws + WS_TOPG)};
            GEMM_PHASE8(S, E, 1024);
        }
        GRID_BAR();
        PH_BEGIN;
        phase_combine((const h16*)(ws + WS_X1), (const unsigned char*)(ws + WS_YS), KIN(I_LNG) + (size_t)(l * 2 + 1) * D, KIN(I_LNB) + (size_t)(l * 2 + 1) * D,
                      l == 3 ? KOUT : (float*)nullptr, (h16*)(ws + WS_XH), gw, NGW, lane);
        if (l < 3) GRID_BAR();
    }
    if (xb_ld(ctl + CW_BAR + XB_TMO) != 0u && wave == 0 && lane_id() == 0) KOUT[(size_t)blk * D] = __builtin_nanf("");
}

extern "C" void kernel_launch(void* const* d_in, const int* in_sizes, int n_in, void* d_out, int out_size, void* d_ws, size_t ws_size, hipStream_t stream) {
    static int grid = 0;
    if (grid == 0) {
        if (n_in != 33 || out_size != T * D || ws_size < WS_END) { fprintf(stderr, "kernel_launch: unexpected shapes (n_in %d out %d ws %zu)\n", n_in, out_size, ws_size); grid = -1; return; }
        if (hipFuncSetAttribute((const void*)yoco_fwd, hipFuncAttributeMaxDynamicSharedMemorySize, LDS_BYTES) != hipSuccess) { fprintf(stderr, "kernel_launch: hipFuncSetAttribute failed\n"); grid = -1; return; }
        int dev = 0, cus = 0, per_cu = 0;
        hipGetDevice(&dev); hipDeviceGetAttribute(&cus, hipDeviceAttributeMultiprocessorCount, dev);
        hipOccupancyMaxActiveBlocksPerMultiprocessor(&per_cu, (const void*)yoco_fwd, NTHR, LDS_BYTES);
        (void)hipGetLastError();
        if (per_cu < 1) fprintf(stderr, "kernel_launch: occupancy query reports %d\n", per_cu);
        grid = cus < 256 ? cus : 256;
    }
    if (grid < 0) return;
    hipMemsetAsync((char*)d_ws + WS_CTL, 0, CTL_ZERO_BYTES, stream);
    Args a{};
    for (int i = 0; i < 33; ++i) a.in[i] = (const float*)d_in[i];
    a.out = (float*)d_out; a.ws = (unsigned char*)d_ws; a.ph_lo = 0; a.ph_hi = 0;
    hipLaunchKernelGGL(yoco_fwd, dim3(grid), dim3(NTHR), LDS_BYTES, stream, a);
}
```

```cpp
#include <hip/hip_runtime.h>
#include <cstdio>
#include <cstdint>
#include <cmath>

#define LAS __attribute__((address_space(3)))
#define GAS __attribute__((address_space(1)))
typedef _Float16 h16;
typedef _Float16 h16x8 __attribute__((ext_vector_type(8)));
typedef _Float16 h16x4 __attribute__((ext_vector_type(4)));
typedef _Float16 h16x2 __attribute__((ext_vector_type(2)));
typedef float f32x4 __attribute__((ext_vector_type(4)));
typedef float f32x2 __attribute__((ext_vector_type(2)));
typedef unsigned u32x4 __attribute__((ext_vector_type(4)));
typedef unsigned u32x2 __attribute__((ext_vector_type(2)));

constexpr int D = 1024, NBATCH = 16, SEQ = 2048, T = NBATCH * SEQ;
constexpr int NEXP = 32, TOPK = 4, ECAP = T;
constexpr int NWAVES = 8, NTHR = NWAVES * 64;
constexpr float ALPHA = 1.6817928305074290f;
constexpr float LN_EPS = 1e-5f;
constexpr float QSCALE = 0.125f * 1.4426950408889634f;
constexpr float LOG2E = 1.4426950408889634f;
constexpr float GU_SCALE = 64.0f, DN_SCALE = 128.0f, YS_SCALE = 16.0f;

constexpr size_t MiB = 1u << 20;
constexpr size_t WS_CTL = 0, CTL_ZERO_BYTES = 1 * MiB;
constexpr size_t WS_W_RKV = 2 * MiB;
constexpr size_t WS_W_RO = 14 * MiB;
constexpr size_t WS_W_L1 = 18 * MiB;
constexpr size_t WS_W_L2 = 22 * MiB;
constexpr size_t WS_W_KV = 26 * MiB;
constexpr size_t WS_W_Q = 30 * MiB;
constexpr size_t WS_W_AO = 34 * MiB;
constexpr size_t WS_WR = 38 * MiB;
constexpr size_t WS_W_GU = 40 * MiB;
constexpr size_t WS_W_DN = 552 * MiB;
constexpr size_t WS_X = 808 * MiB;
constexpr size_t WS_X1 = 936 * MiB;
constexpr size_t WS_H = 1064 * MiB;
constexpr size_t WS_XB = 1192 * MiB;
constexpr size_t WS_XH = 1256 * MiB;
constexpr size_t WS_TOPG = 1320 * MiB;
constexpr size_t WS_LIST = 1321 * MiB;
constexpr size_t WS_ACT = 1328 * MiB;
constexpr size_t WS_YS = 1616 * MiB;
constexpr size_t WS_XM = 1872 * MiB;
constexpr size_t WS_R = 2256 * MiB, WS_K = 2384 * MiB, WS_V = 2512 * MiB, WS_VF = 2640 * MiB;
constexpr size_t WS_L1O = 2768 * MiB;
constexpr size_t WS_WD = 2832 * MiB, WS_AA = 2960 * MiB, WS_GG = 3088 * MiB;
constexpr size_t WS_YG = 3216 * MiB;
constexpr size_t WS_END = 3280 * MiB;
constexpr size_t WS_Q = 1872 * MiB, WS_KK = 1936 * MiB, WS_VV = 2000 * MiB;
constexpr size_t WS_ORAW = 2064 * MiB;
constexpr size_t WS_OB = 2192 * MiB;
constexpr int CW_BAR = 4096;
constexpr int CW_CNT = 16384;

constexpr int LDS_BYTES = 147456;
constexpr int MISC_OFF = 146432;
constexpr int TILE_E_OFF = 143360;

template <int CTRL> __device__ __forceinline__ float dppf(float v) { return __builtin_bit_cast(float, __builtin_amdgcn_mov_dpp(__builtin_bit_cast(int, v), CTRL, 0xF, 0xF, true)); }
__device__ __forceinline__ float swz16f(float v) { return __builtin_bit_cast(float, __builtin_amdgcn_ds_swizzle(__builtin_bit_cast(int, v), (16 << 10) | 0x1F)); }
__device__ __forceinline__ float grp8_sum(float v) { v += dppf<0xB1>(v); v += dppf<0x4E>(v); v += dppf<0x141>(v); return v; }
__device__ __forceinline__ float wave_sum(float v) {
    v += dppf<0xB1>(v); v += dppf<0x4E>(v); v += dppf<0x141>(v); v += dppf<0x140>(v); v += swz16f(v);
    return __builtin_bit_cast(float, __builtin_amdgcn_readlane(__builtin_bit_cast(int, v), 0)) + __builtin_bit_cast(float, __builtin_amdgcn_readlane(__builtin_bit_cast(int, v), 32));
}
__device__ __forceinline__ float wave_max(float v) {
    v = fmaxf(v, dppf<0xB1>(v)); v = fmaxf(v, dppf<0x4E>(v)); v = fmaxf(v, dppf<0x141>(v)); v = fmaxf(v, dppf<0x140>(v)); v = fmaxf(v, swz16f(v));
    return fmaxf(__builtin_bit_cast(float, __builtin_amdgcn_readlane(__builtin_bit_cast(int, v), 0)), __builtin_bit_cast(float, __builtin_amdgcn_readlane(__builtin_bit_cast(int, v), 32)));
}
__device__ __forceinline__ unsigned pkh(float a, float b) { h16x2 v = {(h16)a, (h16)b}; return __builtin_bit_cast(unsigned, v); }
__device__ __forceinline__ u32x2 pkh4(f32x4 v) { u32x2 r; r.x = pkh(v.x, v.y); r.y = pkh(v.z, v.w); return r; }
__device__ __forceinline__ f32x4 ldh4(const h16* p) { const h16x4 v = *(const h16x4*)p; return __builtin_convertvector(v, f32x4); }
__device__ __forceinline__ float sigmoidf_(float x) { return __builtin_amdgcn_rcpf(1.0f + __builtin_amdgcn_exp2f(-1.4426950408889634f * x)); }
__device__ __forceinline__ int lane_id() { int l; asm volatile("v_mbcnt_lo_u32_b32 %0, -1, 0\n\tv_mbcnt_hi_u32_b32 %0, -1, %0" : "=v"(l)); return l; }
#define LDS_WAIT() asm volatile("s_waitcnt lgkmcnt(0)" ::: "memory")
#define OPAQUE(x) asm volatile("" : "+v"(x))

#define XB_TMO      128
#define XB_XCNT(j)  (256  + 64 * (j))
#define XB_XSUB(j)  (1280 + 64 * (j))
#define XB_XGEN(j)  (2304 + 64 * (j))
#define XB_TOP      3328
#define XB_TOPGEN   3392
#define XCD_BAR_WORDS 3456
#define XB_SPIN_CAP (1u << 21)

__device__ __forceinline__ unsigned xb_ld(unsigned* p)              { return __hip_atomic_load((GAS unsigned*)p, __ATOMIC_RELAXED, __HIP_MEMORY_SCOPE_AGENT); }
__device__ __forceinline__ unsigned xb_add(unsigned* p, unsigned v) { return __hip_atomic_fetch_add((GAS unsigned*)p, v, __ATOMIC_RELAXED, __HIP_MEMORY_SCOPE_AGENT); }
__device__ __forceinline__ unsigned xb_xcc_id() { return (unsigned)__builtin_amdgcn_s_getreg((3 << 11) | 20) & 0xFu; }
#define XB_SPIN(cond, bar) do { unsigned _sp = 0; while (cond) { __builtin_amdgcn_s_sleep(1); \
    if ((++_sp & 255u) == 0u) { if (xb_ld(&(bar)[XB_TMO])) break; if (_sp > XB_SPIN_CAP) { (void)xb_add(&(bar)[XB_TMO], 1u); break; } } } } while (0)

struct XcdBarrier { unsigned* bar; unsigned x; volatile LAS unsigned* st; };

__device__ __forceinline__ XcdBarrier xcd_barrier_post(unsigned* bar, volatile LAS unsigned* st, const int wave) {
    XcdBarrier b; b.bar = bar; b.x = xb_xcc_id(); b.st = st;
    if (wave == 0 && lane_id() == 0) (void)xb_add(&bar[XB_XCNT(b.x)], 1u);
    return b;
}
__device__ __forceinline__ void xcd_barrier_complete(unsigned* bar, unsigned x, unsigned& nloc, unsigned& nx) {
    const unsigned G = gridDim.x * gridDim.y * gridDim.z;
    unsigned sum, cnt, mine, sp = 0u;
    for (;;) {
        sum = 0u; cnt = 0u; mine = 0u;
#pragma unroll
        for (unsigned j = 0; j < 16; ++j) { const unsigned c = xb_ld(&bar[XB_XCNT(j)]); sum += c; cnt += (c > 0u) ? 1u : 0u; mine = (j == x) ? c : mine; }
        if (sum == G) break;
        __builtin_amdgcn_s_sleep(1);
        if ((++sp & 255u) == 0u) { if (xb_ld(&bar[XB_TMO])) break; if (sp > XB_SPIN_CAP) { (void)xb_add(&bar[XB_TMO], 1u); break; } }
    }
    nloc = mine > 0u ? mine : 1u; nx = cnt > 0u ? cnt : 1u;
}
__device__ __forceinline__ void xcd_barrier(const XcdBarrier& b, const int wave) {
    asm volatile("s_waitcnt vmcnt(0)" ::: "memory");
    __syncthreads();
    if (wave == 0 && lane_id() == 0) {
        unsigned* bar = b.bar; unsigned bx = b.x;
        asm volatile("" : "+s"(bar), "+s"(bx));
        __builtin_amdgcn_s_waitcnt(0);
        unsigned nloc = b.st[0], nx = b.st[1];
        if (nloc == 0u) { xcd_barrier_complete(bar, bx, nloc, nx); b.st[0] = nloc; b.st[1] = nx; }
        const unsigned old = xb_add(&bar[XB_XSUB(bx)], 1u);
        const unsigned gen = old / nloc;
        if (old + 1u == (gen + 1u) * nloc) {
            __builtin_amdgcn_fence(__ATOMIC_RELEASE, "agent");
            asm volatile("s_waitcnt vmcnt(0)" ::: "memory");
            const unsigned og = xb_add(&bar[XB_TOP], 1u);
            const unsigned tg = og / nx;
            if (og + 1u == (tg + 1u) * nx) xb_add(&bar[XB_TOPGEN], 1u);
            else XB_SPIN(xb_ld(&bar[XB_TOPGEN]) == tg, bar);
            __builtin_amdgcn_fence(__ATOMIC_ACQUIRE, "agent");
            xb_add(&bar[XB_XGEN(bx)], 1u);
            asm volatile("s_waitcnt vmcnt(0)" ::: "memory");
        } else {
            XB_SPIN(xb_ld(&bar[XB_XGEN(bx)]) == gen, bar);
            __builtin_amdgcn_fence(__ATOMIC_ACQUIRE, "agent");
            asm volatile("s_waitcnt vmcnt(0)" ::: "memory");
        }
    }
    __syncthreads();
}

__device__ __forceinline__ void conv_batch(const float* src, int batch, int Kr, int Nr, h16* dst, int Kp, int Np, int perm, LAS float* scr, int gw, int NGW, int lane) {
    lane = lane_id(); OPAQUE(lane);
    const int kbn = Kp / 64, nbn = Np / 32, per = kbn * nbn, total = batch * per;
    for (int it = gw; it < total; it += NGW) {
        const int bi = it / per, r = it - bi * per, kb = r / nbn, nb = r - kb * nbn, k0 = 64 * kb, n0 = 32 * nb;
        const float* W = src + (size_t)bi * Kr * Nr; h16* WT = dst + (size_t)bi * Np * Kp;
        float vals[32];
#pragma unroll
        for (int i = 0; i < 32; ++i) { const int k = k0 + 2 * i + (lane >> 5), n = n0 + (lane & 31); vals[i] = (k < Kr && n < Nr) ? W[(size_t)k * Nr + n] : 0.f; }
#pragma unroll
        for (int i = 0; i < 32; ++i) { float x = vals[i]; if (perm == 2) x = (x - (float)(h16)x) * 4096.0f; scr[(2 * i + (lane >> 5)) * 33 + (lane & 31)] = x; }
        LDS_WAIT();
        const int c = lane & 7;
#pragma unroll
        for (int j = 0; j < 4; ++j) { const int nl = (lane >> 3) + 8 * j; const LAS float* s = scr + (8 * c) * 33 + nl;
            u32x4 o; o.x = pkh(s[0 * 33], s[1 * 33]); o.y = pkh(s[2 * 33], s[3 * 33]); o.z = pkh(s[4 * 33], s[5 * 33]); o.w = pkh(s[6 * 33], s[7 * 33]);
            int n = n0 + nl; if (perm == 1) n = ((n & 1023) >> 7) * 256 + (n >> 10) * 128 + (n & 127);
            if (perm == 3) { const int c5 = n & 31; n = (n & ~31) | (16 * ((c5 >> 2) & 1) + 4 * (c5 >> 3) + (c5 & 3)); }
            *(u32x4*)(WT + (size_t)n * Kp + k0 + 8 * c) = o; }
        LDS_WAIT();
    }
}


__device__ __forceinline__ void conv_batch8(const float* src, int batch, int Kr, int Nr, unsigned char* dst, int Kp, int Np, int perm, float scale, LAS float* scr, int gw_, int NGW_, int lane) {
    lane = lane_id(); OPAQUE(lane);
    const int kbn = Kp / 128, nbn = Np / 32, per = kbn * nbn, total = batch * per;
    for (int it = gw_; it < total; it += NGW_) {
        const int bi = it / per, r = it - bi * per, kb = r / nbn, nb = r - kb * nbn, k0 = 128 * kb, n0 = 32 * nb;
        const float* W = src + (size_t)bi * Kr * Nr; unsigned char* WT = dst + (size_t)bi * Np * Kp;
        float vals[64];
#pragma unroll
        for (int i = 0; i < 64; ++i) { const int k = k0 + 2 * i + (lane >> 5), n = n0 + (lane & 31); vals[i] = (k < Kr && n < Nr) ? W[(size_t)k * Nr + n] : 0.f; }
#pragma unroll
        for (int i = 0; i < 64; ++i) scr[(2 * i + (lane >> 5)) * 33 + (lane & 31)] = vals[i] * scale;
        LDS_WAIT();
        const int c = lane & 7;
#pragma unroll
        for (int j = 0; j < 4; ++j) { const int nl = (lane >> 3) + 8 * j; const LAS float* sp = scr + (16 * c) * 33 + nl; u32x4 o;
#pragma unroll
            for (int q = 0; q < 4; ++q) { int w_ = __builtin_amdgcn_cvt_pk_fp8_f32(sp[(4 * q) * 33], sp[(4 * q + 1) * 33], 0, false); w_ = __builtin_amdgcn_cvt_pk_fp8_f32(sp[(4 * q + 2) * 33], sp[(4 * q + 3) * 33], w_, true); o[q] = (unsigned)w_; }
            int n = n0 + nl; if (perm) n = ((n & 1023) >> 7) * 256 + (n >> 10) * 128 + (n & 127);
            *(u32x4*)(WT + (size_t)n * Kp + k0 + 16 * c) = o; }
        LDS_WAIT();
    }
}

struct Unit { int pm, pn, kind, e, rows, rbase; const char* A; const char* B; const int* list; };

struct DenseDesc { const char* A; const char* B; int kind, pn; };

namespace pg8 {
constexpr int BM = 256, BK = 64, HALF = 128, HTB = HALF * BK * 2, STAGE_BYTES = 8 * HTB;
__device__ __forceinline__ int lds_byte(int r, int c) { const int st = (r >> 4) * 2 + (c >> 5), rr = r & 15, cc = c & 31, ob = rr * 64 + cc * 2; return st * 1024 + (ob ^ (((ob >> 9) & 1) << 5)); }
__device__ __forceinline__ void stage_rc(int b, int& R, int& C) { const int st = b / 1024, sb = b % 1024, swz = sb ^ (((sb >> 9) & 1) << 5); R = (st >> 1) * 16 + swz / 64; C = (st & 1) * 32 + (swz % 64) / 2; }
}
typedef int i32x4 __attribute__((ext_vector_type(4)));
typedef int i32x8 __attribute__((ext_vector_type(8)));
template <bool FP8, class Sched, class Epi>
__device__ __forceinline__ void gemm_phase_pg8(LAS unsigned char* lds, const Sched& S, const Epi& E, const int Kb, const int wave) {
    using namespace pg8;
    int tid = wave * 64 + lane_id(); OPAQUE(tid);
    const int wid = wave, lane = tid & 63, wr = wid >> 2, wc = wid & 3, fr = lane & 15, fq = lane >> 4;
    const int nt = Kb / 128;
    int Rs[2], Cs[2]; unsigned voffB[2];
#pragma unroll
    for (int i = 0; i < 2; ++i) { stage_rc(tid * 16 + i * 8192, Rs[i], Cs[i]); voffB[i] = (unsigned)(Rs[i] * Kb + Cs[i] * 2); }
    const size_t kstep = (size_t)128;
    const size_t hstepB = (size_t)HALF * Kb;
    const unsigned ldsw = (unsigned)wid * 1024u;
    const int aoff = lds_byte(wr * 64 + fr, fq * 8), boff = lds_byte(wc * 32 + fr, fq * 8);
#define PG8_SA(b, h) (((b) * 2 + (h)) * HTB)
#define PG8_SB(b, h) ((4 + (b) * 2 + (h)) * HTB)
#define PG8_STAGE(bufoff, gbase, voff) do { _Pragma("unroll") for (int _i = 0; _i < 2; ++_i) \
        __builtin_amdgcn_global_load_lds((const unsigned*)((const char*)(gbase) + (voff)[_i]), (LAS unsigned*)(lds + (bufoff) + ldsw + _i * 8192), 16, 0, 0); } while (0)
#define PG8_LDA(dst, b, h) do { _Pragma("unroll") for (int m = 0; m < 4; ++m) _Pragma("unroll") for (int k = 0; k < 2; ++k) dst[m][k] = *(const LAS h16x8*)(lds + PG8_SA(b, h) + aoff + m * 2048 + k * 1024); } while (0)
#define PG8_LDB(dst, b, h) do { _Pragma("unroll") for (int n = 0; n < 2; ++n) _Pragma("unroll") for (int k = 0; k < 2; ++k) dst[n][k] = *(const LAS h16x8*)(lds + PG8_SB(b, h) + boff + n * 2048 + k * 1024); } while (0)
#define PG8_MMA(ai, bj, At, Bt) do { __builtin_amdgcn_s_setprio(1); \
        if (FP8) { _Pragma("unroll") for (int m = 0; m < 4; ++m) _Pragma("unroll") for (int n = 0; n < 2; ++n) { \
            const i32x4 b0_ = __builtin_bit_cast(i32x4, Bt[n][0]), b1_ = __builtin_bit_cast(i32x4, Bt[n][1]), a0_ = __builtin_bit_cast(i32x4, At[m][0]), a1_ = __builtin_bit_cast(i32x4, At[m][1]); \
            acc[ai][bj][m][n] = __builtin_amdgcn_mfma_scale_f32_16x16x128_f8f6f4(__builtin_shufflevector(b0_, b1_, 0, 1, 2, 3, 4, 5, 6, 7), __builtin_shufflevector(a0_, a1_, 0, 1, 2, 3, 4, 5, 6, 7), acc[ai][bj][m][n], 0, 0, 0, 0, 0, 0); } } \
        else { _Pragma("unroll") for (int m = 0; m < 4; ++m) _Pragma("unroll") for (int n = 0; n < 2; ++n) _Pragma("unroll") for (int k = 0; k < 2; ++k) \
            acc[ai][bj][m][n] = __builtin_amdgcn_mfma_f32_16x16x32_f16(Bt[n][k], At[m][k], acc[ai][bj][m][n], 0, 0, 0); } \
        __builtin_amdgcn_s_setprio(0); } while (0)
#define PG8_WAIT_V(n) asm volatile("s_waitcnt vmcnt(" #n ")" ::: "memory")
#define PG8_WAIT_L(n) asm volatile("s_waitcnt lgkmcnt(" #n ")" ::: "memory")
#define PG8_BAR __builtin_amdgcn_s_barrier()
#define PG8_SCHED __builtin_amdgcn_sched_barrier(0)
    Unit cur, nxt; int ui = 0;
    if (!S.next(0, cur)) return;
    f32x4 acc[2][2][4][2];
#pragma unroll
    for (int a = 0; a < 2; ++a)
#pragma unroll
        for (int b = 0; b < 2; ++b)
#pragma unroll
            for (int m = 0; m < 4; ++m)
#pragma unroll
                for (int n = 0; n < 2; ++n) acc[a][b][m][n] = (f32x4){0.f, 0.f, 0.f, 0.f};
    h16x8 At[4][2], B0[2][2], B1[2][2];
    unsigned vA[2][2], vAn[2][2];
#pragma unroll
    for (int h = 0; h < 2; ++h)
#pragma unroll
        for (int i = 0; i < 2; ++i) vA[h][i] = S.a_off(cur, 128 * h + Rs[i]) + (unsigned)Cs[i] * 2u;
    const char* cA = cur.A; const char* cB = cur.B;
    PG8_STAGE(PG8_SB(0, 0), cB, voffB); PG8_STAGE(PG8_SB(0, 1), cB + hstepB, voffB); PG8_STAGE(PG8_SA(0, 0), cA, vA[0]); PG8_STAGE(PG8_SA(0, 1), cA, vA[1]);
    if (wr == 1) PG8_BAR;
    PG8_WAIT_V(2); PG8_BAR;
    PG8_STAGE(PG8_SB(1, 0), cB + kstep, voffB); PG8_STAGE(PG8_SA(1, 0), cA + kstep, vA[0]); PG8_STAGE(PG8_SB(1, 1), cB + hstepB + kstep, voffB);
    PG8_WAIT_V(6); PG8_BAR;
    for (;;) {
        const bool has_next = S.next(ui + 1, nxt);
        const char* nA = has_next ? nxt.A : cA; const char* nB = has_next ? nxt.B : cB;
#pragma unroll
        for (int h = 0; h < 2; ++h)
#pragma unroll
            for (int i = 0; i < 2; ++i) vAn[h][i] = has_next ? (S.a_off(nxt, 128 * h + Rs[i]) + (unsigned)Cs[i] * 2u) : vA[h][i];
#pragma unroll 1
        for (int t = 0; t < nt; t += 2) {
            const bool last = (t == nt - 2);
            const char* a1 = cA + (size_t)(t + 1) * kstep;
            const char* a2 = last ? nA : cA + (size_t)(t + 2) * kstep; const char* b2 = last ? nB : cB + (size_t)(t + 2) * kstep;
            const char* a3 = a2 + kstep; const char* b3 = b2 + kstep;
            PG8_LDB(B0, 0, 0); PG8_LDB(B1, 0, 1); PG8_SCHED; PG8_LDA(At, 0, 0); PG8_STAGE(PG8_SA(1, 1), a1, vA[1]);
            if (last) { vA[0][0] = vAn[0][0]; vA[0][1] = vAn[0][1]; vA[1][0] = vAn[1][0]; vA[1][1] = vAn[1][1]; }
            PG8_WAIT_V(8); PG8_WAIT_L(0); PG8_BAR; PG8_MMA(0, 0, At, B0); PG8_MMA(0, 1, At, B1); PG8_BAR; PG8_SCHED;
            PG8_LDA(At, 0, 1); PG8_STAGE(PG8_SB(0, 0), b2, voffB); PG8_STAGE(PG8_SB(0, 1), b2 + hstepB, voffB); PG8_STAGE(PG8_SA(0, 0), a2, vA[0]);
            PG8_WAIT_V(8); PG8_WAIT_L(0); PG8_BAR; PG8_MMA(1, 0, At, B0); PG8_MMA(1, 1, At, B1); PG8_BAR; PG8_SCHED;
            PG8_LDB(B0, 1, 0); PG8_LDB(B1, 1, 1); PG8_SCHED; PG8_LDA(At, 1, 0); PG8_STAGE(PG8_SA(0, 1), a2, vA[1]);
            PG8_WAIT_V(8); PG8_WAIT_L(0); PG8_BAR; PG8_MMA(0, 0, At, B0); PG8_MMA(0, 1, At, B1); PG8_BAR; PG8_SCHED;
            PG8_LDA(At, 1, 1); PG8_STAGE(PG8_SB(1, 0), b3, voffB); PG8_STAGE(PG8_SB(1, 1), b3 + hstepB, voffB); PG8_STAGE(PG8_SA(1, 0), a3, vA[0]);
            PG8_WAIT_V(8); PG8_WAIT_L(0); PG8_BAR; PG8_MMA(1, 0, At, B0); PG8_MMA(1, 1, At, B1); PG8_BAR; PG8_SCHED;
        }
        if (wr == 0) PG8_BAR;
        { int fr_e = fr, fq_e = fq; OPAQUE(fr_e); OPAQUE(fq_e);
          E(acc, cur, wr, wc, fr_e, fq_e); }
        if (!has_next) break;
#pragma unroll
        for (int a = 0; a < 2; ++a)
#pragma unroll
            for (int b = 0; b < 2; ++b)
#pragma unroll
                for (int m = 0; m < 4; ++m)
#pragma unroll
                    for (int n = 0; n < 2; ++n) acc[a][b][m][n] = (f32x4){0.f, 0.f, 0.f, 0.f};
        cur = nxt; cA = nA; cB = nB; ++ui;
        if (wr == 1) PG8_BAR;
    }
    PG8_WAIT_V(0);
    PG8_BAR;
#undef PG8_SA
#undef PG8_SB
#undef PG8_STAGE
#undef PG8_LDA
#undef PG8_LDB
#undef PG8_MMA
#undef PG8_WAIT_V
#undef PG8_WAIT_L
#undef PG8_BAR
#undef PG8_SCHED
}
#define GEMM_PHASE(S, E, K) gemm_phase_pg8<false>(lds, S, E, (K) * 2, wave)
#define GEMM_PHASE8(S, E, K) gemm_phase_pg8<true>(lds, S, E, (K), wave)

#define FOR_ACC2(ai, bj, m) _Pragma("unroll") for (int ai = 0; ai < 2; ++ai) _Pragma("unroll") for (int m = 0; m < 4; ++m) _Pragma("unroll") for (int bj = 0; bj < 2; ++bj)
#define FOR_ACC(ai, bj, m, n) _Pragma("unroll") for (int ai = 0; ai < 2; ++ai) _Pragma("unroll") for (int m = 0; m < 4; ++m) _Pragma("unroll") for (int bj = 0; bj < 2; ++bj) _Pragma("unroll") for (int n = 0; n < 2; ++n)
#define EPI_FENCE() asm volatile("" ::: "memory")

template <bool F16IN>
__device__ __forceinline__ void phase_prep(const void* Xv, const float* mix, h16* XM, int gw_, int NGW_, int lane) {
    lane = lane_id(); OPAQUE(lane);
    const float* Xf = (const float*)Xv; const h16* Xh = (const h16*)Xv;
    for (int ch = gw_; ch < T / 16; ch += NGW_) {
        const int t0 = ch * 16;
        f32x4 prev[4];
        if ((t0 % SEQ) == 0) {
#pragma unroll
            for (int j = 0; j < 4; ++j) prev[j] = (f32x4){0.f, 0.f, 0.f, 0.f};
        } else {
#pragma unroll
            for (int j = 0; j < 4; ++j) prev[j] = F16IN ? ldh4(Xh + (size_t)(t0 - 1) * D + 256 * j + 4 * lane) : *(const f32x4*)(Xf + (size_t)(t0 - 1) * D + 256 * j + 4 * lane);
        }
#pragma unroll 1
        for (int ib = 0; ib < 4; ++ib) {
            f32x4 cur[4][4]; h16x4 curh[4][4];
#pragma unroll
            for (int q = 0; q < 4; ++q)
#pragma unroll
                for (int j = 0; j < 4; ++j) { if (F16IN) curh[q][j] = *(const h16x4*)(Xh + (size_t)(t0 + 4 * ib + q) * D + 256 * j + 4 * lane); else cur[q][j] = *(const f32x4*)(Xf + (size_t)(t0 + 4 * ib + q) * D + 256 * j + 4 * lane); }
            if (F16IN) {
#pragma unroll
                for (int q = 0; q < 4; ++q)
#pragma unroll
                    for (int j = 0; j < 4; ++j) cur[q][j] = __builtin_convertvector(curh[q][j], f32x4);
            }
#pragma unroll
            for (int q = 0; q < 4; ++q) {
                const int t = t0 + 4 * ib + q;
#pragma unroll
                for (int s = 0; s < 6; ++s) {
#pragma unroll
                    for (int j = 0; j < 4; ++j) { const f32x4 mx = *(const f32x4*)(mix + s * D + 256 * j + 4 * lane);
                        const f32x4 pv = (q == 0) ? prev[j] : cur[q == 0 ? 0 : q - 1][j];
                        const f32x4 v = cur[q][j] + (pv - cur[q][j]) * mx;
                        __builtin_nontemporal_store(pkh4(v), (u32x2*)(XM + ((size_t)s * T + t) * D + 256 * j + 4 * lane)); }
                }
            }
#pragma unroll
            for (int j = 0; j < 4; ++j) prev[j] = cur[3][j];
        }
    }
}

struct ScanArgs { const h16 *R, *K, *V; const h16* WD; const h16 *AA, *GG; const float *k_k, *k_a, *r_k, *lnx_g, *lnx_b; h16* YG; const float *wgu, *wdn; unsigned char *gu8, *dn8; int layer_pair; };
__device__ __forceinline__ float row16_sum(float v) { v += dppf<0xB1>(v); v += dppf<0x4E>(v); v += dppf<0x141>(v); v += dppf<0x140>(v); return v; }
struct ConvItem2 { const float* Wrow; unsigned char* WTp; int Nr; float scale; bool valid; };
__device__ __forceinline__ ConvItem2 conv_item2(int sit, int wave, int lane, int layer_pair, const float* wgu, const float* wdn, unsigned char* gu8) {
    ConvItem2 ci; ci.valid = sit < 12288;
    const int s = ci.valid ? sit : 0, ls = s / 6144, r = s - ls * 6144, e = r / 192, q = r - e * 192, le = (layer_pair * 2 + ls) * 32 + e;
    const bool gu = q < 128; const int q2 = gu ? q : q - 128, nb = gu ? (q2 & 31) : (q2 & 15), kq = gu ? (q2 >> 5) : (q2 >> 4), Nr = gu ? 2048 : 1024;
    const int k0 = kq * 256 + wave * 32, n = nb * 64 + lane, c5 = n & 31, p5 = 16 * ((c5 >> 2) & 1) + 4 * (c5 >> 3) + (c5 & 3), np = (n & ~31) | p5;
    const int c8 = n & 255, pdn = (n & ~255) | (128 * ((c8 >> 3) & 1) + 32 * (c8 >> 6) + 16 * ((c8 >> 2) & 1) + 4 * ((c8 >> 4) & 3) + (c8 & 3));
    const int nrow = gu ? ((np & 1023) >> 7) * 256 + (np >> 10) * 128 + (np & 127) : pdn;
    size_t wb; { const int gi = __builtin_amdgcn_readfirstlane(gu ? 1 : 0); asm("s_cmp_lg_u32 %1, 0\n\ts_cselect_b64 %0, %2, %3" : "=s"(wb) : "s"(gi), "s"(wgu), "s"(wdn) : "scc"); }
    const size_t ob = (size_t)gu8 + (gu ? (size_t)0 : (size_t)(WS_W_DN - WS_W_GU));
    ci.Wrow = (const float*)wb + (size_t)le * 1024 * Nr + (size_t)k0 * Nr + nb * 64; ci.WTp = (unsigned char*)ob + (size_t)le * Nr * 1024 + (size_t)nrow * 1024 + k0; ci.Nr = Nr; ci.scale = gu ? GU_SCALE : DN_SCALE;
    return ci;
}
__device__ __forceinline__ void conv_issue2(const ConvItem2& ci, float (&vals)[32], int lane) {
    if (ci.valid) {
        const GAS char* p = (const GAS char*)ci.Wrow; const unsigned lo = (unsigned)lane * 4u; const size_t stride = (size_t)ci.Nr * 4;
#pragma unroll
        for (int i = 0; i < 32; ++i) { vals[i] = __builtin_nontemporal_load((const GAS float*)(p + lo)); p += stride; }
    }
}
__device__ __forceinline__ void conv_finish2(const ConvItem2& ci, const float (&vals)[32]) {
    if (ci.valid) {
#pragma unroll
        for (int j = 0; j < 2; ++j) { u32x4 o;
#pragma unroll
            for (int q = 0; q < 4; ++q) { int pk_ = __builtin_amdgcn_cvt_pk_fp8_f32(vals[16 * j + 4 * q] * ci.scale, vals[16 * j + 4 * q + 1] * ci.scale, 0, false);
                pk_ = __builtin_amdgcn_cvt_pk_fp8_f32(vals[16 * j + 4 * q + 2] * ci.scale, vals[16 * j + 4 * q + 3] * ci.scale, pk_, true); o[q] = (unsigned)pk_; }
            *(u32x4*)(ci.WTp + 16 * j) = o; }
    }
}
__device__ __forceinline__ float row16_reduce_scatter(const float (&q)[16], int lane) {
    const bool b0 = lane & 1, b1 = lane & 2, b2 = lane & 4, b3 = lane & 8;
    float v[16], a[8], c[4], d[2];
#pragma unroll
    for (int s = 0; s < 16; ++s) v[s] = q[((s & 1) << 3) | ((s & 2) << 1) | ((s & 4) >> 1) | ((s & 8) >> 3)];
#pragma unroll
    for (int j = 0; j < 8; ++j) a[j] = (b0 ? v[j + 8] : v[j]) + dppf<0xB1>(b0 ? v[j] : v[j + 8]);
#pragma unroll
    for (int j = 0; j < 4; ++j) c[j] = (b1 ? a[j + 4] : a[j]) + dppf<0x4E>(b1 ? a[j] : a[j + 4]);
#pragma unroll
    for (int j = 0; j < 2; ++j) d[j] = (b2 ? c[j + 2] : c[j]) + dppf<0x124>(b2 ? c[j] : c[j + 2]);
    return (b3 ? d[1] : d[0]) + dppf<0x128>(b3 ? d[0] : d[1]);
}
#define WBAR() do { asm volatile("s_waitcnt lgkmcnt(0)" ::: "memory"); __builtin_amdgcn_s_barrier(); asm volatile("" ::: "memory"); } while (0)
__device__ __forceinline__ void phase_scan_mm(const ScanArgs& a, LAS unsigned char* lds, int blk, int G, const int wave) {
    constexpr int NG = 4, PCH = 13120;
    constexpr int O_AT = 0, O_RT = 2304, O_BBT = 4608, O_KBT = 6656, O_VT = 8704, O_MKT = 10752, O_TMT = 11264, O_NBT = 11776, O_NKT = 12288, O_GC = 12800, O_SRK = 13056;
    constexpr int TMP0 = NG * PCH, TMPB = 5632;
    constexpr int O_SY = TMP0 + 4 * TMPB, O_VO = O_SY + 2 * 16640, O_SRKO = O_VO + 2 * 8192, O_RED = O_SRKO + 512;
    int pass = 0;
    for (int bh = blk; bh < NBATCH * 16; bh += G, ++pass) {
        int tid0 = wave * 64 + lane_id(); OPAQUE(tid0);
        const int b = bh >> 4, h = bh & 15, chn0 = h * 64 + (tid0 & 63);
        const float kkc = a.k_k[chn0], kac = a.k_a[chn0], rkc = a.r_k[chn0], lg = a.lnx_g[chn0], lb = a.lnx_b[chn0];
        f32x4 ST[4];
#pragma unroll
        for (int kt = 0; kt < 4; ++kt) ST[kt] = (f32x4){0.f, 0.f, 0.f, 0.f};
        h16 qr[8], qk[8], qv[8], qa[8], qw[8];
        const int c4w = wave >> 1, hfw = wave & 1;
#pragma unroll
        for (int i = 0; i < 8; ++i) { const size_t tb = ((size_t)bh * SEQ + c4w * 16 + 8 * hfw) * 64 + (tid0 & 63);
            qr[i] = a.R[tb + i * 64]; qk[i] = a.K[tb + i * 64]; qv[i] = a.V[tb + i * 64]; qa[i] = a.AA[tb + i * 64]; qw[i] = a.WD[tb + i * 64]; }
        LAS float* gpr = (LAS float*)(lds + O_RED + 1024);
#define GPROD() ((((1.0f - (float)qw[0]) * (1.0f - (float)qw[1])) * ((1.0f - (float)qw[2]) * (1.0f - (float)qw[3]))) * (((1.0f - (float)qw[4]) * (1.0f - (float)qw[5])) * ((1.0f - (float)qw[6]) * (1.0f - (float)qw[7]))))
        gpr[wave * 64 + (tid0 & 63)] = GPROD();
        WBAR();
        h16 qg[16];
        float cv[32];
        ConvItem2 ci = conv_item2(((pass * 32 + 0) * 2 + 0) * G + blk, wave, tid0 & 63, a.layer_pair, a.wgu, a.wdn, a.gu8);
        conv_issue2(ci, cv, tid0 & 63);
#define OUT_STAGE(gp_) do { const int gp = (gp_); LAS float* red = (LAS float*)(lds + O_RED) + wave * 32; const LAS float* syo = (const LAS float*)(lds + O_SY) + (gp & 1) * (64 * 65); \
            const LAS h16* voo = (const LAS h16*)(lds + O_VO) + (gp & 1) * 4096; const LAS float* srko = (const LAS float*)(lds + O_SRKO) + (gp & 1) * 64; \
            _Pragma("unroll") for (int bt = 0; bt < 2; ++bt) { const int t0 = (wave - 4) * 16 + 8 * bt; float yv[8], q[16]; \
                _Pragma("unroll") for (int p = 0; p < 8; ++p) { yv[p] = syo[(t0 + p) * 65 + lane]; q[p] = yv[p]; q[8 + p] = yv[p] * yv[p]; } \
                float x = row16_reduce_scatter(q, lane); x += swz16f(x); \
                if ((lane & 16) == 0) red[(lane >> 5) * 16 + l16] = x; \
                LDS_WAIT(); \
                f32x4 s1[2], s2[2]; \
                _Pragma("unroll") for (int hq = 0; hq < 2; ++hq) { s1[hq] = *(const LAS f32x4*)(red + 4 * hq) + *(const LAS f32x4*)(red + 16 + 4 * hq); s2[hq] = *(const LAS f32x4*)(red + 8 + 4 * hq) + *(const LAS f32x4*)(red + 24 + 4 * hq); } \
                _Pragma("unroll") for (int p = 0; p < 8; ++p) { const int tt = t0 + p; \
                    const float mu = s1[p >> 2][p & 3] * (1.0f / 64.0f), var = fmaxf(s2[p >> 2][p & 3] * (1.0f / 64.0f) - mu * mu, 0.0f); \
                    float yn = (yv[p] - mu) * rsqrtf(var + 64e-5f) * lg + lb; yn += srko[tt] * (float)voo[tt * 64 + lane]; \
                    a.YG[((size_t)b * SEQ + gp * 64 + tt) * D + chn] = (h16)(yn * (float)qg[8 * bt + p]); } \
                LDS_WAIT(); } } while (0)
#pragma unroll 1
        for (int grp = 0; grp < SEQ / 64; ++grp) {
            int tid = tid0; OPAQUE(tid);
            const int lane = tid & 63, g4 = lane >> 4, l16 = lane & 15, chn = h * 64 + lane;
            {
                LAS unsigned char* pc = lds + c4w * PCH; LAS unsigned char* tb = lds + TMP0 + c4w * TMPB;
                LAS h16* At = (LAS h16*)(pc + O_AT); LAS h16* Rt = (LAS h16*)(pc + O_RT); LAS h16* BbT = (LAS h16*)(pc + O_BBT); LAS h16* KbT = (LAS h16*)(pc + O_KBT); LAS h16* Vt = (LAS h16*)(pc + O_VT);
                LAS h16* MkT = (LAS h16*)(pc + O_MKT); LAS h16* TmT = (LAS h16*)(pc + O_TMT); LAS h16* NbT = (LAS h16*)(pc + O_NBT); LAS h16* NkT = (LAS h16*)(pc + O_NKT);
                LAS float* gC = (LAS float*)(pc + O_GC); LAS float* srk = (LAS float*)(pc + O_SRK);
                LAS h16* Bh = (LAS h16*)tb; LAS h16* Kh = (LAS h16*)(tb + 2304); LAS float* MbF = (LAS float*)(tb + 4608);
                float wf[8];
#pragma unroll
                for (int i = 0; i < 8; ++i) wf[i] = 1.0f - (float)qw[i];
                if (grp + 1 < SEQ / 64) {
#pragma unroll
                    for (int i = 0; i < 8; ++i) qw[i] = a.WD[((size_t)bh * SEQ + (grp + 1) * 64 + c4w * 16 + 8 * hfw) * 64 + lane + i * 64];
                }
                const float gown = ((wf[0] * wf[1]) * (wf[2] * wf[3])) * ((wf[4] * wf[5]) * (wf[6] * wf[7])), goth = gpr[(wave ^ 1) * 64 + lane];
                const float gall = gown * goth;
                float gam = hfw ? goth : 1.0f, bhr[8], khr[8];
                LAS float* red = (LAS float*)(lds + O_RED) + wave * 32;
                float n2s[8];
                {
                    float q[16];
#pragma unroll
                    for (int i = 0; i < 8; ++i) { const float k = (float)qk[i], kk = k * kkc; q[i] = kk * kk; q[8 + i] = (float)qr[i] * (k * (1.0f + ((float)qa[i] - 1.0f) * kac)) * rkc; }
                    float x = row16_reduce_scatter(q, lane); x += swz16f(x);
                    if ((lane & 16) == 0) red[(lane >> 5) * 16 + l16] = x;
                    LDS_WAIT();
                    const f32x4 r0 = *(const LAS f32x4*)(red), r1 = *(const LAS f32x4*)(red + 4), r2 = *(const LAS f32x4*)(red + 16), r3 = *(const LAS f32x4*)(red + 20);
#pragma unroll
                    for (int i = 0; i < 4; ++i) { n2s[i] = r0[i] + r2[i]; n2s[4 + i] = r1[i] + r3[i]; }
                    const float rks = red[8 + (lane & 7)] + red[24 + (lane & 7)];
                    if (lane < 8) ((LAS float*)(lds + O_SRKO))[(grp & 1) * 64 + 16 * c4w + 8 * hfw + lane] = rks;
                }
#pragma unroll
                for (int i = 0; i < 8; ++i) {
                    const int tt = 8 * hfw + i;
                    const float r = (float)qr[i], k = (float)qk[i], v = (float)qv[i], w = wf[i], aa = (float)qa[i];
                    const float kk = k * kkc; const float kkn = kk * __builtin_amdgcn_rsqf(fmaxf(n2s[i], 1e-24f));
                    const float kmod = k * (1.0f + (aa - 1.0f) * kac);
                    At[tt * 72 + lane] = (h16)(gam * -kkn);
                    gam *= w; const float rg = __builtin_amdgcn_rcpf(gam);
                    bhr[i] = fminf(fmaxf(kkn * aa * rg, -6.0e4f), 6.0e4f); khr[i] = fminf(fmaxf(kmod * rg, -6.0e4f), 6.0e4f);
                    Bh[tt * 72 + lane] = (h16)bhr[i]; Kh[tt * 72 + lane] = (h16)khr[i];
                    Rt[tt * 72 + lane] = (h16)(gam * r); ((LAS h16*)(lds + O_VO))[((grp & 1) * 64 + 16 * c4w + tt) * 64 + lane] = (h16)v;
                }
                if (hfw == 0) gC[lane] = gall;
                {
                    u32x4 pb, pk;
#pragma unroll
                    for (int q = 0; q < 4; ++q) { pb[q] = pkh(bhr[2 * q] * gall, bhr[2 * q + 1] * gall); pk[q] = pkh(khr[2 * q] * gall, khr[2 * q + 1] * gall); }
                    *(LAS u32x4*)(BbT + lane * 16 + 8 * hfw) = pb; *(LAS u32x4*)(KbT + lane * 16 + 8 * hfw) = pk;
                }
                conv_finish2(ci, cv);
                if (grp + 1 < SEQ / 64) {
#pragma unroll
                    for (int i = 0; i < 8; ++i) { const size_t tb = ((size_t)bh * SEQ + (grp + 1) * 64 + c4w * 16 + 8 * hfw) * 64 + lane;
                        qr[i] = a.R[tb + i * 64]; qk[i] = a.K[tb + i * 64]; qv[i] = a.V[tb + i * 64]; qa[i] = a.AA[tb + i * 64]; }
                }
                ci = conv_item2(((pass * 32 + grp) * 2 + 1) * G + blk, wave, lane, a.layer_pair, a.wgu, a.wdn, a.gu8);
                conv_issue2(ci, cv, lane);
                WBAR();
                if (hfw == 0) {
                    f32x4 mb = {0.f, 0.f, 0.f, 0.f}, mt = mb;
#pragma unroll
                    for (int s = 0; s < 2; ++s) { const int fo = l16 * 72 + 32 * s + 8 * g4; const h16x8 fb = *(const LAS h16x8*)(Bh + fo), fa = *(const LAS h16x8*)(At + fo);
                        mb = __builtin_amdgcn_mfma_f32_16x16x32_f16(fb, fa, mb, 0, 0, 0);
                        mt = __builtin_amdgcn_mfma_f32_16x16x32_f16(fa, fb, mt, 0, 0, 0); }
                    f32x4 td, ttd;
#pragma unroll
                    for (int e = 0; e < 4; ++e) { const int i = 4 * g4 + e; mb[e] = (i < l16) ? mb[e] : 0.f; mt[e] = (l16 < i) ? mt[e] : 0.f; const float dg = (i == l16) ? 1.0f : 0.0f; td[e] = mb[e] + dg; ttd[e] = mt[e] + dg; }
                    h16x4 xb = __builtin_convertvector(mb, h16x4), xa = __builtin_convertvector(mt, h16x4);
#pragma unroll
                    for (int s = 0; s < 3; ++s) {
                        const f32x4 z4 = {0.f, 0.f, 0.f, 0.f};
                        const f32x4 sq = __builtin_amdgcn_mfma_f32_16x16x16f16(xa, xb, z4, 0, 0, 0);
                        const f32x4 sqt = __builtin_amdgcn_mfma_f32_16x16x16f16(xb, xa, z4, 0, 0, 0);
                        xb = __builtin_convertvector(sq, h16x4); xa = __builtin_convertvector(sqt, h16x4);
                        const h16x4 ta = __builtin_convertvector(ttd, h16x4);
                        td = __builtin_amdgcn_mfma_f32_16x16x16f16(ta, xb, td, 0, 0, 0);
                        if (s < 2) ttd = __builtin_amdgcn_mfma_f32_16x16x16f16(xb, ta, ttd, 0, 0, 0);
                    }
                    *(LAS u32x2*)(TmT + l16 * 16 + 4 * g4) = pkh4(td);
                } else {
                    f32x4 mk = {0.f, 0.f, 0.f, 0.f}, nb = mk, nk = mk;
#pragma unroll
                    for (int s = 0; s < 2; ++s) {
                        const int fo = l16 * 72 + 32 * s + 8 * g4;
                        const h16x8 fb = *(const LAS h16x8*)(Bh + fo), fk = *(const LAS h16x8*)(Kh + fo), fa = *(const LAS h16x8*)(At + fo), fr = *(const LAS h16x8*)(Rt + fo);
                        mk = __builtin_amdgcn_mfma_f32_16x16x32_f16(fk, fa, mk, 0, 0, 0); nb = __builtin_amdgcn_mfma_f32_16x16x32_f16(fb, fr, nb, 0, 0, 0); nk = __builtin_amdgcn_mfma_f32_16x16x32_f16(fk, fr, nk, 0, 0, 0);
                    }
#pragma unroll
                    for (int e = 0; e < 4; ++e) { const int i = 4 * g4 + e; const bool lt = i < l16, le = i <= l16; mk[e] = lt ? mk[e] : 0.f; nb[e] = le ? nb[e] : 0.f; nk[e] = le ? nk[e] : 0.f; }
                    *(LAS u32x2*)(MkT + l16 * 16 + 4 * g4) = pkh4(mk); *(LAS u32x2*)(NbT + l16 * 16 + 4 * g4) = pkh4(nb); *(LAS u32x2*)(NkT + l16 * 16 + 4 * g4) = pkh4(nk);
                }
            }
            WBAR();
            if (wave < 4) {
                LAS float* sy = (LAS float*)(lds + O_SY) + (grp & 1) * (64 * 65);
#pragma unroll 2
                for (int c4 = 0; c4 < NG; ++c4) {
                    LAS unsigned char* pc = lds + c4 * PCH;
                    const LAS h16* At = (const LAS h16*)(pc + O_AT); const LAS h16* Rt = (const LAS h16*)(pc + O_RT); const LAS h16* BbT = (const LAS h16*)(pc + O_BBT); const LAS h16* KbT = (const LAS h16*)(pc + O_KBT);
                    const LAS h16* Vt = (const LAS h16*)(pc + O_VT); const LAS h16* MkT = (const LAS h16*)(pc + O_MKT); const LAS h16* TmT = (const LAS h16*)(pc + O_TMT);
                    const LAS h16* NbT = (const LAS h16*)(pc + O_NBT); const LAS h16* NkT = (const LAS h16*)(pc + O_NKT); const LAS float* gC = (const LAS float*)(pc + O_GC);
                    h16x4 sb[4];
#pragma unroll
                    for (int kt = 0; kt < 4; ++kt) sb[kt] = __builtin_convertvector(ST[kt], h16x4);
                    h16x4 vb;
                    { const LAS h16* vsrc = (const LAS h16*)(lds + O_VO) + ((grp & 1) * 64 + 16 * c4 + 4 * g4) * 64 + 16 * wave + l16;
#pragma unroll
                      for (int e = 0; e < 4; ++e) vb[e] = vsrc[e * 64]; }
                    f32x4 accW = {0.f, 0.f, 0.f, 0.f}, accY = {0.f, 0.f, 0.f, 0.f};
#pragma unroll
                    for (int kt = 0; kt < 4; ++kt) {
                        accW = __builtin_amdgcn_mfma_f32_16x16x16f16(*(const LAS h16x4*)(At + l16 * 72 + 16 * kt + 4 * g4), sb[kt], accW, 0, 0, 0);
                        accY = __builtin_amdgcn_mfma_f32_16x16x16f16(*(const LAS h16x4*)(Rt + l16 * 72 + 16 * kt + 4 * g4), sb[kt], accY, 0, 0, 0);
                    }
                    accW = __builtin_amdgcn_mfma_f32_16x16x16f16(*(const LAS h16x4*)(MkT + l16 * 16 + 4 * g4), vb, accW, 0, 0, 0);
                    accY = __builtin_amdgcn_mfma_f32_16x16x16f16(*(const LAS h16x4*)(NkT + l16 * 16 + 4 * g4), vb, accY, 0, 0, 0);
                    const h16x4 wb = __builtin_convertvector(accW, h16x4);
                    const f32x4 accU = __builtin_amdgcn_mfma_f32_16x16x16f16(*(const LAS h16x4*)(TmT + l16 * 16 + 4 * g4), wb, (f32x4){0.f, 0.f, 0.f, 0.f}, 0, 0, 0);
                    const h16x4 ub = __builtin_convertvector(accU, h16x4);
                    accY = __builtin_amdgcn_mfma_f32_16x16x16f16(*(const LAS h16x4*)(NbT + l16 * 16 + 4 * g4), ub, accY, 0, 0, 0);
#pragma unroll
                    for (int kt = 0; kt < 4; ++kt) {
                        ST[kt] = ST[kt] * *(const LAS f32x4*)(gC + 16 * kt + 4 * g4);
                        ST[kt] = __builtin_amdgcn_mfma_f32_16x16x16f16(*(const LAS h16x4*)(BbT + (16 * kt + l16) * 16 + 4 * g4), ub, ST[kt], 0, 0, 0);
                        ST[kt] = __builtin_amdgcn_mfma_f32_16x16x16f16(*(const LAS h16x4*)(KbT + (16 * kt + l16) * 16 + 4 * g4), vb, ST[kt], 0, 0, 0);
                    }
#pragma unroll
                    for (int e = 0; e < 4; ++e) sy[(16 * c4 + 4 * g4 + e) * 65 + 16 * wave + l16] = accY[e];
                }
            }
            else {
                if (grp > 0) OUT_STAGE(grp - 1);
#pragma unroll
                for (int j = 0; j < 16; ++j) qg[j] = a.GG[((size_t)bh * SEQ + grp * 64 + (wave - 4) * 16) * 64 + lane + j * 64];
            }
            conv_finish2(ci, cv);
            ci = conv_item2(((pass * 32 + grp + 1) * 2 + 0) * G + blk, wave, lane, a.layer_pair, a.wgu, a.wdn, a.gu8);
            if (grp + 1 < SEQ / 64) { conv_issue2(ci, cv, lane); gpr[wave * 64 + lane] = GPROD(); }
            WBAR();
        }
#undef GPROD
        if (wave >= 4) { const int lane = lane_id(), l16 = lane & 15, chn = h * 64 + lane; OUT_STAGE(SEQ / 64 - 1); }
#undef OUT_STAGE
    }
}

__device__ __forceinline__ float row16_max(float v) { v = fmaxf(v, dppf<0xB1>(v)); v = fmaxf(v, dppf<0x4E>(v)); v = fmaxf(v, dppf<0x141>(v)); v = fmaxf(v, dppf<0x140>(v)); return v; }
struct RouterArgs { const h16* H; const float *g, *b; const h16* WRS; const float* rb; h16* X1; unsigned char* XB; float* TOPG; int* LIST; unsigned* CNT; };
__device__ __forceinline__ void phase_ln_router(const RouterArgs& a, LAS unsigned char* lds, int blk, int G, const int wave) {
    constexpr int WPB = 2064;
    LAS unsigned* hcnt = (LAS unsigned*)(lds + 132096); LAS unsigned* hbase = hcnt + 32; LAS unsigned* pe = hbase + 32; LAS unsigned* pp = pe + 512;
    int tid = wave * 64 + lane_id(); OPAQUE(tid);
    const int lane = tid & 63, ex = lane & 15, kg = lane >> 4;
    for (int c = tid; c < 2 * 32 * 128; c += NTHR) { const int row = c >> 7, ch = c & 127; *(LAS u32x4*)(lds + row * WPB + ch * 16) = *(const u32x4*)((const char*)a.WRS + (size_t)row * 2048 + ch * 16); }
    const float rb0 = a.rb[ex], rb1 = a.rb[16 + ex];
    for (int tb = blk; tb < T / 128; tb += G) {
        if (tid < 32) hcnt[tid] = 0u;
        __syncthreads();
        const size_t tw = (size_t)tb * 128 + wave * 16;
#pragma unroll 1
        for (int ib = 0; ib < 4; ++ib) {
            f32x4 vv[4][4]; h16x4 vh[4][4];
#pragma unroll
            for (int q = 0; q < 4; ++q)
#pragma unroll
                for (int j = 0; j < 4; ++j) vh[q][j] = __builtin_nontemporal_load((const h16x4*)(a.H + (tw + 4 * ib + q) * D + 256 * j + 4 * lane));
#pragma unroll
            for (int q = 0; q < 4; ++q)
#pragma unroll
                for (int j = 0; j < 4; ++j) vv[q][j] = __builtin_convertvector(vh[q][j], f32x4);
#pragma unroll
            for (int q = 0; q < 4; ++q) {
                const size_t t = tw + 4 * ib + q; float s1 = 0.f;
#pragma unroll
                for (int j = 0; j < 4; ++j) s1 += (vv[q][j].x + vv[q][j].y) + (vv[q][j].z + vv[q][j].w);
                const float mean = wave_sum(s1) * (1.0f / D); float s2 = 0.f;
#pragma unroll
                for (int j = 0; j < 4; ++j) { vv[q][j] = vv[q][j] - mean; s2 += (vv[q][j].x * vv[q][j].x + vv[q][j].y * vv[q][j].y) + (vv[q][j].z * vv[q][j].z + vv[q][j].w * vv[q][j].w); }
                const float rstd = rsqrtf(wave_sum(s2) * (1.0f / D) + LN_EPS);
#pragma unroll
                for (int j = 0; j < 4; ++j) { const f32x4 o = vv[q][j] * rstd * *(const f32x4*)(a.g + 256 * j + 4 * lane) + *(const f32x4*)(a.b + 256 * j + 4 * lane);
                    *(u32x2*)(a.X1 + t * D + 256 * j + 4 * lane) = pkh4(o);
                    int pk_ = __builtin_amdgcn_cvt_pk_fp8_f32(o.x, o.y, 0, false); pk_ = __builtin_amdgcn_cvt_pk_fp8_f32(o.z, o.w, pk_, true);
                    *(unsigned*)(a.XB + t * D + 256 * j + 4 * lane) = (unsigned)pk_; }
            }
        }
        asm volatile("s_waitcnt vmcnt(0)" ::: "memory");
        f32x4 cA[2], cB[2];
        cA[0] = cA[1] = cB[0] = cB[1] = (f32x4){0.f, 0.f, 0.f, 0.f};
        const h16* xrow = a.X1 + (tw + ex) * D + 8 * kg;
        const LAS unsigned char* bh = lds + ex * WPB + kg * 16; const LAS unsigned char* bl = bh + 32 * WPB;
#pragma unroll 8
        for (int ks = 0; ks < 32; ++ks) {
            const h16x8 xh = *(const h16x8*)(xrow + 32 * ks);
#pragma unroll
            for (int tI = 0; tI < 2; ++tI) {
                const h16x8 wh = *(const LAS h16x8*)(bh + tI * 16 * WPB + ks * 64), wl = *(const LAS h16x8*)(bl + tI * 16 * WPB + ks * 64);
                cA[tI] = __builtin_amdgcn_mfma_f32_16x16x32_f16(xh, wh, cA[tI], 0, 0, 0);
                cB[tI] = __builtin_amdgcn_mfma_f32_16x16x32_f16(xh, wl, cB[tI], 0, 0, 0);
            }
        }
#pragma unroll
        for (int e = 0; e < 4; ++e) {
            float c0 = cA[0][e] + cB[0][e] * (1.0f / 4096.0f) + rb0, c1 = cA[1][e] + cB[1][e] * (1.0f / 4096.0f) + rb1;
            int sel[4]; float val[4];
#pragma unroll
            for (int k = 0; k < 4; ++k) {
                const float m = row16_max(fmaxf(c0, c1));
                const unsigned r0 = (unsigned)(__ballot(c0 == m) >> (16 * kg)) & 0xFFFFu, r1 = (unsigned)(__ballot(c1 == m) >> (16 * kg)) & 0xFFFFu;
                const int hit0 = r0 != 0u; const int wl_ = hit0 ? __builtin_ctz(r0) : __builtin_ctz(r1 | 0x10000u);
                sel[k] = hit0 ? wl_ : 16 + wl_; val[k] = m;
                if (ex == wl_) { if (hit0) c0 = -INFINITY; else c1 = -INFINITY; }
            }
            const float e1 = __expf(val[1] - val[0]), e2 = __expf(val[2] - val[0]), e3 = __expf(val[3] - val[0]);
            const float inv = 1.0f / (1.0f + e1 + e2 + e3);
            if (ex < 4) {
                const int tl = wave * 16 + 4 * kg + e; const size_t t = (size_t)tb * 128 + tl;
                const int mysel = ex == 0 ? sel[0] : ex == 1 ? sel[1] : ex == 2 ? sel[2] : sel[3];
                const float myg = (ex == 0 ? 1.0f : ex == 1 ? e1 : ex == 2 ? e2 : e3) * inv;
                a.TOPG[t * 4 + ex] = myg;
                const unsigned pos = __hip_atomic_fetch_add(hcnt + mysel, 1u, __ATOMIC_RELAXED, __HIP_MEMORY_SCOPE_WORKGROUP);
                pe[tl * 4 + ex] = (unsigned)mysel; pp[tl * 4 + ex] = pos;
            }
        }
        __syncthreads();
        if (tid < 32) hbase[tid] = __hip_atomic_fetch_add(a.CNT + tid, hcnt[tid], __ATOMIC_RELAXED, __HIP_MEMORY_SCOPE_AGENT);
        __syncthreads();
        { const unsigned e = pe[tid]; a.LIST[(size_t)e * ECAP + hbase[e] + pp[tid]] = tb * 512 + tid; }
        __syncthreads();
    }
}

__device__ __forceinline__ void phase_combine(const h16* X1, const unsigned char* YS, const float* g, const float* b, float* Xo  , h16* XH  , int gw_, int NGW_, int lane) {
    lane = lane_id(); OPAQUE(lane);
#pragma unroll 1
    for (int t0 = gw_; t0 < T; t0 += 2 * NGW_) {
        h16x4 x[2][4]; unsigned y[2][4][4];
#pragma unroll
        for (int q = 0; q < 2; ++q) { const size_t t = (size_t)t0 + (size_t)q * NGW_;
#pragma unroll
            for (int j = 0; j < 4; ++j) { x[q][j] = *(const h16x4*)(X1 + t * D + 256 * j + 4 * lane);
#pragma unroll
                for (int k = 0; k < 4; ++k) y[q][j][k] = __builtin_nontemporal_load((const unsigned*)(YS + (t * 4 + k) * D + 256 * j + 4 * lane)); } }
#pragma unroll
        for (int q = 0; q < 2; ++q) { const size_t t = (size_t)t0 + (size_t)q * NGW_;
            f32x4 v[4]; float s = 0.f;
#pragma unroll
            for (int j = 0; j < 4; ++j) { f32x4 ysum = (f32x4){0.f, 0.f, 0.f, 0.f};
#pragma unroll
                for (int k = 0; k < 4; ++k) { const f32x2 lo = __builtin_amdgcn_cvt_pk_f32_fp8((int)y[q][j][k], false), hi = __builtin_amdgcn_cvt_pk_f32_fp8((int)y[q][j][k], true); ysum += (f32x4){lo.x, lo.y, hi.x, hi.y}; }
                v[j] = __builtin_convertvector(x[q][j], f32x4) * ALPHA + ysum * (1.0f / YS_SCALE);
                s += (v[j].x + v[j].y) + (v[j].z + v[j].w); }
            const float mean = wave_sum(s) * (1.0f / D); float s2 = 0.f;
#pragma unroll
            for (int j = 0; j < 4; ++j) { v[j] = v[j] - mean; s2 += (v[j].x * v[j].x + v[j].y * v[j].y) + (v[j].z * v[j].z + v[j].w * v[j].w); }
            const float rstd = rsqrtf(wave_sum(s2) * (1.0f / D) + LN_EPS);
#pragma unroll
            for (int j = 0; j < 4; ++j) { v[j] = v[j] * rstd * *(const f32x4*)(g + 256 * j + 4 * lane) + *(const f32x4*)(b + 256 * j + 4 * lane);
                if (Xo) *(f32x4*)(Xo + t * D + 256 * j + 4 * lane) = v[j]; else *(u32x2*)(XH + t * D + 256 * j + 4 * lane) = pkh4(v[j]); }
        }
    }
}

#include <cmath>
namespace attn_body {
using bf16=_Float16;
using bf16x8=__attribute__((ext_vector_type(8)))short;
using s16x4=__attribute__((ext_vector_type(4)))short;
using f32x16=__attribute__((ext_vector_type(16)))float;
using u32x4=__attribute__((ext_vector_type(4)))unsigned;
constexpr int SEQ=2048,D=64,DM=1024,DMO=2048;
constexpr int NW=8,QBLK=32,QB=QBLK*NW,KVBLK=64,NQB=SEQ/QB;
typedef _Float16 f16x8_t __attribute__((ext_vector_type(8)));
#define MFMA32(a,b,c) __builtin_amdgcn_mfma_f32_32x32x16_f16(__builtin_bit_cast(f16x8_t,(a)),__builtin_bit_cast(f16x8_t,(b)),(c),0,0,0)
__device__ __forceinline__ int crow(int r,int hi){return (r&3)+8*(r>>2)+4*hi;}
#define SBAR() __builtin_amdgcn_sched_barrier(0)
__device__ __forceinline__ void cmask(f32x16&p0,f32x16&p1,int jb,int qrel,int hi){
  const float NEG=-INFINITY; int kb=64*jb+4*hi;
  #pragma unroll
  for(int r=0;r<16;++r){int kv=kb+(r&3)+8*(r>>2); if(kv>qrel)p0[r]=NEG; if(kv+32>qrel)p1[r]=NEG;}
}

constexpr int NSLOT=3, SLOTB=8192;
constexpr int LDS_K=0, LDS_V=NSLOT*SLOTB, LDS_WS=2*NSLOT*SLOTB, LDS_OST=LDS_WS+NW*64*4, LDS_BYTES=LDS_OST+NW*4096;
constexpr float C2=0.125f*1.4426950408889634f;
__device__ __forceinline__ void glds16(const void*gsrc,unsigned lds_dst){unsigned keep;
  asm volatile("s_mov_b32 %0, m0\n\ts_mov_b32 m0, %2\n\ts_nop 0\n\tglobal_load_lds_dwordx4 %1, off\n\ts_mov_b32 m0, %0":"=&s"(keep):"v"(gsrc),"s"(lds_dst):"memory");}
__device__ __forceinline__ float max3f(float a,float b,float c){float r;asm("v_max3_f32 %0, %1, %2, %3":"=v"(r):"v"(a),"v"(b),"v"(c));return r;}
__device__ __forceinline__ float max2f(float a,float b){float r;asm("v_max_f32_e32 %0, %1, %2":"=v"(r):"v"(a),"v"(b));return r;}
__device__ __forceinline__ float fadd_s(float a,float b){float r;asm("v_add_f32_e32 %0, %1, %2":"=v"(r):"v"(a),"v"(b));return r;}
__device__ __forceinline__ float fsub_s(float a,float b){float r;asm("v_sub_f32_e32 %0, %1, %2":"=v"(r):"v"(a),"v"(b));return r;}
typedef float f32x2_t __attribute__((ext_vector_type(2))); typedef _Float16 bf16x2_t __attribute__((ext_vector_type(2)));
__device__ __forceinline__ unsigned cvtpk_s(float lo,float hi){f32x2_t v={lo,hi};bf16x2_t b=__builtin_convertvector(v,bf16x2_t);return __builtin_bit_cast(unsigned,b);}
#define WAIT_BAR(N) asm volatile("s_waitcnt vmcnt(" #N ") lgkmcnt(0)\n\ts_barrier":::"memory")

__device__ __forceinline__ void qkt(f32x16&p0,f32x16&p1,const char*Kslot,const bf16x8*qr,const f32x16&negm,int r32,int hi){
  const char*kb=Kslot+hi*1024+r32*16;
  #pragma unroll
  for(int d0=0;d0<4;++d0){
    const bf16x8 b0=*reinterpret_cast<const bf16x8*>(kb+d0*2048);
    const bf16x8 b1=*reinterpret_cast<const bf16x8*>(kb+d0*2048+512);
    if(d0==0){p0=MFMA32(b0,qr[0],negm);p1=MFMA32(b1,qr[0],negm);}
    else{p0=MFMA32(b0,qr[d0],p0);p1=MFMA32(b1,qr[d0],p1);}}
}
typedef __attribute__((address_space(3))) const char* lds_cptr;
typedef short v4i16_t __attribute__((ext_vector_type(4)));
__device__ __forceinline__ void kload8(bf16x8*kf,lds_cptr kp){
  kf[0]=*(const __attribute__((address_space(3))) bf16x8*)(kp);      kf[1]=*(const __attribute__((address_space(3))) bf16x8*)(kp+512);
  kf[2]=*(const __attribute__((address_space(3))) bf16x8*)(kp+2048); kf[3]=*(const __attribute__((address_space(3))) bf16x8*)(kp+2560);
  kf[4]=*(const __attribute__((address_space(3))) bf16x8*)(kp+4096); kf[5]=*(const __attribute__((address_space(3))) bf16x8*)(kp+4608);
  kf[6]=*(const __attribute__((address_space(3))) bf16x8*)(kp+6144); kf[7]=*(const __attribute__((address_space(3))) bf16x8*)(kp+6656);
}
__device__ __forceinline__ void kload2(bf16x8*kf,lds_cptr kp,int j){ kf[2*j]=*(const __attribute__((address_space(3))) bf16x8*)(kp+j*2048); kf[2*j+1]=*(const __attribute__((address_space(3))) bf16x8*)(kp+j*2048+512); }
__device__ __forceinline__ s16x4 vtr(lds_cptr p){ return __builtin_bit_cast(s16x4,__builtin_amdgcn_ds_read_tr16_b64_v4i16((__attribute__((address_space(3))) v4i16_t*)p)); }
__device__ __forceinline__ float rowmax(const f32x16&p0,const f32x16&p1){
  float a=max3f(p0[0],p0[1],p1[0]),b=max3f(p0[2],p0[3],p1[1]);a=max3f(a,p1[2],p1[3]);
  #pragma unroll
  for(int r=4;r<16;r+=4){a=max3f(a,p0[r],p0[r+1]);b=max3f(b,p0[r+2],p0[r+3]);a=max3f(a,p1[r],p1[r+1]);b=max3f(b,p1[r+2],p1[r+3]);}
  const float m=max2f(a,b);
  auto rr=__builtin_amdgcn_permlane32_swap(__float_as_uint(m),__float_as_uint(m),false,false);
  return max2f(__uint_as_float(rr[0]),__uint_as_float(rr[1]));
}
__device__ __forceinline__ void pv(f32x16*o,int vb,bf16x8 pa0,bf16x8 pa1,bf16x8 pa2,bf16x8 pa3){
  #pragma unroll
  for(int d0=0;d0<2;++d0){s16x4 lo[4],hi[4];
    #pragma unroll
    for(int ks=0;ks<4;++ks){
      asm volatile("ds_read_b64_tr_b16 %0,%1 offset:%c2":"=&v"(lo[ks]):"v"(vb),"i"(d0*4096+ks*1024):"memory");
      asm volatile("ds_read_b64_tr_b16 %0,%1 offset:%c2":"=&v"(hi[ks]):"v"(vb),"i"(d0*4096+ks*1024+512):"memory");}
    asm volatile("s_waitcnt lgkmcnt(0)":::"memory");SBAR();
    #define PK(k) (bf16x8){lo[k][0],lo[k][1],lo[k][2],lo[k][3],hi[k][0],hi[k][1],hi[k][2],hi[k][3]}
    o[d0]=MFMA32(pa0,PK(0),o[d0]);
    o[d0]=MFMA32(pa1,PK(1),o[d0]);
    o[d0]=MFMA32(pa2,PK(2),o[d0]);
    o[d0]=MFMA32(pa3,PK(3),o[d0]);
    #undef PK
  }
}

#ifndef ATTN_STORE16
#define ATTN_STORE16(p,v) (*(u32x4*)(p)=(v))
#endif
template<int THRL> __device__ __forceinline__ void attn_unit(int b,int qcol,int vcol,int ocol,float slope2,int qb,int ts,const bf16*Q,const bf16*__restrict__ K,const bf16*__restrict__ V,bf16*O,char*shm,const int wid){
  int lane; asm volatile("v_mbcnt_lo_u32_b32 %0, -1, 0\n\tv_mbcnt_hi_u32_b32 %0, -1, %0":"=v"(lane)); const int r32=lane&31,hi=lane>>5;
  const long rowbase=(long)b*SEQ; const int q0=qb*QB;
  const bf16*Qw=Q+(rowbase+q0+wid*QBLK)*DM+qcol;
  const bf16*Kh=K+(rowbase+(long)ts*KVBLK)*DM+qcol,*Vh=V+(rowbase+(long)ts*KVBLK)*DM+vcol;
  const unsigned lds0=(unsigned)(uintptr_t)shm;
  float*wsf=(float*)(shm+LDS_WS)+wid*64;
  const bf16*ksrc=Kh+(long)lane*DM+wid*8;
  const bf16*vsrc=Vh+(long)(16*(wid&3)+(lane>>2))*DM+(wid>>2)*32+(lane&3)*8;
  const unsigned kdst=lds0+LDS_K+wid*1024, vdst=lds0+LDS_V+wid*1024;
  #define DMA_K(t,slot) glds16(ksrc+(long)(t)*KVBLK*DM,(unsigned)__builtin_amdgcn_readfirstlane(kdst+(slot)))
  #define DMA_V(t,slot) glds16(vsrc+(long)(t)*KVBLK*DM,(unsigned)__builtin_amdgcn_readfirstlane(vdst+(slot)))
  const int vb0=(int)(lds0+LDS_V)+((lane>>4)&1)*32+(lane&3)*8+(4*hi+((lane&15)>>2))*64;
  const char*Kbase=shm+LDS_K; bf16x8 kf[8];
  const lds_cptr shm3=(lds_cptr)shm; const lds_cptr kp0=shm3+LDS_K+hi*1024+r32*16; const lds_cptr vp0=shm3+LDS_V+((lane>>4)&1)*32+(lane&3)*8+(4*hi+((lane&15)>>2))*64;
  const int NT=(q0+QB)/KVBLK-ts;
  DMA_K(0,0);DMA_V(0,0);DMA_K(1,SLOTB);
  bf16x8 qr[4];
  #pragma unroll
  for(int d0=0;d0<4;++d0)qr[d0]=*reinterpret_cast<const bf16x8*>(&Qw[(long)r32*DM+d0*16+hi*8]);
  float mhat=0.f,l_reg=0.f;f32x16 o[2];o[0]=f32x16{};o[1]=f32x16{};f32x16 negm;
  const float delta=64.f*slope2,c32=32.f*slope2;
  _Pragma("unroll") for(int r=0;r<16;++r)negm[r]=slope2*(float)crow(r,hi); asm volatile("":"+v"(negm));
  const int qrel=wid*QBLK+r32;
  #define CMASK(P0,P1,t) do{int jb_=(t)-(NT-4); if(jb_>=0)cmask(P0,P1,jb_,qrel,hi);}while(0)
  bool resc=false;
  #define START(P0,P1) do{ const float rm=rowmax(P0,P1); resc=false; \
    { const float dl=rm; mhat=fadd_s(mhat,dl); \
      _Pragma("unroll") for(int r=0;r<16;++r){P0[r]=fsub_s(P0[r],dl);P1[r]=fsub_s(P1[r],dl);} \
      _Pragma("unroll") for(int r=0;r<16;++r)negm[r]-=dl; asm volatile("":"+v"(negm)); } \
    _Pragma("unroll") for(int r=0;r<16;++r)P0[r]=__builtin_amdgcn_exp2f(P0[r]); }while(0)
  #define RESC() do{ if(resc){ asm volatile("s_waitcnt lgkmcnt(0)":::"memory"); \
      _Pragma("unroll") for(int d_=0;d_<2;++d_) _Pragma("unroll") for(int r=0;r<16;++r)o[d_][r]*=wsf[crow(r,hi)]; } }while(0)
  f32x16 pA0,pA1,pB0,pB1;
  int sl_prev=0,sl_cur=0,sl_next=SLOTB;
  #define ROT() do{sl_prev=sl_cur;sl_cur=sl_next;sl_next=(sl_next==(NSLOT-1)*SLOTB)?0:sl_next+SLOTB;}while(0)
  DMA_K(2,2*SLOTB);
  WAIT_BAR(3);
  qkt(pA0,pA1,Kbase,qr,negm,r32,hi);asm volatile("s_nop 15\n\ts_nop 7":"+v"(pA0),"+v"(pA1)); _Pragma("unroll") for(int r=0;r<16;++r)pA1[r]+=c32; CMASK(pA0,pA1,0);
  START(pA0,pA1);
  _Pragma("unroll") for(int r=0;r<16;++r)pA1[r]=__builtin_amdgcn_exp2f(pA1[r]);
  WAIT_BAR(0);
  DMA_K(3,0);DMA_V(1,SLOTB);
  ROT();
  kload8(kf,kp0+sl_cur);
  WAIT_BAR(2);
  s16x4 vlo[8],vhi[8]; u32x4 pw0,pw1,pw2,pw3;
  #define PKW(P,B) cvtpk_s(P[B],P[B+1])
  #define PAF(k) __builtin_bit_cast(bf16x8,pw##k)
  #define VFR(i) (bf16x8){vlo[i][0],vlo[i][1],vlo[i][2],vlo[i][3],vhi[i][0],vhi[i][1],vhi[i][2],vhi[i][3]}
  #define PIN(x) asm volatile("":"+v"(x))
  #define MX3(a,b,c) __builtin_fmaxf(__builtin_fmaxf((a),(b)),(c))
  #define GAPA(MF,A0,A1,A2,A3,W0,W1,PW) do{ MF; sacc+=A0; sacc+=A1; sacc+=A2; sacc+=A3; PIN(sacc); W0; W1; PIN(PW); SBAR(); }while(0)
  #define EX(v) __builtin_amdgcn_exp2f(v)
  #define GAPB(MF,X,B) do{ MF; X[B]=EX(X[B]); X[B+1]=EX(X[B+1]); X[B+2]=EX(X[B+2]); X[B+3]=EX(X[B+3]); PIN(X); SBAR(); }while(0)
  #define VRD(i) do{ vlo[i]=vtr(vp_+(((i)>>2)*4096+((i)&3)*1024)); vhi[i]=vtr(vp_+(((i)>>2)*4096+((i)&3)*1024+512)); }while(0)
  #define KRD(G,j) do{ if(G){ kload2(kf,kp0+sl_next,j); SBAR(); } }while(0)
  #define STEP(C0,C1,P0,P1,t,GK,GV,GL) do{ SBAR(); \
    _Pragma("unroll") for(int r=0;r<16;++r)negm[r]+=delta; asm volatile("":"+v"(negm)); \
    const lds_cptr vp_=vp0+sl_prev; \
    VRD(0); SBAR(); float sacc=(P0[0]+P0[1]); \
    GAPA(C0=MFMA32(kf[0],qr[0],negm), P0[2],P0[3],P0[4],P0[5],     pw0[0]=PKW(P0,0), pw0[1]=PKW(P0,2), pw0); \
    VRD(4); SBAR(); GAPA(C1=MFMA32(kf[1],qr[0],negm), P0[6],P0[7],P0[8],P0[9],     pw0[2]=PKW(P0,4), pw0[3]=PKW(P0,6), pw0); \
    VRD(1); SBAR(); GAPA(C0=MFMA32(kf[2],qr[1],C0),   P0[10],P0[11],P0[12],P0[13], pw1[0]=PKW(P0,8), pw1[1]=PKW(P0,10), pw1); \
    VRD(5); SBAR(); GAPA(C1=MFMA32(kf[3],qr[1],C1),   P0[14],P0[15],P1[0],P1[1],   pw1[2]=PKW(P0,12),pw1[3]=PKW(P0,14), pw1); \
    VRD(2); SBAR(); GAPA(C0=MFMA32(kf[4],qr[2],C0),   P1[2],P1[3],P1[4],P1[5],     pw2[0]=PKW(P1,0), pw2[1]=PKW(P1,2), pw2); \
    VRD(6); SBAR(); GAPA(C1=MFMA32(kf[5],qr[2],C1),   P1[6],P1[7],P1[8],P1[9],     pw2[2]=PKW(P1,4), pw2[3]=PKW(P1,6), pw2); \
    VRD(3); SBAR(); GAPA(C0=MFMA32(kf[6],qr[3],C0),   P1[10],P1[11],P1[12],P1[13], pw3[0]=PKW(P1,8), pw3[1]=PKW(P1,10), pw3); \
    VRD(7); SBAR(); GAPA(C1=MFMA32(kf[7],qr[3],C1),   P1[14],P1[15],0.f,0.f,       pw3[2]=PKW(P1,12),pw3[3]=PKW(P1,14), pw3); \
    l_reg+=sacc; \
    if(GK){DMA_K((t)+3,sl_cur);} if(GV){DMA_V((t)+1,sl_next);} \
    _Pragma("unroll") for(int r=0;r<16;++r)C1[r]+=c32; \
    CMASK(C0,C1,t); \
    { float a=MX3(C0[0],C0[1],C1[0]),b=MX3(C0[2],C0[3],C1[1]); a=MX3(a,C1[2],C1[3]); \
      _Pragma("unroll") for(int r=4;r<16;r+=4){a=MX3(a,C0[r],C0[r+1]);b=MX3(b,C0[r+2],C0[r+3]);a=MX3(a,C1[r],C1[r+1]);b=MX3(b,C1[r+2],C1[r+3]);} \
      float rm=__builtin_fmaxf(a,b); { auto rr=__builtin_amdgcn_permlane32_swap(__float_as_uint(rm),__float_as_uint(rm),false,false); rm=__builtin_fmaxf(__uint_as_float(rr[0]),__uint_as_float(rr[1])); } \
      resc=false; \
      if(__builtin_expect(__any(rm>(float)THRL),0)){ const float dl=__builtin_fmaxf(rm,0.f); mhat+=dl; \
        _Pragma("unroll") for(int r=0;r<16;++r){C0[r]-=dl;C1[r]-=dl;} \
        _Pragma("unroll") for(int r=0;r<16;++r)negm[r]-=dl; asm volatile("":"+v"(negm)); \
        const float f=__builtin_amdgcn_exp2f(-dl); l_reg*=f; if(hi==0)wsf[r32]=f; resc=true; } } \
    SBAR(); \
    GAPB(o[0]=MFMA32(PAF(0),VFR(0),o[0]), C0,0); \
    GAPB(o[1]=MFMA32(PAF(0),VFR(4),o[1]), C0,4); \
    KRD(GL,0); GAPB(o[0]=MFMA32(PAF(1),VFR(1),o[0]), C0,8); \
    KRD(GL,1); GAPB(o[1]=MFMA32(PAF(1),VFR(5),o[1]), C0,12); \
    KRD(GL,2); GAPB(o[0]=MFMA32(PAF(2),VFR(2),o[0]), C1,0); \
    KRD(GL,3); GAPB(o[1]=MFMA32(PAF(2),VFR(6),o[1]), C1,4); \
    GAPB(o[0]=MFMA32(PAF(3),VFR(3),o[0]), C1,8); \
    GAPB(o[1]=MFMA32(PAF(3),VFR(7),o[1]), C1,12); \
    }while(0)
  int t=1;
  #undef CMASK
  #define CMASK(P0,P1,t) do{}while(0)
  for(;t+5<NT;t+=2){
    STEP(pB0,pB1,pA0,pA1,t,true,true,true);     WAIT_BAR(2); RESC(); ROT();
    STEP(pA0,pA1,pB0,pB1,t+1,true,true,true);   WAIT_BAR(2); RESC(); ROT();
  }
  #undef CMASK
  #define CMASK(P0,P1,t) do{int jb_=(t)-(NT-4); if(jb_>=0)cmask(P0,P1,jb_,qrel,hi);}while(0)
  #define ENDW(tt) do{ if((tt)+3<NT){WAIT_BAR(2);} else if((tt)+2<NT){WAIT_BAR(1);} else {WAIT_BAR(0);} }while(0)
  for(;t+1<NT;t+=2){
    STEP(pB0,pB1,pA0,pA1,t,(t+3<NT),(t+1<NT),(t+1<NT));       ENDW(t);   RESC(); ROT();
    STEP(pA0,pA1,pB0,pB1,t+1,(t+4<NT),(t+2<NT),(t+2<NT));     ENDW(t+1); RESC(); ROT();
  }
  STEP(pB0,pB1,pA0,pA1,NT-1,false,false,false); RESC();
  { float sacc=pB0[0]+pB0[1]; _Pragma("unroll") for(int r=2;r<16;++r)sacc+=pB0[r]; _Pragma("unroll") for(int r=0;r<16;++r)sacc+=pB1[r]; l_reg+=sacc;
    pw0=(u32x4){PKW(pB0,0),PKW(pB0,2),PKW(pB0,4),PKW(pB0,6)};pw1=(u32x4){PKW(pB0,8),PKW(pB0,10),PKW(pB0,12),PKW(pB0,14)};pw2=(u32x4){PKW(pB1,0),PKW(pB1,2),PKW(pB1,4),PKW(pB1,6)};pw3=(u32x4){PKW(pB1,8),PKW(pB1,10),PKW(pB1,12),PKW(pB1,14)};
    SBAR(); pv(o,vb0+sl_cur,PAF(0),PAF(1),PAF(2),PAF(3)); }
  #undef PKW
  #undef PAF
  #undef VFR
  #undef PIN
  #undef MX3
  #undef GAPA
  #undef GAPB
  #undef EX
  #undef VRD
  #undef KRD
  #undef STEP
  #undef ENDW
  {auto rr=__builtin_amdgcn_permlane32_swap(__float_as_uint(l_reg),__float_as_uint(l_reg),false,false);l_reg=__uint_as_float(rr[0])+__uint_as_float(rr[1]);}
  if(hi==0)wsf[32+r32]=l_reg;asm volatile("s_waitcnt lgkmcnt(0)":::"memory");
  float rli[16];
  #pragma unroll
  for(int r=0;r<16;++r)rli[r]=__builtin_amdgcn_rcpf(wsf[32+crow(r,hi)]);
  bf16*Ow=O+(rowbase+q0+wid*QBLK)*DMO+ocol;
  { bf16*stg=(bf16*)(shm+LDS_OST)+wid*2048;
    #pragma unroll
    for(int r=0;r<16;++r){const int orow=crow(r,hi);
      #pragma unroll
      for(int d0=0;d0<2;++d0)stg[orow*64+d0*32+r32]=(bf16)(o[d0][r]*rli[r]);}
    asm volatile("s_waitcnt lgkmcnt(0)":::"memory");
    #pragma unroll
    for(int i=0;i<4;++i){const int row=i*8+(lane>>3),ch=lane&7; const u32x4 v=*(const u32x4*)(stg+row*64+ch*8); ATTN_STORE16(Ow+(long)row*DMO+ch*8,v);} }
  asm volatile("s_waitcnt lgkmcnt(0)\n\ts_barrier":::"memory");
  #undef DMA_K
  #undef DMA_V
  #undef CMASK
  #undef START
  #undef RESC
  #undef ROT
}
}
#undef SBAR
#undef WAIT_BAR
#undef MFMA32
__device__ const unsigned char ATT_H[64] = {5,6,7,5,6,7,5,6,7,4,4,4,4,5,6,7,4,5,6,7,3,3,3,3,3,3,4,5,6,7,2,2,2,2,2,2,1,1,1,1,1,1,1,2,3,4,5,6,7,0,0,0,0,0,0,0,0,1,2,3,4,5,6,7};
__device__ const unsigned char ATT_Q[64] = {7,7,7,6,6,6,5,5,5,5,6,7,4,4,4,4,3,3,3,3,3,4,5,6,7,2,2,2,2,2,2,3,4,5,6,7,1,2,3,4,5,6,7,1,1,1,1,1,1,1,2,3,4,5,6,7,0,0,0,0,0,0,0,0};
__device__ const unsigned char ATT_S[64] = {0,0,0,0,0,0,0,0,0,2,6,10,0,0,0,0,0,0,0,0,2,6,10,14,18,0,0,0,0,0,2,6,10,14,18,22,0,4,8,12,16,20,24,0,0,0,0,0,0,2,6,10,14,18,22,26,0,0,0,0,0,0,0,0};
__device__ __forceinline__ void phase_attn(const h16* Q, const h16* KK, const h16* VV, h16* ORAW, char* lds_generic, int blk, int G, const int wave) {
    const int vcu = (G % 8 == 0) ? (blk % 8) * (G / 8) + blk / 8 : blk;
#pragma unroll 1
    for (int r = 0; r < 16; ++r) {
        const int p = r * 256 + ((r & 1) ? 255 - vcu : vcu), ci = p >> 6, u = p & 63;
        const int hh = ATT_H[ci], qb = ATT_Q[ci], ts = ATT_S[ci], b = u >> 2, c = (u >> 1) & 1, vh = u & 1;
        const float slope2 = exp2f(-(float)(hh + 1)) * LOG2E;
        attn_body::attn_unit<8>(b, hh * 128 + c * 64, hh * 128 + vh * 64, c * 1024 + hh * 128 + vh * 64, slope2, qb, ts, Q, KK, VV, ORAW, lds_generic, wave);
    }
}

__device__ __forceinline__ float row16_sum(float v);
__device__ __forceinline__ void phase_attn_combine(const h16* ORAW, const float* lamv  , const float* subg  , float lambda_init, h16* OB, int gw_, int NGW_, int lane) {
    lane = lane_id(); OPAQUE(lane);
    const float la = wave_sum(lamv[lane] * lamv[64 + lane]), lb = wave_sum(lamv[128 + lane] * lamv[192 + lane]);
    const float lam = __expf(la) - __expf(lb) + lambda_init;
    const int hs = lane >> 5, d = (lane & 31) * 4;
    const f32x4 gsc = *(const f32x4*)(subg + d) * (1.0f - lambda_init);
#pragma unroll 1
    for (int t0 = gw_; t0 < T; t0 += 2 * NGW_) {
        h16x4 a[2][4], b[2][4];
#pragma unroll
        for (int q = 0; q < 2; ++q) { const size_t t = (size_t)t0 + (size_t)q * NGW_;
#pragma unroll
            for (int hp = 0; hp < 4; ++hp) { const int hh = 2 * hp + hs; a[q][hp] = *(const h16x4*)(ORAW + t * 2048 + hh * 128 + d); b[q][hp] = *(const h16x4*)(ORAW + t * 2048 + 1024 + hh * 128 + d); } }
#pragma unroll
        for (int q = 0; q < 2; ++q) { const size_t t = (size_t)t0 + (size_t)q * NGW_;
#pragma unroll
            for (int hp = 0; hp < 4; ++hp) { const int hh = 2 * hp + hs;
                const f32x4 o = __builtin_convertvector(a[q][hp], f32x4) - __builtin_convertvector(b[q][hp], f32x4) * lam;
                float ss = (o.x * o.x + o.y * o.y) + (o.z * o.z + o.w * o.w); ss = row16_sum(ss); ss += swz16f(ss);
                const float r = rsqrtf(ss * (1.0f / 128.0f) + 1e-5f);
                *(u32x2*)(OB + t * 1024 + hh * 128 + d) = pkh4(o * r * gsc); } }
    }
}

struct SchedRkv {
    const char* XM; const char* Wrkv; const char* Wl1; int nk, G, c;
    __device__ __forceinline__ bool next(int i, Unit& u) const {
        int pm, q;
        if (G == 256) { const int L = i * 32 + (c >> 3), pl = L / nk; q = L - pl * nk; pm = pl * 8 + (c & 7); if (pm >= 128) return false; }
        else { const int U = i * G + c; if (U >= 128 * nk) return false; pm = U / nk; q = U - pm * nk; }
        u.pm = pm; u.rows = 256; u.e = 0; u.rbase = 0; u.list = nullptr;
        int xs, pn, kind; const char* B;
        if (q < 12) { kind = q >> 2; pn = q & 3; xs = kind; B = Wrkv + ((size_t)kind * 1024 + pn * 256) * 2048; }
        else { kind = q - 9; pn = 0; xs = (kind == 6) ? 2 : kind; B = Wl1 + (size_t)(kind - 3) * 256 * 2048; }
        u.kind = kind; u.pn = pn; u.B = B; u.A = XM + ((size_t)xs * T + (size_t)pm * 256) * 2048;
        return true;
    }
    __device__ __forceinline__ unsigned a_off(const Unit&, int row) const { return (unsigned)row * 2048u; }
};
struct SchedL2 {
    const char* L1O; const char* Wl2; int kind, G, c;
    __device__ __forceinline__ bool next(int i, Unit& u) const {
        const int U = i * G + c; if (U >= 128 * 4) return false;
        const int pm = U >> 2; u.pm = pm; u.pn = U & 3; u.rows = 256; u.e = 0; u.rbase = 0; u.list = nullptr; u.kind = kind;
        u.A = L1O + ((size_t)kind * T + (size_t)pm * 256) * 512; u.B = Wl2 + ((size_t)kind * 1024 + u.pn * 256) * 512;
        return true;
    }
    __device__ __forceinline__ unsigned a_off(const Unit&, int row) const { return (unsigned)row * 512u; }
};
struct SchedPlain {
    const char* A; const char* B; int npn, G, c;
    __device__ __forceinline__ bool next(int i, Unit& u) const {
        int pm, pn;
        if (G == 256) { const int L = i * 32 + (c >> 3), pl = L / npn; pn = L - pl * npn; pm = pl * 8 + (c & 7); if (pm >= 128) return false; }
        else { const int U = i * G + c; if (U >= 128 * npn) return false; pm = U / npn; pn = U - pm * npn; }
        u.pm = pm; u.rows = 256; u.e = 0; u.rbase = 0; u.list = nullptr;
        u.kind = pn >> 2; u.pn = pn & 3; u.A = A + (size_t)pm * 256 * 2048; u.B = B + (size_t)pn * 256 * 2048;
        return true;
    }
    __device__ __forceinline__ unsigned a_off(const Unit&, int row) const { return (unsigned)row * 2048u; }
};
struct SchedMoe {
    const LAS unsigned* misc; const LAS int* tile_e; const char* A; const char* W; const int* LIST; int npn, gather, G, c; size_t wstride;
    __device__ __forceinline__ bool next(int i, Unit& u) const {
        const int ntile = __builtin_amdgcn_readfirstlane((int)misc[48 + 32]);
        int rtg, pn;
        if (G == 256) { const int x = c & 7, j = c >> 3, rpr = 32 / npn; rtg = (i * rpr + j / npn) * 8 + x; pn = j % npn; if (rtg >= ntile) return false; }
        else { const int U = i * G + c; if (U >= ntile * npn) return false; rtg = U / npn; pn = U - rtg * npn; }
        const int e = __builtin_amdgcn_readfirstlane(tile_e[rtg]);
        const int rt = rtg - __builtin_amdgcn_readfirstlane((int)misc[48 + e]), cnt = __builtin_amdgcn_readfirstlane((int)misc[16 + e]);
        u.pm = rtg; u.pn = pn; u.kind = 0; u.e = e; u.rbase = rtg * 256; u.rows = min(256, cnt - rt * 256);
        u.list = LIST + (size_t)e * ECAP + rt * 256;
        u.A = gather ? A : A + (size_t)rtg * 256 * 1024; u.B = W + (size_t)e * wstride + (size_t)pn * 256 * 1024;
        return true;
    }
    __device__ __forceinline__ unsigned a_off(const Unit& u, int row) const {
        if (!gather) return (unsigned)row * 1024u;
        const int slot = (row < u.rows) ? u.list[row] : 0;
        return (unsigned)(slot >> 2) * 1024u;
    }
};
__device__ __forceinline__ void moe_tables(const unsigned* CNT, volatile LAS unsigned* misc, LAS int* tile_e, const int wave) {
    if (wave == 0 && lane_id() == 0) {
        unsigned acc = 0;
        for (int e = 0; e < 32; ++e) { const unsigned c = __hip_atomic_load(CNT + e, __ATOMIC_RELAXED, __HIP_MEMORY_SCOPE_AGENT); misc[16 + e] = c; misc[48 + e] = acc; acc += (c + 255u) >> 8; }
        misc[48 + 32] = acc;
    }
    __syncthreads();
    { const int ntile = (int)misc[48 + 32];
      for (int i = wave * 64 + lane_id(); i < ntile; i += NTHR) { int e = 0; for (int j = 1; j < 32; ++j) if ((int)misc[48 + j] <= i) e = j; tile_e[i] = e; } }
    __syncthreads();
}

__device__ __forceinline__ size_t hm_off(int row, int col) { return ((size_t)((row >> 11) * 16 + (col >> 6)) * SEQ + (row & 2047)) * 64 + (col & 63); }
struct EpiRkv {
    h16* Rp; h16* Kp; h16* Vp; h16* L1O;
    __device__ __forceinline__ void operator()(const f32x4 (&acc)[2][2][4][2], const Unit& u, int wr, int wc, int fr, int fq) const {
        if (u.kind < 3) {
            h16* C = u.kind == 0 ? Rp : (u.kind == 1 ? Kp : Vp);
            FOR_ACC2(ai, bj, m) { const int row = u.pm * 256 + 128 * ai + 64 * wr + 16 * m + fr, col = u.pn * 256 + 128 * bj + 32 * wc + 8 * fq;
                const u32x2 lo = pkh4(acc[ai][bj][m][0]), hi = pkh4(acc[ai][bj][m][1]); *(u32x4*)(C + hm_off(row, col)) = (u32x4){lo.x, lo.y, hi.x, hi.y}; }
        } else {
            h16* O = L1O + (size_t)(u.kind - 3) * T * 256; const int kd = u.kind;
            FOR_ACC2(ai, bj, m) { const int row = u.pm * 256 + 128 * ai + 64 * wr + 16 * m + fr, col = 128 * bj + 32 * wc + 8 * fq; u32x2 pk2[2];
#pragma unroll
                for (int n = 0; n < 2; ++n) { f32x4 v = acc[ai][bj][m][n];
                    if (kd == 3) { v.x = tanhf(v.x); v.y = tanhf(v.y); v.z = tanhf(v.z); v.w = tanhf(v.w); }
                    else if (kd == 5) { v.x = sigmoidf_(v.x); v.y = sigmoidf_(v.y); v.z = sigmoidf_(v.z); v.w = sigmoidf_(v.w); }
                    pk2[n] = pkh4(v); }
                *(u32x4*)(O + (size_t)row * 256 + col) = (u32x4){pk2[0].x, pk2[0].y, pk2[1].x, pk2[1].y}; }
        }
    }
};
template <int KD> struct EpiL2 {
    void* O; const h16* VF; const float* bias;
    __device__ __forceinline__ void operator()(const f32x4 (&acc)[2][2][4][2], const Unit& u, int wr, int wc, int fr, int fq) const {
        f32x4 bv[2][2];
#pragma unroll
        for (int bj = 0; bj < 2; ++bj)
#pragma unroll
            for (int n = 0; n < 2; ++n) bv[bj][n] = (KD != 2) ? *(const f32x4*)(bias + u.pn * 256 + 128 * bj + 32 * wc + 8 * fq + 4 * n) : (f32x4){0.f, 0.f, 0.f, 0.f};
#pragma unroll
        for (int ai = 0; ai < 2; ++ai)
#pragma unroll
            for (int mp = 0; mp < 2; ++mp) {
                h16x4 vc[2][2][2], vf[2][2][2];
                if (KD == 3) {
#pragma unroll
                    for (int mm = 0; mm < 2; ++mm)
#pragma unroll
                        for (int bj = 0; bj < 2; ++bj)
#pragma unroll
                            for (int n = 0; n < 2; ++n) { const size_t o = hm_off(u.pm * 256 + 128 * ai + 64 * wr + 16 * (2 * mp + mm) + fr, u.pn * 256 + 128 * bj + 32 * wc + 8 * fq + 4 * n);
                                vc[mm][bj][n] = *(const h16x4*)((const h16*)O + o); vf[mm][bj][n] = *(const h16x4*)(VF + o); }
                }
#pragma unroll
                for (int mm = 0; mm < 2; ++mm)
#pragma unroll
                    for (int bj = 0; bj < 2; ++bj) { const int m = 2 * mp + mm; const size_t o = hm_off(u.pm * 256 + 128 * ai + 64 * wr + 16 * m + fr, u.pn * 256 + 128 * bj + 32 * wc + 8 * fq); u32x2 pk2[2];
#pragma unroll
                        for (int n = 0; n < 2; ++n) {
                            f32x4 v = acc[ai][bj][m][n] + bv[bj][n];
                            if (KD == 0) { v.x = 1.0f - __expf(-0.6065306597126334f * sigmoidf_(v.x)); v.y = 1.0f - __expf(-0.6065306597126334f * sigmoidf_(v.y)); v.z = 1.0f - __expf(-0.6065306597126334f * sigmoidf_(v.z)); v.w = 1.0f - __expf(-0.6065306597126334f * sigmoidf_(v.w)); }
                            if (KD == 1 || KD == 3) { v.x = sigmoidf_(v.x); v.y = sigmoidf_(v.y); v.z = sigmoidf_(v.z); v.w = sigmoidf_(v.w); }
                            if (KD == 3) { const f32x4 c_ = __builtin_convertvector(vc[mm][bj][n], f32x4), f_ = __builtin_convertvector(vf[mm][bj][n], f32x4); v = c_ + (f_ - c_) * v; }
                            pk2[n] = pkh4(v); }
                        *(u32x4*)((h16*)O + o) = (u32x4){pk2[0].x, pk2[0].y, pk2[1].x, pk2[1].y}; }
                if (KD == 3) EPI_FENCE();
            }
    }
};
template <bool F16X> struct EpiRes {
    const void* X; h16* H;
    __device__ __forceinline__ void operator()(const f32x4 (&acc)[2][2][4][2], const Unit& u, int wr, int wc, int fr, int fq) const {
        const float* Xf = (const float*)X; const h16* Xh = (const h16*)X;
#pragma unroll
        for (int ai = 0; ai < 2; ++ai)
#pragma unroll
            for (int mp = 0; mp < 2; ++mp) {
                f32x4 xr[2][2][2]; h16x4 xh[2][2][2];
#pragma unroll
                for (int mm = 0; mm < 2; ++mm)
#pragma unroll
                    for (int bj = 0; bj < 2; ++bj)
#pragma unroll
                        for (int n = 0; n < 2; ++n) { const size_t o = (size_t)(u.pm * 256 + 128 * ai + 64 * wr + 16 * (2 * mp + mm) + fr) * D + u.pn * 256 + 128 * bj + 32 * wc + 8 * fq + 4 * n;
                            if (F16X) xh[mm][bj][n] = *(const h16x4*)(Xh + o); else xr[mm][bj][n] = *(const f32x4*)(Xf + o); }
#pragma unroll
                for (int mm = 0; mm < 2; ++mm)
#pragma unroll
                    for (int bj = 0; bj < 2; ++bj) { const int m = 2 * mp + mm; u32x2 pk2[2];
#pragma unroll
                        for (int n = 0; n < 2; ++n) { const f32x4 xv = F16X ? __builtin_convertvector(xh[mm][bj][n], f32x4) : xr[mm][bj][n]; pk2[n] = pkh4(xv * ALPHA + acc[ai][bj][m][n]); }
                        *(u32x4*)(H + (size_t)(u.pm * 256 + 128 * ai + 64 * wr + 16 * m + fr) * D + u.pn * 256 + 128 * bj + 32 * wc + 8 * fq) = (u32x4){pk2[0].x, pk2[0].y, pk2[1].x, pk2[1].y}; }
                EPI_FENCE();
            }
    }
};
struct EpiQkv {
    h16* O0; h16* O1; float sc0;
    __device__ __forceinline__ void operator()(const f32x4 (&acc)[2][2][4][2], const Unit& u, int wr, int wc, int fr, int fq) const {
        h16* O = u.kind == 0 ? O0 : O1; const float sc = u.kind == 0 ? sc0 : 1.0f;
        FOR_ACC2(ai, bj, m) { const int row = u.pm * 256 + 128 * ai + 64 * wr + 16 * m + fr, col = u.pn * 256 + 128 * bj + 32 * wc + 8 * fq;
            const u32x2 lo = pkh4(acc[ai][bj][m][0] * sc), hi = pkh4(acc[ai][bj][m][1] * sc); *(u32x4*)(O + (size_t)row * 1024 + col) = (u32x4){lo.x, lo.y, hi.x, hi.y}; }
    }
};
struct EpiGu {
    unsigned char* ACT; const float* bgu;
    __device__ __forceinline__ void operator()(const f32x4 (&acc)[2][2][4][2], const Unit& u, int wr, int wc, int fr, int fq) const {
        if (u.rows == 256) body<true>(acc, u, wr, wc, fr, fq); else body<false>(acc, u, wr, wc, fr, fq); }
    template <bool FULL> __device__ __forceinline__ void body(const f32x4 (&acc)[2][2][4][2], const Unit& u, int wr, int wc, int fr, int fq) const {
        const float* bb = bgu + (size_t)u.e * 2048;
        f32x4 bg[2], bu[2];
        const int colb = u.pn * 128 + 32 * wc + 8 * fq;
#pragma unroll
        for (int n = 0; n < 2; ++n) { bg[n] = *(const f32x4*)(bb + colb + 4 * n); bu[n] = *(const f32x4*)(bb + 1024 + colb + 4 * n); }
#pragma unroll
        for (int ai = 0; ai < 2; ++ai)
#pragma unroll
            for (int m = 0; m < 4; ++m) { const int rl = 128 * ai + 64 * wr + 16 * m + fr;
                if (FULL || rl < u.rows) { u32x2 pk2;
#pragma unroll
                    for (int n = 0; n < 2; ++n) {
                        const f32x4 gt = acc[ai][0][m][n] * (1.0f / GU_SCALE) + bg[n], up = acc[ai][1][m][n] * (1.0f / GU_SCALE) + bu[n]; f32x4 r;
#pragma unroll
                        for (int e = 0; e < 4; ++e) { const float g = fminf(gt[e], 7.0f), uu = __builtin_amdgcn_fmed3f(up[e], -7.0f, 7.0f); r[e] = (uu + 1.0f) * (g * __builtin_amdgcn_rcpf(1.0f + __builtin_amdgcn_exp2f((-1.702f * 1.4426950408889634f) * g))); }
                        int pk_ = __builtin_amdgcn_cvt_pk_fp8_f32(r[0], r[1], 0, false); pk_ = __builtin_amdgcn_cvt_pk_fp8_f32(r[2], r[3], pk_, true); pk2[n] = (unsigned)pk_; }
                    *(u32x2*)(ACT + (size_t)(u.rbase + rl) * 1024 + colb) = pk2;
                } }
    }
};
struct EpiDn {
    unsigned char* YS; const float* bdn; const float* TOPG;
    __device__ __forceinline__ void operator()(const f32x4 (&acc)[2][2][4][2], const Unit& u, int wr, int wc, int fr, int fq) const {
        if (u.rows == 256) body<true>(acc, u, wr, wc, fr, fq); else body<false>(acc, u, wr, wc, fr, fq); }
    template <bool FULL> __device__ __forceinline__ void body(const f32x4 (&acc)[2][2][4][2], const Unit& u, int wr, int wc, int fr, int fq) const {
        const float* bb = bdn + (size_t)u.e * 1024;
        f32x4 bv[2][2]; int slot[2][4]; float gt[2][4];
#pragma unroll
        for (int bj = 0; bj < 2; ++bj)
#pragma unroll
            for (int n = 0; n < 2; ++n) bv[bj][n] = *(const f32x4*)(bb + u.pn * 256 + 64 * wc + 16 * fq + 8 * bj + 4 * n);
#pragma unroll
        for (int ai = 0; ai < 2; ++ai)
#pragma unroll
            for (int m = 0; m < 4; ++m) { const int rl = 128 * ai + 64 * wr + 16 * m + fr; if (FULL) slot[ai][m] = u.list[rl]; else slot[ai][m] = (rl < u.rows) ? u.list[rl] : -1; }
#pragma unroll
        for (int ai = 0; ai < 2; ++ai)
#pragma unroll
            for (int m = 0; m < 4; ++m) { const float g_ = TOPG[slot[ai][m] >= 0 ? slot[ai][m] : 0]; gt[ai][m] = (slot[ai][m] >= 0) ? g_ * YS_SCALE : 0.f; }
#pragma unroll
        for (int ai = 0; ai < 2; ++ai)
#pragma unroll
            for (int m = 0; m < 4; ++m) {
                if (FULL || slot[ai][m] >= 0) {
                    u32x4 pk4;
#pragma unroll
                    for (int bj = 0; bj < 2; ++bj)
#pragma unroll
                        for (int n = 0; n < 2; ++n) {
                            const f32x4 yv = (acc[ai][bj][m][n] * (1.0f / DN_SCALE) + bv[bj][n]) * gt[ai][m];
                            int pk_ = __builtin_amdgcn_cvt_pk_fp8_f32(yv[0], yv[1], 0, false); pk_ = __builtin_amdgcn_cvt_pk_fp8_f32(yv[2], yv[3], pk_, true); pk4[2 * bj + n] = (unsigned)pk_; }
                    __builtin_nontemporal_store(pk4, (u32x4*)(YS + (size_t)slot[ai][m] * 1024 + u.pn * 256 + 64 * wc + 16 * fq));
                } }
    }
};

struct Args { const float* in[33]; float* out; unsigned char* ws; int ph_lo, ph_hi; };
enum { I_X = 0, I_LNG, I_LNB, I_MIX, I_WRKV, I_WO, I_W0, I_W1, I_W2, I_A0, I_A1, I_A2, I_G1, I_G2, I_KK, I_KA, I_RK, I_LNXG, I_LNXB, I_V0, I_V1, I_V2,
       I_KVW, I_DAQ, I_DAO, I_DALAM, I_DASUB, I_RW, I_RB, I_WGU, I_BGU, I_WDN, I_BDN };

typedef const float* cfptr;
#define KAS __attribute__((address_space(4)))
#define KA_DECL const KAS cfptr* kin = (const KAS cfptr*)__builtin_amdgcn_kernarg_segment_ptr(); asm volatile("" : "+s"(kin))
#define KA_RELOAD asm volatile("" : "+s"(kin))
#define PH_BEGIN KA_RELOAD; asm volatile("" : "+s"(wave), "+s"(G), "+s"(blk)); ws = KWS; ctl = (unsigned*)(ws + WS_CTL)
#define KIN(i) (kin[i])
#define KOUT ((float*)kin[33])
#define KWS ((unsigned char*)kin[34])
__global__ void __launch_bounds__(NTHR, 2) yoco_fwd(Args args) {
    extern __shared__ __attribute__((aligned(16))) unsigned char lds_raw[];
    LAS unsigned char* lds = (LAS unsigned char*)lds_raw;
    volatile LAS unsigned* MISC = (volatile LAS unsigned*)(lds + MISC_OFF);
    int wave = __builtin_amdgcn_readfirstlane((int)threadIdx.x >> 6);
    int G = gridDim.x, blk = blockIdx.x; int lane = 0;
#define gw (blk * NWAVES + wave)
#define NGW (G * NWAVES)
    KA_DECL;
    unsigned char* ws = KWS;
    unsigned* ctl = (unsigned*)(ws + WS_CTL);
    for (int u = wave * 64 + lane_id(); u < (LDS_BYTES - MISC_OFF) / 4; u += NTHR) ((LAS unsigned*)(lds + MISC_OFF))[u] = 0u;
    __syncthreads();
    XcdBarrier bar = xcd_barrier_post(ctl + CW_BAR, MISC + 8, wave);
#define GRID_BAR() xcd_barrier(bar, wave)

    {
        LAS float* scr = (LAS float*)(lds + wave * 16896);
        conv_batch(KIN(I_WRKV), 6, 1024, 1024, (h16*)(ws + WS_W_RKV), 1024, 1024, 3, scr, gw, NGW, lane);
        conv_batch(KIN(I_WO), 2, 1024, 1024, (h16*)(ws + WS_W_RO), 1024, 1024, 3, scr, gw, NGW, lane);
#pragma unroll
        for (int l = 0; l < 2; ++l) {
            conv_batch(KIN(I_W1) + (size_t)l * 1024 * 64, 1, 1024, 64, (h16*)(ws + WS_W_L1) + (size_t)(l * 4 + 0) * 256 * 1024, 1024, 256, 3, scr, gw, NGW, lane);
            conv_batch(KIN(I_A1) + (size_t)l * 1024 * 64, 1, 1024, 64, (h16*)(ws + WS_W_L1) + (size_t)(l * 4 + 1) * 256 * 1024, 1024, 256, 3, scr, gw, NGW, lane);
            conv_batch(KIN(I_G1) + (size_t)l * 1024 * 160, 1, 1024, 160, (h16*)(ws + WS_W_L1) + (size_t)(l * 4 + 2) * 256 * 1024, 1024, 256, 3, scr, gw, NGW, lane);
            conv_batch(KIN(I_W2) + (size_t)l * 64 * 1024, 1, 64, 1024, (h16*)(ws + WS_W_L2) + (size_t)(l * 4 + 0) * 256 * 1024, 256, 1024, 3, scr, gw, NGW, lane);
            conv_batch(KIN(I_A2) + (size_t)l * 64 * 1024, 1, 64, 1024, (h16*)(ws + WS_W_L2) + (size_t)(l * 4 + 1) * 256 * 1024, 256, 1024, 3, scr, gw, NGW, lane);
            conv_batch(KIN(I_G2) + (size_t)l * 160 * 1024, 1, 160, 1024, (h16*)(ws + WS_W_L2) + (size_t)(l * 4 + 2) * 256 * 1024, 256, 1024, 3, scr, gw, NGW, lane);
        }
        conv_batch(KIN(I_V1), 1, 1024, 32, (h16*)(ws + WS_W_L1) + (size_t)(4 + 3) * 256 * 1024, 1024, 256, 3, scr, gw, NGW, lane);
        conv_batch(KIN(I_V2), 1, 32, 1024, (h16*)(ws + WS_W_L2) + (size_t)(4 + 3) * 256 * 1024, 256, 1024, 3, scr, gw, NGW, lane);
        conv_batch(KIN(I_KVW), 1, 1024, 2048, (h16*)(ws + WS_W_KV), 1024, 2048, 3, scr, gw, NGW, lane);
        conv_batch(KIN(I_DAQ), 2, 1024, 1024, (h16*)(ws + WS_W_Q), 1024, 1024, 3, scr, gw, NGW, lane);
        conv_batch(KIN(I_DAO), 2, 1024, 1024, (h16*)(ws + WS_W_AO), 1024, 1024, 3, scr, gw, NGW, lane);
#pragma unroll
        for (int l4 = 0; l4 < 4; ++l4) { conv_batch(KIN(I_RW) + (size_t)l4 * D * NEXP, 1, 1024, 32, (h16*)(ws + WS_WR) + (size_t)(l4 * 2 + 0) * 32 * 1024, 1024, 32, 0, scr, gw, NGW, lane);
                                        conv_batch(KIN(I_RW) + (size_t)l4 * D * NEXP, 1, 1024, 32, (h16*)(ws + WS_WR) + (size_t)(l4 * 2 + 1) * 32 * 1024, 1024, 32, 2, scr, gw, NGW, lane); }
    }

#pragma unroll 1
    for (int l = 0; l < 4; ++l) {
        if (l < 2) {
            PH_BEGIN;
            if (l == 0) phase_prep<false>(KIN(I_X), KIN(I_MIX), (h16*)(ws + WS_XM), gw, NGW, lane);
            else phase_prep<true>(ws + WS_XH, KIN(I_MIX) + (size_t)l * 6 * D, (h16*)(ws + WS_XM), gw, NGW, lane);
            GRID_BAR();
            PH_BEGIN;
            {
                SchedRkv S{(const char*)(ws + WS_XM), (const char*)(ws + WS_W_RKV) + (size_t)l * 3 * 1024 * 2048, (const char*)(ws + WS_W_L1) + (size_t)l * 4 * 256 * 2048, l == 0 ? 15 : 16, G, blk};
                EpiRkv E{(h16*)(ws + WS_R), (h16*)(ws + WS_K), (h16*)(ws + (l == 0 ? WS_VF : WS_V)), (h16*)(ws + WS_L1O)};
                GEMM_PHASE(S, E, 1024);
            }
            GRID_BAR();
            PH_BEGIN;
            {
                const char* l1o = (const char*)(ws + WS_L1O); const char* wl2 = (const char*)(ws + WS_W_L2) + (size_t)l * 4 * 1024 * 512;
                { SchedL2 S{l1o, wl2, 0, G, blk}; EpiL2<0> E{(void*)(ws + WS_WD), nullptr, KIN(I_W0) + (size_t)l * D}; GEMM_PHASE(S, E, 256); }
                { SchedL2 S{l1o, wl2, 1, G, blk}; EpiL2<1> E{(void*)(ws + WS_AA), nullptr, KIN(I_A0) + (size_t)l * D}; GEMM_PHASE(S, E, 256); }
                { SchedL2 S{l1o, wl2, 2, G, blk}; EpiL2<2> E{(void*)(ws + WS_GG), nullptr, nullptr}; GEMM_PHASE(S, E, 256); }
                if (l == 1) { SchedL2 S{l1o, wl2, 3, G, blk}; EpiL2<3> E{(void*)(ws + WS_V), (const h16*)(ws + WS_VF), KIN(I_V0)}; GEMM_PHASE(S, E, 256); }
            }
            GRID_BAR();
            PH_BEGIN;
            {
                const float* wgu_ = KIN(I_WGU); const float* wdn_ = KIN(I_WDN); asm volatile("" : "+s"(wgu_), "+s"(wdn_));
                ScanArgs sa{(const h16*)(ws + WS_R), (const h16*)(ws + WS_K), (const h16*)(ws + (l == 0 ? WS_VF : WS_V)), (const h16*)(ws + WS_WD), (const h16*)(ws + WS_AA), (const h16*)(ws + WS_GG),
                            KIN(I_KK) + (size_t)l * D, KIN(I_KA) + (size_t)l * D, KIN(I_RK) + (size_t)l * D, KIN(I_LNXG) + (size_t)l * D, KIN(I_LNXB) + (size_t)l * D, (h16*)(ws + WS_YG), wgu_, wdn_, ws + WS_W_GU, ws + WS_W_DN, l};
                phase_scan_mm(sa, lds, blk, G, wave);
            }
            GRID_BAR();
            PH_BEGIN;
            {
                SchedPlain S{(const char*)(ws + WS_YG), (const char*)(ws + WS_W_RO) + (size_t)l * 1024 * 2048, 4, G, blk};
                if (l == 0) { EpiRes<false> E{KIN(I_X), (h16*)(ws + WS_H)}; GEMM_PHASE(S, E, 1024); }
                else { EpiRes<true> E{ws + WS_XH, (h16*)(ws + WS_H)}; GEMM_PHASE(S, E, 1024); }
            }
            GRID_BAR();
        } else {
            const int j = l - 2;
            PH_BEGIN;
            if (l == 2) {
                { SchedPlain S{(const char*)(ws + WS_XH), (const char*)(ws + WS_W_Q), 4, G, blk}; EpiQkv E{(h16*)(ws + WS_Q), nullptr, QSCALE}; GEMM_PHASE(S, E, 1024); }
                { SchedPlain S{(const char*)(ws + WS_XH), (const char*)(ws + WS_W_KV), 8, G, blk}; EpiQkv E{(h16*)(ws + WS_KK), (h16*)(ws + WS_VV), 1.0f}; GEMM_PHASE(S, E, 1024); }
            } else {
                SchedPlain S{(const char*)(ws + WS_XH), (const char*)(ws + WS_W_Q) + (size_t)j * 1024 * 2048, 4, G, blk}; EpiQkv E{(h16*)(ws + WS_Q), nullptr, QSCALE}; GEMM_PHASE(S, E, 1024);
            }
            GRID_BAR();
            PH_BEGIN;
            phase_attn((const h16*)(ws + WS_Q), (const h16*)(ws + WS_KK), (const h16*)(ws + WS_VV), (h16*)(ws + WS_ORAW), (char*)lds_raw, blk, G, wave);
            GRID_BAR();
            PH_BEGIN;
            phase_attn_combine((const h16*)(ws + WS_ORAW), KIN(I_DALAM) + (size_t)j * 256, KIN(I_DASUB) + (size_t)j * 128, 0.8f - 0.6f * expf(-0.3f * (float)l), (h16*)(ws + WS_OB), gw, NGW, lane);
            GRID_BAR();
            PH_BEGIN;
            {
                SchedPlain S{(const char*)(ws + WS_OB), (const char*)(ws + WS_W_AO) + (size_t)j * 1024 * 2048, 4, G, blk};
                EpiRes<true> E{ws + WS_XH, (h16*)(ws + WS_H)};
                GEMM_PHASE(S, E, 1024);
            }
            GRID_BAR();
        }
        PH_BEGIN;
        {
            RouterArgs ra{(const h16*)(ws + WS_H), KIN(I_LNG) + (size_t)(l * 2) * D, KIN(I_LNB) + (size_t)(l * 2) * D, (const h16*)(ws + WS_WR) + (size_t)l * 2 * 32 * 1024, KIN(I_RB) + (size_t)l * NEXP,
                          (h16*)(ws + WS_X1), (unsigned char*)(ws + WS_XB), (float*)(ws + WS_TOPG), (int*)(ws + WS_LIST), ctl + CW_CNT + l * 32};
            phase_ln_router(ra, lds, blk, G, wave);
        }
        GRID_BAR();
        PH_BEGIN;
        moe_tables(ctl + CW_CNT + l * 32, MISC, (LAS int*)(lds + TILE_E_OFF), wave);
        {
            SchedMoe S{(const LAS unsigned*)MISC, (const LAS int*)(lds + TILE_E_OFF), (const char*)(ws + WS_XB), (const char*)(ws + WS_W_GU) + (size_t)l * 32 * 2048 * 1024, (const int*)(ws + WS_LIST), 8, 1, G, blk, (size_t)2048 * 1024};
            EpiGu E{(unsigned char*)(ws + WS_ACT), KIN(I_BGU) + (size_t)l * 32 * 2048};
            GEMM_PHASE8(S, E, 1024);
        }
        GRID_BAR();
        PH_BEGIN;
        {
            SchedMoe S{(const LAS unsigned*)MISC, (const LAS int*)(lds + TILE_E_OFF), (const char*)(ws + WS_ACT), (const char*)(ws + WS_W_DN) + (size_t)l * 32 * 1024 * 1024, (const int*)(ws + WS_LIST), 4, 0, G, blk, (size_t)1024 * 1024};
            EpiDn E{(unsigned char*)(ws + WS_YS), KIN(I_BDN) + (size_t)l * 32 * 1024, (const float*)(ws + WS_TOPG)};
            GEMM_PHASE8(S, E, 1024);
        }
        GRID_BAR();
        PH_BEGIN;
        phase_combine((const h16*)(ws + WS_X1), (const unsigned char*)(ws + WS_YS), KIN(I_LNG) + (size_t)(l * 2 + 1) * D, KIN(I_LNB) + (size_t)(l * 2 + 1) * D,
                      l == 3 ? KOUT : (float*)nullptr, (h16*)(ws + WS_XH), gw, NGW, lane);
        if (l < 3) GRID_BAR();
    }
    if (xb_ld(ctl + CW_BAR + XB_TMO) != 0u && wave == 0 && lane_id() == 0) KOUT[(size_t)blk * D] = __builtin_nanf("");
}

extern "C" void kernel_launch(void* const* d_in, const int* in_sizes, int n_in, void* d_out, int out_size, void* d_ws, size_t ws_size, hipStream_t stream) {
    static int grid = 0;
    if (grid == 0) {
        if (n_in != 33 || out_size != T * D || ws_size < WS_END) { fprintf(stderr, "kernel_launch: unexpected shapes (n_in %d out %d ws %zu)\n", n_in, out_size, ws_size); grid = -1; return; }
        if (hipFuncSetAttribute((const void*)yoco_fwd, hipFuncAttributeMaxDynamicSharedMemorySize, LDS_BYTES) != hipSuccess) { fprintf(stderr, "kernel_launch: hipFuncSetAttribute failed\n"); grid = -1; return; }
        int dev = 0, cus = 0, per_cu = 0;
        hipGetDevice(&dev); hipDeviceGetAttribute(&cus, hipDeviceAttributeMultiprocessorCount, dev);
        hipOccupancyMaxActiveBlocksPerMultiprocessor(&per_cu, (const void*)yoco_fwd, NTHR, LDS_BYTES);
        (void)hipGetLastError();
        if (per_cu < 1) fprintf(stderr, "kernel_launch: occupancy query reports %d\n", per_cu);
        grid = cus < 256 ? cus : 256;
    }
    if (grid < 0) return;
    hipMemsetAsync((char*)d_ws + WS_CTL, 0, CTL_ZERO_BYTES, stream);
    Args a{};
    for (int i = 0; i < 33; ++i) a.in[i] = (const float*)d_in[i];
    a.out = (float*)d_out; a.ws = (unsigned char*)d_ws; a.ph_lo = 0; a.ph_hi = 0;
    hipLaunchKernelGGL(yoco_fwd, dim3(grid), dim3(NTHR), LDS_BYTES, stream, a);
}
```
